# Optimizing an MI355X kernel written in HIP

```python
import jax
import jax.numpy as jnp
from jax import lax
import numpy as np

D_MODEL = 1024
BATCH = 16
SEQ = 4096
DEPTH = 4

HEAD_DIM = 64
MIX_WIDTH = D_MODEL
RWKV_WIDTH = 3 * D_MODEL // 8
LRU_WIDTH = D_MODEL // 4
SBA_WIDTH = MIX_WIDTH - RWKV_WIDTH - LRU_WIDTH
RWKV_HEADS = RWKV_WIDTH // HEAD_DIM
LRU_BLOCKS = LRU_WIDTH // HEAD_DIM
SBA_HEADS = SBA_WIDTH // HEAD_DIM

DECAY_RANK = 64
ICLR_RANK = 64
GATE_RANK = 128
RWKV_GN_EPS = 64e-5

CONV_WIDTH = 4
LRU_C = 8.0

SBA_BLOCK = 128

RWKV_COLS = 3 * RWKV_WIDTH + DECAY_RANK + ICLR_RANK + GATE_RANK
LRU_COLS = 2 * LRU_WIDTH
SBA_COLS = 3 * SBA_WIDTH
IN_COLS = RWKV_COLS + LRU_COLS + SBA_COLS

N_EXPERTS = 16
N_GROUPS = 4
EXPERTS_PER_GROUP = N_EXPERTS // N_GROUPS
TOP_K = 2
D_EXPERT = 512
MOE_BLOCK = 256

ALPHA = (2.0 * DEPTH) ** 0.25
BETA = (8.0 * DEPTH) ** -0.25
LN_EPS = 1e-5
RMS_EPS = 1e-6

kernel_name = 'hymba_rwkv7_rglru_stickbreak_grouped_moe'


def layer_norm(x, g, b):
    xf = x.astype(jnp.float32)
    mu = jnp.mean(xf, -1, keepdims=True)
    var = jnp.mean(jnp.square(xf - mu), -1, keepdims=True)
    return ((xf - mu) * lax.rsqrt(var + LN_EPS) * g + b).astype(x.dtype)


def head_rms_norm(y, g, n_heads):
    bsz, seq, c = y.shape
    yh = y.reshape(bsz, seq, n_heads, c // n_heads)
    yh = yh * lax.rsqrt(jnp.mean(jnp.square(yh), -1, keepdims=True) + RMS_EPS)
    return yh.reshape(bsz, seq, c) * g


def token_shift(p, mu):
    prev = jnp.pad(p, ((0, 0), (1, 0), (0, 0)))[:, :-1]
    return p + mu * (prev - p)


def rwkv7_scan(r, w, k, v, kk, a):
    bsz, _, h, n = r.shape

    def step(state, inp):
        r_t, w_t, k_t, v_t, kk_t, a_t = inp
        sa = jnp.einsum('bhvk,bhk->bhv', state, -kk_t)
        state = (state * w_t[:, :, None, :]
                 + sa[..., None] * (kk_t * a_t)[:, :, None, :]
                 + v_t[..., None] * k_t[:, :, None, :])
        return state, jnp.einsum('bhvk,bhk->bhv', state, r_t)

    xs = tuple(jnp.moveaxis(t, 1, 0) for t in (r, w, k, v, kk, a))
    state0 = jnp.zeros((bsz, h, n, n), jnp.float32)
    _, o = lax.scan(step, state0, xs)
    return jnp.moveaxis(o, 0, 1)


def rwkv7_time_mix(p, w0, w_up, a0, a_up, g_up, k_k, k_a, r_k, ln_g, ln_b):
    bsz, seq, _ = p.shape
    c = RWKV_WIDTH
    r, k, v, dw, da, dg = jnp.split(
        p, [c, 2 * c, 3 * c, 3 * c + DECAY_RANK, 3 * c + DECAY_RANK + ICLR_RANK], axis=-1)
    w_log = -jax.nn.softplus(-(w0 + jnp.tanh(dw) @ w_up)) - 0.5
    decay = jnp.exp(-jnp.exp(w_log))
    a = jax.nn.sigmoid(a0 + da @ a_up)
    g = jax.nn.sigmoid(dg) @ g_up

    def heads(t):
        return t.reshape(bsz, seq, RWKV_HEADS, HEAD_DIM)

    kk = heads(k * k_k)
    kk = kk / jnp.maximum(jnp.sqrt(jnp.sum(kk * kk, -1, keepdims=True)), 1e-12)
    k = k * (1.0 + (a - 1.0) * k_a)
    rh, kh, vh = heads(r), heads(k), heads(v)
    o = rwkv7_scan(rh, heads(decay), kh, vh, kk, heads(a))
    mu = jnp.mean(o, -1, keepdims=True)
    var = jnp.mean(jnp.square(o - mu), -1, keepdims=True)
    o = ((o - mu) * lax.rsqrt(var + RWKV_GN_EPS)).reshape(bsz, seq, c) * ln_g + ln_b
    bonus = jnp.sum(rh * kh * r_k.reshape(RWKV_HEADS, HEAD_DIM), -1, keepdims=True) * vh
    return (o + bonus.reshape(bsz, seq, c)) * g


def rglru_mix(p, conv_w, conv_b, wa, ba, wx, bx, lam, norm_g):
    bsz, seq, _ = p.shape
    gate_in, xin = jnp.split(p, [LRU_WIDTH], axis=-1)
    xc = lax.conv_general_dilated(
        xin, conv_w.astype(jnp.float32)[:, None, :], window_strides=(1,),
        padding=((CONV_WIDTH - 1, 0),), dimension_numbers=('NWC', 'WIO', 'NWC'),
        feature_group_count=LRU_WIDTH) + conv_b
    xb = xc.reshape(bsz, seq, LRU_BLOCKS, HEAD_DIM)
    gate_a = jax.nn.sigmoid(jnp.einsum('bsgi,gij->bsgj', xb, wa).reshape(bsz, seq, LRU_WIDTH) + ba)
    gate_x = jax.nn.sigmoid(jnp.einsum('bsgi,gij->bsgj', xb, wx).reshape(bsz, seq, LRU_WIDTH) + bx)
    log_a = -LRU_C * gate_a * jax.nn.softplus(-lam)
    a = jnp.exp(log_a)
    b_in = jnp.sqrt(-jnp.expm1(2.0 * log_a)) * (gate_x * xc)

    def combine(left, right):
        a1, b1 = left
        a2, b2 = right
        return a1 * a2, a2 * b1 + b2

    _, h = lax.associative_scan(combine, (a, b_in), axis=1)
    y = jax.nn.gelu(gate_in) * h
    return head_rms_norm(y, norm_g, LRU_BLOCKS)


def stick_breaking_attention(p, norm_g):
    bsz, seq, _ = p.shape
    q, k, v = jnp.split(p, [SBA_WIDTH, 2 * SBA_WIDTH], axis=-1)

    def heads(t):
        return jnp.transpose(t.reshape(bsz, seq, SBA_HEADS, HEAD_DIM), (0, 2, 1, 3))

    q, k, v = heads(q), heads(k), heads(v)
    scale = HEAD_DIM ** -0.5
    outs = []
    for i in range(seq // SBA_BLOCK):
        q0 = i * SBA_BLOCK
        kv_len = q0 + SBA_BLOCK
        z = jnp.einsum('bhtd,bhsd->bhts', q[:, :, q0:kv_len], k[:, :, :kv_len]) * scale
        t_idx = q0 + jnp.arange(SBA_BLOCK)[:, None]
        s_idx = jnp.arange(kv_len)[None, :]
        mask = s_idx < t_idx
        log_keep = jnp.where(mask, jax.nn.log_sigmoid(-z), 0.0)
        after = lax.cumsum(log_keep, axis=3, reverse=True) - log_keep
        attn = jnp.where(mask, jnp.exp(jax.nn.log_sigmoid(z) + after), 0.0)
        outs.append(jnp.einsum('bhts,bhsd->bhtd', attn, v[:, :, :kv_len]))
    o = jnp.concatenate(outs, axis=2)
    o = jnp.transpose(o, (0, 2, 1, 3)).reshape(bsz, seq, SBA_WIDTH)
    return head_rms_norm(o, norm_g, SBA_HEADS)


def grouped_moe(x2d, router_w, router_b, w_gate, w_up, w_down):
    n_tok, d = x2d.shape
    scores = jax.nn.softmax(x2d.astype(jnp.float32) @ router_w.astype(jnp.float32) + router_b, axis=-1)
    grouped = scores.reshape(n_tok, N_GROUPS, EXPERTS_PER_GROUP)
    group_score = jnp.sum(lax.top_k(grouped, TOP_K)[0], -1)
    sel = jnp.argmax(group_score, -1).astype(jnp.int32)
    cand = jnp.take_along_axis(grouped, sel[:, None, None], axis=1)[:, 0]
    top_vals, top_idx = lax.top_k(cand, TOP_K)
    expert_ids = sel[:, None] * EXPERTS_PER_GROUP + top_idx.astype(jnp.int32)
    gates = top_vals / jnp.sum(top_vals, -1, keepdims=True)

    n_assign = n_tok * TOP_K
    flat_e = expert_ids.reshape(n_assign)
    flat_tok = jnp.repeat(jnp.arange(n_tok, dtype=jnp.int32), TOP_K)
    flat_g = gates.reshape(n_assign)
    order = jnp.argsort(flat_e)
    se = flat_e[order]
    counts = jnp.bincount(flat_e, length=N_EXPERTS)
    starts = jnp.cumsum(counts) - counts
    padded = (counts + MOE_BLOCK - 1) // MOE_BLOCK * MOE_BLOCK
    pad_ends = jnp.cumsum(padded)
    pad_starts = pad_ends - padded
    dest = pad_starts[se] + jnp.arange(n_assign, dtype=jnp.int32) - starts[se]
    cap = n_assign + N_EXPERTS * MOE_BLOCK
    n_blocks = cap // MOE_BLOCK
    buf_tok = jnp.zeros((cap,), jnp.int32).at[dest].set(flat_tok[order])
    buf_gate = jnp.zeros((cap,), jnp.float32).at[dest].set(flat_g[order])
    block_e = jnp.minimum(
        jnp.searchsorted(pad_ends, jnp.arange(n_blocks, dtype=jnp.int32) * MOE_BLOCK, side='right'),
        N_EXPERTS - 1)

    def expert_block(acc, blk):
        tok, e, g = blk
        xb = x2d[tok]
        h = jax.nn.silu(xb @ w_gate[e]) * (xb @ w_up[e])
        yb = (h @ w_down[e]) * g[:, None]
        return acc.at[tok].add(yb.astype(acc.dtype)), None

    acc, _ = lax.scan(expert_block, jnp.zeros_like(x2d),
                      (buf_tok.reshape(n_blocks, MOE_BLOCK), block_e,
                       buf_gate.reshape(n_blocks, MOE_BLOCK)))
    return acc


def setup_inputs(seed: int = 0) -> dict:
    key = jax.random.key(seed)
    ks = jax.random.split(key, 40)
    f32 = jnp.float32
    L = DEPTH

    def nrm(k, shape, scale):
        return jax.random.normal(k, shape, f32) * scale

    u = jax.random.uniform(ks[20], (L, LRU_WIDTH), f32, 0.9, 0.999)
    p_lam = u ** (1.0 / LRU_C)
    return {
        'x': nrm(ks[0], (BATCH, SEQ, D_MODEL), 1.0),
        'w_in': nrm(ks[1], (L, D_MODEL, IN_COLS), D_MODEL ** -0.5),
        'shift_mu': jax.random.uniform(ks[2], (L, RWKV_COLS), f32),
        'rwkv_w0': jax.random.uniform(ks[3], (L, RWKV_WIDTH), f32, -6.0, 1.0),
        'rwkv_w_up': nrm(ks[4], (L, DECAY_RANK, RWKV_WIDTH), 0.5 * DECAY_RANK ** -0.5),
        'rwkv_a0': nrm(ks[5], (L, RWKV_WIDTH), 0.5),
        'rwkv_a_up': nrm(ks[6], (L, ICLR_RANK, RWKV_WIDTH), 0.5 * ICLR_RANK ** -0.5),
        'rwkv_g_up': nrm(ks[7], (L, GATE_RANK, RWKV_WIDTH), GATE_RANK ** -0.5),
        'rwkv_k_k': 0.85 + nrm(ks[8], (L, RWKV_WIDTH), 0.02),
        'rwkv_k_a': 1.0 + nrm(ks[9], (L, RWKV_WIDTH), 0.02),
        'rwkv_r_k': nrm(ks[10], (L, RWKV_WIDTH), 0.1),
        'rwkv_ln_g': 1.0 + nrm(ks[11], (L, RWKV_WIDTH), 0.02),
        'rwkv_ln_b': nrm(ks[12], (L, RWKV_WIDTH), 0.02),
        'lru_conv_w': nrm(ks[13], (L, CONV_WIDTH, LRU_WIDTH), CONV_WIDTH ** -0.5),
        'lru_conv_b': nrm(ks[14], (L, LRU_WIDTH), 0.02),
        'lru_wa': nrm(ks[15], (L, LRU_BLOCKS, HEAD_DIM, HEAD_DIM), HEAD_DIM ** -0.5),
        'lru_ba': nrm(ks[16], (L, LRU_WIDTH), 0.02),
        'lru_wx': nrm(ks[17], (L, LRU_BLOCKS, HEAD_DIM, HEAD_DIM), HEAD_DIM ** -0.5),
        'lru_bx': nrm(ks[18], (L, LRU_WIDTH), 0.02),
        'lru_lambda': jnp.log(p_lam) - jnp.log1p(-p_lam),
        'lru_norm_g': 1.0 + nrm(ks[19], (L, LRU_WIDTH), 0.02),
        'sba_norm_g': 1.0 + nrm(ks[21], (L, SBA_WIDTH), 0.02),
        'w_out': nrm(ks[22], (L, MIX_WIDTH, D_MODEL), MIX_WIDTH ** -0.5 * BETA),
        'ln1_g': 1.0 + nrm(ks[23], (L, D_MODEL), 0.02),
        'ln1_b': nrm(ks[24], (L, D_MODEL), 0.02),
        'ln2_g': 1.0 + nrm(ks[25], (L, D_MODEL), 0.02),
        'ln2_b': nrm(ks[26], (L, D_MODEL), 0.02),
        'router_w': nrm(ks[27], (D_MODEL, N_EXPERTS), D_MODEL ** -0.5),
        'router_b': nrm(ks[28], (N_EXPERTS,), 0.01),
        'exp_w_gate': nrm(ks[29], (L, N_EXPERTS, D_MODEL, D_EXPERT), D_MODEL ** -0.5),
        'exp_w_up': nrm(ks[30], (L, N_EXPERTS, D_MODEL, D_EXPERT), D_MODEL ** -0.5),
        'exp_w_down': nrm(ks[31], (L, N_EXPERTS, D_EXPERT, D_MODEL), D_EXPERT ** -0.5 * BETA),
    }


def reference(x, w_in, shift_mu, rwkv_w0, rwkv_w_up, rwkv_a0, rwkv_a_up, rwkv_g_up,
              rwkv_k_k, rwkv_k_a, rwkv_r_k, rwkv_ln_g, rwkv_ln_b, lru_conv_w, lru_conv_b,
              lru_wa, lru_ba, lru_wx, lru_bx, lru_lambda, lru_norm_g, sba_norm_g, w_out,
              ln1_g, ln1_b, ln2_g, ln2_b, router_w, router_b, exp_w_gate, exp_w_up,
              exp_w_down):
    bsz, seq, d = x.shape
    f32 = jnp.float32
    for l in range(DEPTH):
        p = x @ w_in[l]
        p_rwkv = token_shift(p[..., :RWKV_COLS].astype(f32), shift_mu[l])
        y_rwkv = rwkv7_time_mix(p_rwkv, rwkv_w0[l], rwkv_w_up[l], rwkv_a0[l], rwkv_a_up[l],
                                rwkv_g_up[l], rwkv_k_k[l], rwkv_k_a[l], rwkv_r_k[l],
                                rwkv_ln_g[l], rwkv_ln_b[l])
        y_lru = rglru_mix(p[..., RWKV_COLS:RWKV_COLS + LRU_COLS].astype(f32), lru_conv_w[l],
                          lru_conv_b[l], lru_wa[l], lru_ba[l], lru_wx[l], lru_bx[l],
                          lru_lambda[l], lru_norm_g[l])
        y_sba = stick_breaking_attention(p[..., RWKV_COLS + LRU_COLS:].astype(f32), sba_norm_g[l])
        mix = jnp.concatenate([y_rwkv, y_lru, y_sba], axis=-1).astype(x.dtype) @ w_out[l]
        x = layer_norm(ALPHA * x + mix, ln1_g[l], ln1_b[l])
        moe = grouped_moe(x.reshape(bsz * seq, d), router_w, router_b, exp_w_gate[l],
                          exp_w_up[l], exp_w_down[l]).reshape(bsz, seq, d)
        x = layer_norm(ALPHA * x + moe, ln2_g[l], ln2_b[l])
    return x
```

```cpp
#include <hip/hip_runtime.h>
#include <cstdio>
#include <cstdint>

#ifndef MK_ONE_LAUNCH
#define MK_ONE_LAUNCH 0
#endif

#define LAS __attribute__((address_space(3)))
#define GAS __attribute__((address_space(1)))
typedef unsigned short bf16;
typedef short bf16x8 __attribute__((ext_vector_type(8)));
typedef short s16x4 __attribute__((ext_vector_type(4)));
typedef float f32x4 __attribute__((ext_vector_type(4)));
typedef float f32x2 __attribute__((ext_vector_type(2)));
typedef float f32x16 __attribute__((ext_vector_type(16)));
typedef unsigned u32x4 __attribute__((ext_vector_type(4)));
typedef unsigned u32x2 __attribute__((ext_vector_type(2)));
typedef __bf16 bf16x2_t __attribute__((ext_vector_type(2)));

constexpr int D = 1024, BATCH = 16, SEQ = 4096, DEPTH = 4, M = BATCH * SEQ;
constexpr int HD = 64, RW = 384, LW = 256, SW = 384, RH = 6, LB = 4, SH = 6;
constexpr int RCOLS = 1408, INC = 3072;
constexpr int PC_R = 0, PC_K = 384, PC_V = 768, PC_DW = 1152, PC_DA = 1216, PC_DG = 1280;
constexpr int PC_LG = 1408, PC_LX = 1664, PC_SQ = 1920, PC_SK = 2304, PC_SV = 2688;
constexpr int MIX_R = 0, MIX_L = 384, MIX_S = 640;
constexpr int NE = 16, DE = 512, LCAP = 2 * M;
constexpr float ALPHA = 1.6817928305074290f;
constexpr float LN_EPS = 1e-5f, RMS_EPS = 1e-6f, GN_EPS = 64e-5f;
constexpr float C2 = 0.125f * 1.4426950408889634f;

constexpr size_t MiB = 1u << 20;
constexpr size_t WS_CTL = 0, CTL_BYTES = 1 * MiB;
constexpr size_t WS_WIN = 1 * MiB;
constexpr size_t WS_WOUT = 7 * MiB;
constexpr size_t WS_WGU = 9 * MiB;
constexpr size_t WS_WDN = 41 * MiB;
constexpr size_t WS_WSM = 57 * MiB;
constexpr size_t WS_LIST = 58 * MiB;
constexpr size_t WS_GATE = 66 * MiB;
constexpr size_t WS_XB = 68 * MiB;
constexpr size_t WS_X1 = 196 * MiB;
constexpr size_t WS_P = 324 * MiB;
constexpr size_t WS_MIX = 708 * MiB;
constexpr size_t WS_H = 324 * MiB;
constexpr size_t WS_YM = 460 * MiB;
constexpr size_t WS_END = 836 * MiB;
static_assert(WS_H + (size_t)(2 * M + NE * 256) * DE * 2 <= WS_YM && WS_YM + (size_t)2 * M * D * 2 <= WS_END, "ws map");

constexpr int CW_BAR = 0;
constexpr int CW_CNT = 8192;
constexpr int CW_Q = 8192 + 1024;

constexpr int NTHR = 512, NWAVES = 8;
constexpr int LDS_BYTES = 139264;
constexpr int GEMM_LDS = 131072;
constexpr int MISC_OFF = GEMM_LDS;

__device__ __forceinline__ float bf2f(unsigned short b) { return __uint_as_float((unsigned)b << 16); }
__device__ __forceinline__ unsigned pk2(float lo, float hi) { f32x2 v = {lo, hi}; bf16x2_t b = __builtin_convertvector(v, bf16x2_t); return __builtin_bit_cast(unsigned, b); }
__device__ __forceinline__ float lo16(unsigned u) { return __uint_as_float(u << 16); }
__device__ __forceinline__ float hi16(unsigned u) { return __uint_as_float(u & 0xffff0000u); }
#define DPP(v, ctrl) __builtin_bit_cast(float, __builtin_amdgcn_update_dpp(__builtin_bit_cast(int, v), __builtin_bit_cast(int, v), (ctrl), 0xF, 0xF, false))
__device__ __forceinline__ float red8(float v) { v += DPP(v, 0xB1); v += DPP(v, 0x4E); v += DPP(v, 0x141); return v; }
__device__ __forceinline__ float red16(float v) { v = red8(v); v += DPP(v, 0x140); return v; }
__device__ __forceinline__ float red64(float v) { v = red16(v); v += __shfl_xor(v, 16); v += __shfl_xor(v, 32); return v; }
__device__ __forceinline__ float sigmoidf_(float x) { return __builtin_amdgcn_rcpf(1.0f + __expf(-x)); }
__device__ __forceinline__ float softplusf_(float x) { return x > 20.f ? x : log1pf(__expf(x)); }

#define XB_TMO      128
#define XB_XCNT(j)  (256  + 64 * (j))
#define XB_XSUB(j)  (1280 + 64 * (j))
#define XB_XGEN(j)  (2304 + 64 * (j))
#define XB_TOP      3328
#define XB_TOPGEN   3392
#define XCD_BAR_WORDS 3456
#define XB_SPIN_CAP (1u << 22)
__device__ __forceinline__ unsigned xb_ld(unsigned* p)              { return __hip_atomic_load(p, __ATOMIC_RELAXED, __HIP_MEMORY_SCOPE_AGENT); }
__device__ __forceinline__ unsigned xb_add(unsigned* p, unsigned v) { return __hip_atomic_fetch_add(p, v, __ATOMIC_RELAXED, __HIP_MEMORY_SCOPE_AGENT); }
__device__ __forceinline__ unsigned xb_xcc_id() { return (unsigned)__builtin_amdgcn_s_getreg((3 << 11) | 20) & 0xFu; }
#define XB_SPIN(cond, bar) do { unsigned _sp = 0; while (cond) { __builtin_amdgcn_s_sleep(1); \
    if ((++_sp & 255u) == 0u) { if (xb_ld(&(bar)[XB_TMO])) break; if (_sp > XB_SPIN_CAP) { atomicAdd(&(bar)[XB_TMO], 1u); break; } } } } while (0)
struct XcdBarrier { unsigned* bar; unsigned x; volatile LAS unsigned* st; };
__device__ __forceinline__ XcdBarrier xcd_barrier_post(const int tid, unsigned* bar, volatile LAS unsigned* st) {
    XcdBarrier b; b.bar = bar; b.x = xb_xcc_id(); b.st = st;
    if (tid == 0) (void)xb_add(&bar[XB_XCNT(b.x)], 1u);
    return b;
}
__device__ __forceinline__ void xcd_barrier_complete(unsigned* bar, unsigned x, unsigned& nloc, unsigned& nx) {
    const unsigned G = gridDim.x * gridDim.y * gridDim.z;
    unsigned sum, cnt, mine, sp = 0u;
    for (;;) {
        sum = 0u; cnt = 0u; mine = 0u;
#pragma unroll
        for (unsigned j = 0; j < 16; ++j) { const unsigned c = xb_ld(&bar[XB_XCNT(j)]); sum += c; cnt += (c > 0u) ? 1u : 0u; mine = (j == x) ? c : mine; }
        if (sum == G) break;
        __builtin_amdgcn_s_sleep(1);
        if ((++sp & 255u) == 0u) { if (xb_ld(&bar[XB_TMO])) break; if (sp > XB_SPIN_CAP) { atomicAdd(&bar[XB_TMO], 1u); break; } }
    }
    nloc = mine > 0u ? mine : 1u; nx = cnt > 0u ? cnt : 1u;
}
__device__ __forceinline__ void xcd_barrier(const int tid, const XcdBarrier& b) {
    asm volatile("s_waitcnt vmcnt(0)" ::: "memory");
    __syncthreads();
    if (tid == 0) {
        unsigned* bar = b.bar;
        __builtin_amdgcn_s_waitcnt(0);
        unsigned nloc = b.st[0], nx = b.st[1];
        if (nloc == 0u) { xcd_barrier_complete(bar, b.x, nloc, nx); b.st[0] = nloc; b.st[1] = nx; }
        const unsigned old = xb_add(&bar[XB_XSUB(b.x)], 1u);
        const unsigned gen = old / nloc;
        if (old + 1u == (gen + 1u) * nloc) {
            __builtin_amdgcn_fence(__ATOMIC_RELEASE, "agent");
            asm volatile("s_waitcnt vmcnt(0)" ::: "memory");
            const unsigned og = xb_add(&bar[XB_TOP], 1u);
            const unsigned tg = og / nx;
            if (og + 1u == (tg + 1u) * nx) xb_add(&bar[XB_TOPGEN], 1u);
            else XB_SPIN(xb_ld(&bar[XB_TOPGEN]) == tg, bar);
            __builtin_amdgcn_fence(__ATOMIC_ACQUIRE, "agent");
            xb_add(&bar[XB_XGEN(b.x)], 1u);
            asm volatile("s_waitcnt vmcnt(0)" ::: "memory");
        } else {
            XB_SPIN(xb_ld(&bar[XB_XGEN(b.x)]) == gen, bar);
            __builtin_amdgcn_fence(__ATOMIC_ACQUIRE, "agent");
            asm volatile("s_waitcnt vmcnt(0)" ::: "memory");
        }
    }
    __syncthreads();
}

namespace pg8 {
constexpr int BM = 256, BK = 64, HALF = 128, HTB = HALF * BK * 2, STAGE_BYTES = 8 * HTB;
__host__ __device__ __forceinline__ int lds_byte(int r, int c) { const int st = (r >> 4) * 2 + (c >> 5), rr = r & 15, cc = c & 31, ob = rr * 64 + cc * 2; return st * 1024 + (ob ^ (((ob >> 9) & 1) << 5)); }
__host__ __device__ __forceinline__ void stage_rc(int b, int& R, int& C) { const int st = b / 1024, sb = b % 1024, swz = sb ^ (((sb >> 9) & 1) << 5); R = (st >> 1) * 16 + swz / 64; C = (st & 1) * 32 + (swz % 64) / 2; }
__host__ __device__ __forceinline__ int perm32(int rho) { const int n = rho >> 4, i = rho & 15; return 8 * (i >> 2) + 4 * n + (i & 3); }

struct Unit { int pm, pn, e, j; };
template <class Epi, class Sched, bool ALIGN_EPI>
__device__ __forceinline__ void gemm_phase(const int tid, LAS unsigned char* lds, const char* Abase, const int K, const Sched& S, const Epi& E) {
    const int wid = __builtin_amdgcn_readfirstlane(tid >> 6), lane = tid & 63, wr = wid >> 2, wc = wid & 3, fr = lane & 15, fq = lane >> 4;
    const int nt = K / BK;
    int R0, C0; stage_rc(tid * 16, R0, C0);
    const int Rb0 = (R0 & ~31) + perm32(R0 & 31);
    unsigned voffB[2]; voffB[0] = (unsigned)(Rb0 * K + C0) * 2u; voffB[1] = (unsigned)((Rb0 + 64) * K + C0) * 2u;
    unsigned voffA[2]; voffA[0] = (unsigned)(R0 * K + C0) * 2u; voffA[1] = (unsigned)((R0 + 64) * K + C0) * 2u;
    const unsigned colA = (unsigned)C0 * 2u;
    const size_t kstep = (size_t)(BK * 2);
    const size_t hstepB = (size_t)HALF * K * 2, hstepA = hstepB;
    const unsigned ldsw = (unsigned)wid * 1024u;
    const int aoff = lds_byte(wr * 64 + fr, fq * 8), boff = lds_byte(wc * 32 + fr, fq * 8);
#define PG8_SA(b, h) (((b) * 2 + (h)) * HTB)
#define PG8_SB(b, h) ((4 + (b) * 2 + (h)) * HTB)
#define PG8_STAGE_B(bufoff, gbase) do { _Pragma("unroll") for (int _i = 0; _i < 2; ++_i) \
        __builtin_amdgcn_global_load_lds((const unsigned*)((const char*)(gbase) + voffB[_i]), (LAS unsigned*)(lds + (bufoff) + ldsw + _i * 8192), 16, 0, 0); } while (0)
#define PG8_STAGE_A(bufoff, h, kbyte, nx) do { \
        if constexpr (Sched::GATHER) { _Pragma("unroll") for (int _i = 0; _i < 2; ++_i) { const unsigned _o = (nx) ? na[h][_i] : ca[h][_i]; \
            __builtin_amdgcn_global_load_lds((const unsigned*)(Abase + (kbyte) + _o), (LAS unsigned*)(lds + (bufoff) + ldsw + _i * 8192), 16, 0, 0); } } \
        else { const char* _p = ((nx) ? nA : cA) + (kbyte) + (size_t)(h) * hstepA; _Pragma("unroll") for (int _i = 0; _i < 2; ++_i) \
            __builtin_amdgcn_global_load_lds((const unsigned*)(_p + voffA[_i]), (LAS unsigned*)(lds + (bufoff) + ldsw + _i * 8192), 16, 0, 0); } } while (0)
#define PG8_LDA(dst, b, h) do { _Pragma("unroll") for (int m = 0; m < 4; ++m) _Pragma("unroll") for (int k = 0; k < 2; ++k) dst[m][k] = *(const LAS bf16x8*)(lds + PG8_SA(b, h) + aoff + m * 2048 + k * 1024); } while (0)
#define PG8_LDB(dst, b, h) do { _Pragma("unroll") for (int n = 0; n < 2; ++n) _Pragma("unroll") for (int k = 0; k < 2; ++k) dst[n][k] = *(const LAS bf16x8*)(lds + PG8_SB(b, h) + boff + n * 2048 + k * 1024); } while (0)
#define PG8_MMA(ai, bj, At, Bt) do { __builtin_amdgcn_s_setprio(1); _Pragma("unroll") for (int m = 0; m < 4; ++m) _Pragma("unroll") for (int n = 0; n < 2; ++n) _Pragma("unroll") for (int k = 0; k < 2; ++k) \
        acc[ai][bj][m][n] = __builtin_amdgcn_mfma_f32_16x16x32_bf16(Bt[n][k], At[m][k], acc[ai][bj][m][n], 0, 0, 0); __builtin_amdgcn_s_setprio(0); } while (0)
#define PG8_WAIT_V(n) asm volatile("s_waitcnt vmcnt(" #n ")" ::: "memory")
#define PG8_WAIT_L(n) asm volatile("s_waitcnt lgkmcnt(" #n ")" ::: "memory")
#define PG8_BAR __builtin_amdgcn_s_barrier()
#define PG8_SCHED __builtin_amdgcn_sched_barrier(0)
    Unit cur, nxt; int ui = 0;
    if (!S.next(0, cur)) return;
    unsigned ca[2][2], na[2][2];
    const char* cA = Abase; const char* nA = Abase;
    if constexpr (Sched::GATHER) S.aoffs(cur, R0, colA, ca); else cA = Abase + (size_t)S.arow0(cur) * K * 2;
    f32x4 acc[2][2][4][2];
#pragma unroll
    for (int a = 0; a < 2; ++a)
#pragma unroll
        for (int b = 0; b < 2; ++b)
#pragma unroll
            for (int m = 0; m < 4; ++m)
#pragma unroll
                for (int n = 0; n < 2; ++n) acc[a][b][m][n] = (f32x4){0.f, 0.f, 0.f, 0.f};
    bf16x8 At[4][2], B0[2][2], B1[2][2];
    const char* cB = S.bbase(cur);
    PG8_STAGE_B(PG8_SB(0, 0), cB); PG8_STAGE_B(PG8_SB(0, 1), cB + hstepB); PG8_STAGE_A(PG8_SA(0, 0), 0, 0, false); PG8_STAGE_A(PG8_SA(0, 1), 1, 0, false);
    if (wr == 1) PG8_BAR;
    PG8_WAIT_V(2); PG8_BAR;
    PG8_STAGE_B(PG8_SB(1, 0), cB + kstep); PG8_STAGE_A(PG8_SA(1, 0), 0, kstep, false); PG8_STAGE_B(PG8_SB(1, 1), cB + hstepB + kstep);
    PG8_WAIT_V(6); PG8_BAR;
    for (;;) {
        const bool has_next = S.next(ui + 1, nxt);
        const char* nB = cB;
        nA = cA;
        if (has_next) { nB = S.bbase(nxt); if constexpr (Sched::GATHER) S.aoffs(nxt, R0, colA, na); else nA = Abase + (size_t)S.arow0(nxt) * K * 2; }
        else if constexpr (Sched::GATHER) { na[0][0] = ca[0][0]; na[0][1] = ca[0][1]; na[1][0] = ca[1][0]; na[1][1] = ca[1][1]; }
        for (int t = 0; t < nt; t += 2) {
            const bool last = (t == nt - 2);
            const size_t k1 = (size_t)(t + 1) * kstep;
            const size_t k2 = last ? 0 : (size_t)(t + 2) * kstep, k3 = k2 + kstep;
            const char* b2 = last ? nB : cB + (size_t)(t + 2) * kstep; const char* b3 = b2 + kstep;
            PG8_LDB(B0, 0, 0); PG8_LDB(B1, 0, 1); PG8_SCHED; PG8_LDA(At, 0, 0); PG8_STAGE_A(PG8_SA(1, 1), 1, k1, false);
            PG8_WAIT_V(8); PG8_WAIT_L(0); PG8_BAR; PG8_MMA(0, 0, At, B0); PG8_MMA(0, 1, At, B1); PG8_BAR; PG8_SCHED;
            PG8_LDA(At, 0, 1); PG8_STAGE_B(PG8_SB(0, 0), b2); PG8_STAGE_B(PG8_SB(0, 1), b2 + hstepB); PG8_STAGE_A(PG8_SA(0, 0), 0, k2, last);
            PG8_WAIT_V(8); PG8_WAIT_L(0); PG8_BAR; PG8_MMA(1, 0, At, B0); PG8_MMA(1, 1, At, B1); PG8_BAR; PG8_SCHED;
            PG8_LDB(B0, 1, 0); PG8_LDB(B1, 1, 1); PG8_SCHED; PG8_LDA(At, 1, 0); PG8_STAGE_A(PG8_SA(0, 1), 1, k2, last);
            PG8_WAIT_V(8); PG8_WAIT_L(0); PG8_BAR; PG8_MMA(0, 0, At, B0); PG8_MMA(0, 1, At, B1); PG8_BAR; PG8_SCHED;
            PG8_LDA(At, 1, 1); PG8_STAGE_B(PG8_SB(1, 0), b3); PG8_STAGE_B(PG8_SB(1, 1), b3 + hstepB); PG8_STAGE_A(PG8_SA(1, 0), 0, k3, last);
            PG8_WAIT_V(8); PG8_WAIT_L(0); PG8_BAR; PG8_MMA(1, 0, At, B0); PG8_MMA(1, 1, At, B1); PG8_BAR; PG8_SCHED;
        }
        if constexpr (ALIGN_EPI) { if (wr == 0) PG8_BAR; }
        E(acc, cur, wr, wc, fr, fq);
        if (!has_next) break;
#pragma unroll
        for (int a = 0; a < 2; ++a)
#pragma unroll
            for (int b = 0; b < 2; ++b)
#pragma unroll
                for (int m = 0; m < 4; ++m)
#pragma unroll
                    for (int n = 0; n < 2; ++n) acc[a][b][m][n] = (f32x4){0.f, 0.f, 0.f, 0.f};
        cur = nxt; cB = nB; cA = nA; ++ui;
        if constexpr (Sched::GATHER) { ca[0][0] = na[0][0]; ca[0][1] = na[0][1]; ca[1][0] = na[1][0]; ca[1][1] = na[1][1]; }
        if constexpr (ALIGN_EPI) { if (wr == 1) PG8_BAR; }
    }
    PG8_WAIT_V(0);
    if constexpr (!ALIGN_EPI) { if (wr == 0) PG8_BAR; }
    PG8_BAR;
#undef PG8_SA
#undef PG8_SB
#undef PG8_STAGE_A
#undef PG8_STAGE_B
#undef PG8_LDA
#undef PG8_LDB
#undef PG8_MMA
#undef PG8_WAIT_V
#undef PG8_WAIT_L
#undef PG8_BAR
#undef PG8_SCHED
}

struct DenseOrder {
    static constexpr bool GATHER = false;
    int nM, nN, nwg, G, c, K; const char* Bt;
    __device__ __forceinline__ int arow0(const Unit& u) const { return u.pm * BM; }
    __device__ __forceinline__ void init(int M_, int N_, int K_, int G_, int c_, const void* Bt_) { nM = M_ / BM; nN = N_ / BM; nwg = nM * nN; G = G_; c = c_; K = K_; Bt = (const char*)Bt_; }
    __device__ __forceinline__ bool next(int i, Unit& u) const {
        const long L = (long)i * G + c; if (L >= nwg) return false;
        int wgid = (int)L; { const int q = nwg / 8, r = nwg % 8, xcd = wgid % 8, off = wgid / 8; wgid = (xcd < r ? xcd * (q + 1) : r * (q + 1) + (xcd - r) * q) + off; }
        const int nig = 8 * nN, gid = wgid / nig, fm = gid * 8, gsz = (nM - fm) < 8 ? (nM - fm) : 8;
        u.pm = fm + ((wgid % nig) % gsz); u.pn = (wgid % nig) / gsz; u.e = 0; u.j = 0; return true;
    }
    __device__ __forceinline__ void aoffs(const Unit& u, int R0, unsigned colA, unsigned (&o)[2][2]) const {
#pragma unroll
        for (int h = 0; h < 2; ++h)
#pragma unroll
            for (int i = 0; i < 2; ++i) o[h][i] = (unsigned)(u.pm * BM + h * HALF + R0 + 64 * i) * (unsigned)(K * 2) + colA;
    }
    __device__ __forceinline__ const char* bbase(const Unit& u) const { return Bt + (size_t)u.pn * BM * K * 2; }
};
template <bool GATHER_>
struct MoeOrder {
    static constexpr bool GATHER = GATHER_;
    __device__ __forceinline__ int arow0(const Unit& u) const { return u.pm * BM; }
    const LAS int* tab;
    int G, c, K, nN; const char* Bt; size_t estride;
    const int* list;
    __device__ __forceinline__ bool next(int i, Unit& u) const {
        const int L = i * G + c; const int nb = tab[16];
        if (L >= nb * nN) return false;
        const int rb = L / nN; u.pn = L % nN; u.pm = rb;
        int e = 0;
#pragma unroll
        for (int k = 1; k < 16; ++k) e += (rb >= tab[k]) ? 1 : 0;
        u.e = e; u.j = rb - tab[e]; return true;
    }
    __device__ __forceinline__ void aoffs(const Unit& u, int R0, unsigned colA, unsigned (&o)[2][2]) const {
        const int cnt = tab[32 + u.e];
#pragma unroll
        for (int h = 0; h < 2; ++h)
#pragma unroll
            for (int i = 0; i < 2; ++i) {
                const int r = h * HALF + R0 + 64 * i;
                const int pos = u.j * BM + r; const unsigned row = (pos < cnt) ? (unsigned)(list[(size_t)u.e * LCAP + pos] >> 1) : 0u;
                o[h][i] = row * (unsigned)(K * 2) + colA;
            }
    }
    __device__ __forceinline__ const char* bbase(const Unit& u) const { return Bt + (size_t)u.e * estride + (size_t)u.pn * BM * K * 2; }
};

__device__ __forceinline__ u32x4 pack8(const f32x4 v0, const f32x4 v1) { u32x4 w; w.x = pk2(v0[0], v0[1]); w.y = pk2(v0[2], v0[3]); w.z = pk2(v1[0], v1[1]); w.w = pk2(v1[2], v1[3]); return w; }
struct EpiIn {
    bf16* O;
    __device__ __forceinline__ void operator()(const f32x4 (&acc)[2][2][4][2], const Unit& u, int wr, int wc, int fr, int fq) const {
        const int row0 = u.pm * BM + wr * 64 + fr, col0 = u.pn * BM + wc * 32 + 8 * fq;
#pragma unroll
        for (int ai = 0; ai < 2; ++ai)
#pragma unroll
            for (int m = 0; m < 4; ++m) { bf16* rowp = O + (size_t)(row0 + ai * HALF + m * 16) * INC + col0;
#pragma unroll
                for (int bj = 0; bj < 2; ++bj) { const int c = col0 + bj * HALF; const float sc = (c >= PC_SQ && c < PC_SK) ? C2 : 1.0f;
                    *(u32x4*)(rowp + bj * HALF) = pack8(acc[ai][bj][m][0] * sc, acc[ai][bj][m][1] * sc); } }
    }
};
struct EpiOut {
    const bf16* X; bf16* O;
    __device__ __forceinline__ void operator()(const f32x4 (&acc)[2][2][4][2], const Unit& u, int wr, int wc, int fr, int fq) const {
        const int row0 = u.pm * BM + wr * 64 + fr, col0 = u.pn * BM + wc * 32 + 8 * fq;
#pragma unroll
        for (int ai = 0; ai < 2; ++ai)
#pragma unroll
            for (int m = 0; m < 4; ++m) { const size_t off = (size_t)(row0 + ai * HALF + m * 16) * D + col0;
#pragma unroll
                for (int bj = 0; bj < 2; ++bj) { const u32x4 xv = *(const u32x4*)(X + off + bj * HALF);
                    f32x4 v0 = acc[ai][bj][m][0], v1 = acc[ai][bj][m][1];
                    v0[0] += ALPHA * lo16(xv.x); v0[1] += ALPHA * hi16(xv.x); v0[2] += ALPHA * lo16(xv.y); v0[3] += ALPHA * hi16(xv.y);
                    v1[0] += ALPHA * lo16(xv.z); v1[1] += ALPHA * hi16(xv.z); v1[2] += ALPHA * lo16(xv.w); v1[3] += ALPHA * hi16(xv.w);
                    *(u32x4*)(O + off + bj * HALF) = pack8(v0, v1); } }
    }
};
struct EpiMoe1 {
    bf16* Hb;
    __device__ __forceinline__ void operator()(const f32x4 (&acc)[2][2][4][2], const Unit& u, int wr, int wc, int fr, int fq) const {
        const int row0 = u.pm * BM + wr * 64 + fr, col0 = u.pn * HALF + wc * 32 + 8 * fq;
#pragma unroll
        for (int ai = 0; ai < 2; ++ai)
#pragma unroll
            for (int m = 0; m < 4; ++m) {
                f32x4 g0 = acc[ai][0][m][0], g1 = acc[ai][0][m][1]; const f32x4 u0 = acc[ai][1][m][0], u1 = acc[ai][1][m][1];
#pragma unroll
                for (int q = 0; q < 4; ++q) { g0[q] = g0[q] * sigmoidf_(g0[q]) * u0[q]; g1[q] = g1[q] * sigmoidf_(g1[q]) * u1[q]; }
                *(u32x4*)(Hb + (size_t)(row0 + ai * HALF + m * 16) * DE + col0) = pack8(g0, g1); }
    }
};
struct EpiMoe2 {
    bf16* Y; const int* list; const float* gate; const LAS int* tab;
    __device__ __forceinline__ void operator()(const f32x4 (&acc)[2][2][4][2], const Unit& u, int wr, int wc, int fr, int fq) const {
        const int col0 = u.pn * BM + wc * 32 + 8 * fq; const int cnt = tab[32 + u.e];
#pragma unroll
        for (int ai = 0; ai < 2; ++ai)
#pragma unroll
            for (int m = 0; m < 4; ++m) { const int pos = u.j * BM + ai * HALF + wr * 64 + m * 16 + fr;
                if (pos < cnt) { const int a = list[(size_t)u.e * LCAP + pos]; const float g = gate[a];
#pragma unroll
                    for (int bj = 0; bj < 2; ++bj) *(u32x4*)(Y + (size_t)a * D + col0 + bj * HALF) = pack8(acc[ai][bj][m][0] * g, acc[ai][bj][m][1] * g); } }
    }
};
}

struct Args {
    const float* in[32]; float* out; unsigned char* ws;
    int l_lo, l_hi, ph_lo, ph_hi;
    int use_bar, pad;
};
enum { I_X = 0, I_WIN, I_MU, I_W0, I_WUP, I_A0, I_AUP, I_GUP, I_KK, I_KA, I_RK, I_LNG, I_LNB, I_CW, I_CB, I_WA, I_BA, I_WX, I_BX, I_LAM, I_LRUG, I_SBAG,
       I_WOUT, I_LN1G, I_LN1B, I_LN2G, I_LN2B, I_RW, I_RB, I_EG, I_EU, I_ED };
constexpr int NPH = 8;

__device__ __forceinline__ void transpose_item(const float* W, int N, bf16* WT, int pitch, int drow0, int k0, int n0, float* scr, int lane) {
#pragma unroll 8
    for (int i = 0; i < 32; ++i) { const int kk = 2 * i + (lane >> 5); scr[kk * 33 + (lane & 31)] = W[(size_t)(k0 + kk) * N + n0 + (lane & 31)]; }
    asm volatile("s_waitcnt lgkmcnt(0)" ::: "memory");
    const int c = lane & 7;
#pragma unroll
    for (int j = 0; j < 4; ++j) { const int n = (lane >> 3) + 8 * j; const float* s = scr + (8 * c) * 33 + n;
        u32x4 o; o.x = pk2(s[0 * 33], s[1 * 33]); o.y = pk2(s[2 * 33], s[3 * 33]); o.z = pk2(s[4 * 33], s[5 * 33]); o.w = pk2(s[6 * 33], s[7 * 33]);
        *(u32x4*)(WT + (size_t)(drow0 + n) * pitch + k0 + 8 * c) = o; }
    asm volatile("s_waitcnt lgkmcnt(0)" ::: "memory");
}
__device__ __forceinline__ void phase_convert(const int tid, const Args& A, int layer, float* ldsf, int vcu, int G) {
    const int lane = tid & 63, wave = tid >> 6;
    float* scr = ldsf + wave * 4096;
    unsigned char* ws = A.ws;
    bf16* Win = (bf16*)(ws + WS_WIN); bf16* Wout = (bf16*)(ws + WS_WOUT); bf16* Wgu = (bf16*)(ws + WS_WGU); bf16* Wdn = (bf16*)(ws + WS_WDN);
    bf16* WupT = (bf16*)(ws + WS_WSM); bf16* AupT = WupT + 384 * 64; bf16* GupT = AupT + 384 * 64;
    const int gw = vcu * NWAVES + wave, NGW = G * NWAVES;
    constexpr int I_IN = 16 * 96, I_OUT = 16 * 32, I_G = 16 * 256, I_U = 16 * 256, I_D = 16 * 256, I_S1 = 12, I_S2 = 12, I_S3 = 24;
    constexpr int NIT = I_IN + I_OUT + I_G + I_U + I_D + I_S1 + I_S2 + I_S3;
    for (int it = gw; it < NIT; it += NGW) {
        int r = it;
        if (r < I_IN) { const int kb = r / 96, nb = r % 96; transpose_item(A.in[I_WIN] + (size_t)layer * D * INC, INC, Win, D, 32 * nb, 64 * kb, 32 * nb, scr, lane); continue; } r -= I_IN;
        if (r < I_OUT) { const int kb = r / 32, nb = r % 32; transpose_item(A.in[I_WOUT] + (size_t)layer * D * D, D, Wout, D, 32 * nb, 64 * kb, 32 * nb, scr, lane); continue; } r -= I_OUT;
        if (r < I_G + I_U) { const int up = r >= I_G; if (up) r -= I_G; const int e = r / 256, q = r % 256, kb = q / 16, nb = q % 16, n0 = 32 * nb;
            const float* src = A.in[up ? I_EU : I_EG] + ((size_t)layer * NE + e) * D * DE;
            transpose_item(src, DE, Wgu, D, e * 1024 + (n0 >> 7) * 256 + up * 128 + (n0 & 127), 64 * kb, n0, scr, lane); continue; } r -= I_G + I_U;
        if (r < I_D) { const int e = r / 256, q = r % 256, kb = q / 32, nb = q % 32;
            transpose_item(A.in[I_ED] + ((size_t)layer * NE + e) * DE * D, D, Wdn, DE, e * 1024 + 32 * nb, 64 * kb, 32 * nb, scr, lane); continue; } r -= I_D;
        if (r < I_S1) { transpose_item(A.in[I_WUP] + (size_t)layer * 64 * RW, RW, WupT, 64, 32 * r, 0, 32 * r, scr, lane); continue; } r -= I_S1;
        if (r < I_S2) { transpose_item(A.in[I_AUP] + (size_t)layer * 64 * RW, RW, AupT, 64, 32 * r, 0, 32 * r, scr, lane); continue; } r -= I_S2;
        { const int kb = r / 12, nb = r % 12; transpose_item(A.in[I_GUP] + (size_t)layer * 128 * RW, RW, GupT, 128, 32 * nb, 64 * kb, 32 * nb, scr, lane); }
    }
    if (layer == 0) {
        const f32x4* x4 = (const f32x4*)A.in[I_X]; u32x4* o = (u32x4*)(ws + WS_XB);
        const size_t n8 = (size_t)M * D / 8;
        for (size_t i = (size_t)vcu * NTHR + tid; i < n8; i += (size_t)G * NTHR) { const f32x4 a = x4[2 * i], b = x4[2 * i + 1]; o[i] = pg8::pack8(a, b); }
    }
}

__device__ __forceinline__ void attn_unit(const int tid, const Args& A, int layer, int bh, int qb, unsigned char* lds) {
    const int lane = tid & 63, wave = __builtin_amdgcn_readfirstlane(tid >> 6), r = lane & 31, hh = lane >> 5;
    const int b = bh / SH, h = bh % SH;
    const bf16* P = (const bf16*)(A.ws + WS_P) + (size_t)b * SEQ * INC;
    bf16* MIX = (bf16*)(A.ws + WS_MIX) + (size_t)b * SEQ * D;
    bf16* Ks = (bf16*)lds;
    bf16* Vt = (bf16*)(lds + 64 * 72 * 2);
    const int q0w = qb * 256 + wave * 32;
    bf16x8 qr[4];
#pragma unroll
    for (int s = 0; s < 4; ++s) qr[s] = *(const bf16x8*)(P + (size_t)(q0w + r) * INC + PC_SQ + h * 64 + 16 * s + 8 * hh);
    f32x16 o0 = {}, o1 = {};
    float Rrun = 1.0f;
    const int qmine = q0w + r;
    const int lkey = tid >> 3, lch = (tid & 7) * 8;
    int jt = 4 * qb + 3;
    u32x4 kreg = *(const u32x4*)(P + (size_t)(64 * jt + lkey) * INC + PC_SK + h * 64 + lch);
    u32x4 vreg = *(const u32x4*)(P + (size_t)(64 * jt + lkey) * INC + PC_SV + h * 64 + lch);
    for (; jt >= 0; --jt) {
        __syncthreads();
        *(u32x4*)(Ks + lkey * 72 + lch) = kreg;
        { const unsigned short* vs = (const unsigned short*)&vreg;
#pragma unroll
          for (int i = 0; i < 8; ++i) Vt[(lch + i) * 72 + lkey] = vs[i]; }
        __syncthreads();
        if (jt > 0) {
            kreg = *(const u32x4*)(P + (size_t)(64 * (jt - 1) + lkey) * INC + PC_SK + h * 64 + lch);
            vreg = *(const u32x4*)(P + (size_t)(64 * (jt - 1) + lkey) * INC + PC_SV + h * 64 + lch);
        }
        const int k0 = 64 * jt;
        if (k0 >= q0w + 31) continue;
        f32x16 p0 = {}, p1 = {};
#pragma unroll
        for (int s = 0; s < 4; ++s) {
            const bf16x8 ka = *(const bf16x8*)(Ks + r * 72 + 16 * s + 8 * hh);
            const bf16x8 kb = *(const bf16x8*)(Ks + (32 + r) * 72 + 16 * s + 8 * hh);
            p0 = __builtin_amdgcn_mfma_f32_32x32x16_bf16(ka, qr[s], p0, 0, 0, 0);
            p1 = __builtin_amdgcn_mfma_f32_32x32x16_bf16(kb, qr[s], p1, 0, 0, 0);
        }
        const bool need_mask = (k0 + 63 >= q0w);
        float pa[8];
#pragma unroll
        for (int g = 0; g < 8; ++g) {
            float kp[4], sg[4];
#pragma unroll
            for (int i = 0; i < 4; ++i) {
                const float z = (g < 4) ? p0[4 * g + i] : p1[4 * (g - 4) + i];
                const float e = __builtin_amdgcn_exp2f(z);
                float kk = __builtin_amdgcn_rcpf(1.0f + e);
                float s_ = 1.0f - kk;
                if (need_mask) { const int key = k0 + 32 * (g >> 2) + 8 * (g & 3) + 4 * hh + i; if (key >= qmine) { kk = 1.0f; s_ = 0.0f; } }
                kp[i] = kk; sg[i] = s_;
            }
            const float x2 = kp[3], x1 = x2 * kp[2], x0 = x1 * kp[1];
            pa[g] = x0 * kp[0];
            const float v0 = sg[0] * x0, v1 = sg[1] * x1, v2 = sg[2] * x2, v3 = sg[3];
            if (g < 4) { p0[4 * g] = v0; p0[4 * g + 1] = v1; p0[4 * g + 2] = v2; p0[4 * g + 3] = v3; }
            else { p1[4 * (g - 4)] = v0; p1[4 * (g - 4) + 1] = v1; p1[4 * (g - 4) + 2] = v2; p1[4 * (g - 4) + 3] = v3; }
        }
        float pb[8];
#pragma unroll
        for (int g = 0; g < 8; ++g) pb[g] = __shfl_xor(pa[g], 32);
        float E[8];
        E[7] = hh ? 1.0f : pb[7];
#pragma unroll
        for (int g = 6; g >= 0; --g) E[g] = E[g + 1] * pa[g + 1] * (hh ? pb[g + 1] : pb[g]);
        const float T = E[0] * pa[0] * (hh ? pb[0] : 1.0f);
#pragma unroll
        for (int g = 0; g < 8; ++g) { const float re = E[g] * Rrun;
#pragma unroll
            for (int i = 0; i < 4; ++i) { if (g < 4) p0[4 * g + i] *= re; else p1[4 * (g - 4) + i] *= re; } }
        Rrun *= T;
#pragma unroll
        for (int s = 0; s < 4; ++s) {
            u32x4 pw;
            if (s < 2) { pw.x = pk2(p0[8 * s], p0[8 * s + 1]); pw.y = pk2(p0[8 * s + 2], p0[8 * s + 3]); pw.z = pk2(p0[8 * s + 4], p0[8 * s + 5]); pw.w = pk2(p0[8 * s + 6], p0[8 * s + 7]); }
            else { const int s2 = s - 2; pw.x = pk2(p1[8 * s2], p1[8 * s2 + 1]); pw.y = pk2(p1[8 * s2 + 2], p1[8 * s2 + 3]); pw.z = pk2(p1[8 * s2 + 4], p1[8 * s2 + 5]); pw.w = pk2(p1[8 * s2 + 6], p1[8 * s2 + 7]); }
            const bf16x8 pf = __builtin_bit_cast(bf16x8, pw);
            const int kb = 16 * s;
            { const s16x4 lo = *(const s16x4*)(Vt + r * 72 + kb + 4 * hh), hi = *(const s16x4*)(Vt + r * 72 + kb + 8 + 4 * hh);
              const bf16x8 vf = __builtin_shufflevector(lo, hi, 0, 1, 2, 3, 4, 5, 6, 7);
              o0 = __builtin_amdgcn_mfma_f32_32x32x16_bf16(vf, pf, o0, 0, 0, 0); }
            { const s16x4 lo = *(const s16x4*)(Vt + (32 + r) * 72 + kb + 4 * hh), hi = *(const s16x4*)(Vt + (32 + r) * 72 + kb + 8 + 4 * hh);
              const bf16x8 vf = __builtin_shufflevector(lo, hi, 0, 1, 2, 3, 4, 5, 6, 7);
              o1 = __builtin_amdgcn_mfma_f32_32x32x16_bf16(vf, pf, o1, 0, 0, 0); }
        }
    }
    float ss = 0.f;
#pragma unroll
    for (int i = 0; i < 16; ++i) ss += o0[i] * o0[i] + o1[i] * o1[i];
    ss += __shfl_xor(ss, 32);
    const float sc = rsqrtf(ss * (1.0f / 64.0f) + RMS_EPS);
    const float* ng = A.in[I_SBAG] + layer * SW + h * 64;
    bf16* orow = MIX + (size_t)(q0w + r) * D + MIX_S + h * 64;
#pragma unroll
    for (int g = 0; g < 4; ++g) {
        const int d = 8 * g + 4 * hh;
        const f32x4 g0 = *(const f32x4*)(ng + d), g1 = *(const f32x4*)(ng + 32 + d);
        u32x2 w0, w1;
        w0.x = pk2(o0[4 * g] * sc * g0[0], o0[4 * g + 1] * sc * g0[1]); w0.y = pk2(o0[4 * g + 2] * sc * g0[2], o0[4 * g + 3] * sc * g0[3]);
        w1.x = pk2(o1[4 * g] * sc * g1[0], o1[4 * g + 1] * sc * g1[1]); w1.y = pk2(o1[4 * g + 2] * sc * g1[2], o1[4 * g + 3] * sc * g1[3]);
        *(u32x2*)(orow + d) = w0; *(u32x2*)(orow + 32 + d) = w1;
    }
    __syncthreads();
}

constexpr int RT = 32;
__device__ __forceinline__ void rwkv_unit(const int tid, const Args& A, int layer, int bh, unsigned char* lds) {
    const int lane = tid & 63, wave = __builtin_amdgcn_readfirstlane(tid >> 6);
    const int b = bh / RH, h = bh % RH;
    const bf16* P = (const bf16*)(A.ws + WS_P) + (size_t)b * SEQ * INC;
    bf16* MIX = (bf16*)(A.ws + WS_MIX) + (size_t)b * SEQ * D;
    float* rS = (float*)lds; float* kS = rS + RT * 64; float* vS = kS + RT * 64; float* wS = vS + RT * 64; float* aS = wS + RT * 64;
    float* gS = aS + RT * 64; float* nS = gS + RT * 64; float* oS = nS + RT * 64; float* rho = oS + RT * 64;
    bf16* AL = (bf16*)(rho + 64);
    const bf16* WupT = (const bf16*)(A.ws + WS_WSM); const bf16* AupT = WupT + 384 * 64; const bf16* GupT = AupT + 384 * 64;
    const float* mu = A.in[I_MU] + layer * RCOLS;
    const int c4 = (tid & 15) * 4, tk = tid >> 4, ch = h * 64 + c4;
    const f32x4 w0v = *(const f32x4*)(A.in[I_W0] + layer * RW + ch), a0v = *(const f32x4*)(A.in[I_A0] + layer * RW + ch);
    const f32x4 kkv = *(const f32x4*)(A.in[I_KK] + layer * RW + ch), kav = *(const f32x4*)(A.in[I_KA] + layer * RW + ch);
    const f32x4 rkv = *(const f32x4*)(A.in[I_RK] + layer * RW + ch), lgv = *(const f32x4*)(A.in[I_LNG] + layer * RW + ch), lbv = *(const f32x4*)(A.in[I_LNB] + layer * RW + ch);
    const int vl = lane >> 3, kq = lane & 7;
    float s[8];
#pragma unroll
    for (int j = 0; j < 8; ++j) s[j] = 0.f;
    for (int t0 = 0; t0 < SEQ; t0 += RT) {
        for (int it = 0; it < 4; ++it) {
            const int item = tid + NTHR * it;
            if (item < RT * 56) {
                const int tok = item / 56, cg = item % 56, c = cg * 8;
                const int pc = (c < 64) ? (PC_R + h * 64 + c) : (c < 128) ? (PC_K + h * 64 + c - 64) : (c < 192) ? (PC_V + h * 64 + c - 128) : (c + 960);
                const int t = t0 + tok;
                const u32x4 cu = *(const u32x4*)(P + (size_t)t * INC + pc);
                u32x4 pv = {0u, 0u, 0u, 0u};
                if (t > 0) pv = *(const u32x4*)(P + (size_t)(t - 1) * INC + pc);
                const f32x4 m0 = *(const f32x4*)(mu + pc), m1 = *(const f32x4*)(mu + pc + 4);
                float v[8];
                { float c_, p_;
                  c_ = lo16(cu.x); p_ = lo16(pv.x); v[0] = c_ + m0[0] * (p_ - c_); c_ = hi16(cu.x); p_ = hi16(pv.x); v[1] = c_ + m0[1] * (p_ - c_);
                  c_ = lo16(cu.y); p_ = lo16(pv.y); v[2] = c_ + m0[2] * (p_ - c_); c_ = hi16(cu.y); p_ = hi16(pv.y); v[3] = c_ + m0[3] * (p_ - c_);
                  c_ = lo16(cu.z); p_ = lo16(pv.z); v[4] = c_ + m1[0] * (p_ - c_); c_ = hi16(cu.z); p_ = hi16(pv.z); v[5] = c_ + m1[1] * (p_ - c_);
                  c_ = lo16(cu.w); p_ = lo16(pv.w); v[6] = c_ + m1[2] * (p_ - c_); c_ = hi16(cu.w); p_ = hi16(pv.w); v[7] = c_ + m1[3] * (p_ - c_); }
                if (c < 192) {
                    float* dst = ((c < 64) ? rS : (c < 128) ? kS : vS) + tok * 64 + (c & 63);
                    *(f32x4*)dst = (f32x4){v[0], v[1], v[2], v[3]}; *(f32x4*)(dst + 4) = (f32x4){v[4], v[5], v[6], v[7]};
                } else {
                    if (c < 256) {
#pragma unroll
                        for (int i = 0; i < 8; ++i) v[i] = tanhf(v[i]);
                    } else if (c >= 320) {
#pragma unroll
                        for (int i = 0; i < 8; ++i) v[i] = sigmoidf_(v[i]);
                    }
                    u32x4 w; w.x = pk2(v[0], v[1]); w.y = pk2(v[2], v[3]); w.z = pk2(v[4], v[5]); w.w = pk2(v[6], v[7]);
                    *(u32x4*)(AL + tok * 264 + (c - 192)) = w;
                }
            }
        }
        __syncthreads();
#pragma unroll
        for (int q = 0; q < 3; ++q) {
            const int idx = wave * 3 + q, mtx = idx >> 3, tt = (idx >> 2) & 1, jt = idx & 3;
            const int Kd = (mtx == 2) ? 128 : 64, koff = (mtx == 0) ? 0 : (mtx == 1) ? 64 : 128;
            const bf16* Wt = (mtx == 0) ? WupT : (mtx == 1) ? AupT : GupT;
            f32x4 acc = {0.f, 0.f, 0.f, 0.f};
            for (int ks = 0; ks < Kd / 32; ++ks) {
                const bf16x8 af = *(const bf16x8*)(Wt + (size_t)(h * 64 + 16 * jt + (lane & 15)) * Kd + 32 * ks + 8 * (lane >> 4));
                const bf16x8 bfr = *(const bf16x8*)(AL + (16 * tt + (lane & 15)) * 264 + koff + 32 * ks + 8 * (lane >> 4));
                acc = __builtin_amdgcn_mfma_f32_16x16x32_bf16(af, bfr, acc, 0, 0, 0);
            }
            float* dst = (mtx == 0) ? wS : (mtx == 1) ? aS : gS;
            *(f32x4*)(dst + (16 * tt + (lane & 15)) * 64 + 16 * jt + 4 * (lane >> 4)) = acc;
        }
        __syncthreads();
        {
            const f32x4 wp = *(const f32x4*)(wS + tk * 64 + c4), ap = *(const f32x4*)(aS + tk * 64 + c4);
            const f32x4 kv = *(const f32x4*)(kS + tk * 64 + c4), rv = *(const f32x4*)(rS + tk * 64 + c4);
            f32x4 dec, av, kkx, kt; float n2 = 0.f, rp = 0.f;
#pragma unroll
            for (int i = 0; i < 4; ++i) {
                const float wl = -softplusf_(-(w0v[i] + wp[i])) - 0.5f;
                dec[i] = __expf(-__expf(wl));
                av[i] = sigmoidf_(a0v[i] + ap[i]);
                kkx[i] = kv[i] * kkv[i]; n2 += kkx[i] * kkx[i];
                kt[i] = kv[i] * (1.0f + (av[i] - 1.0f) * kav[i]);
                rp += rv[i] * kt[i] * rkv[i];
            }
            n2 = red16(n2); rp = red16(rp);
            const float inv = 1.0f / fmaxf(sqrtf(n2), 1e-12f);
            f32x4 nk, bh_;
#pragma unroll
            for (int i = 0; i < 4; ++i) { const float kkn = kkx[i] * inv; nk[i] = -kkn; bh_[i] = kkn * av[i]; }
            *(f32x4*)(wS + tk * 64 + c4) = dec; *(f32x4*)(aS + tk * 64 + c4) = bh_; *(f32x4*)(kS + tk * 64 + c4) = kt; *(f32x4*)(nS + tk * 64 + c4) = nk;
            if ((tid & 15) == 0) rho[tk] = rp;
        }
        __syncthreads();
        for (int t = 0; t < RT; ++t) {
            const f32x4 wa = *(const f32x4*)(wS + t * 64 + 8 * kq), wb = *(const f32x4*)(wS + t * 64 + 8 * kq + 4);
            const f32x4 na = *(const f32x4*)(nS + t * 64 + 8 * kq), nb = *(const f32x4*)(nS + t * 64 + 8 * kq + 4);
            const f32x4 ba = *(const f32x4*)(aS + t * 64 + 8 * kq), bb = *(const f32x4*)(aS + t * 64 + 8 * kq + 4);
            const f32x4 ka = *(const f32x4*)(kS + t * 64 + 8 * kq), kb = *(const f32x4*)(kS + t * 64 + 8 * kq + 4);
            const f32x4 ra = *(const f32x4*)(rS + t * 64 + 8 * kq), rb = *(const f32x4*)(rS + t * 64 + 8 * kq + 4);
            const float vv = vS[t * 64 + 8 * wave + vl];
            float sa = (s[0] * na[0] + s[1] * na[1]) + (s[2] * na[2] + s[3] * na[3]) + (s[4] * nb[0] + s[5] * nb[1]) + (s[6] * nb[2] + s[7] * nb[3]);
            sa = red8(sa);
            s[0] = s[0] * wa[0] + sa * ba[0] + vv * ka[0]; s[1] = s[1] * wa[1] + sa * ba[1] + vv * ka[1];
            s[2] = s[2] * wa[2] + sa * ba[2] + vv * ka[2]; s[3] = s[3] * wa[3] + sa * ba[3] + vv * ka[3];
            s[4] = s[4] * wb[0] + sa * bb[0] + vv * kb[0]; s[5] = s[5] * wb[1] + sa * bb[1] + vv * kb[1];
            s[6] = s[6] * wb[2] + sa * bb[2] + vv * kb[2]; s[7] = s[7] * wb[3] + sa * bb[3] + vv * kb[3];
            float o = (s[0] * ra[0] + s[1] * ra[1]) + (s[2] * ra[2] + s[3] * ra[3]) + (s[4] * rb[0] + s[5] * rb[1]) + (s[6] * rb[2] + s[7] * rb[3]);
            o = red8(o);
            if (kq == 0) oS[t * 64 + 8 * wave + vl] = o;
        }
        __syncthreads();
        {
            const f32x4 ov = *(const f32x4*)(oS + tk * 64 + c4), vv = *(const f32x4*)(vS + tk * 64 + c4), gv = *(const f32x4*)(gS + tk * 64 + c4);
            float sm = (ov[0] + ov[1]) + (ov[2] + ov[3]); sm = red16(sm);
            const float mean = sm * (1.0f / 64.0f);
            float q2 = 0.f;
#pragma unroll
            for (int i = 0; i < 4; ++i) { const float d_ = ov[i] - mean; q2 += d_ * d_; }
            q2 = red16(q2);
            const float rstd = rsqrtf(q2 * (1.0f / 64.0f) + GN_EPS), rh = rho[tk];
            float y[4];
#pragma unroll
            for (int i = 0; i < 4; ++i) y[i] = ((ov[i] - mean) * rstd * lgv[i] + lbv[i] + rh * vv[i]) * gv[i];
            u32x2 w; w.x = pk2(y[0], y[1]); w.y = pk2(y[2], y[3]);
            *(u32x2*)(MIX + (size_t)(t0 + tk) * D + MIX_R + ch) = w;
        }
        __syncthreads();
    }
}

constexpr int LT = 8;
__device__ __forceinline__ float gelu_tanh(float x) { const float u = 0.7978845608028654f * (x + 0.044715f * x * x * x); return 0.5f * x * (1.0f + tanhf(u)); }
__device__ __forceinline__ void lru_unit(const int tid, const Args& A, int layer, int bg, unsigned char* lds) {
    const int lane = tid & 63, wave = __builtin_amdgcn_readfirstlane(tid >> 6);
    const int b = bg / LB, g = bg % LB, c = g * 64 + lane;
    const bf16* P = (const bf16*)(A.ws + WS_P) + (size_t)b * SEQ * INC;
    bf16* MIX = (bf16*)(A.ws + WS_MIX) + (size_t)b * SEQ * D;
    float* xcS = (float*)lds + wave * 64;
    float* totA = (float*)lds + 8 * 64;
    float* totH = totA + 8 * 64;
    float* carryS = totH + 8 * 64;
    const float* wa = A.in[I_WA] + ((size_t)layer * LB + g) * 4096; const float* wx = A.in[I_WX] + ((size_t)layer * LB + g) * 4096;
    float* wxS = carryS + 64;
    float war[64];
#pragma unroll
    for (int i = 0; i < 64; ++i) war[i] = wa[i * 64 + lane];
    for (int i = tid; i < 4096; i += NTHR) wxS[i] = wx[i];
    const float cw0 = A.in[I_CW][(layer * 4 + 0) * LW + c], cw1 = A.in[I_CW][(layer * 4 + 1) * LW + c], cw2 = A.in[I_CW][(layer * 4 + 2) * LW + c], cw3 = A.in[I_CW][(layer * 4 + 3) * LW + c];
    const float cb = A.in[I_CB][layer * LW + c], ba = A.in[I_BA][layer * LW + c], bx = A.in[I_BX][layer * LW + c];
    const float sp8 = 8.0f * softplusf_(-A.in[I_LAM][layer * LW + c]);
    const float ng = A.in[I_LRUG][layer * LW + c];
    if (tid < 64) carryS[tid] = 0.f;
    __syncthreads();
    for (int st = 0; st < SEQ; st += 8 * LT) {
        const int T0 = st + wave * LT;
        float xm3 = (T0 >= 3) ? bf2f(P[(size_t)(T0 - 3) * INC + PC_LX + c]) : 0.f;
        float xm2 = (T0 >= 2) ? bf2f(P[(size_t)(T0 - 2) * INC + PC_LX + c]) : 0.f;
        float xm1 = (T0 >= 1) ? bf2f(P[(size_t)(T0 - 1) * INC + PC_LX + c]) : 0.f;
        float xin[LT], gin[LT];
#pragma unroll
        for (int t = 0; t < LT; ++t) { xin[t] = bf2f(P[(size_t)(T0 + t) * INC + PC_LX + c]); gin[t] = bf2f(P[(size_t)(T0 + t) * INC + PC_LG + c]); }
        float hl[LT], Ac[LT];
        float hrun = 0.f, arun = 1.f;
#pragma unroll
        for (int t = 0; t < LT; ++t) {
            const float xc = cw0 * xm3 + cw1 * xm2 + cw2 * xm1 + cw3 * xin[t] + cb;
            xm3 = xm2; xm2 = xm1; xm1 = xin[t];
            xcS[lane] = xc;
            asm volatile("s_waitcnt lgkmcnt(0)" ::: "memory");
            float ga = ba, gx = bx;
#pragma unroll
            for (int i4 = 0; i4 < 16; ++i4) { const f32x4 xv = *(const f32x4*)(xcS + 4 * i4);
                ga += xv[0] * war[4 * i4] + xv[1] * war[4 * i4 + 1] + xv[2] * war[4 * i4 + 2] + xv[3] * war[4 * i4 + 3];
                gx += xv[0] * wxS[(4 * i4) * 64 + lane] + xv[1] * wxS[(4 * i4 + 1) * 64 + lane] + xv[2] * wxS[(4 * i4 + 2) * 64 + lane] + xv[3] * wxS[(4 * i4 + 3) * 64 + lane]; }
            asm volatile("s_waitcnt lgkmcnt(0)" ::: "memory");
            const float la = -sp8 * sigmoidf_(ga);
            const float a = __expf(la);
            const float bi = sqrtf(-expm1f(2.0f * la)) * sigmoidf_(gx) * xc;
            hrun = a * hrun + bi; arun *= a;
            hl[t] = hrun; Ac[t] = arun;
        }
        totA[wave * 64 + lane] = arun; totH[wave * 64 + lane] = hrun;
        __syncthreads();
        float cin = carryS[lane];
        for (int u = 0; u < wave; ++u) cin = totA[u * 64 + lane] * cin + totH[u * 64 + lane];
        float cout = cin;
        if (wave == 7) cout = totA[7 * 64 + lane] * cin + totH[7 * 64 + lane];
#pragma unroll
        for (int t = 0; t < LT; ++t) {
            const float hv = hl[t] + Ac[t] * cin;
            const float y = gelu_tanh(gin[t]) * hv;
            const float ss = red64(y * y);
            const float o = y * rsqrtf(ss * (1.0f / 64.0f) + RMS_EPS) * ng;
            ((unsigned short*)MIX)[(size_t)(T0 + t) * D + MIX_L + c] = (unsigned short)(pk2(o, 0.f) & 0xffffu);
        }
        __syncthreads();
        if (wave == 7) carryS[lane] = cout;
        __syncthreads();
    }
}

__device__ __forceinline__ void phase_mixers(const int tid, const Args& A, int layer, unsigned char* lds, volatile LAS unsigned* misc) {
    unsigned* qhead = (unsigned*)(A.ws + WS_CTL) + CW_Q + layer * 64;
    constexpr int NU = 96 + 64 + 96 * 16;
    for (;;) {
        __syncthreads();
        if (tid == 0) misc[4] = __hip_atomic_fetch_add(qhead, 1u, __ATOMIC_RELAXED, __HIP_MEMORY_SCOPE_AGENT);
        __syncthreads();
        const int u = (int)misc[4];
        if (u >= NU) break;
#ifndef UMASK
#define UMASK 7
#endif
        if (u < 96) { if (UMASK & 1) rwkv_unit(tid, A, layer, u, lds); }
        else if (u < 160) { if (UMASK & 2) lru_unit(tid, A, layer, u - 96, lds); }
        else { const int a = u - 160; if (UMASK & 4) attn_unit(tid, A, layer, a % 96, 15 - a / 96, lds); }
    }
}

__device__ __forceinline__ void phase_ln1_router(const int tid, const Args& A, int layer, unsigned char* lds, int vcu, int G) {
    const int lane = tid & 63, wave = tid >> 6;
    float* rwT = (float*)lds;
    int* hist = (int*)(lds + 65536);
    int* rowinfo = (int*)(lds + 65536 + 256);
    bf16* X1 = (bf16*)(A.ws + WS_X1);
    int* list = (int*)(A.ws + WS_LIST); float* gate = (float*)(A.ws + WS_GATE);
    unsigned* gcnt = (unsigned*)(A.ws + WS_CTL) + CW_CNT + layer * 64;
    const float* rw = A.in[I_RW];
    for (int i = tid; i < 16 * 1024; i += NTHR) { const int c = i >> 4, e = i & 15; rwT[e * 1024 + c] = rw[i]; }
    float rb[16];
#pragma unroll
    for (int e = 0; e < 16; ++e) rb[e] = A.in[I_RB][e];
    const float* g1 = A.in[I_LN1G] + layer * D; const float* b1 = A.in[I_LN1B] + layer * D;
    const int rows_per = M / G;
    for (int chunk = 0; chunk < rows_per / 256; ++chunk) {
        const int base = vcu * rows_per + chunk * 256;
        if (tid < 16) hist[tid] = 0;
        __syncthreads();
        for (int rp = 0; rp < 16; ++rp) {
            const int lr = wave * 32 + rp * 2;
            float y[2][16];
#pragma unroll
            for (int q = 0; q < 2; ++q) {
                const bf16* xr = X1 + (size_t)(base + lr + q) * D;
                float v[16]; float sm = 0.f;
#pragma unroll
                for (int i = 0; i < 16; ++i) { v[i] = bf2f(xr[lane + 64 * i]); sm += v[i]; }
                const float mean = red64(sm) * (1.0f / D); float s2 = 0.f;
#pragma unroll
                for (int i = 0; i < 16; ++i) { v[i] -= mean; s2 += v[i] * v[i]; }
                const float rstd = rsqrtf(red64(s2) * (1.0f / D) + LN_EPS);
#pragma unroll
                for (int i = 0; i < 16; ++i) y[q][i] = v[i] * rstd * g1[lane + 64 * i] + b1[lane + 64 * i];
                bf16* xo = X1 + (size_t)(base + lr + q) * D;
#pragma unroll
                for (int i = 0; i < 16; ++i) xo[lane + 64 * i] = (unsigned short)(pk2(y[q][i], 0.f) & 0xffffu);
            }
            float lg[2][16];
#pragma unroll
            for (int e = 0; e < 16; ++e) { float a0 = 0.f, a1 = 0.f;
#pragma unroll
                for (int i = 0; i < 16; ++i) { const float w = rwT[e * 1024 + lane + 64 * i]; a0 += y[0][i] * w; a1 += y[1][i] * w; }
                lg[0][e] = red64(a0) + rb[e]; lg[1][e] = red64(a1) + rb[e]; }
#pragma unroll
            for (int q = 0; q < 2; ++q) {
                float mx = lg[q][0];
#pragma unroll
                for (int e = 1; e < 16; ++e) mx = fmaxf(mx, lg[q][e]);
                float sc[16], den = 0.f;
#pragma unroll
                for (int e = 0; e < 16; ++e) { sc[e] = __expf(lg[q][e] - mx); den += sc[e]; }
                const float inv = 1.0f / den;
#pragma unroll
                for (int e = 0; e < 16; ++e) sc[e] *= inv;
                int sel = 0; float best = -1.f;
#pragma unroll
                for (int gq = 0; gq < 4; ++gq) {
                    const float a = sc[4 * gq], b_ = sc[4 * gq + 1], c_ = sc[4 * gq + 2], d_ = sc[4 * gq + 3];
                    const float m1 = fmaxf(fmaxf(a, b_), fmaxf(c_, d_));
                    const float m2 = fmaxf(fmaxf(fminf(a, b_), fminf(c_, d_)), fminf(fmaxf(a, b_), fmaxf(c_, d_)));
                    const float gs = m1 + m2;
                    if (gs > best) { best = gs; sel = gq; }
                }
                float cd[4];
#pragma unroll
                for (int i = 0; i < 4; ++i) cd[i] = (sel == 0) ? sc[i] : (sel == 1) ? sc[4 + i] : (sel == 2) ? sc[8 + i] : sc[12 + i];
                int i0 = 0; float v0 = cd[0];
#pragma unroll
                for (int i = 1; i < 4; ++i) if (cd[i] > v0) { v0 = cd[i]; i0 = i; }
                int i1 = -1; float v1 = -1.f;
#pragma unroll
                for (int i = 0; i < 4; ++i) if (i != i0 && cd[i] > v1) { v1 = cd[i]; i1 = i; }
                const int e0 = sel * 4 + i0, e1 = sel * 4 + i1;
                const float gsum = v0 + v1;
                if (lane == 0) {
                    const int row = base + lr + q;
                    gate[2 * row] = v0 / gsum; gate[2 * row + 1] = v1 / gsum;
                    const int r0 = atomicAdd(&hist[e0], 1), r1 = atomicAdd(&hist[e1], 1);
                    rowinfo[2 * (lr + q)] = e0 | (r0 << 8); rowinfo[2 * (lr + q) + 1] = e1 | (r1 << 8);
                }
            }
        }
        __syncthreads();
        if (tid < 16) hist[16 + tid] = (int)__hip_atomic_fetch_add(gcnt + tid, (unsigned)hist[tid], __ATOMIC_RELAXED, __HIP_MEMORY_SCOPE_AGENT);
        __syncthreads();
        { const int info = rowinfo[tid]; const int e = info & 255, rk = info >> 8;
          list[(size_t)e * LCAP + hist[16 + e] + rk] = (base + (tid >> 1)) * 2 + (tid & 1); }
        __syncthreads();
    }
}

__device__ __forceinline__ void phase_ln2(const int tid, const Args& A, int layer, int vcu, int G) {
    const int lane = tid & 63, wave = tid >> 6;
    const bf16* X1 = (const bf16*)(A.ws + WS_X1); const bf16* YM = (const bf16*)(A.ws + WS_YM);
    bf16* XB = (bf16*)(A.ws + WS_XB);
    const float* g2 = A.in[I_LN2G] + layer * D; const float* b2 = A.in[I_LN2B] + layer * D;
    f32x4 gg[4], bb[4];
#pragma unroll
    for (int j = 0; j < 4; ++j) { gg[j] = *(const f32x4*)(g2 + 4 * lane + 256 * j); bb[j] = *(const f32x4*)(b2 + 4 * lane + 256 * j); }
    const int gw = vcu * NWAVES + wave, NGW = G * NWAVES;
    for (int row = gw; row < M; row += NGW) {
        f32x4 v[4]; float sm = 0.f;
#pragma unroll
        for (int j = 0; j < 4; ++j) {
            const u32x2 a = *(const u32x2*)(X1 + (size_t)row * D + 4 * lane + 256 * j);
            const u32x2 y0 = *(const u32x2*)(YM + (size_t)(2 * row) * D + 4 * lane + 256 * j);
            const u32x2 y1 = *(const u32x2*)(YM + (size_t)(2 * row + 1) * D + 4 * lane + 256 * j);
            v[j][0] = ALPHA * lo16(a.x) + lo16(y0.x) + lo16(y1.x); v[j][1] = ALPHA * hi16(a.x) + hi16(y0.x) + hi16(y1.x);
            v[j][2] = ALPHA * lo16(a.y) + lo16(y0.y) + lo16(y1.y); v[j][3] = ALPHA * hi16(a.y) + hi16(y0.y) + hi16(y1.y);
            sm += (v[j][0] + v[j][1]) + (v[j][2] + v[j][3]);
        }
        const float mean = red64(sm) * (1.0f / D); float s2 = 0.f;
#pragma unroll
        for (int j = 0; j < 4; ++j) { v[j] = v[j] - mean; s2 += (v[j][0] * v[j][0] + v[j][1] * v[j][1]) + (v[j][2] * v[j][2] + v[j][3] * v[j][3]); }
        const float rstd = rsqrtf(red64(s2) * (1.0f / D) + LN_EPS);
#pragma unroll
        for (int j = 0; j < 4; ++j) {
            const f32x4 o = v[j] * rstd * gg[j] + bb[j];
            if (layer == DEPTH - 1) *(f32x4*)(A.out + (size_t)row * D + 4 * lane + 256 * j) = o;
            else { u32x2 w; w.x = pk2(o[0], o[1]); w.y = pk2(o[2], o[3]); *(u32x2*)(XB + (size_t)row * D + 4 * lane + 256 * j) = w; }
        }
    }
}

__device__ __forceinline__ void moe_table(const int tid, const Args& A, int layer, LAS int* tab) {
    if (tid == 0) {
        const unsigned* gcnt = (const unsigned*)(A.ws + WS_CTL) + CW_CNT + layer * 64;
        int acc = 0;
        for (int e = 0; e < 16; ++e) { const int c = (int)__hip_atomic_load(gcnt + e, __ATOMIC_RELAXED, __HIP_MEMORY_SCOPE_AGENT); tab[e] = acc; tab[32 + e] = c; acc += (c + 255) >> 8; }
        tab[16] = acc;
    }
    __syncthreads();
}

__global__ void __launch_bounds__(NTHR, 2) fwd_kernel(Args args) {
    extern __shared__ __attribute__((aligned(16))) unsigned char lds[];
    LAS unsigned char* ldsl = (LAS unsigned char*)lds;
    volatile LAS unsigned* misc = (volatile LAS unsigned*)(ldsl + MISC_OFF);
    const int wave_s = __builtin_amdgcn_readfirstlane((int)threadIdx.x >> 6);
#define MKTID() ({ unsigned z_ = 0u; asm volatile("" : "+v"(z_)); (int)(wave_s * 64 + (int)__builtin_amdgcn_mbcnt_hi(~0u, __builtin_amdgcn_mbcnt_lo(~0u, z_))); })
    { const int tid = MKTID(); for (int u = tid; u < (LDS_BYTES - MISC_OFF) / 4; u += NTHR) misc[u] = 0u; }
    __syncthreads();
    const int G = gridDim.x, bx = blockIdx.x;
    const int vcu = (G % 8 == 0) ? (bx % 8) * (G / 8) + bx / 8 : bx;
    unsigned* ctl = (unsigned*)(args.ws + WS_CTL);
    XcdBarrier bar; bar.bar = ctl + CW_BAR; bar.x = 0; bar.st = nullptr;
    if (args.use_bar) bar = xcd_barrier_post(MKTID(), ctl + CW_BAR, misc + 8);
    LAS int* tab = (LAS int*)(ldsl + MISC_OFF + 256);
    const int lo = args.ph_lo, hi = args.ph_hi;
#ifndef PHMASK
#define PHMASK 0xFF
#endif
#define IN(k) (((PHMASK >> (k)) & 1) && lo <= (k) && (k) < hi)
#define SEAM(k) do { if (args.use_bar && !((k) == NPH - 1 && layer == args.l_hi - 1)) xcd_barrier(MKTID(), bar); } while (0)
    for (int layer = args.l_lo; layer < args.l_hi; ++layer) {
        if (IN(0)) { phase_convert(MKTID(), args, layer, (float*)lds, vcu, G); SEAM(0); }
        if (IN(1)) {
            pg8::DenseOrder S; S.init(M, INC, D, G, bx, args.ws + WS_WIN);
            pg8::EpiIn E{(bf16*)(args.ws + WS_P)};
            pg8::gemm_phase<pg8::EpiIn, pg8::DenseOrder, true>(MKTID(), ldsl, (const char*)(args.ws + WS_XB), D, S, E);
            SEAM(1);
        }
        if (IN(2)) { phase_mixers(MKTID(), args, layer, lds, misc); SEAM(2); }
        if (IN(3)) {
            pg8::DenseOrder S; S.init(M, D, D, G, bx, args.ws + WS_WOUT);
            pg8::EpiOut E{(const bf16*)(args.ws + WS_XB), (bf16*)(args.ws + WS_X1)};
            pg8::gemm_phase<pg8::EpiOut, pg8::DenseOrder, true>(MKTID(), ldsl, (const char*)(args.ws + WS_MIX), D, S, E);
            SEAM(3);
        }
        if (IN(4)) { phase_ln1_router(MKTID(), args, layer, lds, vcu, G); SEAM(4); }
        if (IN(5)) {
            moe_table(MKTID(), args, layer, tab);
            pg8::MoeOrder<true> S{tab, G, vcu, D, 4, (const char*)(args.ws + WS_WGU), (size_t)1024 * D * 2, (const int*)(args.ws + WS_LIST)};
            pg8::EpiMoe1 E{(bf16*)(args.ws + WS_H)};
            pg8::gemm_phase<pg8::EpiMoe1, pg8::MoeOrder<true>, true>(MKTID(), ldsl, (const char*)(args.ws + WS_X1), D, S, E);
            SEAM(5);
        }
        if (IN(6)) {
            moe_table(MKTID(), args, layer, tab);
            pg8::MoeOrder<false> S{tab, G, vcu, DE, 4, (const char*)(args.ws + WS_WDN), (size_t)1024 * DE * 2, (const int*)(args.ws + WS_LIST)};
            pg8::EpiMoe2 E{(bf16*)(args.ws + WS_YM), (const int*)(args.ws + WS_LIST), (const float*)(args.ws + WS_GATE), tab};
            pg8::gemm_phase<pg8::EpiMoe2, pg8::MoeOrder<false>, true>(MKTID(), ldsl, (const char*)(args.ws + WS_H), DE, S, E);
            SEAM(6);
        }
        if (IN(7)) { phase_ln2(MKTID(), args, layer, vcu, G); SEAM(7); }
    }
#undef IN
#undef SEAM
}

extern "C" void kernel_launch(void* const* d_in, const int* in_sizes, int n_in, void* d_out, int out_size, void* d_ws, size_t ws_size, hipStream_t stream) {
    static int grid = 0;
    if (grid == 0) {
        if (n_in != 32 || out_size != M * D || ws_size < WS_END) { fprintf(stderr, "kernel_launch: unexpected shapes (n_in %d out %d ws %zu)\n", n_in, out_size, ws_size); grid = -1; return; }
        int dev = 0, cus = 0;
        if (hipGetDevice(&dev) != hipSuccess || hipDeviceGetAttribute(&cus, hipDeviceAttributeMultiprocessorCount, dev) != hipSuccess) { grid = -1; return; }
        if (hipFuncSetAttribute((const void*)fwd_kernel, hipFuncAttributeMaxDynamicSharedMemorySize, LDS_BYTES) != hipSuccess) { fprintf(stderr, "kernel_launch: hipFuncSetAttribute failed\n"); grid = -1; return; }
        int per_cu = 0;
        (void)hipOccupancyMaxActiveBlocksPerMultiprocessor(&per_cu, (const void*)fwd_kernel, NTHR, LDS_BYTES);
        (void)hipGetLastError();
        if (per_cu < 1) fprintf(stderr, "kernel_launch: occupancy query reports %d\n", per_cu);
        grid = cus;
    }
    if (grid < 0) return;
    (void)hipMemsetAsync((char*)d_ws + WS_CTL, 0, CTL_BYTES, stream);
    Args a{};
    for (int i = 0; i < 32; ++i) a.in[i] = (const float*)d_in[i];
    a.out = (float*)d_out; a.ws = (unsigned char*)d_ws;
#if MK_ONE_LAUNCH
    a.l_lo = 0; a.l_hi = DEPTH; a.ph_lo = 0; a.ph_hi = NPH; a.use_bar = 1; a.pad = 0;
    hipLaunchKernelGGL(fwd_kernel, dim3(grid), dim3(NTHR), LDS_BYTES, stream, a);
#else
    for (int l = 0; l < DEPTH; ++l)
        for (int p = 0; p < NPH; ++p) {
            a.l_lo = l; a.l_hi = l + 1; a.ph_lo = p; a.ph_hi = p + 1; a.use_bar = 0; a.pad = 0;
            hipLaunchKernelGGL(fwd_kernel, dim3(grid), dim3(NTHR), LDS_BYTES, stream, a);
        }
#endif
}
```

```cpp
#include <hip/hip_runtime.h>
#include <cstdio>
#include <cstdint>

#ifndef MK_ONE_LAUNCH
#define MK_ONE_LAUNCH 1
#endif

#define LAS __attribute__((address_space(3)))
#define GAS __attribute__((address_space(1)))
typedef unsigned short bf16;
typedef short bf16x8 __attribute__((ext_vector_type(8)));
typedef short s16x4 __attribute__((ext_vector_type(4)));
typedef float f32x4 __attribute__((ext_vector_type(4)));
typedef float f32x2 __attribute__((ext_vector_type(2)));
typedef float f32x16 __attribute__((ext_vector_type(16)));
typedef unsigned u32x4 __attribute__((ext_vector_type(4)));
typedef unsigned u32x2 __attribute__((ext_vector_type(2)));
typedef __bf16 bf16x2_t __attribute__((ext_vector_type(2)));

constexpr int D = 1024, BATCH = 16, SEQ = 4096, DEPTH = 4, M = BATCH * SEQ;
constexpr int HD = 64, RW = 384, LW = 256, SW = 384, RH = 6, LB = 4, SH = 6;
constexpr int RCOLS = 1408, INC = 3072;
constexpr int PC_R = 0, PC_K = 384, PC_V = 768, PC_DW = 1152, PC_DA = 1216, PC_DG = 1280;
constexpr int PC_LG = 1408, PC_LX = 1664, PC_SQ = 1920, PC_SK = 2304, PC_SV = 2688;
constexpr int MIX_R = 0, MIX_L = 384, MIX_S = 640;
constexpr int NE = 16, DE = 512, LCAP = 2 * M;
constexpr float ALPHA = 1.6817928305074290f;
constexpr float LN_EPS = 1e-5f, RMS_EPS = 1e-6f, GN_EPS = 64e-5f;
constexpr float C2 = 0.125f * 1.4426950408889634f;

constexpr size_t MiB = 1u << 20;
constexpr size_t WS_CTL = 0, CTL_BYTES = 1 * MiB;
constexpr size_t WS_WIN = 1 * MiB;
constexpr size_t WS_WOUT = 7 * MiB;
constexpr size_t WS_WGU = 9 * MiB;
constexpr size_t WS_WDN = 41 * MiB;
constexpr size_t WS_WSM = 57 * MiB;
constexpr size_t WS_LIST = 58 * MiB;
constexpr size_t WS_GATE = 66 * MiB;
constexpr size_t WS_XB = 68 * MiB;
constexpr size_t WS_X1 = 196 * MiB;
constexpr size_t WS_P = 324 * MiB;
constexpr size_t WS_MIX = 708 * MiB;
constexpr size_t WS_H = 324 * MiB;
constexpr size_t WS_YM = 460 * MiB;
constexpr size_t WS_END = 836 * MiB;
static_assert(WS_H + (size_t)(2 * M + NE * 256) * DE * 2 <= WS_YM && WS_YM + (size_t)2 * M * D * 2 <= WS_END, "ws map");

constexpr int CW_BAR = 0;
constexpr int CW_CNT = 8192;
constexpr int CW_Q = 8192 + 1024;

constexpr int NTHR = 512, NWAVES = 8;
constexpr int LDS_BYTES = 139264;
constexpr int GEMM_LDS = 131072;
constexpr int MISC_OFF = GEMM_LDS;

__device__ __forceinline__ float bf2f(unsigned short b) { return __uint_as_float((unsigned)b << 16); }
__device__ __forceinline__ unsigned pk2(float lo, float hi) { f32x2 v = {lo, hi}; bf16x2_t b = __builtin_convertvector(v, bf16x2_t); return __builtin_bit_cast(unsigned, b); }
__device__ __forceinline__ float lo16(unsigned u) { return __uint_as_float(u << 16); }
__device__ __forceinline__ float hi16(unsigned u) { return __uint_as_float(u & 0xffff0000u); }
#define DPP(v, ctrl) __builtin_bit_cast(float, __builtin_amdgcn_update_dpp(__builtin_bit_cast(int, v), __builtin_bit_cast(int, v), (ctrl), 0xF, 0xF, false))
__device__ __forceinline__ float red8(float v) { v += DPP(v, 0xB1); v += DPP(v, 0x4E); v += DPP(v, 0x141); return v; }
__device__ __forceinline__ float red16(float v) { v = red8(v); v += DPP(v, 0x140); return v; }
__device__ __forceinline__ float red64(float v) { v = red16(v); v += __shfl_xor(v, 16); v += __shfl_xor(v, 32); return v; }
__device__ __forceinline__ float sigmoidf_(float x) { return __builtin_amdgcn_rcpf(1.0f + __expf(-x)); }
__device__ __forceinline__ float softplusf_(float x) { return x > 20.f ? x : log1pf(__expf(x)); }

#define XB_TMO      128
#define XB_XCNT(j)  (256  + 64 * (j))
#define XB_XSUB(j)  (1280 + 64 * (j))
#define XB_XGEN(j)  (2304 + 64 * (j))
#define XB_TOP      3328
#define XB_TOPGEN   3392
#define XCD_BAR_WORDS 3456
#define XB_SPIN_CAP (1u << 22)
__device__ __forceinline__ unsigned xb_ld(unsigned* p)              { return __hip_atomic_load(p, __ATOMIC_RELAXED, __HIP_MEMORY_SCOPE_AGENT); }
__device__ __forceinline__ unsigned xb_add(unsigned* p, unsigned v) { return __hip_atomic_fetch_add(p, v, __ATOMIC_RELAXED, __HIP_MEMORY_SCOPE_AGENT); }
__device__ __forceinline__ unsigned xb_xcc_id() { return (unsigned)__builtin_amdgcn_s_getreg((3 << 11) | 20) & 0xFu; }
#define XB_SPIN(cond, bar) do { unsigned _sp = 0; while (cond) { __builtin_amdgcn_s_sleep(1); \
    if ((++_sp & 255u) == 0u) { if (xb_ld(&(bar)[XB_TMO])) break; if (_sp > XB_SPIN_CAP) { atomicAdd(&(bar)[XB_TMO], 1u); break; } } } } while (0)
struct XcdBarrier { unsigned* bar; unsigned x; volatile LAS unsigned* st; };
__device__ __forceinline__ XcdBarrier xcd_barrier_post(const int tid, unsigned* bar, volatile LAS unsigned* st) {
    XcdBarrier b; b.bar = bar; b.x = xb_xcc_id(); b.st = st;
    if (tid == 0) (void)xb_add(&bar[XB_XCNT(b.x)], 1u);
    return b;
}
__device__ __forceinline__ void xcd_barrier_complete(unsigned* bar, unsigned x, unsigned& nloc, unsigned& nx) {
    const unsigned G = gridDim.x * gridDim.y * gridDim.z;
    unsigned sum, cnt, mine, sp = 0u;
    for (;;) {
        sum = 0u; cnt = 0u; mine = 0u;
#pragma unroll
        for (unsigned j = 0; j < 16; ++j) { const unsigned c = xb_ld(&bar[XB_XCNT(j)]); sum += c; cnt += (c > 0u) ? 1u : 0u; mine = (j == x) ? c : mine; }
        if (sum == G) break;
        __builtin_amdgcn_s_sleep(1);
        if ((++sp & 255u) == 0u) { if (xb_ld(&bar[XB_TMO])) break; if (sp > XB_SPIN_CAP) { atomicAdd(&bar[XB_TMO], 1u); break; } }
    }
    nloc = mine > 0u ? mine : 1u; nx = cnt > 0u ? cnt : 1u;
}
__device__ __forceinline__ void xcd_barrier(const int tid, const XcdBarrier& b) {
    asm volatile("s_waitcnt vmcnt(0)" ::: "memory");
    __syncthreads();
    if (tid == 0) {
        unsigned* bar = b.bar;
        __builtin_amdgcn_s_waitcnt(0);
        unsigned nloc = b.st[0], nx = b.st[1];
        if (nloc == 0u) { xcd_barrier_complete(bar, b.x, nloc, nx); b.st[0] = nloc; b.st[1] = nx; }
        const unsigned old = xb_add(&bar[XB_XSUB(b.x)], 1u);
        const unsigned gen = old / nloc;
        if (old + 1u == (gen + 1u) * nloc) {
            __builtin_amdgcn_fence(__ATOMIC_RELEASE, "agent");
            asm volatile("s_waitcnt vmcnt(0)" ::: "memory");
            const unsigned og = xb_add(&bar[XB_TOP], 1u);
            const unsigned tg = og / nx;
            if (og + 1u == (tg + 1u) * nx) xb_add(&bar[XB_TOPGEN], 1u);
            else XB_SPIN(xb_ld(&bar[XB_TOPGEN]) == tg, bar);
            __builtin_amdgcn_fence(__ATOMIC_ACQUIRE, "agent");
            xb_add(&bar[XB_XGEN(b.x)], 1u);
            asm volatile("s_waitcnt vmcnt(0)" ::: "memory");
        } else {
            XB_SPIN(xb_ld(&bar[XB_XGEN(b.x)]) == gen, bar);
            __builtin_amdgcn_fence(__ATOMIC_ACQUIRE, "agent");
            asm volatile("s_waitcnt vmcnt(0)" ::: "memory");
        }
    }
    __syncthreads();
}

namespace pg8 {
constexpr int BM = 256, BK = 64, HALF = 128, HTB = HALF * BK * 2, STAGE_BYTES = 8 * HTB;
__host__ __device__ __forceinline__ int lds_byte(int r, int c) { const int st = (r >> 4) * 2 + (c >> 5), rr = r & 15, cc = c & 31, ob = rr * 64 + cc * 2; return st * 1024 + (ob ^ (((ob >> 9) & 1) << 5)); }
__host__ __device__ __forceinline__ void stage_rc(int b, int& R, int& C) { const int st = b / 1024, sb = b % 1024, swz = sb ^ (((sb >> 9) & 1) << 5); R = (st >> 1) * 16 + swz / 64; C = (st & 1) * 32 + (swz % 64) / 2; }
__host__ __device__ __forceinline__ int perm32(int rho) { const int n = rho >> 4, i = rho & 15; return 8 * (i >> 2) + 4 * n + (i & 3); }

struct Unit { int pm, pn, e, j; };
template <class Epi, class Sched, bool ALIGN_EPI>
__device__ __forceinline__ void gemm_phase(const int tid, LAS unsigned char* lds, const char* Abase, const int K, const Sched& S, const Epi& E) {
    const int wid = __builtin_amdgcn_readfirstlane(tid >> 6), lane = tid & 63, wr = wid >> 2, wc = wid & 3, fr = lane & 15, fq = lane >> 4;
    const int nt = K / BK;
    int R0, C0; stage_rc(tid * 16, R0, C0);
    const int Rb0 = (R0 & ~31) + perm32(R0 & 31);
    unsigned voffB[2]; voffB[0] = (unsigned)(Rb0 * K + C0) * 2u; voffB[1] = (unsigned)((Rb0 + 64) * K + C0) * 2u;
    unsigned voffA[2]; voffA[0] = (unsigned)(R0 * K + C0) * 2u; voffA[1] = (unsigned)((R0 + 64) * K + C0) * 2u;
    const unsigned colA = (unsigned)C0 * 2u;
    const size_t kstep = (size_t)(BK * 2);
    const size_t hstepB = (size_t)HALF * K * 2, hstepA = hstepB;
    const unsigned ldsw = (unsigned)wid * 1024u;
    const int aoff = lds_byte(wr * 64 + fr, fq * 8), boff = lds_byte(wc * 32 + fr, fq * 8);
#define PG8_SA(b, h) (((b) * 2 + (h)) * HTB)
#define PG8_SB(b, h) ((4 + (b) * 2 + (h)) * HTB)
#define PG8_STAGE_B(bufoff, gbase) do { _Pragma("unroll") for (int _i = 0; _i < 2; ++_i) \
        __builtin_amdgcn_global_load_lds((const unsigned*)((const char*)(gbase) + voffB[_i]), (LAS unsigned*)(lds + (bufoff) + ldsw + _i * 8192), 16, 0, 0); } while (0)
#define PG8_STAGE_A(bufoff, h, kbyte, nx) do { \
        if constexpr (Sched::GATHER) { _Pragma("unroll") for (int _i = 0; _i < 2; ++_i) { const unsigned _o = (nx) ? na[h][_i] : ca[h][_i]; \
            __builtin_amdgcn_global_load_lds((const unsigned*)(Abase + (kbyte) + _o), (LAS unsigned*)(lds + (bufoff) + ldsw + _i * 8192), 16, 0, 0); } } \
        else { const char* _p = ((nx) ? nA : cA) + (kbyte) + (size_t)(h) * hstepA; _Pragma("unroll") for (int _i = 0; _i < 2; ++_i) \
            __builtin_amdgcn_global_load_lds((const unsigned*)(_p + voffA[_i]), (LAS unsigned*)(lds + (bufoff) + ldsw + _i * 8192), 16, 0, 0); } } while (0)
#define PG8_LDA(dst, b, h) do { _Pragma("unroll") for (int m = 0; m < 4; ++m) _Pragma("unroll") for (int k = 0; k < 2; ++k) dst[m][k] = *(const LAS bf16x8*)(lds + PG8_SA(b, h) + aoff + m * 2048 + k * 1024); } while (0)
#define PG8_LDB(dst, b, h) do { _Pragma("unroll") for (int n = 0; n < 2; ++n) _Pragma("unroll") for (int k = 0; k < 2; ++k) dst[n][k] = *(const LAS bf16x8*)(lds + PG8_SB(b, h) + boff + n * 2048 + k * 1024); } while (0)
#define PG8_MMA(ai, bj, At, Bt) do { __builtin_amdgcn_s_setprio(1); _Pragma("unroll") for (int m = 0; m < 4; ++m) _Pragma("unroll") for (int n = 0; n < 2; ++n) _Pragma("unroll") for (int k = 0; k < 2; ++k) \
        acc[ai][bj][m][n] = __builtin_amdgcn_mfma_f32_16x16x32_bf16(Bt[n][k], At[m][k], acc[ai][bj][m][n], 0, 0, 0); __builtin_amdgcn_s_setprio(0); } while (0)
#define PG8_WAIT_V(n) asm volatile("s_waitcnt vmcnt(" #n ")" ::: "memory")
#define PG8_WAIT_L(n) asm volatile("s_waitcnt lgkmcnt(" #n ")" ::: "memory")
#define PG8_BAR __builtin_amdgcn_s_barrier()
#define PG8_SCHED __builtin_amdgcn_sched_barrier(0)
    Unit cur, nxt; int ui = 0;
    if (!S.next(0, cur)) return;
    unsigned ca[2][2], na[2][2];
    const char* cA = Abase; const char* nA = Abase;
    if constexpr (Sched::GATHER) S.aoffs(cur, R0, colA, ca); else cA = Abase + (size_t)S.arow0(cur) * K * 2;
    f32x4 acc[2][2][4][2];
#pragma unroll
    for (int a = 0; a < 2; ++a)
#pragma unroll
        for (int b = 0; b < 2; ++b)
#pragma unroll
            for (int m = 0; m < 4; ++m)
#pragma unroll
                for (int n = 0; n < 2; ++n) acc[a][b][m][n] = (f32x4){0.f, 0.f, 0.f, 0.f};
    bf16x8 At[4][2], B0[2][2], B1[2][2];
    const char* cB = S.bbase(cur);
    PG8_STAGE_B(PG8_SB(0, 0), cB); PG8_STAGE_B(PG8_SB(0, 1), cB + hstepB); PG8_STAGE_A(PG8_SA(0, 0), 0, 0, false); PG8_STAGE_A(PG8_SA(0, 1), 1, 0, false);
    if (wr == 1) PG8_BAR;
    PG8_WAIT_V(2); PG8_BAR;
    PG8_STAGE_B(PG8_SB(1, 0), cB + kstep); PG8_STAGE_A(PG8_SA(1, 0), 0, kstep, false); PG8_STAGE_B(PG8_SB(1, 1), cB + hstepB + kstep);
    PG8_WAIT_V(6); PG8_BAR;
    for (;;) {
        const bool has_next = S.next(ui + 1, nxt);
        const char* nB = cB;
        nA = cA;
        if (has_next) { nB = S.bbase(nxt); if constexpr (Sched::GATHER) S.aoffs(nxt, R0, colA, na); else nA = Abase + (size_t)S.arow0(nxt) * K * 2; }
        else if constexpr (Sched::GATHER) { na[0][0] = ca[0][0]; na[0][1] = ca[0][1]; na[1][0] = ca[1][0]; na[1][1] = ca[1][1]; }
        for (int t = 0; t < nt; t += 2) {
            const bool last = (t == nt - 2);
            const size_t k1 = (size_t)(t + 1) * kstep;
            const size_t k2 = last ? 0 : (size_t)(t + 2) * kstep, k3 = k2 + kstep;
            const char* b2 = last ? nB : cB + (size_t)(t + 2) * kstep; const char* b3 = b2 + kstep;
            PG8_LDB(B0, 0, 0); PG8_LDB(B1, 0, 1); PG8_SCHED; PG8_LDA(At, 0, 0); PG8_STAGE_A(PG8_SA(1, 1), 1, k1, false);
            PG8_WAIT_V(8); PG8_WAIT_L(0); PG8_BAR; PG8_MMA(0, 0, At, B0); PG8_MMA(0, 1, At, B1); PG8_BAR; PG8_SCHED;
            PG8_LDA(At, 0, 1); PG8_STAGE_B(PG8_SB(0, 0), b2); PG8_STAGE_B(PG8_SB(0, 1), b2 + hstepB); PG8_STAGE_A(PG8_SA(0, 0), 0, k2, last);
            PG8_WAIT_V(8); PG8_WAIT_L(0); PG8_BAR; PG8_MMA(1, 0, At, B0); PG8_MMA(1, 1, At, B1); PG8_BAR; PG8_SCHED;
            PG8_LDB(B0, 1, 0); PG8_LDB(B1, 1, 1); PG8_SCHED; PG8_LDA(At, 1, 0); PG8_STAGE_A(PG8_SA(0, 1), 1, k2, last);
            PG8_WAIT_V(8); PG8_WAIT_L(0); PG8_BAR; PG8_MMA(0, 0, At, B0); PG8_MMA(0, 1, At, B1); PG8_BAR; PG8_SCHED;
            PG8_LDA(At, 1, 1); PG8_STAGE_B(PG8_SB(1, 0), b3); PG8_STAGE_B(PG8_SB(1, 1), b3 + hstepB); PG8_STAGE_A(PG8_SA(1, 0), 0, k3, last);
            PG8_WAIT_V(8); PG8_WAIT_L(0); PG8_BAR; PG8_MMA(1, 0, At, B0); PG8_MMA(1, 1, At, B1); PG8_BAR; PG8_SCHED;
        }
        if constexpr (ALIGN_EPI) { if (wr == 0) PG8_BAR; }
        E(acc, cur, wr, wc, fr, fq);
        if (!has_next) break;
#pragma unroll
        for (int a = 0; a < 2; ++a)
#pragma unroll
            for (int b = 0; b < 2; ++b)
#pragma unroll
                for (int m = 0; m < 4; ++m)
#pragma unroll
                    for (int n = 0; n < 2; ++n) acc[a][b][m][n] = (f32x4){0.f, 0.f, 0.f, 0.f};
        cur = nxt; cB = nB; cA = nA; ++ui;
        if constexpr (Sched::GATHER) { ca[0][0] = na[0][0]; ca[0][1] = na[0][1]; ca[1][0] = na[1][0]; ca[1][1] = na[1][1]; }
        if constexpr (ALIGN_EPI) { if (wr == 1) PG8_BAR; }
    }
    PG8_WAIT_V(0);
    if constexpr (!ALIGN_EPI) { if (wr == 0) PG8_BAR; }
    PG8_BAR;
#undef PG8_SA
#undef PG8_SB
#undef PG8_STAGE_A
#undef PG8_STAGE_B
#undef PG8_LDA
#undef PG8_LDB
#undef PG8_MMA
#undef PG8_WAIT_V
#undef PG8_WAIT_L
#undef PG8_BAR
#undef PG8_SCHED
}

struct DenseOrder {
    static constexpr bool GATHER = false;
    int nM, nN, nwg, G, c, K; const char* Bt;
    __device__ __forceinline__ int arow0(const Unit& u) const { return u.pm * BM; }
    __device__ __forceinline__ void init(int M_, int N_, int K_, int G_, int c_, const void* Bt_) { nM = M_ / BM; nN = N_ / BM; nwg = nM * nN; G = G_; c = c_; K = K_; Bt = (const char*)Bt_; }
    __device__ __forceinline__ bool next(int i, Unit& u) const {
        const long L = (long)i * G + c; if (L >= nwg) return false;
        int wgid = (int)L; { const int q = nwg / 8, r = nwg % 8, xcd = wgid % 8, off = wgid / 8; wgid = (xcd < r ? xcd * (q + 1) : r * (q + 1) + (xcd - r) * q) + off; }
        const int nig = 8 * nN, gid = wgid / nig, fm = gid * 8, gsz = (nM - fm) < 8 ? (nM - fm) : 8;
        u.pm = fm + ((wgid % nig) % gsz); u.pn = (wgid % nig) / gsz; u.e = 0; u.j = 0; return true;
    }
    __device__ __forceinline__ void aoffs(const Unit& u, int R0, unsigned colA, unsigned (&o)[2][2]) const {
#pragma unroll
        for (int h = 0; h < 2; ++h)
#pragma unroll
            for (int i = 0; i < 2; ++i) o[h][i] = (unsigned)(u.pm * BM + h * HALF + R0 + 64 * i) * (unsigned)(K * 2) + colA;
    }
    __device__ __forceinline__ const char* bbase(const Unit& u) const { return Bt + (size_t)u.pn * BM * K * 2; }
};
template <bool GATHER_>
struct MoeOrder {
    static constexpr bool GATHER = GATHER_;
    __device__ __forceinline__ int arow0(const Unit& u) const { return u.pm * BM; }
    const LAS int* tab;
    int G, c, K, nN; const char* Bt; size_t estride;
    const int* list;
    __device__ __forceinline__ bool next(int i, Unit& u) const {
        const int L = i * G + c; const int nb = tab[16];
        if (L >= nb * nN) return false;
        const int rb = L / nN; u.pn = L % nN; u.pm = rb;
        int e = 0;
#pragma unroll
        for (int k = 1; k < 16; ++k) e += (rb >= tab[k]) ? 1 : 0;
        u.e = e; u.j = rb - tab[e]; return true;
    }
    __device__ __forceinline__ void aoffs(const Unit& u, int R0, unsigned colA, unsigned (&o)[2][2]) const {
        const int cnt = tab[32 + u.e];
#pragma unroll
        for (int h = 0; h < 2; ++h)
#pragma unroll
            for (int i = 0; i < 2; ++i) {
                const int r = h * HALF + R0 + 64 * i;
                const int pos = u.j * BM + r; const unsigned row = (pos < cnt) ? (unsigned)(list[(size_t)u.e * LCAP + pos] >> 1) : 0u;
                o[h][i] = row * (unsigned)(K * 2) + colA;
            }
    }
    __device__ __forceinline__ const char* bbase(const Unit& u) const { return Bt + (size_t)u.e * estride + (size_t)u.pn * BM * K * 2; }
};

__device__ __forceinline__ u32x4 pack8(const f32x4 v0, const f32x4 v1) { u32x4 w; w.x = pk2(v0[0], v0[1]); w.y = pk2(v0[2], v0[3]); w.z = pk2(v1[0], v1[1]); w.w = pk2(v1[2], v1[3]); return w; }
struct EpiIn {
    bf16* O;
    __device__ __forceinline__ void operator()(const f32x4 (&acc)[2][2][4][2], const Unit& u, int wr, int wc, int fr, int fq) const {
        const int row0 = u.pm * BM + wr * 64 + fr, col0 = u.pn * BM + wc * 32 + 8 * fq;
#pragma unroll
        for (int ai = 0; ai < 2; ++ai)
#pragma unroll
            for (int m = 0; m < 4; ++m) { bf16* rowp = O + (size_t)(row0 + ai * HALF + m * 16) * INC + col0;
#pragma unroll
                for (int bj = 0; bj < 2; ++bj) { const int c = col0 + bj * HALF; const float sc = (c >= PC_SQ && c < PC_SK) ? C2 : 1.0f;
                    *(u32x4*)(rowp + bj * HALF) = pack8(acc[ai][bj][m][0] * sc, acc[ai][bj][m][1] * sc); } }
    }
};
struct EpiOut {
    const bf16* X; bf16* O;
    __device__ __forceinline__ void operator()(const f32x4 (&acc)[2][2][4][2], const Unit& u, int wr, int wc, int fr, int fq) const {
        const int row0 = u.pm * BM + wr * 64 + fr, col0 = u.pn * BM + wc * 32 + 8 * fq;
#pragma unroll
        for (int ai = 0; ai < 2; ++ai)
#pragma unroll
            for (int m = 0; m < 4; ++m) { const size_t off = (size_t)(row0 + ai * HALF + m * 16) * D + col0;
#pragma unroll
                for (int bj = 0; bj < 2; ++bj) { const u32x4 xv = *(const u32x4*)(X + off + bj * HALF);
                    f32x4 v0 = acc[ai][bj][m][0], v1 = acc[ai][bj][m][1];
                    v0[0] += ALPHA * lo16(xv.x); v0[1] += ALPHA * hi16(xv.x); v0[2] += ALPHA * lo16(xv.y); v0[3] += ALPHA * hi16(xv.y);
                    v1[0] += ALPHA * lo16(xv.z); v1[1] += ALPHA * hi16(xv.z); v1[2] += ALPHA * lo16(xv.w); v1[3] += ALPHA * hi16(xv.w);
                    *(u32x4*)(O + off + bj * HALF) = pack8(v0, v1); } }
    }
};
struct EpiMoe1 {
    bf16* Hb;
    __device__ __forceinline__ void operator()(const f32x4 (&acc)[2][2][4][2], const Unit& u, int wr, int wc, int fr, int fq) const {
        const int row0 = u.pm * BM + wr * 64 + fr, col0 = u.pn * HALF + wc * 32 + 8 * fq;
#pragma unroll
        for (int ai = 0; ai < 2; ++ai)
#pragma unroll
            for (int m = 0; m < 4; ++m) {
                f32x4 g0 = acc[ai][0][m][0], g1 = acc[ai][0][m][1]; const f32x4 u0 = acc[ai][1][m][0], u1 = acc[ai][1][m][1];
#pragma unroll
                for (int q = 0; q < 4; ++q) { g0[q] = g0[q] * sigmoidf_(g0[q]) * u0[q]; g1[q] = g1[q] * sigmoidf_(g1[q]) * u1[q]; }
                *(u32x4*)(Hb + (size_t)(row0 + ai * HALF + m * 16) * DE + col0) = pack8(g0, g1); }
    }
};
struct EpiMoe2 {
    bf16* Y; const int* list; const float* gate; const LAS int* tab;
    __device__ __forceinline__ void operator()(const f32x4 (&acc)[2][2][4][2], const Unit& u, int wr, int wc, int fr, int fq) const {
        const int col0 = u.pn * BM + wc * 32 + 8 * fq; const int cnt = tab[32 + u.e];
#pragma unroll
        for (int ai = 0; ai < 2; ++ai)
#pragma unroll
            for (int m = 0; m < 4; ++m) { const int pos = u.j * BM + ai * HALF + wr * 64 + m * 16 + fr;
                if (pos < cnt) { const int a = list[(size_t)u.e * LCAP + pos]; const float g = gate[a];
#pragma unroll
                    for (int bj = 0; bj < 2; ++bj) *(u32x4*)(Y + (size_t)a * D + col0 + bj * HALF) = pack8(acc[ai][bj][m][0] * g, acc[ai][bj][m][1] * g); } }
    }
};
}

struct Args {
    const float* in[32]; float* out; unsigned char* ws;
    int l_lo, l_hi, ph_lo, ph_hi;
    int use_bar, pad;
};
enum { I_X = 0, I_WIN, I_MU, I_W0, I_WUP, I_A0, I_AUP, I_GUP, I_KK, I_KA, I_RK, I_LNG, I_LNB, I_CW, I_CB, I_WA, I_BA, I_WX, I_BX, I_LAM, I_LRUG, I_SBAG,
       I_WOUT, I_LN1G, I_LN1B, I_LN2G, I_LN2B, I_RW, I_RB, I_EG, I_EU, I_ED };
constexpr int NPH = 8;

__device__ __forceinline__ void transpose_item(const float* W, int N, bf16* WT, int pitch, int drow0, int k0, int n0, float* scr, int lane) {
#pragma unroll 8
    for (int i = 0; i < 32; ++i) { const int kk = 2 * i + (lane >> 5); scr[kk * 33 + (lane & 31)] = W[(size_t)(k0 + kk) * N + n0 + (lane & 31)]; }
    asm volatile("s_waitcnt lgkmcnt(0)" ::: "memory");
    const int c = lane & 7;
#pragma unroll
    for (int j = 0; j < 4; ++j) { const int n = (lane >> 3) + 8 * j; const float* s = scr + (8 * c) * 33 + n;
        u32x4 o; o.x = pk2(s[0 * 33], s[1 * 33]); o.y = pk2(s[2 * 33], s[3 * 33]); o.z = pk2(s[4 * 33], s[5 * 33]); o.w = pk2(s[6 * 33], s[7 * 33]);
        *(u32x4*)(WT + (size_t)(drow0 + n) * pitch + k0 + 8 * c) = o; }
    asm volatile("s_waitcnt lgkmcnt(0)" ::: "memory");
}
__device__ __forceinline__ void phase_convert(const int tid, const Args& A, int layer, float* ldsf, int vcu, int G) {
    const int lane = tid & 63, wave = tid >> 6;
    float* scr = ldsf + wave * 4096;
    unsigned char* ws = A.ws;
    bf16* Win = (bf16*)(ws + WS_WIN); bf16* Wout = (bf16*)(ws + WS_WOUT); bf16* Wgu = (bf16*)(ws + WS_WGU); bf16* Wdn = (bf16*)(ws + WS_WDN);
    bf16* WupT = (bf16*)(ws + WS_WSM); bf16* AupT = WupT + 384 * 64; bf16* GupT = AupT + 384 * 64;
    const int gw = vcu * NWAVES + wave, NGW = G * NWAVES;
    constexpr int I_IN = 16 * 96, I_OUT = 16 * 32, I_G = 16 * 256, I_U = 16 * 256, I_D = 16 * 256, I_S1 = 12, I_S2 = 12, I_S3 = 24;
    constexpr int NIT = I_IN + I_OUT + I_G + I_U + I_D + I_S1 + I_S2 + I_S3;
    for (int it = gw; it < NIT; it += NGW) {
        int r = it;
        if (r < I_IN) { const int kb = r / 96, nb = r % 96; transpose_item(A.in[I_WIN] + (size_t)layer * D * INC, INC, Win, D, 32 * nb, 64 * kb, 32 * nb, scr, lane); continue; } r -= I_IN;
        if (r < I_OUT) { const int kb = r / 32, nb = r % 32; transpose_item(A.in[I_WOUT] + (size_t)layer * D * D, D, Wout, D, 32 * nb, 64 * kb, 32 * nb, scr, lane); continue; } r -= I_OUT;
        if (r < I_G + I_U) { const int up = r >= I_G; if (up) r -= I_G; const int e = r / 256, q = r % 256, kb = q / 16, nb = q % 16, n0 = 32 * nb;
            const float* src = A.in[up ? I_EU : I_EG] + ((size_t)layer * NE + e) * D * DE;
            transpose_item(src, DE, Wgu, D, e * 1024 + (n0 >> 7) * 256 + up * 128 + (n0 & 127), 64 * kb, n0, scr, lane); continue; } r -= I_G + I_U;
        if (r < I_D) { const int e = r / 256, q = r % 256, kb = q / 32, nb = q % 32;
            transpose_item(A.in[I_ED] + ((size_t)layer * NE + e) * DE * D, D, Wdn, DE, e * 1024 + 32 * nb, 64 * kb, 32 * nb, scr, lane); continue; } r -= I_D;
        if (r < I_S1) { transpose_item(A.in[I_WUP] + (size_t)layer * 64 * RW, RW, WupT, 64, 32 * r, 0, 32 * r, scr, lane); continue; } r -= I_S1;
        if (r < I_S2) { transpose_item(A.in[I_AUP] + (size_t)layer * 64 * RW, RW, AupT, 64, 32 * r, 0, 32 * r, scr, lane); continue; } r -= I_S2;
        { const int kb = r / 12, nb = r % 12; transpose_item(A.in[I_GUP] + (size_t)layer * 128 * RW, RW, GupT, 128, 32 * nb, 64 * kb, 32 * nb, scr, lane); }
    }
    if (layer == 0) {
        const f32x4* x4 = (const f32x4*)A.in[I_X]; u32x4* o = (u32x4*)(ws + WS_XB);
        const size_t n8 = (size_t)M * D / 8;
        for (size_t i = (size_t)vcu * NTHR + tid; i < n8; i += (size_t)G * NTHR) { const f32x4 a = x4[2 * i], b = x4[2 * i + 1]; o[i] = pg8::pack8(a, b); }
    }
}

__device__ __forceinline__ void attn_unit(const int tid, const Args& A, int layer, int bh, int qb, unsigned char* lds) {
    const int lane = tid & 63, wave = __builtin_amdgcn_readfirstlane(tid >> 6), r = lane & 31, hh = lane >> 5;
    const int b = bh / SH, h = bh % SH;
    const bf16* P = (const bf16*)(A.ws + WS_P) + (size_t)b * SEQ * INC;
    bf16* MIX = (bf16*)(A.ws + WS_MIX) + (size_t)b * SEQ * D;
    bf16* Ks = (bf16*)lds;
    bf16* Vt = (bf16*)(lds + 64 * 72 * 2);
    const int q0w = qb * 256 + wave * 32;
    bf16x8 qr[4];
#pragma unroll
    for (int s = 0; s < 4; ++s) qr[s] = *(const bf16x8*)(P + (size_t)(q0w + r) * INC + PC_SQ + h * 64 + 16 * s + 8 * hh);
    f32x16 o0 = {}, o1 = {};
    float Rrun = 1.0f;
    const int qmine = q0w + r;
    const int lkey = tid >> 3, lch = (tid & 7) * 8;
    int jt = 4 * qb + 3;
    u32x4 kreg = *(const u32x4*)(P + (size_t)(64 * jt + lkey) * INC + PC_SK + h * 64 + lch);
    u32x4 vreg = *(const u32x4*)(P + (size_t)(64 * jt + lkey) * INC + PC_SV + h * 64 + lch);
    for (; jt >= 0; --jt) {
        __syncthreads();
        *(u32x4*)(Ks + lkey * 72 + lch) = kreg;
        { const unsigned short* vs = (const unsigned short*)&vreg;
#pragma unroll
          for (int i = 0; i < 8; ++i) Vt[(lch + i) * 72 + lkey] = vs[i]; }
        __syncthreads();
        if (jt > 0) {
            kreg = *(const u32x4*)(P + (size_t)(64 * (jt - 1) + lkey) * INC + PC_SK + h * 64 + lch);
            vreg = *(const u32x4*)(P + (size_t)(64 * (jt - 1) + lkey) * INC + PC_SV + h * 64 + lch);
        }
        const int k0 = 64 * jt;
        if (k0 >= q0w + 31) continue;
        f32x16 p0 = {}, p1 = {};
#pragma unroll
        for (int s = 0; s < 4; ++s) {
            const bf16x8 ka = *(const bf16x8*)(Ks + r * 72 + 16 * s + 8 * hh);
            const bf16x8 kb = *(const bf16x8*)(Ks + (32 + r) * 72 + 16 * s + 8 * hh);
            p0 = __builtin_amdgcn_mfma_f32_32x32x16_bf16(ka, qr[s], p0, 0, 0, 0);
            p1 = __builtin_amdgcn_mfma_f32_32x32x16_bf16(kb, qr[s], p1, 0, 0, 0);
        }
        const bool need_mask = (k0 + 63 >= q0w);
        float pa[8];
#pragma unroll
        for (int g = 0; g < 8; ++g) {
            float kp[4], sg[4];
#pragma unroll
            for (int i = 0; i < 4; ++i) {
                const float z = (g < 4) ? p0[4 * g + i] : p1[4 * (g - 4) + i];
                const float e = __builtin_amdgcn_exp2f(z);
                float kk = __builtin_amdgcn_rcpf(1.0f + e);
                float s_ = 1.0f - kk;
                if (need_mask) { const int key = k0 + 32 * (g >> 2) + 8 * (g & 3) + 4 * hh + i; if (key >= qmine) { kk = 1.0f; s_ = 0.0f; } }
                kp[i] = kk; sg[i] = s_;
            }
            const float x2 = kp[3], x1 = x2 * kp[2], x0 = x1 * kp[1];
            pa[g] = x0 * kp[0];
            const float v0 = sg[0] * x0, v1 = sg[1] * x1, v2 = sg[2] * x2, v3 = sg[3];
            if (g < 4) { p0[4 * g] = v0; p0[4 * g + 1] = v1; p0[4 * g + 2] = v2; p0[4 * g + 3] = v3; }
            else { p1[4 * (g - 4)] = v0; p1[4 * (g - 4) + 1] = v1; p1[4 * (g - 4) + 2] = v2; p1[4 * (g - 4) + 3] = v3; }
        }
        float pb[8];
#pragma unroll
        for (int g = 0; g < 8; ++g) pb[g] = __shfl_xor(pa[g], 32);
        float E[8];
        E[7] = hh ? 1.0f : pb[7];
#pragma unroll
        for (int g = 6; g >= 0; --g) E[g] = E[g + 1] * pa[g + 1] * (hh ? pb[g + 1] : pb[g]);
        const float T = E[0] * pa[0] * (hh ? pb[0] : 1.0f);
#pragma unroll
        for (int g = 0; g < 8; ++g) { const float re = E[g] * Rrun;
#pragma unroll
            for (int i = 0; i < 4; ++i) { if (g < 4) p0[4 * g + i] *= re; else p1[4 * (g - 4) + i] *= re; } }
        Rrun *= T;
#pragma unroll
        for (int s = 0; s < 4; ++s) {
            u32x4 pw;
            if (s < 2) { pw.x = pk2(p0[8 * s], p0[8 * s + 1]); pw.y = pk2(p0[8 * s + 2], p0[8 * s + 3]); pw.z = pk2(p0[8 * s + 4], p0[8 * s + 5]); pw.w = pk2(p0[8 * s + 6], p0[8 * s + 7]); }
            else { const int s2 = s - 2; pw.x = pk2(p1[8 * s2], p1[8 * s2 + 1]); pw.y = pk2(p1[8 * s2 + 2], p1[8 * s2 + 3]); pw.z = pk2(p1[8 * s2 + 4], p1[8 * s2 + 5]); pw.w = pk2(p1[8 * s2 + 6], p1[8 * s2 + 7]); }
            const bf16x8 pf = __builtin_bit_cast(bf16x8, pw);
            const int kb = 16 * s;
            { const s16x4 lo = *(const s16x4*)(Vt + r * 72 + kb + 4 * hh), hi = *(const s16x4*)(Vt + r * 72 + kb + 8 + 4 * hh);
              const bf16x8 vf = __builtin_shufflevector(lo, hi, 0, 1, 2, 3, 4, 5, 6, 7);
              o0 = __builtin_amdgcn_mfma_f32_32x32x16_bf16(vf, pf, o0, 0, 0, 0); }
            { const s16x4 lo = *(const s16x4*)(Vt + (32 + r) * 72 + kb + 4 * hh), hi = *(const s16x4*)(Vt + (32 + r) * 72 + kb + 8 + 4 * hh);
              const bf16x8 vf = __builtin_shufflevector(lo, hi, 0, 1, 2, 3, 4, 5, 6, 7);
              o1 = __builtin_amdgcn_mfma_f32_32x32x16_bf16(vf, pf, o1, 0, 0, 0); }
        }
    }
    float ss = 0.f;
#pragma unroll
    for (int i = 0; i < 16; ++i) ss += o0[i] * o0[i] + o1[i] * o1[i];
    ss += __shfl_xor(ss, 32);
    const float sc = rsqrtf(ss * (1.0f / 64.0f) + RMS_EPS);
    const float* ng = A.in[I_SBAG] + layer * SW + h * 64;
    bf16* orow = MIX + (size_t)(q0w + r) * D + MIX_S + h * 64;
#pragma unroll
    for (int g = 0; g < 4; ++g) {
        const int d = 8 * g + 4 * hh;
        const f32x4 g0 = *(const f32x4*)(ng + d), g1 = *(const f32x4*)(ng + 32 + d);
        u32x2 w0, w1;
        w0.x = pk2(o0[4 * g] * sc * g0[0], o0[4 * g + 1] * sc * g0[1]); w0.y = pk2(o0[4 * g + 2] * sc * g0[2], o0[4 * g + 3] * sc * g0[3]);
        w1.x = pk2(o1[4 * g] * sc * g1[0], o1[4 * g + 1] * sc * g1[1]); w1.y = pk2(o1[4 * g + 2] * sc * g1[2], o1[4 * g + 3] * sc * g1[3]);
        *(u32x2*)(orow + d) = w0; *(u32x2*)(orow + 32 + d) = w1;
    }
    __syncthreads();
}

constexpr int RT = 32;
__device__ __forceinline__ void rwkv_unit(const int tid, const Args& A, int layer, int bh, unsigned char* lds) {
    const int lane = tid & 63, wave = __builtin_amdgcn_readfirstlane(tid >> 6);
    const int b = bh / RH, h = bh % RH;
    const bf16* P = (const bf16*)(A.ws + WS_P) + (size_t)b * SEQ * INC;
    bf16* MIX = (bf16*)(A.ws + WS_MIX) + (size_t)b * SEQ * D;
    float* rS = (float*)lds; float* kS = rS + RT * 64; float* vS = kS + RT * 64; float* wS = vS + RT * 64; float* aS = wS + RT * 64;
    float* gS = aS + RT * 64; float* nS = gS + RT * 64; float* oS = nS + RT * 64; float* rho = oS + RT * 64;
    bf16* AL = (bf16*)(rho + 64);
    const bf16* WupT = (const bf16*)(A.ws + WS_WSM); const bf16* AupT = WupT + 384 * 64; const bf16* GupT = AupT + 384 * 64;
    const float* mu = A.in[I_MU] + layer * RCOLS;
    const int c4 = (tid & 15) * 4, tk = tid >> 4, ch = h * 64 + c4;
    const f32x4 w0v = *(const f32x4*)(A.in[I_W0] + layer * RW + ch), a0v = *(const f32x4*)(A.in[I_A0] + layer * RW + ch);
    const f32x4 kkv = *(const f32x4*)(A.in[I_KK] + layer * RW + ch), kav = *(const f32x4*)(A.in[I_KA] + layer * RW + ch);
    const f32x4 rkv = *(const f32x4*)(A.in[I_RK] + layer * RW + ch), lgv = *(const f32x4*)(A.in[I_LNG] + layer * RW + ch), lbv = *(const f32x4*)(A.in[I_LNB] + layer * RW + ch);
    const int vl = lane >> 3, kq = lane & 7;
    float s[8];
#pragma unroll
    for (int j = 0; j < 8; ++j) s[j] = 0.f;
    for (int t0 = 0; t0 < SEQ; t0 += RT) {
        for (int it = 0; it < 4; ++it) {
            const int item = tid + NTHR * it;
            if (item < RT * 56) {
                const int tok = item / 56, cg = item % 56, c = cg * 8;
                const int pc = (c < 64) ? (PC_R + h * 64 + c) : (c < 128) ? (PC_K + h * 64 + c - 64) : (c < 192) ? (PC_V + h * 64 + c - 128) : (c + 960);
                const int t = t0 + tok;
                const u32x4 cu = *(const u32x4*)(P + (size_t)t * INC + pc);
                u32x4 pv = {0u, 0u, 0u, 0u};
                if (t > 0) pv = *(const u32x4*)(P + (size_t)(t - 1) * INC + pc);
                const f32x4 m0 = *(const f32x4*)(mu + pc), m1 = *(const f32x4*)(mu + pc + 4);
                float v[8];
                { float c_, p_;
                  c_ = lo16(cu.x); p_ = lo16(pv.x); v[0] = c_ + m0[0] * (p_ - c_); c_ = hi16(cu.x); p_ = hi16(pv.x); v[1] = c_ + m0[1] * (p_ - c_);
                  c_ = lo16(cu.y); p_ = lo16(pv.y); v[2] = c_ + m0[2] * (p_ - c_); c_ = hi16(cu.y); p_ = hi16(pv.y); v[3] = c_ + m0[3] * (p_ - c_);
                  c_ = lo16(cu.z); p_ = lo16(pv.z); v[4] = c_ + m1[0] * (p_ - c_); c_ = hi16(cu.z); p_ = hi16(pv.z); v[5] = c_ + m1[1] * (p_ - c_);
                  c_ = lo16(cu.w); p_ = lo16(pv.w); v[6] = c_ + m1[2] * (p_ - c_); c_ = hi16(cu.w); p_ = hi16(pv.w); v[7] = c_ + m1[3] * (p_ - c_); }
                if (c < 192) {
                    float* dst = ((c < 64) ? rS : (c < 128) ? kS : vS) + tok * 64 + (c & 63);
                    *(f32x4*)dst = (f32x4){v[0], v[1], v[2], v[3]}; *(f32x4*)(dst + 4) = (f32x4){v[4], v[5], v[6], v[7]};
                } else {
                    if (c < 256) {
#pragma unroll
                        for (int i = 0; i < 8; ++i) v[i] = tanhf(v[i]);
                    } else if (c >= 320) {
#pragma unroll
                        for (int i = 0; i < 8; ++i) v[i] = sigmoidf_(v[i]);
                    }
                    u32x4 w; w.x = pk2(v[0], v[1]); w.y = pk2(v[2], v[3]); w.z = pk2(v[4], v[5]); w.w = pk2(v[6], v[7]);
                    *(u32x4*)(AL + tok * 264 + (c - 192)) = w;
                }
            }
        }
        __syncthreads();
#pragma unroll
        for (int q = 0; q < 3; ++q) {
            const int idx = wave * 3 + q, mtx = idx >> 3, tt = (idx >> 2) & 1, jt = idx & 3;
            const int Kd = (mtx == 2) ? 128 : 64, koff = (mtx == 0) ? 0 : (mtx == 1) ? 64 : 128;
            const bf16* Wt = (mtx == 0) ? WupT : (mtx == 1) ? AupT : GupT;
            f32x4 acc = {0.f, 0.f, 0.f, 0.f};
            for (int ks = 0; ks < Kd / 32; ++ks) {
                const bf16x8 af = *(const bf16x8*)(Wt + (size_t)(h * 64 + 16 * jt + (lane & 15)) * Kd + 32 * ks + 8 * (lane >> 4));
                const bf16x8 bfr = *(const bf16x8*)(AL + (16 * tt + (lane & 15)) * 264 + koff + 32 * ks + 8 * (lane >> 4));
                acc = __builtin_amdgcn_mfma_f32_16x16x32_bf16(af, bfr, acc, 0, 0, 0);
            }
            float* dst = (mtx == 0) ? wS : (mtx == 1) ? aS : gS;
            *(f32x4*)(dst + (16 * tt + (lane & 15)) * 64 + 16 * jt + 4 * (lane >> 4)) = acc;
        }
        __syncthreads();
        {
            const f32x4 wp = *(const f32x4*)(wS + tk * 64 + c4), ap = *(const f32x4*)(aS + tk * 64 + c4);
            const f32x4 kv = *(const f32x4*)(kS + tk * 64 + c4), rv = *(const f32x4*)(rS + tk * 64 + c4);
            f32x4 dec, av, kkx, kt; float n2 = 0.f, rp = 0.f;
#pragma unroll
            for (int i = 0; i < 4; ++i) {
                const float wl = -softplusf_(-(w0v[i] + wp[i])) - 0.5f;
                dec[i] = __expf(-__expf(wl));
                av[i] = sigmoidf_(a0v[i] + ap[i]);
                kkx[i] = kv[i] * kkv[i]; n2 += kkx[i] * kkx[i];
                kt[i] = kv[i] * (1.0f + (av[i] - 1.0f) * kav[i]);
                rp += rv[i] * kt[i] * rkv[i];
            }
            n2 = red16(n2); rp = red16(rp);
            const float inv = 1.0f / fmaxf(sqrtf(n2), 1e-12f);
            f32x4 nk, bh_;
#pragma unroll
            for (int i = 0; i < 4; ++i) { const float kkn = kkx[i] * inv; nk[i] = -kkn; bh_[i] = kkn * av[i]; }
            *(f32x4*)(wS + tk * 64 + c4) = dec; *(f32x4*)(aS + tk * 64 + c4) = bh_; *(f32x4*)(kS + tk * 64 + c4) = kt; *(f32x4*)(nS + tk * 64 + c4) = nk;
            if ((tid & 15) == 0) rho[tk] = rp;
        }
        __syncthreads();
        for (int t = 0; t < RT; ++t) {
            const f32x4 wa = *(const f32x4*)(wS + t * 64 + 8 * kq), wb = *(const f32x4*)(wS + t * 64 + 8 * kq + 4);
            const f32x4 na = *(const f32x4*)(nS + t * 64 + 8 * kq), nb = *(const f32x4*)(nS + t * 64 + 8 * kq + 4);
            const f32x4 ba = *(const f32x4*)(aS + t * 64 + 8 * kq), bb = *(const f32x4*)(aS + t * 64 + 8 * kq + 4);
            const f32x4 ka = *(const f32x4*)(kS + t * 64 + 8 * kq), kb = *(const f32x4*)(kS + t * 64 + 8 * kq + 4);
            const f32x4 ra = *(const f32x4*)(rS + t * 64 + 8 * kq), rb = *(const f32x4*)(rS + t * 64 + 8 * kq + 4);
            const float vv = vS[t * 64 + 8 * wave + vl];
            float sa = (s[0] * na[0] + s[1] * na[1]) + (s[2] * na[2] + s[3] * na[3]) + (s[4] * nb[0] + s[5] * nb[1]) + (s[6] * nb[2] + s[7] * nb[3]);
            sa = red8(sa);
            s[0] = s[0] * wa[0] + sa * ba[0] + vv * ka[0]; s[1] = s[1] * wa[1] + sa * ba[1] + vv * ka[1];
            s[2] = s[2] * wa[2] + sa * ba[2] + vv * ka[2]; s[3] = s[3] * wa[3] + sa * ba[3] + vv * ka[3];
            s[4] = s[4] * wb[0] + sa * bb[0] + vv * kb[0]; s[5] = s[5] * wb[1] + sa * bb[1] + vv * kb[1];
            s[6] = s[6] * wb[2] + sa * bb[2] + vv * kb[2]; s[7] = s[7] * wb[3] + sa * bb[3] + vv * kb[3];
            float o = (s[0] * ra[0] + s[1] * ra[1]) + (s[2] * ra[2] + s[3] * ra[3]) + (s[4] * rb[0] + s[5] * rb[1]) + (s[6] * rb[2] + s[7] * rb[3]);
            o = red8(o);
            if (kq == 0) oS[t * 64 + 8 * wave + vl] = o;
        }
        __syncthreads();
        {
            const f32x4 ov = *(const f32x4*)(oS + tk * 64 + c4), vv = *(const f32x4*)(vS + tk * 64 + c4), gv = *(const f32x4*)(gS + tk * 64 + c4);
            float sm = (ov[0] + ov[1]) + (ov[2] + ov[3]); sm = red16(sm);
            const float mean = sm * (1.0f / 64.0f);
            float q2 = 0.f;
#pragma unroll
            for (int i = 0; i < 4; ++i) { const float d_ = ov[i] - mean; q2 += d_ * d_; }
            q2 = red16(q2);
            const float rstd = rsqrtf(q2 * (1.0f / 64.0f) + GN_EPS), rh = rho[tk];
            float y[4];
#pragma unroll
            for (int i = 0; i < 4; ++i) y[i] = ((ov[i] - mean) * rstd * lgv[i] + lbv[i] + rh * vv[i]) * gv[i];
            u32x2 w; w.x = pk2(y[0], y[1]); w.y = pk2(y[2], y[3]);
            *(u32x2*)(MIX + (size_t)(t0 + tk) * D + MIX_R + ch) = w;
        }
        __syncthreads();
    }
}

constexpr int LT = 8;
__device__ __forceinline__ float gelu_tanh(float x) { const float u = 0.7978845608028654f * (x + 0.044715f * x * x * x); return 0.5f * x * (1.0f + tanhf(u)); }
__device__ __forceinline__ void lru_unit(const int tid, const Args& A, int layer, int bg, unsigned char* lds) {
    const int lane = tid & 63, wave = __builtin_amdgcn_readfirstlane(tid >> 6);
    const int b = bg / LB, g = bg % LB, c = g * 64 + lane;
    const bf16* P = (const bf16*)(A.ws + WS_P) + (size_t)b * SEQ * INC;
    bf16* MIX = (bf16*)(A.ws + WS_MIX) + (size_t)b * SEQ * D;
    float* xcS = (float*)lds + wave * 64;
    float* totA = (float*)lds + 8 * 64;
    float* totH = totA + 8 * 64;
    float* carryS = totH + 8 * 64;
    const float* wa = A.in[I_WA] + ((size_t)layer * LB + g) * 4096; const float* wx = A.in[I_WX] + ((size_t)layer * LB + g) * 4096;
    float* wxS = carryS + 64;
    float war[64];
#pragma unroll
    for (int i = 0; i < 64; ++i) war[i] = wa[i * 64 + lane];
    for (int i = tid; i < 4096; i += NTHR) wxS[i] = wx[i];
    const float cw0 = A.in[I_CW][(layer * 4 + 0) * LW + c], cw1 = A.in[I_CW][(layer * 4 + 1) * LW + c], cw2 = A.in[I_CW][(layer * 4 + 2) * LW + c], cw3 = A.in[I_CW][(layer * 4 + 3) * LW + c];
    const float cb = A.in[I_CB][layer * LW + c], ba = A.in[I_BA][layer * LW + c], bx = A.in[I_BX][layer * LW + c];
    const float sp8 = 8.0f * softplusf_(-A.in[I_LAM][layer * LW + c]);
    const float ng = A.in[I_LRUG][layer * LW + c];
    if (tid < 64) carryS[tid] = 0.f;
    __syncthreads();
    for (int st = 0; st < SEQ; st += 8 * LT) {
        const int T0 = st + wave * LT;
        float xm3 = (T0 >= 3) ? bf2f(P[(size_t)(T0 - 3) * INC + PC_LX + c]) : 0.f;
        float xm2 = (T0 >= 2) ? bf2f(P[(size_t)(T0 - 2) * INC + PC_LX + c]) : 0.f;
        float xm1 = (T0 >= 1) ? bf2f(P[(size_t)(T0 - 1) * INC + PC_LX + c]) : 0.f;
        float xin[LT], gin[LT];
#pragma unroll
        for (int t = 0; t < LT; ++t) { xin[t] = bf2f(P[(size_t)(T0 + t) * INC + PC_LX + c]); gin[t] = bf2f(P[(size_t)(T0 + t) * INC + PC_LG + c]); }
        float hl[LT], Ac[LT];
        float hrun = 0.f, arun = 1.f;
#pragma unroll
        for (int t = 0; t < LT; ++t) {
            const float xc = cw0 * xm3 + cw1 * xm2 + cw2 * xm1 + cw3 * xin[t] + cb;
            xm3 = xm2; xm2 = xm1; xm1 = xin[t];
            xcS[lane] = xc;
            asm volatile("s_waitcnt lgkmcnt(0)" ::: "memory");
            float ga = ba, gx = bx;
#pragma unroll
            for (int i4 = 0; i4 < 16; ++i4) { const f32x4 xv = *(const f32x4*)(xcS + 4 * i4);
                ga += xv[0] * war[4 * i4] + xv[1] * war[4 * i4 + 1] + xv[2] * war[4 * i4 + 2] + xv[3] * war[4 * i4 + 3];
                gx += xv[0] * wxS[(4 * i4) * 64 + lane] + xv[1] * wxS[(4 * i4 + 1) * 64 + lane] + xv[2] * wxS[(4 * i4 + 2) * 64 + lane] + xv[3] * wxS[(4 * i4 + 3) * 64 + lane]; }
            asm volatile("s_waitcnt lgkmcnt(0)" ::: "memory");
            const float la = -sp8 * sigmoidf_(ga);
            const float a = __expf(la);
            const float bi = sqrtf(-expm1f(2.0f * la)) * sigmoidf_(gx) * xc;
            hrun = a * hrun + bi; arun *= a;
            hl[t] = hrun; Ac[t] = arun;
        }
        totA[wave * 64 + lane] = arun; totH[wave * 64 + lane] = hrun;
        __syncthreads();
        float cin = carryS[lane];
        for (int u = 0; u < wave; ++u) cin = totA[u * 64 + lane] * cin + totH[u * 64 + lane];
        float cout = cin;
        if (wave == 7) cout = totA[7 * 64 + lane] * cin + totH[7 * 64 + lane];
#pragma unroll
        for (int t = 0; t < LT; ++t) {
            const float hv = hl[t] + Ac[t] * cin;
            const float y = gelu_tanh(gin[t]) * hv;
            const float ss = red64(y * y);
            const float o = y * rsqrtf(ss * (1.0f / 64.0f) + RMS_EPS) * ng;
            ((unsigned short*)MIX)[(size_t)(T0 + t) * D + MIX_L + c] = (unsigned short)(pk2(o, 0.f) & 0xffffu);
        }
        __syncthreads();
        if (wave == 7) carryS[lane] = cout;
        __syncthreads();
    }
}

__device__ __forceinline__ void phase_mixers(const int tid, const Args& A, int layer, unsigned char* lds, volatile LAS unsigned* misc) {
    unsigned* qhead = (unsigned*)(A.ws + WS_CTL) + CW_Q + layer * 64;
    constexpr int NU = 96 + 64 + 96 * 16;
    for (;;) {
        __syncthreads();
        if (tid == 0) misc[4] = __hip_atomic_fetch_add(qhead, 1u, __ATOMIC_RELAXED, __HIP_MEMORY_SCOPE_AGENT);
        __syncthreads();
        const int u = (int)misc[4];
        if (u >= NU) break;
#ifndef UMASK
#define UMASK 7
#endif
        if (u < 96) { if (UMASK & 1) rwkv_unit(tid, A, layer, u, lds); }
        else if (u < 160) { if (UMASK & 2) lru_unit(tid, A, layer, u - 96, lds); }
        else { const int a = u - 160; if (UMASK & 4) attn_unit(tid, A, layer, a % 96, 15 - a / 96, lds); }
    }
}

__device__ __forceinline__ void phase_ln1_router(const int tid, const Args& A, int layer, unsigned char* lds, int vcu, int G) {
    const int lane = tid & 63, wave = tid >> 6;
    float* rwT = (float*)lds;
    int* hist = (int*)(lds + 65536);
    int* rowinfo = (int*)(lds + 65536 + 256);
    bf16* X1 = (bf16*)(A.ws + WS_X1);
    int* list = (int*)(A.ws + WS_LIST); float* gate = (float*)(A.ws + WS_GATE);
    unsigned* gcnt = (unsigned*)(A.ws + WS_CTL) + CW_CNT + layer * 64;
    const float* rw = A.in[I_RW];
    for (int i = tid; i < 16 * 1024; i += NTHR) { const int c = i >> 4, e = i & 15; rwT[e * 1024 + c] = rw[i]; }
    float rb[16];
#pragma unroll
    for (int e = 0; e < 16; ++e) rb[e] = A.in[I_RB][e];
    const float* g1 = A.in[I_LN1G] + layer * D; const float* b1 = A.in[I_LN1B] + layer * D;
    const int rows_per = M / G;
    for (int chunk = 0; chunk < rows_per / 256; ++chunk) {
        const int base = vcu * rows_per + chunk * 256;
        if (tid < 16) hist[tid] = 0;
        __syncthreads();
        for (int rp = 0; rp < 16; ++rp) {
            const int lr = wave * 32 + rp * 2;
            float y[2][16];
#pragma unroll
            for (int q = 0; q < 2; ++q) {
                const bf16* xr = X1 + (size_t)(base + lr + q) * D;
                float v[16]; float sm = 0.f;
#pragma unroll
                for (int i = 0; i < 16; ++i) { v[i] = bf2f(xr[lane + 64 * i]); sm += v[i]; }
                const float mean = red64(sm) * (1.0f / D); float s2 = 0.f;
#pragma unroll
                for (int i = 0; i < 16; ++i) { v[i] -= mean; s2 += v[i] * v[i]; }
                const float rstd = rsqrtf(red64(s2) * (1.0f / D) + LN_EPS);
#pragma unroll
                for (int i = 0; i < 16; ++i) y[q][i] = v[i] * rstd * g1[lane + 64 * i] + b1[lane + 64 * i];
                bf16* xo = X1 + (size_t)(base + lr + q) * D;
#pragma unroll
                for (int i = 0; i < 16; ++i) xo[lane + 64 * i] = (unsigned short)(pk2(y[q][i], 0.f) & 0xffffu);
            }
            float lg[2][16];
#pragma unroll
            for (int e = 0; e < 16; ++e) { float a0 = 0.f, a1 = 0.f;
#pragma unroll
                for (int i = 0; i < 16; ++i) { const float w = rwT[e * 1024 + lane + 64 * i]; a0 += y[0][i] * w; a1 += y[1][i] * w; }
                lg[0][e] = red64(a0) + rb[e]; lg[1][e] = red64(a1) + rb[e]; }
#pragma unroll
            for (int q = 0; q < 2; ++q) {
                float mx = lg[q][0];
#pragma unroll
                for (int e = 1; e < 16; ++e) mx = fmaxf(mx, lg[q][e]);
                float sc[16], den = 0.f;
#pragma unroll
                for (int e = 0; e < 16; ++e) { sc[e] = __expf(lg[q][e] - mx); den += sc[e]; }
                const float inv = 1.0f / den;
#pragma unroll
                for (int e = 0; e < 16; ++e) sc[e] *= inv;
                int sel = 0; float best = -1.f;
#pragma unroll
                for (int gq = 0; gq < 4; ++gq) {
                    const float a = sc[4 * gq], b_ = sc[4 * gq + 1], c_ = sc[4 * gq + 2], d_ = sc[4 * gq + 3];
                    const float m1 = fmaxf(fmaxf(a, b_), fmaxf(c_, d_));
                    const float m2 = fmaxf(fmaxf(fminf(a, b_), fminf(c_, d_)), fminf(fmaxf(a, b_), fmaxf(c_, d_)));
                    const float gs = m1 + m2;
                    if (gs > best) { best = gs; sel = gq; }
                }
                float cd[4];
#pragma unroll
                for (int i = 0; i < 4; ++i) cd[i] = (sel == 0) ? sc[i] : (sel == 1) ? sc[4 + i] : (sel == 2) ? sc[8 + i] : sc[12 + i];
                int i0 = 0; float v0 = cd[0];
#pragma unroll
                for (int i = 1; i < 4; ++i) if (cd[i] > v0) { v0 = cd[i]; i0 = i; }
                int i1 = -1; float v1 = -1.f;
#pragma unroll
                for (int i = 0; i < 4; ++i) if (i != i0 && cd[i] > v1) { v1 = cd[i]; i1 = i; }
                const int e0 = sel * 4 + i0, e1 = sel * 4 + i1;
                const float gsum = v0 + v1;
                if (lane == 0) {
                    const int row = base + lr + q;
                    gate[2 * row] = v0 / gsum; gate[2 * row + 1] = v1 / gsum;
                    const int r0 = atomicAdd(&hist[e0], 1), r1 = atomicAdd(&hist[e1], 1);
                    rowinfo[2 * (lr + q)] = e0 | (r0 << 8); rowinfo[2 * (lr + q) + 1] = e1 | (r1 << 8);
                }
            }
        }
        __syncthreads();
        if (tid < 16) hist[16 + tid] = (int)__hip_atomic_fetch_add(gcnt + tid, (unsigned)hist[tid], __ATOMIC_RELAXED, __HIP_MEMORY_SCOPE_AGENT);
        __syncthreads();
        { const int info = rowinfo[tid]; const int e = info & 255, rk = info >> 8;
          list[(size_t)e * LCAP + hist[16 + e] + rk] = (base + (tid >> 1)) * 2 + (tid & 1); }
        __syncthreads();
    }
}

__device__ __forceinline__ void phase_ln2(const int tid, const Args& A, int layer, int vcu, int G) {
    const int lane = tid & 63, wave = tid >> 6;
    const bf16* X1 = (const bf16*)(A.ws + WS_X1); const bf16* YM = (const bf16*)(A.ws + WS_YM);
    bf16* XB = (bf16*)(A.ws + WS_XB);
    const float* g2 = A.in[I_LN2G] + layer * D; const float* b2 = A.in[I_LN2B] + layer * D;
    f32x4 gg[4], bb[4];
#pragma unroll
    for (int j = 0; j < 4; ++j) { gg[j] = *(const f32x4*)(g2 + 4 * lane + 256 * j); bb[j] = *(const f32x4*)(b2 + 4 * lane + 256 * j); }
    const int gw = vcu * NWAVES + wave, NGW = G * NWAVES;
    for (int row = gw; row < M; row += NGW) {
        f32x4 v[4]; float sm = 0.f;
#pragma unroll
        for (int j = 0; j < 4; ++j) {
            const u32x2 a = *(const u32x2*)(X1 + (size_t)row * D + 4 * lane + 256 * j);
            const u32x2 y0 = *(const u32x2*)(YM + (size_t)(2 * row) * D + 4 * lane + 256 * j);
            const u32x2 y1 = *(const u32x2*)(YM + (size_t)(2 * row + 1) * D + 4 * lane + 256 * j);
            v[j][0] = ALPHA * lo16(a.x) + lo16(y0.x) + lo16(y1.x); v[j][1] = ALPHA * hi16(a.x) + hi16(y0.x) + hi16(y1.x);
            v[j][2] = ALPHA * lo16(a.y) + lo16(y0.y) + lo16(y1.y); v[j][3] = ALPHA * hi16(a.y) + hi16(y0.y) + hi16(y1.y);
            sm += (v[j][0] + v[j][1]) + (v[j][2] + v[j][3]);
        }
        const float mean = red64(sm) * (1.0f / D); float s2 = 0.f;
#pragma unroll
        for (int j = 0; j < 4; ++j) { v[j] = v[j] - mean; s2 += (v[j][0] * v[j][0] + v[j][1] * v[j][1]) + (v[j][2] * v[j][2] + v[j][3] * v[j][3]); }
        const float rstd = rsqrtf(red64(s2) * (1.0f / D) + LN_EPS);
#pragma unroll
        for (int j = 0; j < 4; ++j) {
            const f32x4 o = v[j] * rstd * gg[j] + bb[j];
            if (layer == DEPTH - 1) *(f32x4*)(A.out + (size_t)row * D + 4 * lane + 256 * j) = o;
            else { u32x2 w; w.x = pk2(o[0], o[1]); w.y = pk2(o[2], o[3]); *(u32x2*)(XB + (size_t)row * D + 4 * lane + 256 * j) = w; }
        }
    }
}

__device__ __forceinline__ void moe_table(const int tid, const Args& A, int layer, LAS int* tab) {
    if (tid == 0) {
        const unsigned* gcnt = (const unsigned*)(A.ws + WS_CTL) + CW_CNT + layer * 64;
        int acc = 0;
        for (int e = 0; e < 16; ++e) { const int c = (int)__hip_atomic_load(gcnt + e, __ATOMIC_RELAXED, __HIP_MEMORY_SCOPE_AGENT); tab[e] = acc; tab[32 + e] = c; acc += (c + 255) >> 8; }
        tab[16] = acc;
    }
    __syncthreads();
}

__global__ void __launch_bounds__(NTHR, 2) fwd_kernel(Args args) {
    extern __shared__ __attribute__((aligned(16))) unsigned char lds[];
    LAS unsigned char* ldsl = (LAS unsigned char*)lds;
    volatile LAS unsigned* misc = (volatile LAS unsigned*)(ldsl + MISC_OFF);
    const int wave_s = __builtin_amdgcn_readfirstlane((int)threadIdx.x >> 6);
#define MKTID() ({ unsigned z_ = 0u; asm volatile("" : "+v"(z_)); (int)(wave_s * 64 + (int)__builtin_amdgcn_mbcnt_hi(~0u, __builtin_amdgcn_mbcnt_lo(~0u, z_))); })
    { const int tid = MKTID(); for (int u = tid; u < (LDS_BYTES - MISC_OFF) / 4; u += NTHR) misc[u] = 0u; }
    __syncthreads();
    const int G = gridDim.x, bx = blockIdx.x;
    const int vcu = (G % 8 == 0) ? (bx % 8) * (G / 8) + bx / 8 : bx;
    unsigned* ctl = (unsigned*)(args.ws + WS_CTL);
    XcdBarrier bar; bar.bar = ctl + CW_BAR; bar.x = 0; bar.st = nullptr;
    if (args.use_bar) bar = xcd_barrier_post(MKTID(), ctl + CW_BAR, misc + 8);
    LAS int* tab = (LAS int*)(ldsl + MISC_OFF + 256);
    const int lo = args.ph_lo, hi = args.ph_hi;
#ifndef PHMASK
#define PHMASK 0xFF
#endif
#define IN(k) (((PHMASK >> (k)) & 1) && lo <= (k) && (k) < hi)
#define SEAM(k) do { if (args.use_bar && !((k) == NPH - 1 && layer == args.l_hi - 1)) xcd_barrier(MKTID(), bar); } while (0)
    for (int layer = args.l_lo; layer < args.l_hi; ++layer) {
        if (IN(0)) { phase_convert(MKTID(), args, layer, (float*)lds, vcu, G); SEAM(0); }
        if (IN(1)) {
            pg8::DenseOrder S; S.init(M, INC, D, G, bx, args.ws + WS_WIN);
            pg8::EpiIn E{(bf16*)(args.ws + WS_P)};
            pg8::gemm_phase<pg8::EpiIn, pg8::DenseOrder, true>(MKTID(), ldsl, (const char*)(args.ws + WS_XB), D, S, E);
            SEAM(1);
        }
        if (IN(2)) { phase_mixers(MKTID(), args, layer, lds, misc); SEAM(2); }
        if (IN(3)) {
            pg8::DenseOrder S; S.init(M, D, D, G, bx, args.ws + WS_WOUT);
            pg8::EpiOut E{(const bf16*)(args.ws + WS_XB), (bf16*)(args.ws + WS_X1)};
            pg8::gemm_phase<pg8::EpiOut, pg8::DenseOrder, true>(MKTID(), ldsl, (const char*)(args.ws + WS_MIX), D, S, E);
            SEAM(3);
        }
        if (IN(4)) { phase_ln1_router(MKTID(), args, layer, lds, vcu, G); SEAM(4); }
        if (IN(5)) {
            moe_table(MKTID(), args, layer, tab);
            pg8::MoeOrder<true> S{tab, G, vcu, D, 4, (const char*)(args.ws + WS_WGU), (size_t)1024 * D * 2, (const int*)(args.ws + WS_LIST)};
            pg8::EpiMoe1 E{(bf16*)(args.ws + WS_H)};
            pg8::gemm_phase<pg8::EpiMoe1, pg8::MoeOrder<true>, true>(MKTID(), ldsl, (const char*)(args.ws + WS_X1), D, S, E);
            SEAM(5);
        }
        if (IN(6)) {
            moe_table(MKTID(), args, layer, tab);
            pg8::MoeOrder<false> S{tab, G, vcu, DE, 4, (const char*)(args.ws + WS_WDN), (size_t)1024 * DE * 2, (const int*)(args.ws + WS_LIST)};
            pg8::EpiMoe2 E{(bf16*)(args.ws + WS_YM), (const int*)(args.ws + WS_LIST), (const float*)(args.ws + WS_GATE), tab};
            pg8::gemm_phase<pg8::EpiMoe2, pg8::MoeOrder<false>, true>(MKTID(), ldsl, (const char*)(args.ws + WS_H), DE, S, E);
            SEAM(6);
        }
        if (IN(7)) { phase_ln2(MKTID(), args, layer, vcu, G); SEAM(7); }
    }
#undef IN
#undef SEAM
}

extern "C" void kernel_launch(void* const* d_in, const int* in_sizes, int n_in, void* d_out, int out_size, void* d_ws, size_t ws_size, hipStream_t stream) {
    static int grid = 0;
    if (grid == 0) {
        if (n_in != 32 || out_size != M * D || ws_size < WS_END) { fprintf(stderr, "kernel_launch: unexpected shapes (n_in %d out %d ws %zu)\n", n_in, out_size, ws_size); grid = -1; return; }
        int dev = 0, cus = 0;
        if (hipGetDevice(&dev) != hipSuccess || hipDeviceGetAttribute(&cus, hipDeviceAttributeMultiprocessorCount, dev) != hipSuccess) { grid = -1; return; }
        if (hipFuncSetAttribute((const void*)fwd_kernel, hipFuncAttributeMaxDynamicSharedMemorySize, LDS_BYTES) != hipSuccess) { fprintf(stderr, "kernel_launch: hipFuncSetAttribute failed\n"); grid = -1; return; }
        int per_cu = 0;
        (void)hipOccupancyMaxActiveBlocksPerMultiprocessor(&per_cu, (const void*)fwd_kernel, NTHR, LDS_BYTES);
        (void)hipGetLastError();
        if (per_cu < 1) fprintf(stderr, "kernel_launch: occupancy query reports %d\n", per_cu);
        grid = cus;
    }
    if (grid < 0) return;
    (void)hipMemsetAsync((char*)d_ws + WS_CTL, 0, CTL_BYTES, stream);
    Args a{};
    for (int i = 0; i < 32; ++i) a.in[i] = (const float*)d_in[i];
    a.out = (float*)d_out; a.ws = (unsigned char*)d_ws;
#if MK_ONE_LAUNCH
    a.l_lo = 0; a.l_hi = DEPTH; a.ph_lo = 0; a.ph_hi = NPH; a.use_bar = 1; a.pad = 0;
    hipLaunchKernelGGL(fwd_kernel, dim3(grid), dim3(NTHR), LDS_BYTES, stream, a);
#else
    for (int l = 0; l < DEPTH; ++l)
        for (int p = 0; p < NPH; ++p) {
            a.l_lo = l; a.l_hi = l + 1; a.ph_lo = p; a.ph_hi = p + 1; a.use_bar = 0; a.pad = 0;
            hipLaunchKernelGGL(fwd_kernel, dim3(grid), dim3(NTHR), LDS_BYTES, stream, a);
        }
#endif
}
```

```cpp
#include <hip/hip_runtime.h>
#include <cstdio>
#include <cstdint>

#ifndef MK_ONE_LAUNCH
#define MK_ONE_LAUNCH 1
#endif

#define LAS __attribute__((address_space(3)))
#define GAS __attribute__((address_space(1)))
typedef unsigned short bf16;
typedef short bf16x8 __attribute__((ext_vector_type(8)));
typedef short s16x4 __attribute__((ext_vector_type(4)));
typedef float f32x4 __attribute__((ext_vector_type(4)));
typedef float f32x2 __attribute__((ext_vector_type(2)));
typedef float f32x16 __attribute__((ext_vector_type(16)));
typedef unsigned u32x4 __attribute__((ext_vector_type(4)));
typedef unsigned u32x2 __attribute__((ext_vector_type(2)));
typedef __bf16 bf16x2_t __attribute__((ext_vector_type(2)));

constexpr int D = 1024, BATCH = 16, SEQ = 4096, DEPTH = 4, M = BATCH * SEQ;
constexpr int HD = 64, RW = 384, LW = 256, SW = 384, RH = 6, LB = 4, SH = 6;
constexpr int RCOLS = 1408, INC = 3072;
constexpr int PC_R = 0, PC_K = 384, PC_V = 768, PC_DW = 1152, PC_DA = 1216, PC_DG = 1280;
constexpr int PC_LG = 1408, PC_LX = 1664, PC_SQ = 1920, PC_SK = 2304, PC_SV = 2688;
constexpr int MIX_R = 0, MIX_L = 384, MIX_S = 640;
constexpr int NE = 16, DE = 512, LCAP = 2 * M;
constexpr float ALPHA = 1.6817928305074290f;
constexpr float LN_EPS = 1e-5f, RMS_EPS = 1e-6f, GN_EPS = 64e-5f;
constexpr float C2 = 0.125f * 1.4426950408889634f;

constexpr size_t MiB = 1u << 20;
constexpr size_t WS_CTL = 0, CTL_BYTES = 1 * MiB;
constexpr size_t WS_WIN = 1 * MiB;
constexpr size_t WS_WOUT = 7 * MiB;
constexpr size_t WS_WGU = 9 * MiB;
constexpr size_t WS_WDN = 41 * MiB;
constexpr size_t WS_WSM = 57 * MiB;
constexpr size_t WS_LIST = 58 * MiB;
constexpr size_t WS_GATE = 66 * MiB;
constexpr size_t WS_XB = 68 * MiB;
constexpr size_t WS_X1 = 196 * MiB;
constexpr size_t WS_P = 324 * MiB;
constexpr size_t WS_MIX = 708 * MiB;
constexpr size_t WS_H = 324 * MiB;
constexpr size_t WS_YM = 460 * MiB;
constexpr size_t WS_END = 888 * MiB;
static_assert(WS_H + (size_t)(2 * M + NE * 256) * DE * 2 <= WS_YM && WS_YM + (size_t)2 * M * D * 2 <= WS_END, "ws map");

constexpr int CW_BAR = 0;
constexpr int CW_CNT = 8192;
constexpr int CW_Q = 8192 + 1024;

constexpr int NTHR = 512, NWAVES = 8;
constexpr int LDS_BYTES = 155648;
constexpr int GEMM_LDS = 131072;
constexpr int MISC_OFF = 147456;

__device__ __forceinline__ float bf2f(unsigned short b) { return __uint_as_float((unsigned)b << 16); }
__device__ __forceinline__ unsigned pk2(float lo, float hi) { f32x2 v = {lo, hi}; bf16x2_t b = __builtin_convertvector(v, bf16x2_t); return __builtin_bit_cast(unsigned, b); }
__device__ __forceinline__ float lo16(unsigned u) { return __uint_as_float(u << 16); }
__device__ __forceinline__ float hi16(unsigned u) { return __uint_as_float(u & 0xffff0000u); }
#define DPP(v, ctrl) __builtin_bit_cast(float, __builtin_amdgcn_update_dpp(__builtin_bit_cast(int, v), __builtin_bit_cast(int, v), (ctrl), 0xF, 0xF, false))
__device__ __forceinline__ float red8(float v) { v += DPP(v, 0xB1); v += DPP(v, 0x4E); v += DPP(v, 0x141); return v; }
__device__ __forceinline__ float red16(float v) { v = red8(v); v += DPP(v, 0x140); return v; }
__device__ __forceinline__ float red64(float v) { v = red16(v); v += __shfl_xor(v, 16); v += __shfl_xor(v, 32); return v; }
__device__ __forceinline__ float sigmoidf_(float x) { return __builtin_amdgcn_rcpf(1.0f + __expf(-x)); }
__device__ __forceinline__ float log1p_fast(float y) { return (y < 0.06f) ? y * (1.0f + y * (-0.5f + y * (0.33333334f + y * (-0.25f + y * (0.2f - y * 0.16666667f))))) : __logf(1.0f + y); }
__device__ __forceinline__ float softplusf_(float x) { return x > 20.f ? x : log1p_fast(__expf(x)); }

#define XB_TMO      128
#define XB_XCNT(j)  (256  + 64 * (j))
#define XB_XSUB(j)  (1280 + 64 * (j))
#define XB_XGEN(j)  (2304 + 64 * (j))
#define XB_TOP      3328
#define XB_TOPGEN   3392
#define XCD_BAR_WORDS 3456
#define XB_SPIN_CAP (1u << 22)
__device__ __forceinline__ unsigned xb_ld(unsigned* p)              { return __hip_atomic_load(p, __ATOMIC_RELAXED, __HIP_MEMORY_SCOPE_AGENT); }
__device__ __forceinline__ unsigned xb_add(unsigned* p, unsigned v) { return __hip_atomic_fetch_add(p, v, __ATOMIC_RELAXED, __HIP_MEMORY_SCOPE_AGENT); }
__device__ __forceinline__ unsigned xb_xcc_id() { return (unsigned)__builtin_amdgcn_s_getreg((3 << 11) | 20) & 0xFu; }
#define XB_SPIN(cond, bar) do { unsigned _sp = 0; while (cond) { __builtin_amdgcn_s_sleep(1); \
    if ((++_sp & 255u) == 0u) { if (xb_ld(&(bar)[XB_TMO])) break; if (_sp > XB_SPIN_CAP) { atomicAdd(&(bar)[XB_TMO], 1u); break; } } } } while (0)
struct XcdBarrier { unsigned* bar; unsigned x; volatile LAS unsigned* st; };
__device__ __forceinline__ XcdBarrier xcd_barrier_post(const int tid, unsigned* bar, volatile LAS unsigned* st) {
    XcdBarrier b; b.bar = bar; b.x = xb_xcc_id(); b.st = st;
    if (tid == 0) (void)xb_add(&bar[XB_XCNT(b.x)], 1u);
    return b;
}
__device__ __forceinline__ void xcd_barrier_complete(unsigned* bar, unsigned x, unsigned& nloc, unsigned& nx) {
    const unsigned G = gridDim.x * gridDim.y * gridDim.z;
    unsigned sum, cnt, mine, sp = 0u;
    for (;;) {
        sum = 0u; cnt = 0u; mine = 0u;
#pragma unroll
        for (unsigned j = 0; j < 16; ++j) { const unsigned c = xb_ld(&bar[XB_XCNT(j)]); sum += c; cnt += (c > 0u) ? 1u : 0u; mine = (j == x) ? c : mine; }
        if (sum == G) break;
        __builtin_amdgcn_s_sleep(1);
        if ((++sp & 255u) == 0u) { if (xb_ld(&bar[XB_TMO])) break; if (sp > XB_SPIN_CAP) { atomicAdd(&bar[XB_TMO], 1u); break; } }
    }
    nloc = mine > 0u ? mine : 1u; nx = cnt > 0u ? cnt : 1u;
}
__device__ __forceinline__ void xcd_barrier(const int tid, const XcdBarrier& b) {
    asm volatile("s_waitcnt vmcnt(0)" ::: "memory");
    __syncthreads();
    if (tid == 0) {
        unsigned* bar = b.bar;
        __builtin_amdgcn_s_waitcnt(0);
        unsigned nloc = b.st[0], nx = b.st[1];
        if (nloc == 0u) { xcd_barrier_complete(bar, b.x, nloc, nx); b.st[0] = nloc; b.st[1] = nx; }
        const unsigned old = xb_add(&bar[XB_XSUB(b.x)], 1u);
        const unsigned gen = old / nloc;
        if (old + 1u == (gen + 1u) * nloc) {
            __builtin_amdgcn_fence(__ATOMIC_RELEASE, "agent");
            asm volatile("s_waitcnt vmcnt(0)" ::: "memory");
            const unsigned og = xb_add(&bar[XB_TOP], 1u);
            const unsigned tg = og / nx;
            if (og + 1u == (tg + 1u) * nx) xb_add(&bar[XB_TOPGEN], 1u);
            else XB_SPIN(xb_ld(&bar[XB_TOPGEN]) == tg, bar);
            __builtin_amdgcn_fence(__ATOMIC_ACQUIRE, "agent");
            xb_add(&bar[XB_XGEN(b.x)], 1u);
            asm volatile("s_waitcnt vmcnt(0)" ::: "memory");
        } else {
            XB_SPIN(xb_ld(&bar[XB_XGEN(b.x)]) == gen, bar);
            __builtin_amdgcn_fence(__ATOMIC_ACQUIRE, "agent");
            asm volatile("s_waitcnt vmcnt(0)" ::: "memory");
        }
    }
    __syncthreads();
}

namespace pg8 {
constexpr int BM = 256, BK = 64, HALF = 128, HTB = HALF * BK * 2, STAGE_BYTES = 8 * HTB;
__host__ __device__ __forceinline__ int lds_byte(int r, int c) { const int st = (r >> 4) * 2 + (c >> 5), rr = r & 15, cc = c & 31, ob = rr * 64 + cc * 2; return st * 1024 + (ob ^ (((ob >> 9) & 1) << 5)); }
__host__ __device__ __forceinline__ void stage_rc(int b, int& R, int& C) { const int st = b / 1024, sb = b % 1024, swz = sb ^ (((sb >> 9) & 1) << 5); R = (st >> 1) * 16 + swz / 64; C = (st & 1) * 32 + (swz % 64) / 2; }
__host__ __device__ __forceinline__ int perm32(int rho) { const int n = rho >> 4, i = rho & 15; return 8 * (i >> 2) + 4 * n + (i & 3); }

struct Unit { int pm, pn, e, j; };
template <class Epi, class Sched, bool ALIGN_EPI>
__device__ __forceinline__ void gemm_phase(const int tid, LAS unsigned char* lds, const char* Abase, const int K, const Sched& S, const Epi& E) {
    const int wid = __builtin_amdgcn_readfirstlane(tid >> 6), lane = tid & 63, wr = wid >> 2, wc = wid & 3, fr = lane & 15, fq = lane >> 4;
    const int nt = K / BK;
    int R0, C0; stage_rc(tid * 16, R0, C0);
    const int Rb0 = (R0 & ~31) + perm32(R0 & 31);
    unsigned voffB[2]; voffB[0] = (unsigned)(Rb0 * K + C0) * 2u; voffB[1] = (unsigned)((Rb0 + 64) * K + C0) * 2u;
    unsigned voffA[2]; voffA[0] = (unsigned)(R0 * K + C0) * 2u; voffA[1] = (unsigned)((R0 + 64) * K + C0) * 2u;
    const unsigned colA = (unsigned)C0 * 2u;
    const size_t kstep = (size_t)(BK * 2);
    const size_t hstepB = (size_t)HALF * K * 2, hstepA = hstepB;
    const unsigned ldsw = (unsigned)wid * 1024u;
    const int aoff = lds_byte(wr * 64 + fr, fq * 8), boff = lds_byte(wc * 32 + fr, fq * 8);
#define PG8_SA(b, h) (((b) * 2 + (h)) * HTB)
#define PG8_SB(b, h) ((4 + (b) * 2 + (h)) * HTB)
#define PG8_STAGE_B(bufoff, gbase) do { _Pragma("unroll") for (int _i = 0; _i < 2; ++_i) \
        __builtin_amdgcn_global_load_lds((const unsigned*)((const char*)(gbase) + voffB[_i]), (LAS unsigned*)(lds + (bufoff) + ldsw + _i * 8192), 16, 0, 0); } while (0)
#define PG8_STAGE_A(bufoff, h, kbyte, nx) do { \
        if constexpr (Sched::GATHER) { _Pragma("unroll") for (int _i = 0; _i < 2; ++_i) { const unsigned _o = (nx) ? na[h][_i] : ca[h][_i]; \
            __builtin_amdgcn_global_load_lds((const unsigned*)(Abase + (kbyte) + _o), (LAS unsigned*)(lds + (bufoff) + ldsw + _i * 8192), 16, 0, 0); } } \
        else { const char* _p = ((nx) ? nA : cA) + (kbyte) + (size_t)(h) * hstepA; _Pragma("unroll") for (int _i = 0; _i < 2; ++_i) \
            __builtin_amdgcn_global_load_lds((const unsigned*)(_p + voffA[_i]), (LAS unsigned*)(lds + (bufoff) + ldsw + _i * 8192), 16, 0, 0); } } while (0)
#define PG8_LDA(dst, b, h) do { _Pragma("unroll") for (int m = 0; m < 4; ++m) _Pragma("unroll") for (int k = 0; k < 2; ++k) dst[m][k] = *(const LAS bf16x8*)(lds + PG8_SA(b, h) + aoff + m * 2048 + k * 1024); } while (0)
#define PG8_LDB(dst, b, h) do { _Pragma("unroll") for (int n = 0; n < 2; ++n) _Pragma("unroll") for (int k = 0; k < 2; ++k) dst[n][k] = *(const LAS bf16x8*)(lds + PG8_SB(b, h) + boff + n * 2048 + k * 1024); } while (0)
#define PG8_MMA(ai, bj, At, Bt) do { __builtin_amdgcn_s_setprio(1); _Pragma("unroll") for (int m = 0; m < 4; ++m) _Pragma("unroll") for (int n = 0; n < 2; ++n) _Pragma("unroll") for (int k = 0; k < 2; ++k) \
        acc[ai][bj][m][n] = __builtin_amdgcn_mfma_f32_16x16x32_bf16(Bt[n][k], At[m][k], acc[ai][bj][m][n], 0, 0, 0); __builtin_amdgcn_s_setprio(0); } while (0)
#define PG8_WAIT_V(n) asm volatile("s_waitcnt vmcnt(" #n ")" ::: "memory")
#define PG8_WAIT_L(n) asm volatile("s_waitcnt lgkmcnt(" #n ")" ::: "memory")
#define PG8_BAR __builtin_amdgcn_s_barrier()
#define PG8_SCHED __builtin_amdgcn_sched_barrier(0)
    Unit cur, nxt; int ui = 0;
    if (!S.next(0, cur)) return;
    unsigned ca[2][2], na[2][2];
    const char* cA = Abase; const char* nA = Abase;
    if constexpr (Sched::GATHER) S.aoffs(cur, R0, colA, ca); else cA = Abase + (size_t)S.arow0(cur) * K * 2;
    f32x4 acc[2][2][4][2];
#pragma unroll
    for (int a = 0; a < 2; ++a)
#pragma unroll
        for (int b = 0; b < 2; ++b)
#pragma unroll
            for (int m = 0; m < 4; ++m)
#pragma unroll
                for (int n = 0; n < 2; ++n) acc[a][b][m][n] = (f32x4){0.f, 0.f, 0.f, 0.f};
    bf16x8 At[4][2], B0[2][2], B1[2][2];
    const char* cB = S.bbase(cur);
    PG8_STAGE_B(PG8_SB(0, 0), cB); PG8_STAGE_B(PG8_SB(0, 1), cB + hstepB); PG8_STAGE_A(PG8_SA(0, 0), 0, 0, false); PG8_STAGE_A(PG8_SA(0, 1), 1, 0, false);
    if (wr == 1) PG8_BAR;
    PG8_WAIT_V(2); PG8_BAR;
    PG8_STAGE_B(PG8_SB(1, 0), cB + kstep); PG8_STAGE_A(PG8_SA(1, 0), 0, kstep, false); PG8_STAGE_B(PG8_SB(1, 1), cB + hstepB + kstep);
    PG8_WAIT_V(6); PG8_BAR;
    for (;;) {
        const bool has_next = S.next(ui + 1, nxt);
        const char* nB = cB;
        nA = cA;
        if (has_next) { nB = S.bbase(nxt); if constexpr (Sched::GATHER) S.aoffs(nxt, R0, colA, na); else nA = Abase + (size_t)S.arow0(nxt) * K * 2; }
        else if constexpr (Sched::GATHER) { na[0][0] = ca[0][0]; na[0][1] = ca[0][1]; na[1][0] = ca[1][0]; na[1][1] = ca[1][1]; }
        for (int t = 0; t < nt; t += 2) {
            const bool last = (t == nt - 2);
            const size_t k1 = (size_t)(t + 1) * kstep;
            const size_t k2 = last ? 0 : (size_t)(t + 2) * kstep, k3 = k2 + kstep;
            const char* b2 = last ? nB : cB + (size_t)(t + 2) * kstep; const char* b3 = b2 + kstep;
            PG8_LDB(B0, 0, 0); PG8_LDB(B1, 0, 1); PG8_SCHED; PG8_LDA(At, 0, 0); PG8_STAGE_A(PG8_SA(1, 1), 1, k1, false);
            PG8_WAIT_V(8); PG8_WAIT_L(0); PG8_BAR; PG8_MMA(0, 0, At, B0); PG8_MMA(0, 1, At, B1); PG8_BAR; PG8_SCHED;
            PG8_LDA(At, 0, 1); PG8_STAGE_B(PG8_SB(0, 0), b2); PG8_STAGE_B(PG8_SB(0, 1), b2 + hstepB); PG8_STAGE_A(PG8_SA(0, 0), 0, k2, last);
            PG8_WAIT_V(8); PG8_WAIT_L(0); PG8_BAR; PG8_MMA(1, 0, At, B0); PG8_MMA(1, 1, At, B1); PG8_BAR; PG8_SCHED;
            PG8_LDB(B0, 1, 0); PG8_LDB(B1, 1, 1); PG8_SCHED; PG8_LDA(At, 1, 0); PG8_STAGE_A(PG8_SA(0, 1), 1, k2, last);
            PG8_WAIT_V(8); PG8_WAIT_L(0); PG8_BAR; PG8_MMA(0, 0, At, B0); PG8_MMA(0, 1, At, B1); PG8_BAR; PG8_SCHED;
            PG8_LDA(At, 1, 1); PG8_STAGE_B(PG8_SB(1, 0), b3); PG8_STAGE_B(PG8_SB(1, 1), b3 + hstepB); PG8_STAGE_A(PG8_SA(1, 0), 0, k3, last);
            PG8_WAIT_V(8); PG8_WAIT_L(0); PG8_BAR; PG8_MMA(1, 0, At, B0); PG8_MMA(1, 1, At, B1); PG8_BAR; PG8_SCHED;
        }
        if constexpr (ALIGN_EPI) { if (wr == 0) PG8_BAR; }
        E(acc, cur, wr, wc, fr, fq);
        if (!has_next) break;
#pragma unroll
        for (int a = 0; a < 2; ++a)
#pragma unroll
            for (int b = 0; b < 2; ++b)
#pragma unroll
                for (int m = 0; m < 4; ++m)
#pragma unroll
                    for (int n = 0; n < 2; ++n) acc[a][b][m][n] = (f32x4){0.f, 0.f, 0.f, 0.f};
        cur = nxt; cB = nB; cA = nA; ++ui;
        if constexpr (Sched::GATHER) { ca[0][0] = na[0][0]; ca[0][1] = na[0][1]; ca[1][0] = na[1][0]; ca[1][1] = na[1][1]; }
        if constexpr (ALIGN_EPI) { if (wr == 1) PG8_BAR; }
    }
    PG8_WAIT_V(0);
    if constexpr (!ALIGN_EPI) { if (wr == 0) PG8_BAR; }
    PG8_BAR;
#undef PG8_SA
#undef PG8_SB
#undef PG8_STAGE_A
#undef PG8_STAGE_B
#undef PG8_LDA
#undef PG8_LDB
#undef PG8_MMA
#undef PG8_WAIT_V
#undef PG8_WAIT_L
#undef PG8_BAR
#undef PG8_SCHED
}

struct DenseOrder {
    static constexpr bool GATHER = false;
    int nM, nN, nwg, G, c, K; const char* Bt;
    __device__ __forceinline__ int arow0(const Unit& u) const { return u.pm * BM; }
    __device__ __forceinline__ void init(int M_, int N_, int K_, int G_, int c_, const void* Bt_) { nM = M_ / BM; nN = N_ / BM; nwg = nM * nN; G = G_; c = c_; K = K_; Bt = (const char*)Bt_; }
    __device__ __forceinline__ bool next(int i, Unit& u) const {
        const long L = (long)i * G + c; if (L >= nwg) return false;
        int wgid = (int)L; { const int q = nwg / 8, r = nwg % 8, xcd = wgid % 8, off = wgid / 8; wgid = (xcd < r ? xcd * (q + 1) : r * (q + 1) + (xcd - r) * q) + off; }
        const int nig = 8 * nN, gid = wgid / nig, fm = gid * 8, gsz = (nM - fm) < 8 ? (nM - fm) : 8;
        u.pm = fm + ((wgid % nig) % gsz); u.pn = (wgid % nig) / gsz; u.e = 0; u.j = 0; return true;
    }
    __device__ __forceinline__ void aoffs(const Unit& u, int R0, unsigned colA, unsigned (&o)[2][2]) const {
#pragma unroll
        for (int h = 0; h < 2; ++h)
#pragma unroll
            for (int i = 0; i < 2; ++i) o[h][i] = (unsigned)(u.pm * BM + h * HALF + R0 + 64 * i) * (unsigned)(K * 2) + colA;
    }
    __device__ __forceinline__ const char* bbase(const Unit& u) const { return Bt + (size_t)u.pn * BM * K * 2; }
};
template <bool GATHER_>
struct MoeOrder {
    static constexpr bool GATHER = GATHER_;
    __device__ __forceinline__ int arow0(const Unit& u) const { return u.pm * BM; }
    const LAS int* tab;
    int G, c, K, nN; const char* Bt; size_t estride;
    const int* list;
    __device__ __forceinline__ bool next(int i, Unit& u) const {
        const int L = i * G + c; const int nb = tab[16];
        if (L >= nb * nN) return false;
        const int rb = L / nN; u.pn = L % nN; u.pm = rb;
        int e = 0;
#pragma unroll
        for (int k = 1; k < 16; ++k) e += (rb >= tab[k]) ? 1 : 0;
        u.e = e; u.j = rb - tab[e]; return true;
    }
    __device__ __forceinline__ void aoffs(const Unit& u, int R0, unsigned colA, unsigned (&o)[2][2]) const {
        const int cnt = tab[32 + u.e];
#pragma unroll
        for (int h = 0; h < 2; ++h)
#pragma unroll
            for (int i = 0; i < 2; ++i) {
                const int r = h * HALF + R0 + 64 * i;
                const int pos = u.j * BM + r; const unsigned row = (pos < cnt) ? (unsigned)(list[(size_t)u.e * LCAP + pos] >> 1) : 0u;
                o[h][i] = row * (unsigned)(K * 2) + colA;
            }
    }
    __device__ __forceinline__ const char* bbase(const Unit& u) const { return Bt + (size_t)u.e * estride + (size_t)u.pn * BM * K * 2; }
};

__device__ __forceinline__ u32x4 pack8(const f32x4 v0, const f32x4 v1) { u32x4 w; w.x = pk2(v0[0], v0[1]); w.y = pk2(v0[2], v0[3]); w.z = pk2(v1[0], v1[1]); w.w = pk2(v1[2], v1[3]); return w; }
struct EpiIn {
    bf16* O;
    __device__ __forceinline__ void operator()(const f32x4 (&acc)[2][2][4][2], const Unit& u, int wr, int wc, int fr, int fq) const {
        const int row0 = u.pm * BM + wr * 64 + fr, col0 = u.pn * BM + wc * 32 + 8 * fq;
#pragma unroll
        for (int ai = 0; ai < 2; ++ai)
#pragma unroll
            for (int m = 0; m < 4; ++m) { bf16* rowp = O + (size_t)(row0 + ai * HALF + m * 16) * INC + col0;
#pragma unroll
                for (int bj = 0; bj < 2; ++bj) { const int c = col0 + bj * HALF; const float sc = (c >= PC_SQ && c < PC_SK) ? C2 : 1.0f;
                    *(u32x4*)(rowp + bj * HALF) = pack8(acc[ai][bj][m][0] * sc, acc[ai][bj][m][1] * sc); } }
    }
};
struct EpiOut {
    const bf16* X; bf16* O;
    __device__ __forceinline__ void operator()(const f32x4 (&acc)[2][2][4][2], const Unit& u, int wr, int wc, int fr, int fq) const {
        const int row0 = u.pm * BM + wr * 64 + fr, col0 = u.pn * BM + wc * 32 + 8 * fq;
#pragma unroll
        for (int ai = 0; ai < 2; ++ai)
#pragma unroll
            for (int m = 0; m < 4; ++m) { const size_t off = (size_t)(row0 + ai * HALF + m * 16) * D + col0;
#pragma unroll
                for (int bj = 0; bj < 2; ++bj) { const u32x4 xv = *(const u32x4*)(X + off + bj * HALF);
                    f32x4 v0 = acc[ai][bj][m][0], v1 = acc[ai][bj][m][1];
                    v0[0] += ALPHA * lo16(xv.x); v0[1] += ALPHA * hi16(xv.x); v0[2] += ALPHA * lo16(xv.y); v0[3] += ALPHA * hi16(xv.y);
                    v1[0] += ALPHA * lo16(xv.z); v1[1] += ALPHA * hi16(xv.z); v1[2] += ALPHA * lo16(xv.w); v1[3] += ALPHA * hi16(xv.w);
                    *(u32x4*)(O + off + bj * HALF) = pack8(v0, v1); } }
    }
};
struct EpiMoe1 {
    bf16* Hb;
    __device__ __forceinline__ void operator()(const f32x4 (&acc)[2][2][4][2], const Unit& u, int wr, int wc, int fr, int fq) const {
        const int row0 = u.pm * BM + wr * 64 + fr, col0 = u.pn * HALF + wc * 32 + 8 * fq;
#pragma unroll
        for (int ai = 0; ai < 2; ++ai)
#pragma unroll
            for (int m = 0; m < 4; ++m) {
                f32x4 g0 = acc[ai][0][m][0], g1 = acc[ai][0][m][1]; const f32x4 u0 = acc[ai][1][m][0], u1 = acc[ai][1][m][1];
#pragma unroll
                for (int q = 0; q < 4; ++q) { g0[q] = g0[q] * sigmoidf_(g0[q]) * u0[q]; g1[q] = g1[q] * sigmoidf_(g1[q]) * u1[q]; }
                *(u32x4*)(Hb + (size_t)(row0 + ai * HALF + m * 16) * DE + col0) = pack8(g0, g1); }
    }
};
struct EpiMoe2 {
    bf16* Y; const int* list; const float* gate; const LAS int* tab;
    __device__ __forceinline__ void operator()(const f32x4 (&acc)[2][2][4][2], const Unit& u, int wr, int wc, int fr, int fq) const {
        const int col0 = u.pn * BM + wc * 32 + 8 * fq; const int cnt = tab[32 + u.e];
#pragma unroll
        for (int ai = 0; ai < 2; ++ai)
#pragma unroll
            for (int m = 0; m < 4; ++m) { const int pos = u.j * BM + ai * HALF + wr * 64 + m * 16 + fr;
                if (pos < cnt) { const int a = list[(size_t)u.e * LCAP + pos]; const float g = gate[a];
#pragma unroll
                    for (int bj = 0; bj < 2; ++bj) *(u32x4*)(Y + (size_t)a * D + col0 + bj * HALF) = pack8(acc[ai][bj][m][0] * g, acc[ai][bj][m][1] * g); } }
    }
};
}

struct Args {
    const float* in[32]; float* out; unsigned char* ws;
    int l_lo, l_hi, ph_lo, ph_hi;
    int use_bar, pad;
};
enum { I_X = 0, I_WIN, I_MU, I_W0, I_WUP, I_A0, I_AUP, I_GUP, I_KK, I_KA, I_RK, I_LNG, I_LNB, I_CW, I_CB, I_WA, I_BA, I_WX, I_BX, I_LAM, I_LRUG, I_SBAG,
       I_WOUT, I_LN1G, I_LN1B, I_LN2G, I_LN2B, I_RW, I_RB, I_EG, I_EU, I_ED };
constexpr int NPH = 10;

__device__ __forceinline__ void transpose_item(const float* W, int N, bf16* WT, int pitch, int drow0, int k0, int n0, float* scr, int lane) {
#pragma unroll 8
    for (int i = 0; i < 32; ++i) { const int kk = 2 * i + (lane >> 5); scr[kk * 33 + (lane & 31)] = W[(size_t)(k0 + kk) * N + n0 + (lane & 31)]; }
    asm volatile("s_waitcnt lgkmcnt(0)" ::: "memory");
    const int c = lane & 7;
#pragma unroll
    for (int j = 0; j < 4; ++j) { const int n = (lane >> 3) + 8 * j; const float* s = scr + (8 * c) * 33 + n;
        u32x4 o; o.x = pk2(s[0 * 33], s[1 * 33]); o.y = pk2(s[2 * 33], s[3 * 33]); o.z = pk2(s[4 * 33], s[5 * 33]); o.w = pk2(s[6 * 33], s[7 * 33]);
        *(u32x4*)(WT + (size_t)(drow0 + n) * pitch + k0 + 8 * c) = o; }
    asm volatile("s_waitcnt lgkmcnt(0)" ::: "memory");
}
__device__ __forceinline__ void phase_convert(const int tid, const Args& A, int layer, float* ldsf, int vcu, int G) {
    const int lane = tid & 63, wave = tid >> 6;
    float* scr = ldsf + wave * 4096;
    unsigned char* ws = A.ws;
    bf16* Win = (bf16*)(ws + WS_WIN); bf16* Wout = (bf16*)(ws + WS_WOUT); bf16* Wgu = (bf16*)(ws + WS_WGU); bf16* Wdn = (bf16*)(ws + WS_WDN);
    bf16* WupT = (bf16*)(ws + WS_WSM); bf16* AupT = WupT + 384 * 64; bf16* GupT = AupT + 384 * 64;
    const int gw = vcu * NWAVES + wave, NGW = G * NWAVES;
    constexpr int I_IN = 16 * 96, I_OUT = 16 * 32, I_G = 16 * 256, I_U = 16 * 256, I_D = 16 * 256, I_S1 = 12, I_S2 = 12, I_S3 = 24, I_S4 = 16;
    constexpr int NIT = I_IN + I_OUT + I_G + I_U + I_D + I_S1 + I_S2 + I_S3 + I_S4;
    for (int it = gw; it < NIT; it += NGW) {
        int r = it;
        if (r < I_IN) { const int kb = r / 96, nb = r % 96; transpose_item(A.in[I_WIN] + (size_t)layer * D * INC, INC, Win, D, 32 * nb, 64 * kb, 32 * nb, scr, lane); continue; } r -= I_IN;
        if (r < I_OUT) { const int kb = r / 32, nb = r % 32; transpose_item(A.in[I_WOUT] + (size_t)layer * D * D, D, Wout, D, 32 * nb, 64 * kb, 32 * nb, scr, lane); continue; } r -= I_OUT;
        if (r < I_G + I_U) { const int up = r >= I_G; if (up) r -= I_G; const int e = r / 256, q = r % 256, kb = q / 16, nb = q % 16, n0 = 32 * nb;
            const float* src = A.in[up ? I_EU : I_EG] + ((size_t)layer * NE + e) * D * DE;
            transpose_item(src, DE, Wgu, D, e * 1024 + (n0 >> 7) * 256 + up * 128 + (n0 & 127), 64 * kb, n0, scr, lane); continue; } r -= I_G + I_U;
        if (r < I_D) { const int e = r / 256, q = r % 256, kb = q / 32, nb = q % 32;
            transpose_item(A.in[I_ED] + ((size_t)layer * NE + e) * DE * D, D, Wdn, DE, e * 1024 + 32 * nb, 64 * kb, 32 * nb, scr, lane); continue; } r -= I_D;
        if (r < I_S1) { transpose_item(A.in[I_WUP] + (size_t)layer * 64 * RW, RW, WupT, 64, 32 * r, 0, 32 * r, scr, lane); continue; } r -= I_S1;
        if (r < I_S2) { transpose_item(A.in[I_AUP] + (size_t)layer * 64 * RW, RW, AupT, 64, 32 * r, 0, 32 * r, scr, lane); continue; } r -= I_S2;
        if (r < I_S3) { const int kb = r / 12, nb = r % 12; transpose_item(A.in[I_GUP] + (size_t)layer * 128 * RW, RW, GupT, 128, 32 * nb, 64 * kb, 32 * nb, scr, lane); continue; } r -= I_S3;
        { const int x = r >> 3, gq = (r >> 1) & 3, nb = r & 1;
          transpose_item(A.in[x ? I_WX : I_WA] + ((size_t)layer * LB + gq) * 4096, 64, GupT + 384 * 128 + x * 16384, 64, gq * 64 + 32 * nb, 0, 32 * nb, scr, lane); }
    }
    if (layer == 0) {
        const f32x4* x4 = (const f32x4*)A.in[I_X]; u32x4* o = (u32x4*)(ws + WS_XB);
        const size_t n8 = (size_t)M * D / 8;
        for (size_t i = (size_t)vcu * NTHR + tid; i < n8; i += (size_t)G * NTHR) { const f32x4 a = x4[2 * i], b = x4[2 * i + 1]; o[i] = pg8::pack8(a, b); }
    }
}

__device__ __forceinline__ void attn_unit(const int tid_in, const Args& A, int layer, int bh, int qb, unsigned char* lds) {
    int tid = tid_in; asm volatile("" : "+v"(tid));
    const int lane = tid & 63, wave = __builtin_amdgcn_readfirstlane(tid >> 6), r = lane & 31, hh = lane >> 5;
    const int b = bh / SH, h = bh % SH;
    const bf16* P = (const bf16*)(A.ws + WS_P) + (size_t)b * SEQ * INC;
    bf16* MIX = (bf16*)(A.ws + WS_MIX) + (size_t)b * SEQ * D;
    bf16* Ks = (bf16*)lds;
    bf16* Vt = (bf16*)(lds + 64 * 72 * 2);
    const int q0w = qb * 256 + wave * 32;
    bf16x8 qr[4];
#pragma unroll
    for (int s = 0; s < 4; ++s) qr[s] = *(const bf16x8*)(P + (size_t)(q0w + r) * INC + PC_SQ + h * 64 + 16 * s + 8 * hh);
    f32x16 o0 = {}, o1 = {};
    float Rrun = 1.0f;
    const int qmine = q0w + r;
    const int lkey = tid >> 3, lch = (tid & 7) * 8;
    int jt = 4 * qb + 3;
    u32x4 kreg = *(const u32x4*)(P + (size_t)(64 * jt + lkey) * INC + PC_SK + h * 64 + lch);
    u32x4 vreg = *(const u32x4*)(P + (size_t)(64 * jt + lkey) * INC + PC_SV + h * 64 + lch);
    for (; jt >= 0; --jt) {
        __syncthreads();
        *(u32x4*)(Ks + lkey * 72 + lch) = kreg;
        { const unsigned short* vs = (const unsigned short*)&vreg;
#pragma unroll
          for (int i = 0; i < 8; ++i) Vt[(lch + i) * 72 + lkey] = vs[i]; }
        __syncthreads();
        if (jt > 0) {
            kreg = *(const u32x4*)(P + (size_t)(64 * (jt - 1) + lkey) * INC + PC_SK + h * 64 + lch);
            vreg = *(const u32x4*)(P + (size_t)(64 * (jt - 1) + lkey) * INC + PC_SV + h * 64 + lch);
        }
        const int k0 = 64 * jt;
        if (k0 >= q0w + 31) continue;
        f32x16 p0 = {}, p1 = {};
#pragma unroll
        for (int s = 0; s < 4; ++s) {
            const bf16x8 ka = *(const bf16x8*)(Ks + r * 72 + 16 * s + 8 * hh);
            const bf16x8 kb = *(const bf16x8*)(Ks + (32 + r) * 72 + 16 * s + 8 * hh);
            p0 = __builtin_amdgcn_mfma_f32_32x32x16_bf16(ka, qr[s], p0, 0, 0, 0);
            p1 = __builtin_amdgcn_mfma_f32_32x32x16_bf16(kb, qr[s], p1, 0, 0, 0);
        }
        const bool need_mask = (k0 + 63 >= q0w);
        float pa[8];
#pragma unroll
        for (int g = 0; g < 8; ++g) {
            float kp[4], sg[4];
#pragma unroll
            for (int i = 0; i < 4; ++i) {
                const float z = (g < 4) ? p0[4 * g + i] : p1[4 * (g - 4) + i];
                const float e = __builtin_amdgcn_exp2f(z);
                float kk = __builtin_amdgcn_rcpf(1.0f + e);
                float s_ = 1.0f - kk;
                if (need_mask) { const int key = k0 + 32 * (g >> 2) + 8 * (g & 3) + 4 * hh + i; if (key >= qmine) { kk = 1.0f; s_ = 0.0f; } }
                kp[i] = kk; sg[i] = s_;
            }
            const float x2 = kp[3], x1 = x2 * kp[2], x0 = x1 * kp[1];
            pa[g] = x0 * kp[0];
            const float v0 = sg[0] * x0, v1 = sg[1] * x1, v2 = sg[2] * x2, v3 = sg[3];
            if (g < 4) { p0[4 * g] = v0; p0[4 * g + 1] = v1; p0[4 * g + 2] = v2; p0[4 * g + 3] = v3; }
            else { p1[4 * (g - 4)] = v0; p1[4 * (g - 4) + 1] = v1; p1[4 * (g - 4) + 2] = v2; p1[4 * (g - 4) + 3] = v3; }
        }
        float pb[8];
#pragma unroll
        for (int g = 0; g < 8; ++g) pb[g] = __shfl_xor(pa[g], 32);
        float E[8];
        E[7] = hh ? 1.0f : pb[7];
#pragma unroll
        for (int g = 6; g >= 0; --g) E[g] = E[g + 1] * pa[g + 1] * (hh ? pb[g + 1] : pb[g]);
        const float T = E[0] * pa[0] * (hh ? pb[0] : 1.0f);
#pragma unroll
        for (int g = 0; g < 8; ++g) { const float re = E[g] * Rrun;
#pragma unroll
            for (int i = 0; i < 4; ++i) { if (g < 4) p0[4 * g + i] *= re; else p1[4 * (g - 4) + i] *= re; } }
        Rrun *= T;
#pragma unroll
        for (int s = 0; s < 4; ++s) {
            u32x4 pw;
            if (s < 2) { pw.x = pk2(p0[8 * s], p0[8 * s + 1]); pw.y = pk2(p0[8 * s + 2], p0[8 * s + 3]); pw.z = pk2(p0[8 * s + 4], p0[8 * s + 5]); pw.w = pk2(p0[8 * s + 6], p0[8 * s + 7]); }
            else { const int s2 = s - 2; pw.x = pk2(p1[8 * s2], p1[8 * s2 + 1]); pw.y = pk2(p1[8 * s2 + 2], p1[8 * s2 + 3]); pw.z = pk2(p1[8 * s2 + 4], p1[8 * s2 + 5]); pw.w = pk2(p1[8 * s2 + 6], p1[8 * s2 + 7]); }
            const bf16x8 pf = __builtin_bit_cast(bf16x8, pw);
            const int kb = 16 * s;
            { const s16x4 lo = *(const s16x4*)(Vt + r * 72 + kb + 4 * hh), hi = *(const s16x4*)(Vt + r * 72 + kb + 8 + 4 * hh);
              const bf16x8 vf = __builtin_shufflevector(lo, hi, 0, 1, 2, 3, 4, 5, 6, 7);
              o0 = __builtin_amdgcn_mfma_f32_32x32x16_bf16(vf, pf, o0, 0, 0, 0); }
            { const s16x4 lo = *(const s16x4*)(Vt + (32 + r) * 72 + kb + 4 * hh), hi = *(const s16x4*)(Vt + (32 + r) * 72 + kb + 8 + 4 * hh);
              const bf16x8 vf = __builtin_shufflevector(lo, hi, 0, 1, 2, 3, 4, 5, 6, 7);
              o1 = __builtin_amdgcn_mfma_f32_32x32x16_bf16(vf, pf, o1, 0, 0, 0); }
        }
    }
    float ss = 0.f;
#pragma unroll
    for (int i = 0; i < 16; ++i) ss += o0[i] * o0[i] + o1[i] * o1[i];
    ss += __shfl_xor(ss, 32);
    const float sc = rsqrtf(ss * (1.0f / 64.0f) + RMS_EPS);
    const float* ng = A.in[I_SBAG] + layer * SW + h * 64;
    bf16* orow = MIX + (size_t)(q0w + r) * D + MIX_S + h * 64;
#pragma unroll
    for (int g = 0; g < 4; ++g) {
        const int d = 8 * g + 4 * hh;
        const f32x4 g0 = *(const f32x4*)(ng + d), g1 = *(const f32x4*)(ng + 32 + d);
        u32x2 w0, w1;
        w0.x = pk2(o0[4 * g] * sc * g0[0], o0[4 * g + 1] * sc * g0[1]); w0.y = pk2(o0[4 * g + 2] * sc * g0[2], o0[4 * g + 3] * sc * g0[3]);
        w1.x = pk2(o1[4 * g] * sc * g1[0], o1[4 * g + 1] * sc * g1[1]); w1.y = pk2(o1[4 * g + 2] * sc * g1[2], o1[4 * g + 3] * sc * g1[3]);
        *(u32x2*)(orow + d) = w0; *(u32x2*)(orow + 32 + d) = w1;
    }
    __syncthreads();
}

constexpr int CP = 72;
constexpr size_t SC_MP = 0, SC_NN = 48 * MiB, SC_QH = 96 * MiB, SC_OL = 144 * MiB;
constexpr size_t WS_G = 836 * MiB, WS_RHO = 884 * MiB, WS_GC = 886 * MiB;
__device__ __forceinline__ f32x16 mm32(const bf16* X, const bf16* Y, int lane, f32x16 acc) {
    const int r = lane & 31, hh = lane >> 5;
#pragma unroll
    for (int s_ = 0; s_ < 4; ++s_) {
        const bf16x8 a = *(const bf16x8*)(X + r * CP + 16 * s_ + 8 * hh);
        const bf16x8 b = *(const bf16x8*)(Y + r * CP + 16 * s_ + 8 * hh);
        acc = __builtin_amdgcn_mfma_f32_32x32x16_bf16(a, b, acc, 0, 0, 0);
    }
    return acc;
}
__device__ __forceinline__ u32x4 packfrag(const f32x16& a, int sp) {
    u32x4 w;
    if (sp == 0) { w.x = pk2(a[0], a[1]); w.y = pk2(a[2], a[3]); w.z = pk2(a[4], a[5]); w.w = pk2(a[6], a[7]); }
    else { w.x = pk2(a[8], a[9]); w.y = pk2(a[10], a[11]); w.z = pk2(a[12], a[13]); w.w = pk2(a[14], a[15]); }
    return w;
}
__device__ __forceinline__ void rwkv_r1_unit(const int tid_in, const Args& A, int layer, int uidx, unsigned char* lds, const int stop = 99) {
    int tid = tid_in; asm volatile("" : "+v"(tid));
    const int lane = tid & 63, wave = __builtin_amdgcn_readfirstlane(tid >> 6), r31 = lane & 31, hh = lane >> 5;
    const int head = uidx >> 6, c = uidx & 63, b = head / RH, h = head % RH, t0 = c * 64;
    const size_t brow = (size_t)b * SEQ;
    const bf16* P = (const bf16*)(A.ws + WS_P) + brow * INC;
    float* wS = (float*)lds; float* aS = wS + 4096; float* gS = aS + 4096;
    bf16* AAB = (bf16*)lds; bf16* AAK = AAB + 64 * CP; bf16* ARB = AAK + 64 * CP; bf16* ARK = ARB + 64 * CP;
    bf16* TM = ARK + 64 * CP; bf16* TMt = TM + 64 * CP; bf16* X1t = TMt + 64 * CP;
    unsigned char* ob = lds + 7 * 64 * CP * 2;
    bf16* AL = (bf16*)ob;
    bf16* AH = (bf16*)ob; bf16* QT = AH + 64 * CP; bf16* BH = QT + 64 * CP; bf16* KH = BH + 64 * CP;
    bf16* BHt = KH + 64 * CP; bf16* KHt = BHt + 64 * CP; bf16* Vt = KHt + 64 * CP; bf16* AHt = Vt + 64 * CP;
    bf16* WTt = KH; bf16* UTt = AH;
    float* segT = (float*)(ob + 8 * 64 * CP * 2);
    float* gCs = segT + 512;
    bf16* PTs = (bf16*)(gCs + 64);
    const float* mu = A.in[I_MU] + layer * RCOLS;
    const int c4 = (tid & 15) * 4, tkA = tid >> 4, ch = h * 64 + c4;
#pragma unroll 2
    for (int q = 0; q < 4; ++q) {
        const int item = tid + NTHR * q, tok = item >> 5, cc = (item & 31) * 8, pc = PC_DW + cc, t = t0 + tok;
        const u32x4 cu = *(const u32x4*)(P + (size_t)t * INC + pc);
        u32x4 pv = {0u, 0u, 0u, 0u};
        if (t > 0) pv = *(const u32x4*)(P + (size_t)(t - 1) * INC + pc);
        const f32x4 m0 = *(const f32x4*)(mu + pc), m1 = *(const f32x4*)(mu + pc + 4);
        float v[8];
        { float c_, p_;
          c_ = lo16(cu.x); p_ = lo16(pv.x); v[0] = c_ + m0[0] * (p_ - c_); c_ = hi16(cu.x); p_ = hi16(pv.x); v[1] = c_ + m0[1] * (p_ - c_);
          c_ = lo16(cu.y); p_ = lo16(pv.y); v[2] = c_ + m0[2] * (p_ - c_); c_ = hi16(cu.y); p_ = hi16(pv.y); v[3] = c_ + m0[3] * (p_ - c_);
          c_ = lo16(cu.z); p_ = lo16(pv.z); v[4] = c_ + m1[0] * (p_ - c_); c_ = hi16(cu.z); p_ = hi16(pv.z); v[5] = c_ + m1[1] * (p_ - c_);
          c_ = lo16(cu.w); p_ = lo16(pv.w); v[6] = c_ + m1[2] * (p_ - c_); c_ = hi16(cu.w); p_ = hi16(pv.w); v[7] = c_ + m1[3] * (p_ - c_); }
        if (cc < 64) {
#pragma unroll
            for (int i = 0; i < 8; ++i) { const float e2 = __expf(2.0f * v[i]); v[i] = 1.0f - 2.0f * __builtin_amdgcn_rcpf(e2 + 1.0f); }
        } else if (cc >= 128) {
#pragma unroll
            for (int i = 0; i < 8; ++i) v[i] = sigmoidf_(v[i]);
        }
        u32x4 w; w.x = pk2(v[0], v[1]); w.y = pk2(v[2], v[3]); w.z = pk2(v[4], v[5]); w.w = pk2(v[6], v[7]);
        *(u32x4*)(AL + tok * 264 + cc) = w;
    }
    __syncthreads();
    if (stop <= 1) return;
    {
        const bf16* WupT = (const bf16*)(A.ws + WS_WSM); const bf16* AupT = WupT + 384 * 64; const bf16* GupT = AupT + 384 * 64;
        const int jt = wave & 3, rowj = h * 64 + 16 * jt + (lane & 15), kq8 = 8 * (lane >> 4);
        bf16x8 fw[2], fa[2], fg[4];
#pragma unroll
        for (int ks = 0; ks < 2; ++ks) { fw[ks] = *(const bf16x8*)(WupT + (size_t)rowj * 64 + 32 * ks + kq8); fa[ks] = *(const bf16x8*)(AupT + (size_t)rowj * 64 + 32 * ks + kq8); }
#pragma unroll
        for (int ks = 0; ks < 4; ++ks) fg[ks] = *(const bf16x8*)(GupT + (size_t)rowj * 128 + 32 * ks + kq8);
#pragma unroll
        for (int q = 0; q < 2; ++q) {
            const int tt = 2 * (wave >> 2) + q;
            const bf16* bl = AL + (16 * tt + (lane & 15)) * 264 + kq8;
            f32x4 accw = {0.f, 0.f, 0.f, 0.f}, acca = accw, accg = accw;
#pragma unroll
            for (int ks = 0; ks < 2; ++ks) { accw = __builtin_amdgcn_mfma_f32_16x16x32_bf16(fw[ks], *(const bf16x8*)(bl + 32 * ks), accw, 0, 0, 0);
                                            acca = __builtin_amdgcn_mfma_f32_16x16x32_bf16(fa[ks], *(const bf16x8*)(bl + 64 + 32 * ks), acca, 0, 0, 0); }
#pragma unroll
            for (int ks = 0; ks < 4; ++ks) accg = __builtin_amdgcn_mfma_f32_16x16x32_bf16(fg[ks], *(const bf16x8*)(bl + 128 + 32 * ks), accg, 0, 0, 0);
            const int o_ = (16 * tt + (lane & 15)) * 64 + 16 * jt + 4 * (lane >> 4);
            *(f32x4*)(wS + o_) = accw; *(f32x4*)(aS + o_) = acca; *(f32x4*)(gS + o_) = accg;
        }
    }
    __syncthreads();
    if (stop <= 2) return;
    f32x4 rs[2], kts[2], kkn[2], avs[2], lws[2];
    {
        const f32x4 w0v = *(const f32x4*)(A.in[I_W0] + layer * RW + ch), a0v = *(const f32x4*)(A.in[I_A0] + layer * RW + ch);
        const f32x4 kkv = *(const f32x4*)(A.in[I_KK] + layer * RW + ch), kav = *(const f32x4*)(A.in[I_KA] + layer * RW + ch), rkv = *(const f32x4*)(A.in[I_RK] + layer * RW + ch);
        const f32x4 mur = *(const f32x4*)(mu + PC_R + ch), muk = *(const f32x4*)(mu + PC_K + ch), muv = *(const f32x4*)(mu + PC_V + ch);
        bf16* Gs = (bf16*)(A.ws + WS_G); float* RHOs = (float*)(A.ws + WS_RHO);
#pragma unroll
        for (int q = 0; q < 2; ++q) {
            const int tok = tkA + 32 * q, t = t0 + tok;
            const bf16* pr = P + (size_t)t * INC;
            const u32x2 cr = *(const u32x2*)(pr + PC_R + ch), ck = *(const u32x2*)(pr + PC_K + ch), cv = *(const u32x2*)(pr + PC_V + ch);
            u32x2 qr_ = {0u, 0u}, qk_ = {0u, 0u}, qv_ = {0u, 0u};
            if (t > 0) { qr_ = *(const u32x2*)(pr - INC + PC_R + ch); qk_ = *(const u32x2*)(pr - INC + PC_K + ch); qv_ = *(const u32x2*)(pr - INC + PC_V + ch); }
            f32x4 rc = {lo16(cr.x), hi16(cr.x), lo16(cr.y), hi16(cr.y)}, rp_ = {lo16(qr_.x), hi16(qr_.x), lo16(qr_.y), hi16(qr_.y)};
            f32x4 kc = {lo16(ck.x), hi16(ck.x), lo16(ck.y), hi16(ck.y)}, kp_ = {lo16(qk_.x), hi16(qk_.x), lo16(qk_.y), hi16(qk_.y)};
            f32x4 vc = {lo16(cv.x), hi16(cv.x), lo16(cv.y), hi16(cv.y)}, vp_ = {lo16(qv_.x), hi16(qv_.x), lo16(qv_.y), hi16(qv_.y)};
            const f32x4 rv = rc + mur * (rp_ - rc), kv = kc + muk * (kp_ - kc), vv = vc + muv * (vp_ - vc);
            const f32x4 wp = *(const f32x4*)(wS + tok * 64 + c4), ap = *(const f32x4*)(aS + tok * 64 + c4), gp = *(const f32x4*)(gS + tok * 64 + c4);
            f32x4 lw, av, kkx, kt; float n2 = 0.f, rpv = 0.f;
#pragma unroll
            for (int i = 0; i < 4; ++i) {
                const float x = w0v[i] + wp[i];
                lw[i] = -(__builtin_amdgcn_rcpf(1.0f + __expf(-x)) * 0.6065306597126334f);
                av[i] = sigmoidf_(a0v[i] + ap[i]);
                kkx[i] = kv[i] * kkv[i]; n2 += kkx[i] * kkx[i];
                kt[i] = kv[i] * (1.0f + (av[i] - 1.0f) * kav[i]);
                rpv += rv[i] * kt[i] * rkv[i];
            }
            n2 = red16(n2); rpv = red16(rpv);
            const float inv = 1.0f / fmaxf(sqrtf(n2), 1e-12f);
            rs[q] = rv; kts[q] = kt; kkn[q] = kkx * inv; avs[q] = av; lws[q] = lw;
#pragma unroll
            for (int i = 0; i < 4; ++i) Vt[(c4 + i) * CP + tok] = (unsigned short)(pk2(vv[i], 0.f) & 0xffffu);
            *(f32x4*)(wS + tok * 64 + c4) = lw;
            u32x2 gw; gw.x = pk2(gp[0], gp[1]); gw.y = pk2(gp[2], gp[3]);
            *(u32x2*)(Gs + (brow + t) * RW + ch) = gw;
            if ((tid & 15) == 0) RHOs[(brow + t) * RH + h] = rpv;
        }
    }
    __syncthreads();
    if (stop <= 3) return;
    { const int k = tid & 63, seg = tid >> 6; float run = 0.f;
#pragma unroll
      for (int i = 0; i < 8; ++i) { float* p = wS + (8 * seg + i) * 64 + k; run += *p; *p = run; }
      segT[seg * 64 + k] = run; }
    __syncthreads();
    if (stop <= 4) return;
    { u32x4* z = (u32x4*)TM; const u32x4 zz = {0u, 0u, 0u, 0u};
      for (int i = tid; i < 2 * 64 * CP * 2 / 16; i += NTHR) z[i] = zz;
      if (tid < 3 * 16 * 40 * 2 / 16) ((u32x4*)PTs)[tid] = zz; }
#pragma unroll
    for (int q = 0; q < 2; ++q) {
        const int tok = tkA + 32 * q, seg = tok >> 3;
        f32x4 L = *(const f32x4*)(wS + tok * 64 + c4);
        for (int s_ = 0; s_ < seg; ++s_) L = L + *(const f32x4*)(segT + s_ * 64 + c4);
        f32x4 eL, eNL, eLp;
#pragma unroll
        for (int i = 0; i < 4; ++i) { eL[i] = __expf(L[i]); eNL[i] = __expf(-L[i]); eLp[i] = __expf(L[i] - lws[q][i]); }
        const f32x4 qt = rs[q] * eL, kh = kts[q] * eNL, ah = -(kkn[q] * eLp), bh = kkn[q] * avs[q] * eNL;
        u32x2 w;
        w.x = pk2(ah[0], ah[1]); w.y = pk2(ah[2], ah[3]); *(u32x2*)(AH + tok * CP + c4) = w;
        w.x = pk2(qt[0], qt[1]); w.y = pk2(qt[2], qt[3]); *(u32x2*)(QT + tok * CP + c4) = w;
        w.x = pk2(bh[0], bh[1]); w.y = pk2(bh[2], bh[3]); *(u32x2*)(BH + tok * CP + c4) = w;
        w.x = pk2(kh[0], kh[1]); w.y = pk2(kh[2], kh[3]); *(u32x2*)(KH + tok * CP + c4) = w;
#pragma unroll
        for (int i = 0; i < 4; ++i) {
            BHt[(c4 + i) * CP + tok] = (unsigned short)(pk2(bh[i], 0.f) & 0xffffu);
            KHt[(c4 + i) * CP + tok] = (unsigned short)(pk2(kh[i], 0.f) & 0xffffu);
        }
#pragma unroll
        for (int i = 0; i < 4; ++i) AHt[(c4 + i) * CP + tok] = (unsigned short)(pk2(ah[i], 0.f) & 0xffffu);
        if (tok == 63) { *(f32x4*)(gCs + c4) = eL; *(f32x4*)((float*)(A.ws + WS_GC) + (size_t)uidx * 64 + c4) = eL; }
    }
    __syncthreads();
    if (stop <= 5) return;
    {
        const int yt = wave & 3;
        const bf16* X = ((yt < 2) ? BH : KH) + 32 * (yt & 1) * CP;
#pragma unroll
        for (int q = 0; q < 2; ++q) {
            const int xt = 2 * (wave >> 2) + q;
            const bf16* Y = ((xt < 2) ? AH : QT) + 32 * (xt & 1) * CP;
            f32x16 acc = {};
            acc = mm32(X, Y, lane, acc);
            bf16* dst = (xt < 2) ? ((yt < 2) ? AAB : AAK) : ((yt < 2) ? ARB : ARK);
            const int i = 32 * (xt & 1) + r31;
#pragma unroll
            for (int g = 0; g < 4; ++g) {
                const int j0 = 32 * (yt & 1) + 8 * g + 4 * hh;
                float v[4];
#pragma unroll
                for (int e = 0; e < 4; ++e) { const int j = j0 + e; const bool keep = (xt < 2) ? (j < i) : (j <= i); v[e] = keep ? acc[4 * g + e] : 0.f; }
                { u32x2 w; w.x = pk2(v[0], v[1]); w.y = pk2(v[2], v[3]); *(u32x2*)(dst + i * CP + j0) = w; }
            }
        }
    }
    __syncthreads();
    if (stop <= 6) return;
    if (wave < 4) {
        const int mt = wave & 1, nt = wave >> 1;
        f32x16 acc = {};
        acc = mm32(AAK + 32 * mt * CP, Vt + 32 * nt * CP, lane, acc);
#pragma unroll
        for (int g = 0; g < 4; ++g) { u32x2 w; w.x = pk2(acc[4 * g], acc[4 * g + 1]); w.y = pk2(acc[4 * g + 2], acc[4 * g + 3]);
            *(u32x2*)(X1t + (32 * nt + r31) * CP + 32 * mt + 8 * g + 4 * hh) = w; }
    } else if (wave == 4) {
        const int bi = lane >> 4, cc = lane & 15;
        float x[16];
#pragma unroll
        for (int i = 0; i < 16; ++i) {
            const u32x4 a0 = *(const u32x4*)(AAB + (16 * bi + i) * CP + 16 * bi), a1 = *(const u32x4*)(AAB + (16 * bi + i) * CP + 16 * bi + 8);
            const float av_[16] = {lo16(a0.x), hi16(a0.x), lo16(a0.y), hi16(a0.y), lo16(a0.z), hi16(a0.z), lo16(a0.w), hi16(a0.w),
                                   lo16(a1.x), hi16(a1.x), lo16(a1.y), hi16(a1.y), lo16(a1.z), hi16(a1.z), lo16(a1.w), hi16(a1.w)};
            float v_ = (i == cc) ? 1.0f : 0.0f;
#pragma unroll
            for (int j = 0; j < i; ++j) v_ += av_[j] * x[j];
            x[i] = v_;
            TM[(16 * bi + i) * CP + 16 * bi + cc] = (unsigned short)(pk2(v_, 0.f) & 0xffffu);
        }
        u32x4 w0, w1;
        w0.x = pk2(x[0], x[1]); w0.y = pk2(x[2], x[3]); w0.z = pk2(x[4], x[5]); w0.w = pk2(x[6], x[7]);
        w1.x = pk2(x[8], x[9]); w1.y = pk2(x[10], x[11]); w1.z = pk2(x[12], x[13]); w1.w = pk2(x[14], x[15]);
        *(u32x4*)(TMt + (16 * bi + cc) * CP + 16 * bi) = w0; *(u32x4*)(TMt + (16 * bi + cc) * CP + 16 * bi + 8) = w1;
    }
    __syncthreads();
    if (stop <= 7) return;
#pragma unroll
    for (int lvl = 1; lvl < 4; ++lvl) {
        if (wave < 4 - lvl) {
            const int bj = wave, bi = wave + lvl, l15 = lane & 15, q4 = lane >> 4;
            bf16* Pt = PTs + wave * (16 * 40);
            f32x4 acc = {0.f, 0.f, 0.f, 0.f};
#pragma unroll
            for (int ks = 0; ks < 2; ++ks)
                acc = __builtin_amdgcn_mfma_f32_16x16x32_bf16(*(const bf16x8*)(AAB + (16 * bi + l15) * CP + 32 * ks + 8 * q4), *(const bf16x8*)(TMt + (16 * bj + l15) * CP + 32 * ks + 8 * q4), acc, 0, 0, 0);
            { u32x2 w; w.x = pk2(acc[0], acc[1]); w.y = pk2(acc[2], acc[3]); *(u32x2*)(Pt + l15 * 40 + 4 * q4) = w; }
            asm volatile("s_waitcnt lgkmcnt(0)" ::: "memory");
            bf16x8 a2 = {0, 0, 0, 0, 0, 0, 0, 0};
            if (q4 < 2) a2 = *(const bf16x8*)(TM + (16 * bi + l15) * CP + 16 * bi + 8 * q4);
            const bf16x8 b2 = *(const bf16x8*)(Pt + l15 * 40 + 8 * q4);
            f32x4 xo = {0.f, 0.f, 0.f, 0.f};
            xo = __builtin_amdgcn_mfma_f32_16x16x32_bf16(a2, b2, xo, 0, 0, 0);
#pragma unroll
            for (int e = 0; e < 4; ++e) TM[(16 * bi + 4 * q4 + e) * CP + 16 * bj + l15] = (unsigned short)(pk2(xo[e], 0.f) & 0xffffu);
            { u32x2 w; w.x = pk2(xo[0], xo[1]); w.y = pk2(xo[2], xo[3]); *(u32x2*)(TMt + (16 * bj + l15) * CP + 16 * bi + 4 * q4) = w; }
        }
        __syncthreads();
    }
    {
        const int it = wave & 1, ct = (wave >> 1) & 1;
        const bf16* Y = (wave < 4) ? AHt : X1t; bf16* dst = (wave < 4) ? WTt : UTt;
        f32x16 acc = {};
        acc = mm32(TM + 32 * it * CP, Y + 32 * ct * CP, lane, acc);
#pragma unroll
        for (int g = 0; g < 4; ++g) { u32x2 w; w.x = pk2(acc[4 * g], acc[4 * g + 1]); w.y = pk2(acc[4 * g + 2], acc[4 * g + 3]);
            *(u32x2*)(dst + (32 * ct + r31) * CP + 32 * it + 8 * g + 4 * hh) = w; }
    }
    __syncthreads();
    if (stop <= 8) return;
    {
        u32x4* MPs = (u32x4*)((unsigned char*)A.out + SC_MP) + (size_t)uidx * 512;
        u32x4* NNs = (u32x4*)((unsigned char*)A.out + SC_NN) + (size_t)uidx * 512;
        u32x4* QHs = (u32x4*)((unsigned char*)A.out + SC_QH) + (size_t)uidx * 512;
        u32x4* OLs = (u32x4*)((unsigned char*)A.out + SC_OL) + (size_t)uidx * 512;
        if (wave < 2) {
            const int it = wave;
#pragma unroll
            for (int kt = 0; kt < 2; ++kt) {
                f32x16 acc = {};
                acc = mm32(WTt + 32 * kt * CP, ARB + 32 * it * CP, lane, acc);
#pragma unroll
                for (int g = 0; g < 4; ++g) { const u32x2 qv = *(const u32x2*)(QT + (32 * it + r31) * CP + 32 * kt + 8 * g + 4 * hh);
                    acc[4 * g] += lo16(qv.x); acc[4 * g + 1] += hi16(qv.x); acc[4 * g + 2] += lo16(qv.y); acc[4 * g + 3] += hi16(qv.y); }
                QHs[(it * 4 + 2 * kt) * 64 + lane] = packfrag(acc, 0); QHs[(it * 4 + 2 * kt + 1) * 64 + lane] = packfrag(acc, 1);
            }
        } else if (wave < 4) {
            const int ktp = wave - 2; const float gc = gCs[32 * ktp + r31];
#pragma unroll
            for (int kt = 0; kt < 2; ++kt) {
                f32x16 acc = {};
                acc = mm32(WTt + 32 * kt * CP, BHt + 32 * ktp * CP, lane, acc);
                acc = acc * gc;
                MPs[((ktp * 2 + kt) * 2) * 64 + lane] = packfrag(acc, 0); MPs[((ktp * 2 + kt) * 2 + 1) * 64 + lane] = packfrag(acc, 1);
            }
        } else {
            const int q = wave & 3;
            { const int kt = q & 1, vt = q >> 1;
              f32x16 nacc = {};
              nacc = mm32(KHt + 32 * kt * CP, Vt + 32 * vt * CP, lane, nacc);
              nacc = mm32(BHt + 32 * kt * CP, UTt + 32 * vt * CP, lane, nacc);
#pragma unroll
              for (int g = 0; g < 4; ++g) { const f32x4 gc = *(const f32x4*)(gCs + 32 * kt + 8 * g + 4 * hh);
                  nacc[4 * g] *= gc[0]; nacc[4 * g + 1] *= gc[1]; nacc[4 * g + 2] *= gc[2]; nacc[4 * g + 3] *= gc[3]; }
              NNs[((vt * 2 + kt) * 2) * 64 + lane] = packfrag(nacc, 0); NNs[((vt * 2 + kt) * 2 + 1) * 64 + lane] = packfrag(nacc, 1); }
            { const int vt = q & 1, it = q >> 1;
              f32x16 oacc = {};
              oacc = mm32(Vt + 32 * vt * CP, ARK + 32 * it * CP, lane, oacc);
              oacc = mm32(UTt + 32 * vt * CP, ARB + 32 * it * CP, lane, oacc);
              OLs[((it * 2 + vt) * 2) * 64 + lane] = packfrag(oacc, 0); OLs[((it * 2 + vt) * 2 + 1) * 64 + lane] = packfrag(oacc, 1); }
        }
    }
    __syncthreads();
}
__device__ __forceinline__ void rwkv_r2_unit(const int tid_in, const Args& A, int u) {
    int tid = tid_in; asm volatile("" : "+v"(tid));
    const int lane = tid & 63, wave = __builtin_amdgcn_readfirstlane(tid >> 6), hh = lane >> 5;
    const int head = 4 * u + (wave >> 1), vt = wave & 1;
    const u32x4* MPs = (const u32x4*)((unsigned char*)A.out + SC_MP) + (size_t)head * 64 * 512;
    u32x4* NNs = (u32x4*)((unsigned char*)A.out + SC_NN) + (size_t)head * 64 * 512;
    const float* GCs = (const float*)(A.ws + WS_GC) + (size_t)head * 64 * 64;
    f32x16 acc0 = {}, acc1 = {};
    for (int c = 0; c < 64; ++c) {
        u32x4 mp[8], nn[4]; f32x4 gm[8];
#pragma unroll
        for (int i = 0; i < 8; ++i) mp[i] = MPs[(size_t)c * 512 + i * 64 + lane];
#pragma unroll
        for (int i = 0; i < 4; ++i) nn[i] = NNs[(size_t)c * 512 + vt * 256 + i * 64 + lane];
#pragma unroll
        for (int i = 0; i < 8; ++i) gm[i] = *(const f32x4*)(GCs + c * 64 + 32 * (i >> 2) + 8 * (i & 3) + 4 * hh);
        const u32x4 hb0 = packfrag(acc0, 0), hb1 = packfrag(acc0, 1), hb2 = packfrag(acc1, 0), hb3 = packfrag(acc1, 1);
#pragma unroll
        for (int g = 0; g < 4; ++g) {
            const unsigned* n0 = (const unsigned*)&nn[g >> 1]; const unsigned* n1 = (const unsigned*)&nn[2 + (g >> 1)];
            const int o_ = 2 * (g & 1);
            acc0[4 * g] = acc0[4 * g] * gm[g][0] + lo16(n0[o_]); acc0[4 * g + 1] = acc0[4 * g + 1] * gm[g][1] + hi16(n0[o_]);
            acc0[4 * g + 2] = acc0[4 * g + 2] * gm[g][2] + lo16(n0[o_ + 1]); acc0[4 * g + 3] = acc0[4 * g + 3] * gm[g][3] + hi16(n0[o_ + 1]);
            acc1[4 * g] = acc1[4 * g] * gm[4 + g][0] + lo16(n1[o_]); acc1[4 * g + 1] = acc1[4 * g + 1] * gm[4 + g][1] + hi16(n1[o_]);
            acc1[4 * g + 2] = acc1[4 * g + 2] * gm[4 + g][2] + lo16(n1[o_ + 1]); acc1[4 * g + 3] = acc1[4 * g + 3] * gm[4 + g][3] + hi16(n1[o_ + 1]);
        }
        NNs[(size_t)c * 512 + vt * 256 + 0 * 64 + lane] = hb0; NNs[(size_t)c * 512 + vt * 256 + 1 * 64 + lane] = hb1;
        NNs[(size_t)c * 512 + vt * 256 + 2 * 64 + lane] = hb2; NNs[(size_t)c * 512 + vt * 256 + 3 * 64 + lane] = hb3;
        const bf16x8 b0 = __builtin_bit_cast(bf16x8, hb0), b1 = __builtin_bit_cast(bf16x8, hb1), b2 = __builtin_bit_cast(bf16x8, hb2), b3 = __builtin_bit_cast(bf16x8, hb3);
        acc0 = __builtin_amdgcn_mfma_f32_32x32x16_bf16(__builtin_bit_cast(bf16x8, mp[0]), b0, acc0, 0, 0, 0);
        acc1 = __builtin_amdgcn_mfma_f32_32x32x16_bf16(__builtin_bit_cast(bf16x8, mp[4]), b0, acc1, 0, 0, 0);
        acc0 = __builtin_amdgcn_mfma_f32_32x32x16_bf16(__builtin_bit_cast(bf16x8, mp[1]), b1, acc0, 0, 0, 0);
        acc1 = __builtin_amdgcn_mfma_f32_32x32x16_bf16(__builtin_bit_cast(bf16x8, mp[5]), b1, acc1, 0, 0, 0);
        acc0 = __builtin_amdgcn_mfma_f32_32x32x16_bf16(__builtin_bit_cast(bf16x8, mp[2]), b2, acc0, 0, 0, 0);
        acc1 = __builtin_amdgcn_mfma_f32_32x32x16_bf16(__builtin_bit_cast(bf16x8, mp[6]), b2, acc1, 0, 0, 0);
        acc0 = __builtin_amdgcn_mfma_f32_32x32x16_bf16(__builtin_bit_cast(bf16x8, mp[3]), b3, acc0, 0, 0, 0);
        acc1 = __builtin_amdgcn_mfma_f32_32x32x16_bf16(__builtin_bit_cast(bf16x8, mp[7]), b3, acc1, 0, 0, 0);
    }
}
__device__ __forceinline__ void rwkv_r3_unit(const int tid_in, const Args& A, int layer, int u) {
    int tid = tid_in; asm volatile("" : "+v"(tid));
    const int lane = tid & 63, wave = __builtin_amdgcn_readfirstlane(tid >> 6), r31 = lane & 31, hh = lane >> 5;
    const int uidx = 4 * u + (wave >> 1), it = wave & 1;
    const int head = uidx >> 6, c = uidx & 63, b = head / RH, h = head % RH;
    const size_t trow = (size_t)b * SEQ + c * 64 + 32 * it + r31;
    const u32x4* HSs = (const u32x4*)((unsigned char*)A.out + SC_NN) + (size_t)uidx * 512;
    const u32x4* QHs = (const u32x4*)((unsigned char*)A.out + SC_QH) + (size_t)uidx * 512;
    const u32x4* OLs = (const u32x4*)((unsigned char*)A.out + SC_OL) + (size_t)uidx * 512;
    f32x16 acc[2];
#pragma unroll
    for (int vt = 0; vt < 2; ++vt) {
        const u32x4 o0 = OLs[((it * 2 + vt) * 2) * 64 + lane], o1 = OLs[((it * 2 + vt) * 2 + 1) * 64 + lane];
        acc[vt][0] = lo16(o0.x); acc[vt][1] = hi16(o0.x); acc[vt][2] = lo16(o0.y); acc[vt][3] = hi16(o0.y); acc[vt][4] = lo16(o0.z); acc[vt][5] = hi16(o0.z); acc[vt][6] = lo16(o0.w); acc[vt][7] = hi16(o0.w);
        acc[vt][8] = lo16(o1.x); acc[vt][9] = hi16(o1.x); acc[vt][10] = lo16(o1.y); acc[vt][11] = hi16(o1.y); acc[vt][12] = lo16(o1.z); acc[vt][13] = hi16(o1.z); acc[vt][14] = lo16(o1.w); acc[vt][15] = hi16(o1.w);
    }
#pragma unroll
    for (int s_ = 0; s_ < 4; ++s_) {
        const bf16x8 qf = __builtin_bit_cast(bf16x8, QHs[(it * 4 + s_) * 64 + lane]);
#pragma unroll
        for (int vt = 0; vt < 2; ++vt) {
            const bf16x8 hf = __builtin_bit_cast(bf16x8, HSs[vt * 256 + s_ * 64 + lane]);
            acc[vt] = __builtin_amdgcn_mfma_f32_32x32x16_bf16(hf, qf, acc[vt], 0, 0, 0);
        }
    }
    float sm = 0.f;
#pragma unroll
    for (int e = 0; e < 16; ++e) sm += acc[0][e] + acc[1][e];
    sm += __shfl_xor(sm, 32);
    const float mean = sm * (1.0f / 64.0f);
    float q2 = 0.f;
#pragma unroll
    for (int e = 0; e < 16; ++e) { const float d0 = acc[0][e] - mean, d1 = acc[1][e] - mean; q2 += d0 * d0 + d1 * d1; }
    q2 += __shfl_xor(q2, 32);
    const float rstd = rsqrtf(q2 * (1.0f / 64.0f) + GN_EPS);
    const float rh = ((const float*)(A.ws + WS_RHO))[trow * RH + h];
    const bf16* P = (const bf16*)(A.ws + WS_P); const bf16* Gs = (const bf16*)(A.ws + WS_G); bf16* MIX = (bf16*)(A.ws + WS_MIX);
    const bool hasprev = (c * 64 + 32 * it + r31) > 0;
#pragma unroll
    for (int vt = 0; vt < 2; ++vt)
#pragma unroll
        for (int g = 0; g < 4; ++g) {
            const int vch = h * 64 + 32 * vt + 8 * g + 4 * hh;
            const f32x4 lg = *(const f32x4*)(A.in[I_LNG] + layer * RW + vch), lb = *(const f32x4*)(A.in[I_LNB] + layer * RW + vch), muv = *(const f32x4*)(A.in[I_MU] + layer * RCOLS + PC_V + vch);
            const u32x2 cv = *(const u32x2*)(P + trow * INC + PC_V + vch);
            u32x2 pv = {0u, 0u}; if (hasprev) pv = *(const u32x2*)(P + (trow - 1) * INC + PC_V + vch);
            const u32x2 gw = *(const u32x2*)(Gs + trow * RW + vch);
            const f32x4 vc = {lo16(cv.x), hi16(cv.x), lo16(cv.y), hi16(cv.y)}, vp = {lo16(pv.x), hi16(pv.x), lo16(pv.y), hi16(pv.y)};
            const f32x4 vv = vc + muv * (vp - vc), gg = {lo16(gw.x), hi16(gw.x), lo16(gw.y), hi16(gw.y)};
            float y[4];
#pragma unroll
            for (int e = 0; e < 4; ++e) y[e] = ((acc[vt][4 * g + e] - mean) * rstd * lg[e] + lb[e] + rh * vv[e]) * gg[e];
            u32x2 w; w.x = pk2(y[0], y[1]); w.y = pk2(y[2], y[3]);
            *(u32x2*)(MIX + trow * D + MIX_R + vch) = w;
        }
}

constexpr int LT = 16;
__device__ __forceinline__ float gelu_tanh(float x) { const float u = 0.7978845608028654f * (x + 0.044715f * x * x * x); return x * __builtin_amdgcn_rcpf(1.0f + __expf(-2.0f * u)); }
__device__ __forceinline__ float neg_expm1(float x) { return (x > -0.25f) ? -x * (1.0f + x * (0.5f + x * (0.16666667f + x * (0.041666668f + x * (0.0083333338f + x * 0.0013888889f))))) : 1.0f - __expf(x); }
__device__ __forceinline__ void lru_unit(const int tid_in, const Args& A, int layer, int bg, unsigned char* lds) {
    int tid = tid_in; asm volatile("" : "+v"(tid));
    const int lane = tid & 63, wave = __builtin_amdgcn_readfirstlane(tid >> 6);
    const int b = bg / LB, g = bg % LB, c = g * 64 + lane;
    const bf16* P = (const bf16*)(A.ws + WS_P) + (size_t)b * SEQ * INC;
    bf16* MIX = (bf16*)(A.ws + WS_MIX) + (size_t)b * SEQ * D;
    bf16* WAs = (bf16*)lds;
    bf16* WXs = WAs + 64 * 72;
    float* totA = (float*)(WXs + 64 * 72);
    float* totH = totA + 8 * 64;
    float* carryS = totH + 8 * 64;
    bf16* XC = (bf16*)(carryS + 64) + wave * (LT * 72);
    float* PRE = (float*)((bf16*)(carryS + 64) + 8 * LT * 72) + wave * (2 * LT * 68);
    const bf16* LwaT = (const bf16*)(A.ws + WS_WSM) + 98304 + g * 4096; const bf16* LwxT = LwaT + 16384;
    { const int j = tid >> 3, i8 = (tid & 7) * 8;
      *(u32x4*)(WAs + j * 72 + i8) = *(const u32x4*)(LwaT + j * 64 + i8); *(u32x4*)(WXs + j * 72 + i8) = *(const u32x4*)(LwxT + j * 64 + i8); }
    const float cw0 = A.in[I_CW][(layer * 4 + 0) * LW + c], cw1 = A.in[I_CW][(layer * 4 + 1) * LW + c], cw2 = A.in[I_CW][(layer * 4 + 2) * LW + c], cw3 = A.in[I_CW][(layer * 4 + 3) * LW + c];
    const float cb = A.in[I_CB][layer * LW + c], ba = A.in[I_BA][layer * LW + c], bx = A.in[I_BX][layer * LW + c];
    const float sp8 = 8.0f * softplusf_(-A.in[I_LAM][layer * LW + c]);
    const float ng = A.in[I_LRUG][layer * LW + c];
    if (tid < 64) carryS[tid] = 0.f;
    __syncthreads();
    for (int st = 0; st < SEQ; st += 8 * LT) {
        const int T0 = st + wave * LT;
        float xm3 = (T0 >= 3) ? bf2f(P[(size_t)(T0 - 3) * INC + PC_LX + c]) : 0.f;
        float xm2 = (T0 >= 2) ? bf2f(P[(size_t)(T0 - 2) * INC + PC_LX + c]) : 0.f;
        float xm1 = (T0 >= 1) ? bf2f(P[(size_t)(T0 - 1) * INC + PC_LX + c]) : 0.f;
        float xc[LT], gin[LT];
#pragma unroll
        for (int t = 0; t < LT; ++t) { xc[t] = bf2f(P[(size_t)(T0 + t) * INC + PC_LX + c]); gin[t] = bf2f(P[(size_t)(T0 + t) * INC + PC_LG + c]); }
#pragma unroll
        for (int t = 0; t < LT; ++t) {
            const float x = xc[t];
            xc[t] = cw0 * xm3 + cw1 * xm2 + cw2 * xm1 + cw3 * x + cb;
            xm3 = xm2; xm2 = xm1; xm1 = x;
            XC[t * 72 + lane] = (unsigned short)(pk2(xc[t], 0.f) & 0xffffu);
        }
        asm volatile("s_waitcnt lgkmcnt(0)" ::: "memory");
        {
            const bf16* bl = XC + (lane & 15) * 72 + 8 * (lane >> 4);
            const bf16x8 b0 = *(const bf16x8*)(bl), b1 = *(const bf16x8*)(bl + 32);
#pragma unroll
            for (int gt = 0; gt < 2; ++gt) {
                const bf16* Ws = gt ? WXs : WAs;
#pragma unroll
                for (int jt = 0; jt < 4; ++jt) {
                    const bf16* al = Ws + (16 * jt + (lane & 15)) * 72 + 8 * (lane >> 4);
                    f32x4 acc = {0.f, 0.f, 0.f, 0.f};
                    acc = __builtin_amdgcn_mfma_f32_16x16x32_bf16(*(const bf16x8*)(al), b0, acc, 0, 0, 0);
                    acc = __builtin_amdgcn_mfma_f32_16x16x32_bf16(*(const bf16x8*)(al + 32), b1, acc, 0, 0, 0);
                    *(f32x4*)(PRE + gt * (LT * 68) + (lane & 15) * 68 + 16 * jt + 4 * (lane >> 4)) = acc;
                }
            }
        }
        asm volatile("s_waitcnt lgkmcnt(0)" ::: "memory");
        float hl[LT], Ac[LT];
        float hrun = 0.f, arun = 1.f;
#pragma unroll
        for (int t = 0; t < LT; ++t) {
            const float ga = PRE[t * 68 + lane] + ba, gx = PRE[LT * 68 + t * 68 + lane] + bx;
            const float la = -sp8 * sigmoidf_(ga);
            const float a = __expf(la);
            const float bi = sqrtf(neg_expm1(2.0f * la)) * sigmoidf_(gx) * xc[t];
            hrun = a * hrun + bi; arun *= a;
            hl[t] = hrun; Ac[t] = arun;
        }
        totA[wave * 64 + lane] = arun; totH[wave * 64 + lane] = hrun;
        __syncthreads();
        float cin = carryS[lane];
        for (int u = 0; u < wave; ++u) cin = totA[u * 64 + lane] * cin + totH[u * 64 + lane];
        float cout = cin;
        if (wave == 7) cout = totA[7 * 64 + lane] * cin + totH[7 * 64 + lane];
#pragma unroll
        for (int t = 0; t < LT; ++t) {
            const float hv = hl[t] + Ac[t] * cin;
            const float y = gelu_tanh(gin[t]) * hv;
            const float ss = red64(y * y);
            const float o = y * rsqrtf(ss * (1.0f / 64.0f) + RMS_EPS) * ng;
            ((unsigned short*)MIX)[(size_t)(T0 + t) * D + MIX_L + c] = (unsigned short)(pk2(o, 0.f) & 0xffffu);
        }
        __syncthreads();
        if (wave == 7) carryS[lane] = cout;
        __syncthreads();
    }
}

__device__ __forceinline__ void phase_mixers(const int tid, const Args& A, int layer, int sub, unsigned char* lds, volatile LAS unsigned* misc, const int umask = 7, const int qslot = 0, const int r1stop = 99) {
    unsigned* qhead = (unsigned*)(A.ws + WS_CTL) + CW_Q + layer * 64 + sub * 8 + qslot;
    const int nR = (sub == 0) ? (64 + 1536) : (sub == 1) ? 24 : 1536;
    const int a0 = (sub == 0) ? 0 : (sub == 1) ? 288 : 384, a1 = (sub == 0) ? 288 : (sub == 1) ? 384 : 1536;
    const int NU = nR + (a1 - a0);
    for (;;) {
        __syncthreads();
        if (tid == 0) misc[4] = __hip_atomic_fetch_add(qhead, 1u, __ATOMIC_RELAXED, __HIP_MEMORY_SCOPE_AGENT);
        __syncthreads();
        const int u = (int)misc[4];
        if (u >= NU) break;
        if (u < nR) {
            if (sub == 0) {
#ifndef CUMASK
#define CUMASK 7
#endif
                if (u < 64) { if ((CUMASK & 2) && (umask & 2)) lru_unit(tid, A, layer, u, lds); }
                else if ((CUMASK & 1) && (umask & 1)) { for (int q = 0; q < 4; ++q) rwkv_r1_unit(tid, A, layer, 4 * (u - 64) + q, lds, r1stop); }
            } else if (sub == 1) { if ((CUMASK & 1) && (umask & 1)) rwkv_r2_unit(tid, A, u); }
            else { if ((CUMASK & 1) && (umask & 1)) rwkv_r3_unit(tid, A, layer, u); }
        } else { const int a = a0 + (u - nR); if ((CUMASK & 4) && (umask & 4)) attn_unit(tid, A, layer, a % 96, 15 - a / 96, lds); }
    }
}

__device__ __forceinline__ void phase_ln1_router(const int tid, const Args& A, int layer, unsigned char* lds, int vcu, int G) {
    const int lane = tid & 63, wave = tid >> 6;
    float* rwT = (float*)lds;
    int* hist = (int*)(lds + 65536);
    int* rowinfo = (int*)(lds + 65536 + 256);
    bf16* X1 = (bf16*)(A.ws + WS_X1);
    int* list = (int*)(A.ws + WS_LIST); float* gate = (float*)(A.ws + WS_GATE);
    unsigned* gcnt = (unsigned*)(A.ws + WS_CTL) + CW_CNT + layer * 64;
    const float* rw = A.in[I_RW];
    for (int i = tid; i < 16 * 1024; i += NTHR) { const int c = i >> 4, e = i & 15; rwT[e * 1024 + c] = rw[i]; }
    float rb[16];
#pragma unroll
    for (int e = 0; e < 16; ++e) rb[e] = A.in[I_RB][e];
    const float* g1 = A.in[I_LN1G] + layer * D; const float* b1 = A.in[I_LN1B] + layer * D;
    const int rows_per = M / G;
    for (int chunk = 0; chunk < rows_per / 256; ++chunk) {
        const int base = vcu * rows_per + chunk * 256;
        if (tid < 16) hist[tid] = 0;
        __syncthreads();
        for (int rp = 0; rp < 16; ++rp) {
            const int lr = wave * 32 + rp * 2;
            float y[2][16];
#pragma unroll
            for (int q = 0; q < 2; ++q) {
                const bf16* xr = X1 + (size_t)(base + lr + q) * D;
                float v[16]; float sm = 0.f;
#pragma unroll
                for (int i = 0; i < 16; ++i) { v[i] = bf2f(xr[lane + 64 * i]); sm += v[i]; }
                const float mean = red64(sm) * (1.0f / D); float s2 = 0.f;
#pragma unroll
                for (int i = 0; i < 16; ++i) { v[i] -= mean; s2 += v[i] * v[i]; }
                const float rstd = rsqrtf(red64(s2) * (1.0f / D) + LN_EPS);
#pragma unroll
                for (int i = 0; i < 16; ++i) y[q][i] = v[i] * rstd * g1[lane + 64 * i] + b1[lane + 64 * i];
                bf16* xo = X1 + (size_t)(base + lr + q) * D;
#pragma unroll
                for (int i = 0; i < 16; ++i) xo[lane + 64 * i] = (unsigned short)(pk2(y[q][i], 0.f) & 0xffffu);
            }
            float lg[2][16];
#pragma unroll
            for (int e = 0; e < 16; ++e) { float a0 = 0.f, a1 = 0.f;
#pragma unroll
                for (int i = 0; i < 16; ++i) { const float w = rwT[e * 1024 + lane + 64 * i]; a0 += y[0][i] * w; a1 += y[1][i] * w; }
                lg[0][e] = red64(a0) + rb[e]; lg[1][e] = red64(a1) + rb[e]; }
#pragma unroll
            for (int q = 0; q < 2; ++q) {
                float mx = lg[q][0];
#pragma unroll
                for (int e = 1; e < 16; ++e) mx = fmaxf(mx, lg[q][e]);
                float sc[16], den = 0.f;
#pragma unroll
                for (int e = 0; e < 16; ++e) { sc[e] = __expf(lg[q][e] - mx); den += sc[e]; }
                const float inv = 1.0f / den;
#pragma unroll
                for (int e = 0; e < 16; ++e) sc[e] *= inv;
                int sel = 0; float best = -1.f;
#pragma unroll
                for (int gq = 0; gq < 4; ++gq) {
                    const float a = sc[4 * gq], b_ = sc[4 * gq + 1], c_ = sc[4 * gq + 2], d_ = sc[4 * gq + 3];
                    const float m1 = fmaxf(fmaxf(a, b_), fmaxf(c_, d_));
                    const float m2 = fmaxf(fmaxf(fminf(a, b_), fminf(c_, d_)), fminf(fmaxf(a, b_), fmaxf(c_, d_)));
                    const float gs = m1 + m2;
                    if (gs > best) { best = gs; sel = gq; }
                }
                float cd[4];
#pragma unroll
                for (int i = 0; i < 4; ++i) cd[i] = (sel == 0) ? sc[i] : (sel == 1) ? sc[4 + i] : (sel == 2) ? sc[8 + i] : sc[12 + i];
                int i0 = 0; float v0 = cd[0];
#pragma unroll
                for (int i = 1; i < 4; ++i) if (cd[i] > v0) { v0 = cd[i]; i0 = i; }
                int i1 = -1; float v1 = -1.f;
#pragma unroll
                for (int i = 0; i < 4; ++i) if (i != i0 && cd[i] > v1) { v1 = cd[i]; i1 = i; }
                const int e0 = sel * 4 + i0, e1 = sel * 4 + i1;
                const float gsum = v0 + v1;
                if (lane == 0) {
                    const int row = base + lr + q;
                    gate[2 * row] = v0 / gsum; gate[2 * row + 1] = v1 / gsum;
                    const int r0 = atomicAdd(&hist[e0], 1), r1 = atomicAdd(&hist[e1], 1);
                    rowinfo[2 * (lr + q)] = e0 | (r0 << 8); rowinfo[2 * (lr + q) + 1] = e1 | (r1 << 8);
                }
            }
        }
        __syncthreads();
        if (tid < 16) hist[16 + tid] = (int)__hip_atomic_fetch_add(gcnt + tid, (unsigned)hist[tid], __ATOMIC_RELAXED, __HIP_MEMORY_SCOPE_AGENT);
        __syncthreads();
        { const int info = rowinfo[tid]; const int e = info & 255, rk = info >> 8;
          list[(size_t)e * LCAP + hist[16 + e] + rk] = (base + (tid >> 1)) * 2 + (tid & 1); }
        __syncthreads();
    }
}

__device__ __forceinline__ void phase_ln2(const int tid, const Args& A, int layer, int vcu, int G) {
    const int lane = tid & 63, wave = tid >> 6;
    const bf16* X1 = (const bf16*)(A.ws + WS_X1); const bf16* YM = (const bf16*)(A.ws + WS_YM);
    bf16* XB = (bf16*)(A.ws + WS_XB);
    const float* g2 = A.in[I_LN2G] + layer * D; const float* b2 = A.in[I_LN2B] + layer * D;
    f32x4 gg[4], bb[4];
#pragma unroll
    for (int j = 0; j < 4; ++j) { gg[j] = *(const f32x4*)(g2 + 4 * lane + 256 * j); bb[j] = *(const f32x4*)(b2 + 4 * lane + 256 * j); }
    const int gw = vcu * NWAVES + wave, NGW = G * NWAVES;
    for (int row = gw; row < M; row += NGW) {
        f32x4 v[4]; float sm = 0.f;
#pragma unroll
        for (int j = 0; j < 4; ++j) {
            const u32x2 a = *(const u32x2*)(X1 + (size_t)row * D + 4 * lane + 256 * j);
            const u32x2 y0 = *(const u32x2*)(YM + (size_t)(2 * row) * D + 4 * lane + 256 * j);
            const u32x2 y1 = *(const u32x2*)(YM + (size_t)(2 * row + 1) * D + 4 * lane + 256 * j);
            v[j][0] = ALPHA * lo16(a.x) + lo16(y0.x) + lo16(y1.x); v[j][1] = ALPHA * hi16(a.x) + hi16(y0.x) + hi16(y1.x);
            v[j][2] = ALPHA * lo16(a.y) + lo16(y0.y) + lo16(y1.y); v[j][3] = ALPHA * hi16(a.y) + hi16(y0.y) + hi16(y1.y);
            sm += (v[j][0] + v[j][1]) + (v[j][2] + v[j][3]);
        }
        const float mean = red64(sm) * (1.0f / D); float s2 = 0.f;
#pragma unroll
        for (int j = 0; j < 4; ++j) { v[j] = v[j] - mean; s2 += (v[j][0] * v[j][0] + v[j][1] * v[j][1]) + (v[j][2] * v[j][2] + v[j][3] * v[j][3]); }
        const float rstd = rsqrtf(red64(s2) * (1.0f / D) + LN_EPS);
#pragma unroll
        for (int j = 0; j < 4; ++j) {
            const f32x4 o = v[j] * rstd * gg[j] + bb[j];
            if (layer == DEPTH - 1) *(f32x4*)(A.out + (size_t)row * D + 4 * lane + 256 * j) = o;
            else { u32x2 w; w.x = pk2(o[0], o[1]); w.y = pk2(o[2], o[3]); *(u32x2*)(XB + (size_t)row * D + 4 * lane + 256 * j) = w; }
        }
    }
}

__device__ __forceinline__ void moe_table(const int tid, const Args& A, int layer, LAS int* tab) {
    if (tid == 0) {
        const unsigned* gcnt = (const unsigned*)(A.ws + WS_CTL) + CW_CNT + layer * 64;
        int acc = 0;
        for (int e = 0; e < 16; ++e) { const int c = (int)__hip_atomic_load(gcnt + e, __ATOMIC_RELAXED, __HIP_MEMORY_SCOPE_AGENT); tab[e] = acc; tab[32 + e] = c; acc += (c + 255) >> 8; }
        tab[16] = acc;
    }
    __syncthreads();
}

__global__ void __launch_bounds__(NTHR, 2) fwd_kernel(Args args) {
    extern __shared__ __attribute__((aligned(16))) unsigned char lds[];
    LAS unsigned char* ldsl = (LAS unsigned char*)lds;
    volatile LAS unsigned* misc = (volatile LAS unsigned*)(ldsl + MISC_OFF);
    const int wave_s = __builtin_amdgcn_readfirstlane((int)threadIdx.x >> 6);
#define MKTID() ({ unsigned z_ = 0u; asm volatile("" : "+v"(z_)); (int)(wave_s * 64 + (int)__builtin_amdgcn_mbcnt_hi(~0u, __builtin_amdgcn_mbcnt_lo(~0u, z_))); })
    { const int tid = MKTID(); for (int u = tid; u < (LDS_BYTES - MISC_OFF) / 4; u += NTHR) misc[u] = 0u; }
    __syncthreads();
    const int G = gridDim.x, bx = blockIdx.x;
    const int vcu = (G % 8 == 0) ? (bx % 8) * (G / 8) + bx / 8 : bx;
    unsigned* ctl = (unsigned*)(args.ws + WS_CTL);
    XcdBarrier bar; bar.bar = ctl + CW_BAR; bar.x = 0; bar.st = nullptr;
    if (args.use_bar) bar = xcd_barrier_post(MKTID(), ctl + CW_BAR, misc + 8);
    LAS int* tab = (LAS int*)(ldsl + MISC_OFF + 256);
    const int lo = args.ph_lo, hi = args.ph_hi;
#ifndef PHMASK
#define PHMASK 0x3FF
#endif
#define IN(k) (((PHMASK >> (k)) & 1) && lo <= (k) && (k) < hi)
#define SEAM(k) do { if (args.use_bar && (REP_PH || !((k) == NPH - 1 && layer == args.l_hi - 1))) xcd_barrier(MKTID(), bar); } while (0)
#ifndef REP_PH
#define REP_PH 0
#endif
#ifndef REP_UMASK
#define REP_UMASK 7
#endif
    for (int layer = args.l_lo; layer < args.l_hi; ++layer) {
      {
#define RUN(k) if (IN(k)) for (int rep = 0; rep < ((((REP_PH) >> (k)) & 1) ? 2 : 1); ++rep)
        RUN(0) { phase_convert(MKTID(), args, layer, (float*)lds, vcu, G); SEAM(0); }
        RUN(1) {
            pg8::DenseOrder S; S.init(M, INC, D, G, bx, args.ws + WS_WIN);
            pg8::EpiIn E{(bf16*)(args.ws + WS_P)};
            pg8::gemm_phase<pg8::EpiIn, pg8::DenseOrder, true>(MKTID(), ldsl, (const char*)(args.ws + WS_XB), D, S, E);
            SEAM(1);
        }
#ifndef R1STOP
#define R1STOP 99
#endif
        RUN(2) { const bool probe = ((REP_PH >> 2) & 1) && rep == 0; phase_mixers(MKTID(), args, layer, 0, lds, misc, probe ? REP_UMASK : 7, rep * 4, probe ? R1STOP : 99); SEAM(2); }
        RUN(3) { phase_mixers(MKTID(), args, layer, 1, lds, misc, rep ? REP_UMASK : 7, rep * 4); SEAM(3); }
        RUN(4) { phase_mixers(MKTID(), args, layer, 2, lds, misc, rep ? REP_UMASK : 7, rep * 4); SEAM(4); }
        RUN(5) {
            pg8::DenseOrder S; S.init(M, D, D, G, bx, args.ws + WS_WOUT);
            pg8::EpiOut E{(const bf16*)(args.ws + WS_XB), (bf16*)(args.ws + WS_X1)};
            pg8::gemm_phase<pg8::EpiOut, pg8::DenseOrder, true>(MKTID(), ldsl, (const char*)(args.ws + WS_MIX), D, S, E);
            SEAM(5);
        }
        RUN(6) { phase_ln1_router(MKTID(), args, layer, lds, vcu, G); SEAM(6); }
        RUN(7) {
            moe_table(MKTID(), args, layer, tab);
            pg8::MoeOrder<true> S{tab, G, vcu, D, 4, (const char*)(args.ws + WS_WGU), (size_t)1024 * D * 2, (const int*)(args.ws + WS_LIST)};
            pg8::EpiMoe1 E{(bf16*)(args.ws + WS_H)};
            pg8::gemm_phase<pg8::EpiMoe1, pg8::MoeOrder<true>, true>(MKTID(), ldsl, (const char*)(args.ws + WS_X1), D, S, E);
            SEAM(7);
        }
        RUN(8) {
            moe_table(MKTID(), args, layer, tab);
            pg8::MoeOrder<false> S{tab, G, vcu, DE, 4, (const char*)(args.ws + WS_WDN), (size_t)1024 * DE * 2, (const int*)(args.ws + WS_LIST)};
            pg8::EpiMoe2 E{(bf16*)(args.ws + WS_YM), (const int*)(args.ws + WS_LIST), (const float*)(args.ws + WS_GATE), tab};
            pg8::gemm_phase<pg8::EpiMoe2, pg8::MoeOrder<false>, true>(MKTID(), ldsl, (const char*)(args.ws + WS_H), DE, S, E);
            SEAM(8);
        }
        RUN(9) { phase_ln2(MKTID(), args, layer, vcu, G); SEAM(9); }
#undef RUN
      }
    }
#undef IN
#undef SEAM
}

extern "C" void kernel_launch(void* const* d_in, const int* in_sizes, int n_in, void* d_out, int out_size, void* d_ws, size_t ws_size, hipStream_t stream) {
    static int grid = 0;
    if (grid == 0) {
        if (n_in != 32 || out_size != M * D || ws_size < WS_END) { fprintf(stderr, "kernel_launch: unexpected shapes (n_in %d out %d ws %zu)\n", n_in, out_size, ws_size); grid = -1; return; }
        int dev = 0, cus = 0;
        if (hipGetDevice(&dev) != hipSuccess || hipDeviceGetAttribute(&cus, hipDeviceAttributeMultiprocessorCount, dev) != hipSuccess) { grid = -1; return; }
        if (hipFuncSetAttribute((const void*)fwd_kernel, hipFuncAttributeMaxDynamicSharedMemorySize, LDS_BYTES) != hipSuccess) { fprintf(stderr, "kernel_launch: hipFuncSetAttribute failed\n"); grid = -1; return; }
        int per_cu = 0;
        (void)hipOccupancyMaxActiveBlocksPerMultiprocessor(&per_cu, (const void*)fwd_kernel, NTHR, LDS_BYTES);
        (void)hipGetLastError();
        if (per_cu < 1) fprintf(stderr, "kernel_launch: occupancy query reports %d\n", per_cu);
        grid = cus;
    }
    if (grid < 0) return;
    (void)hipMemsetAsync((char*)d_ws + WS_CTL, 0, CTL_BYTES, stream);
    Args a{};
    for (int i = 0; i < 32; ++i) a.in[i] = (const float*)d_in[i];
    a.out = (float*)d_out; a.ws = (unsigned char*)d_ws;
#if MK_ONE_LAUNCH
    a.l_lo = 0; a.l_hi = DEPTH; a.ph_lo = 0; a.ph_hi = NPH; a.use_bar = 1; a.pad = 0;
    hipLaunchKernelGGL(fwd_kernel, dim3(grid), dim3(NTHR), LDS_BYTES, stream, a);
#else
    for (int l = 0; l < DEPTH; ++l)
        for (int p = 0; p < NPH; ++p) {
            a.l_lo = l; a.l_hi = l + 1; a.ph_lo = p; a.ph_hi = p + 1; a.use_bar = 0; a.pad = 0;
            hipLaunchKernelGGL(fwd_kernel, dim3(grid), dim3(NTHR), LDS_BYTES, stream, a);
        }
#endif
}
```

```cpp
#include <hip/hip_runtime.h>
#include <cstdio>
#include <cstdint>

#ifndef MK_ONE_LAUNCH
#define MK_ONE_LAUNCH 1
#endif

#define LAS __attribute__((address_space(3)))
#define GAS __attribute__((address_space(1)))
typedef unsigned short bf16;
typedef short bf16x8 __attribute__((ext_vector_type(8)));
typedef short s16x4 __attribute__((ext_vector_type(4)));
typedef float f32x4 __attribute__((ext_vector_type(4)));
typedef float f32x2 __attribute__((ext_vector_type(2)));
typedef float f32x16 __attribute__((ext_vector_type(16)));
typedef unsigned u32x4 __attribute__((ext_vector_type(4)));
typedef unsigned u32x2 __attribute__((ext_vector_type(2)));
typedef __bf16 bf16x2_t __attribute__((ext_vector_type(2)));

constexpr int D = 1024, BATCH = 16, SEQ = 4096, DEPTH = 4, M = BATCH * SEQ;
constexpr int HD = 64, RW = 384, LW = 256, SW = 384, RH = 6, LB = 4, SH = 6;
constexpr int RCOLS = 1408, INC = 3072;
constexpr int PC_R = 0, PC_K = 384, PC_V = 768, PC_DW = 1152, PC_DA = 1216, PC_DG = 1280;
constexpr int PC_LG = 1408, PC_LX = 1664, PC_SQ = 1920, PC_SK = 2304, PC_SV = 2688;
constexpr int MIX_R = 0, MIX_L = 384, MIX_S = 640;
constexpr int NE = 16, DE = 512, LCAP = 2 * M;
constexpr float ALPHA = 1.6817928305074290f;
constexpr float LN_EPS = 1e-5f, RMS_EPS = 1e-6f, GN_EPS = 64e-5f;
constexpr float C2 = 0.125f * 1.4426950408889634f;

constexpr size_t MiB = 1u << 20;
constexpr size_t WS_CTL = 0, CTL_BYTES = 1 * MiB;
constexpr size_t WS_WIN = 1 * MiB;
constexpr size_t WS_WOUT = 7 * MiB;
constexpr size_t WS_WGU = 9 * MiB;
constexpr size_t WS_WDN = 41 * MiB;
constexpr size_t WS_WSM = 57 * MiB;
constexpr size_t WS_LIST = 58 * MiB;
constexpr size_t WS_GATE = 66 * MiB;
constexpr size_t WS_EINFO = 67 * MiB;
constexpr size_t WS_XB = 68 * MiB;
constexpr size_t WS_X1 = 196 * MiB;
constexpr size_t WS_P = 324 * MiB;
constexpr size_t WS_MIX = 708 * MiB;
constexpr size_t WS_H = 324 * MiB;
constexpr size_t WS_YM = 460 * MiB;
constexpr size_t WS_END = 888 * MiB;
static_assert(WS_H + (size_t)(2 * M + NE * 256) * DE * 2 <= WS_YM && WS_YM + (size_t)2 * M * D * 2 <= WS_END, "ws map");

constexpr int CW_BAR = 0;
constexpr int CW_CNT = 8192;
constexpr int CW_Q = 8192 + 1024;

constexpr int NTHR = 512, NWAVES = 8;
constexpr int LDS_BYTES = 155648;
constexpr int GEMM_LDS = 131072;
constexpr int MISC_OFF = 147456;

__device__ __forceinline__ float bf2f(unsigned short b) { return __uint_as_float((unsigned)b << 16); }
__device__ __forceinline__ unsigned pk2(float lo, float hi) { f32x2 v = {lo, hi}; bf16x2_t b = __builtin_convertvector(v, bf16x2_t); return __builtin_bit_cast(unsigned, b); }
__device__ __forceinline__ float lo16(unsigned u) { return __uint_as_float(u << 16); }
__device__ __forceinline__ float hi16(unsigned u) { return __uint_as_float(u & 0xffff0000u); }
#define DPP(v, ctrl) __builtin_bit_cast(float, __builtin_amdgcn_update_dpp(__builtin_bit_cast(int, v), __builtin_bit_cast(int, v), (ctrl), 0xF, 0xF, false))
__device__ __forceinline__ float red8(float v) { v += DPP(v, 0xB1); v += DPP(v, 0x4E); v += DPP(v, 0x141); return v; }
__device__ __forceinline__ float red16(float v) { v = red8(v); v += DPP(v, 0x140); return v; }
__device__ __forceinline__ float red64(float v) { v = red16(v); v += __shfl_xor(v, 16); v += __shfl_xor(v, 32); return v; }
__device__ __forceinline__ float sigmoidf_(float x) { return __builtin_amdgcn_rcpf(1.0f + __expf(-x)); }
__device__ __forceinline__ float log1p_fast(float y) { return (y < 0.06f) ? y * (1.0f + y * (-0.5f + y * (0.33333334f + y * (-0.25f + y * (0.2f - y * 0.16666667f))))) : __logf(1.0f + y); }
__device__ __forceinline__ float softplusf_(float x) { return x > 20.f ? x : log1p_fast(__expf(x)); }

#define XB_TMO      128
#define XB_XCNT(j)  (256  + 64 * (j))
#define XB_XSUB(j)  (1280 + 64 * (j))
#define XB_XGEN(j)  (2304 + 64 * (j))
#define XB_TOP      3328
#define XB_TOPGEN   3392
#define XCD_BAR_WORDS 3456
#define XB_SPIN_CAP (1u << 22)
__device__ __forceinline__ unsigned xb_ld(unsigned* p)              { return __hip_atomic_load(p, __ATOMIC_RELAXED, __HIP_MEMORY_SCOPE_AGENT); }
__device__ __forceinline__ unsigned xb_add(unsigned* p, unsigned v) { return __hip_atomic_fetch_add(p, v, __ATOMIC_RELAXED, __HIP_MEMORY_SCOPE_AGENT); }
__device__ __forceinline__ unsigned xb_xcc_id() { return (unsigned)__builtin_amdgcn_s_getreg((3 << 11) | 20) & 0xFu; }
#define XB_SPIN(cond, bar) do { unsigned _sp = 0; while (cond) { __builtin_amdgcn_s_sleep(1); \
    if ((++_sp & 255u) == 0u) { if (xb_ld(&(bar)[XB_TMO])) break; if (_sp > XB_SPIN_CAP) { atomicAdd(&(bar)[XB_TMO], 1u); break; } } } } while (0)
struct XcdBarrier { unsigned* bar; unsigned x; volatile LAS unsigned* st; };
__device__ __forceinline__ XcdBarrier xcd_barrier_post(const int tid, unsigned* bar, volatile LAS unsigned* st) {
    XcdBarrier b; b.bar = bar; b.x = xb_xcc_id(); b.st = st;
    if (tid == 0) (void)xb_add(&bar[XB_XCNT(b.x)], 1u);
    return b;
}
__device__ __forceinline__ void xcd_barrier_complete(unsigned* bar, unsigned x, unsigned& nloc, unsigned& nx) {
    const unsigned G = gridDim.x * gridDim.y * gridDim.z;
    unsigned sum, cnt, mine, sp = 0u;
    for (;;) {
        sum = 0u; cnt = 0u; mine = 0u;
#pragma unroll
        for (unsigned j = 0; j < 16; ++j) { const unsigned c = xb_ld(&bar[XB_XCNT(j)]); sum += c; cnt += (c > 0u) ? 1u : 0u; mine = (j == x) ? c : mine; }
        if (sum == G) break;
        __builtin_amdgcn_s_sleep(1);
        if ((++sp & 255u) == 0u) { if (xb_ld(&bar[XB_TMO])) break; if (sp > XB_SPIN_CAP) { atomicAdd(&bar[XB_TMO], 1u); break; } }
    }
    nloc = mine > 0u ? mine : 1u; nx = cnt > 0u ? cnt : 1u;
}
__device__ __forceinline__ void xcd_barrier(const int tid, const XcdBarrier& b) {
    asm volatile("s_waitcnt vmcnt(0)" ::: "memory");
    __syncthreads();
    if (tid == 0) {
        unsigned* bar = b.bar;
        __builtin_amdgcn_s_waitcnt(0);
        unsigned nloc = b.st[0], nx = b.st[1];
        if (nloc == 0u) { xcd_barrier_complete(bar, b.x, nloc, nx); b.st[0] = nloc; b.st[1] = nx; }
        const unsigned old = xb_add(&bar[XB_XSUB(b.x)], 1u);
        const unsigned gen = old / nloc;
        if (old + 1u == (gen + 1u) * nloc) {
            __builtin_amdgcn_fence(__ATOMIC_RELEASE, "agent");
            asm volatile("s_waitcnt vmcnt(0)" ::: "memory");
            const unsigned og = xb_add(&bar[XB_TOP], 1u);
            const unsigned tg = og / nx;
            if (og + 1u == (tg + 1u) * nx) xb_add(&bar[XB_TOPGEN], 1u);
            else XB_SPIN(xb_ld(&bar[XB_TOPGEN]) == tg, bar);
            __builtin_amdgcn_fence(__ATOMIC_ACQUIRE, "agent");
            xb_add(&bar[XB_XGEN(b.x)], 1u);
            asm volatile("s_waitcnt vmcnt(0)" ::: "memory");
        } else {
            XB_SPIN(xb_ld(&bar[XB_XGEN(b.x)]) == gen, bar);
            __builtin_amdgcn_fence(__ATOMIC_ACQUIRE, "agent");
            asm volatile("s_waitcnt vmcnt(0)" ::: "memory");
        }
    }
    __syncthreads();
}

namespace pg8 {
constexpr int BM = 256, BK = 64, HALF = 128, HTB = HALF * BK * 2, STAGE_BYTES = 8 * HTB;
__host__ __device__ __forceinline__ int lds_byte(int r, int c) { const int st = (r >> 4) * 2 + (c >> 5), rr = r & 15, cc = c & 31, ob = rr * 64 + cc * 2; return st * 1024 + (ob ^ (((ob >> 9) & 1) << 5)); }
__host__ __device__ __forceinline__ void stage_rc(int b, int& R, int& C) { const int st = b / 1024, sb = b % 1024, swz = sb ^ (((sb >> 9) & 1) << 5); R = (st >> 1) * 16 + swz / 64; C = (st & 1) * 32 + (swz % 64) / 2; }
__host__ __device__ __forceinline__ int perm32(int rho) { const int n = rho >> 4, i = rho & 15; return 8 * (i >> 2) + 4 * n + (i & 3); }

struct Unit { int pm, pn, e, j; };
template <class Epi, class Sched, bool ALIGN_EPI>
__device__ __forceinline__ void gemm_phase(const int tid, LAS unsigned char* lds, const char* Abase, const int K, const Sched& S, const Epi& E) {
    const int wid = __builtin_amdgcn_readfirstlane(tid >> 6), lane = tid & 63, wr = wid >> 2, wc = wid & 3, fr = lane & 15, fq = lane >> 4;
    const int nt = K / BK;
    int R0, C0; stage_rc(tid * 16, R0, C0);
    const int Rb0 = (R0 & ~31) + perm32(R0 & 31);
    unsigned voffB[2]; voffB[0] = (unsigned)(Rb0 * K + C0) * 2u; voffB[1] = (unsigned)((Rb0 + 64) * K + C0) * 2u;
    unsigned voffA[2]; voffA[0] = (unsigned)(R0 * K + C0) * 2u; voffA[1] = (unsigned)((R0 + 64) * K + C0) * 2u;
    const unsigned colA = (unsigned)C0 * 2u;
    const size_t kstep = (size_t)(BK * 2);
    const size_t hstepB = (size_t)HALF * K * 2, hstepA = hstepB;
    const unsigned ldsw = (unsigned)wid * 1024u;
    const int aoff = lds_byte(wr * 64 + fr, fq * 8), boff = lds_byte(wc * 32 + fr, fq * 8);
#define PG8_SA(b, h) (((b) * 2 + (h)) * HTB)
#define PG8_SB(b, h) ((4 + (b) * 2 + (h)) * HTB)
#define PG8_STAGE_B(bufoff, gbase) do { _Pragma("unroll") for (int _i = 0; _i < 2; ++_i) \
        __builtin_amdgcn_global_load_lds((const unsigned*)((const char*)(gbase) + voffB[_i]), (LAS unsigned*)(lds + (bufoff) + ldsw + _i * 8192), 16, 0, 0); } while (0)
#define PG8_STAGE_A(bufoff, h, kbyte, nx) do { \
        if constexpr (Sched::GATHER) { _Pragma("unroll") for (int _i = 0; _i < 2; ++_i) { const unsigned _o = (nx) ? na[h][_i] : ca[h][_i]; \
            __builtin_amdgcn_global_load_lds((const unsigned*)(Abase + (kbyte) + _o), (LAS unsigned*)(lds + (bufoff) + ldsw + _i * 8192), 16, 0, 0); } } \
        else { const char* _p = ((nx) ? nA : cA) + (kbyte) + (size_t)(h) * hstepA; _Pragma("unroll") for (int _i = 0; _i < 2; ++_i) \
            __builtin_amdgcn_global_load_lds((const unsigned*)(_p + voffA[_i]), (LAS unsigned*)(lds + (bufoff) + ldsw + _i * 8192), 16, 0, 0); } } while (0)
#define PG8_LDA(dst, b, h) do { _Pragma("unroll") for (int m = 0; m < 4; ++m) _Pragma("unroll") for (int k = 0; k < 2; ++k) dst[m][k] = *(const LAS bf16x8*)(lds + PG8_SA(b, h) + aoff + m * 2048 + k * 1024); } while (0)
#define PG8_LDB(dst, b, h) do { _Pragma("unroll") for (int n = 0; n < 2; ++n) _Pragma("unroll") for (int k = 0; k < 2; ++k) dst[n][k] = *(const LAS bf16x8*)(lds + PG8_SB(b, h) + boff + n * 2048 + k * 1024); } while (0)
#define PG8_MMA(ai, bj, At, Bt) do { __builtin_amdgcn_s_setprio(1); _Pragma("unroll") for (int m = 0; m < 4; ++m) _Pragma("unroll") for (int n = 0; n < 2; ++n) _Pragma("unroll") for (int k = 0; k < 2; ++k) \
        acc[ai][bj][m][n] = __builtin_amdgcn_mfma_f32_16x16x32_bf16(Bt[n][k], At[m][k], acc[ai][bj][m][n], 0, 0, 0); __builtin_amdgcn_s_setprio(0); } while (0)
#define PG8_WAIT_V(n) asm volatile("s_waitcnt vmcnt(" #n ")" ::: "memory")
#define PG8_WAIT_L(n) asm volatile("s_waitcnt lgkmcnt(" #n ")" ::: "memory")
#define PG8_BAR __builtin_amdgcn_s_barrier()
#define PG8_SCHED __builtin_amdgcn_sched_barrier(0)
    Unit cur, nxt; int ui = 0;
    if (!S.next(0, cur)) return;
    unsigned ca[2][2], na[2][2];
    const char* cA = Abase; const char* nA = Abase;
    if constexpr (Sched::GATHER) S.aoffs(cur, R0, colA, ca); else cA = Abase + (size_t)S.arow0(cur) * K * 2;
    f32x4 acc[2][2][4][2];
#pragma unroll
    for (int a = 0; a < 2; ++a)
#pragma unroll
        for (int b = 0; b < 2; ++b)
#pragma unroll
            for (int m = 0; m < 4; ++m)
#pragma unroll
                for (int n = 0; n < 2; ++n) acc[a][b][m][n] = (f32x4){0.f, 0.f, 0.f, 0.f};
    bf16x8 At[4][2], B0[2][2], B1[2][2];
    const char* cB = S.bbase(cur);
    PG8_STAGE_B(PG8_SB(0, 0), cB); PG8_STAGE_B(PG8_SB(0, 1), cB + hstepB); PG8_STAGE_A(PG8_SA(0, 0), 0, 0, false); PG8_STAGE_A(PG8_SA(0, 1), 1, 0, false);
    if (wr == 1) PG8_BAR;
    PG8_WAIT_V(2); PG8_BAR;
    PG8_STAGE_B(PG8_SB(1, 0), cB + kstep); PG8_STAGE_A(PG8_SA(1, 0), 0, kstep, false); PG8_STAGE_B(PG8_SB(1, 1), cB + hstepB + kstep);
    PG8_WAIT_V(6); PG8_BAR;
    for (;;) {
        const bool has_next = S.next(ui + 1, nxt);
        const char* nB = cB;
        nA = cA;
        if (has_next) { nB = S.bbase(nxt); if constexpr (Sched::GATHER) S.aoffs(nxt, R0, colA, na); else nA = Abase + (size_t)S.arow0(nxt) * K * 2; }
        else if constexpr (Sched::GATHER) { na[0][0] = ca[0][0]; na[0][1] = ca[0][1]; na[1][0] = ca[1][0]; na[1][1] = ca[1][1]; }
        for (int t = 0; t < nt; t += 2) {
            const bool last = (t == nt - 2);
            const size_t k1 = (size_t)(t + 1) * kstep;
            const size_t k2 = last ? 0 : (size_t)(t + 2) * kstep, k3 = k2 + kstep;
            const char* b2 = last ? nB : cB + (size_t)(t + 2) * kstep; const char* b3 = b2 + kstep;
            PG8_LDB(B0, 0, 0); PG8_LDB(B1, 0, 1); PG8_SCHED; PG8_LDA(At, 0, 0); PG8_STAGE_A(PG8_SA(1, 1), 1, k1, false);
            PG8_WAIT_V(8); PG8_WAIT_L(0); PG8_BAR; PG8_MMA(0, 0, At, B0); PG8_MMA(0, 1, At, B1); PG8_BAR; PG8_SCHED;
            PG8_LDA(At, 0, 1); PG8_STAGE_B(PG8_SB(0, 0), b2); PG8_STAGE_B(PG8_SB(0, 1), b2 + hstepB); PG8_STAGE_A(PG8_SA(0, 0), 0, k2, last);
            PG8_WAIT_V(8); PG8_WAIT_L(0); PG8_BAR; PG8_MMA(1, 0, At, B0); PG8_MMA(1, 1, At, B1); PG8_BAR; PG8_SCHED;
            PG8_LDB(B0, 1, 0); PG8_LDB(B1, 1, 1); PG8_SCHED; PG8_LDA(At, 1, 0); PG8_STAGE_A(PG8_SA(0, 1), 1, k2, last);
            PG8_WAIT_V(8); PG8_WAIT_L(0); PG8_BAR; PG8_MMA(0, 0, At, B0); PG8_MMA(0, 1, At, B1); PG8_BAR; PG8_SCHED;
            PG8_LDA(At, 1, 1); PG8_STAGE_B(PG8_SB(1, 0), b3); PG8_STAGE_B(PG8_SB(1, 1), b3 + hstepB); PG8_STAGE_A(PG8_SA(1, 0), 0, k3, last);
            PG8_WAIT_V(8); PG8_WAIT_L(0); PG8_BAR; PG8_MMA(1, 0, At, B0); PG8_MMA(1, 1, At, B1); PG8_BAR; PG8_SCHED;
        }
        if constexpr (ALIGN_EPI) { if (wr == 0) PG8_BAR; }
        E(acc, cur, wr, wc, fr, fq);
        if (!has_next) break;
#pragma unroll
        for (int a = 0; a < 2; ++a)
#pragma unroll
            for (int b = 0; b < 2; ++b)
#pragma unroll
                for (int m = 0; m < 4; ++m)
#pragma unroll
                    for (int n = 0; n < 2; ++n) acc[a][b][m][n] = (f32x4){0.f, 0.f, 0.f, 0.f};
        cur = nxt; cB = nB; cA = nA; ++ui;
        if constexpr (Sched::GATHER) { ca[0][0] = na[0][0]; ca[0][1] = na[0][1]; ca[1][0] = na[1][0]; ca[1][1] = na[1][1]; }
        if constexpr (ALIGN_EPI) { if (wr == 1) PG8_BAR; }
    }
    PG8_WAIT_V(0);
    if constexpr (!ALIGN_EPI) { if (wr == 0) PG8_BAR; }
    PG8_BAR;
#undef PG8_SA
#undef PG8_SB
#undef PG8_STAGE_A
#undef PG8_STAGE_B
#undef PG8_LDA
#undef PG8_LDB
#undef PG8_MMA
#undef PG8_WAIT_V
#undef PG8_WAIT_L
#undef PG8_BAR
#undef PG8_SCHED
}

struct DenseOrder {
    static constexpr bool GATHER = false;
    int nM, nN, nwg, G, c, K; const char* Bt;
    __device__ __forceinline__ int arow0(const Unit& u) const { return u.pm * BM; }
    __device__ __forceinline__ void init(int M_, int N_, int K_, int G_, int c_, const void* Bt_) { nM = M_ / BM; nN = N_ / BM; nwg = nM * nN; G = G_; c = c_; K = K_; Bt = (const char*)Bt_; }
    __device__ __forceinline__ bool next(int i, Unit& u) const {
        const long L = (long)i * G + c; if (L >= nwg) return false;
        int wgid = (int)L; { const int q = nwg / 8, r = nwg % 8, xcd = wgid % 8, off = wgid / 8; wgid = (xcd < r ? xcd * (q + 1) : r * (q + 1) + (xcd - r) * q) + off; }
        const int nig = 8 * nN, gid = wgid / nig, fm = gid * 8, gsz = (nM - fm) < 8 ? (nM - fm) : 8;
        u.pm = fm + ((wgid % nig) % gsz); u.pn = (wgid % nig) / gsz; u.e = 0; u.j = 0; return true;
    }
    __device__ __forceinline__ void aoffs(const Unit& u, int R0, unsigned colA, unsigned (&o)[2][2]) const {
#pragma unroll
        for (int h = 0; h < 2; ++h)
#pragma unroll
            for (int i = 0; i < 2; ++i) o[h][i] = (unsigned)(u.pm * BM + h * HALF + R0 + 64 * i) * (unsigned)(K * 2) + colA;
    }
    __device__ __forceinline__ const char* bbase(const Unit& u) const { return Bt + (size_t)u.pn * BM * K * 2; }
};
template <bool GATHER_>
struct MoeOrder {
    static constexpr bool GATHER = GATHER_;
    __device__ __forceinline__ int arow0(const Unit& u) const { return u.pm * BM; }
    const LAS int* tab;
    int G, c, K, nN; const char* Bt; size_t estride;
    const int* list;
    __device__ __forceinline__ bool next(int i, Unit& u) const {
        const int L = i * G + c; const int nb = tab[16];
        if (L >= nb * nN) return false;
        const int rb = L / nN; u.pn = L % nN; u.pm = rb;
        int e = 0;
#pragma unroll
        for (int k = 1; k < 16; ++k) e += (rb >= tab[k]) ? 1 : 0;
        u.e = e; u.j = rb - tab[e]; return true;
    }
    __device__ __forceinline__ void aoffs(const Unit& u, int R0, unsigned colA, unsigned (&o)[2][2]) const {
        const int cnt = tab[32 + u.e];
#pragma unroll
        for (int h = 0; h < 2; ++h)
#pragma unroll
            for (int i = 0; i < 2; ++i) {
                const int r = h * HALF + R0 + 64 * i;
                const int pos = u.j * BM + r; const unsigned row = (pos < cnt) ? (unsigned)(list[(size_t)u.e * LCAP + pos] >> 1) : 0u;
                o[h][i] = row * (unsigned)(K * 2) + colA;
            }
    }
    __device__ __forceinline__ const char* bbase(const Unit& u) const { return Bt + (size_t)u.e * estride + (size_t)u.pn * BM * K * 2; }
};

__device__ __forceinline__ u32x4 pack8(const f32x4 v0, const f32x4 v1) { u32x4 w; w.x = pk2(v0[0], v0[1]); w.y = pk2(v0[2], v0[3]); w.z = pk2(v1[0], v1[1]); w.w = pk2(v1[2], v1[3]); return w; }
struct EpiIn {
    bf16* O;
    __device__ __forceinline__ void operator()(const f32x4 (&acc)[2][2][4][2], const Unit& u, int wr, int wc, int fr, int fq) const {
        const int row0 = u.pm * BM + wr * 64 + fr, col0 = u.pn * BM + wc * 32 + 8 * fq;
#pragma unroll
        for (int ai = 0; ai < 2; ++ai)
#pragma unroll
            for (int m = 0; m < 4; ++m) { bf16* rowp = O + (size_t)(row0 + ai * HALF + m * 16) * INC + col0;
#pragma unroll
                for (int bj = 0; bj < 2; ++bj) { const int c = col0 + bj * HALF; const float sc = (c >= PC_SQ && c < PC_SK) ? C2 : 1.0f;
                    *(u32x4*)(rowp + bj * HALF) = pack8(acc[ai][bj][m][0] * sc, acc[ai][bj][m][1] * sc); } }
    }
};
struct EpiOut {
    const bf16* X; bf16* O;
    __device__ __forceinline__ void operator()(const f32x4 (&acc)[2][2][4][2], const Unit& u, int wr, int wc, int fr, int fq) const {
        const int row0 = u.pm * BM + wr * 64 + fr, col0 = u.pn * BM + wc * 32 + 8 * fq;
#pragma unroll
        for (int ai = 0; ai < 2; ++ai)
#pragma unroll
            for (int m = 0; m < 4; ++m) { const size_t off = (size_t)(row0 + ai * HALF + m * 16) * D + col0;
#pragma unroll
                for (int bj = 0; bj < 2; ++bj) { const u32x4 xv = *(const u32x4*)(X + off + bj * HALF);
                    f32x4 v0 = acc[ai][bj][m][0], v1 = acc[ai][bj][m][1];
                    v0[0] += ALPHA * lo16(xv.x); v0[1] += ALPHA * hi16(xv.x); v0[2] += ALPHA * lo16(xv.y); v0[3] += ALPHA * hi16(xv.y);
                    v1[0] += ALPHA * lo16(xv.z); v1[1] += ALPHA * hi16(xv.z); v1[2] += ALPHA * lo16(xv.w); v1[3] += ALPHA * hi16(xv.w);
                    *(u32x4*)(O + off + bj * HALF) = pack8(v0, v1); } }
    }
};
struct EpiMoe1 {
    bf16* Hb;
    __device__ __forceinline__ void operator()(const f32x4 (&acc)[2][2][4][2], const Unit& u, int wr, int wc, int fr, int fq) const {
        const int row0 = u.pm * BM + wr * 64 + fr, col0 = u.pn * HALF + wc * 32 + 8 * fq;
#pragma unroll
        for (int ai = 0; ai < 2; ++ai)
#pragma unroll
            for (int m = 0; m < 4; ++m) {
                f32x4 g0 = acc[ai][0][m][0], g1 = acc[ai][0][m][1]; const f32x4 u0 = acc[ai][1][m][0], u1 = acc[ai][1][m][1];
#pragma unroll
                for (int q = 0; q < 4; ++q) { g0[q] = g0[q] * sigmoidf_(g0[q]) * u0[q]; g1[q] = g1[q] * sigmoidf_(g1[q]) * u1[q]; }
                *(u32x4*)(Hb + (size_t)(row0 + ai * HALF + m * 16) * DE + col0) = pack8(g0, g1); }
    }
};
struct EpiMoe2 {
    bf16* Y;
    __device__ __forceinline__ void operator()(const f32x4 (&acc)[2][2][4][2], const Unit& u, int wr, int wc, int fr, int fq) const {
        const int row0 = u.pm * BM + wr * 64 + fr, col0 = u.pn * BM + wc * 32 + 8 * fq;
#pragma unroll
        for (int ai = 0; ai < 2; ++ai)
#pragma unroll
            for (int m = 0; m < 4; ++m) { bf16* rowp = Y + (size_t)(row0 + ai * HALF + m * 16) * D + col0;
#pragma unroll
                for (int bj = 0; bj < 2; ++bj) *(u32x4*)(rowp + bj * HALF) = pack8(acc[ai][bj][m][0], acc[ai][bj][m][1]); }
    }
};
}

struct Args {
    const float* in[32]; float* out; unsigned char* ws;
    int l_lo, l_hi, ph_lo, ph_hi;
    int use_bar, pad;
};
enum { I_X = 0, I_WIN, I_MU, I_W0, I_WUP, I_A0, I_AUP, I_GUP, I_KK, I_KA, I_RK, I_LNG, I_LNB, I_CW, I_CB, I_WA, I_BA, I_WX, I_BX, I_LAM, I_LRUG, I_SBAG,
       I_WOUT, I_LN1G, I_LN1B, I_LN2G, I_LN2B, I_RW, I_RB, I_EG, I_EU, I_ED };
constexpr int NPH = 10;

__device__ __forceinline__ void transpose_item(const float* W, int N, bf16* WT, int pitch, int drow0, int k0, int n0, float* scr, int lane) {
#pragma unroll 8
    for (int i = 0; i < 32; ++i) { const int kk = 2 * i + (lane >> 5); scr[kk * 33 + (lane & 31)] = W[(size_t)(k0 + kk) * N + n0 + (lane & 31)]; }
    asm volatile("s_waitcnt lgkmcnt(0)" ::: "memory");
    const int c = lane & 7;
#pragma unroll
    for (int j = 0; j < 4; ++j) { const int n = (lane >> 3) + 8 * j; const float* s = scr + (8 * c) * 33 + n;
        u32x4 o; o.x = pk2(s[0 * 33], s[1 * 33]); o.y = pk2(s[2 * 33], s[3 * 33]); o.z = pk2(s[4 * 33], s[5 * 33]); o.w = pk2(s[6 * 33], s[7 * 33]);
        *(u32x4*)(WT + (size_t)(drow0 + n) * pitch + k0 + 8 * c) = o; }
    asm volatile("s_waitcnt lgkmcnt(0)" ::: "memory");
}
__device__ __forceinline__ void phase_convert(const int tid, const Args& A, int layer, float* ldsf, int vcu, int G) {
    const int lane = tid & 63, wave = tid >> 6;
    float* scr = ldsf + wave * 4096;
    unsigned char* ws = A.ws;
    bf16* Win = (bf16*)(ws + WS_WIN); bf16* Wout = (bf16*)(ws + WS_WOUT); bf16* Wgu = (bf16*)(ws + WS_WGU); bf16* Wdn = (bf16*)(ws + WS_WDN);
    bf16* WupT = (bf16*)(ws + WS_WSM); bf16* AupT = WupT + 384 * 64; bf16* GupT = AupT + 384 * 64;
    const int gw = vcu * NWAVES + wave, NGW = G * NWAVES;
    constexpr int I_IN = 16 * 96, I_OUT = 16 * 32, I_G = 16 * 256, I_U = 16 * 256, I_D = 16 * 256, I_S1 = 12, I_S2 = 12, I_S3 = 24, I_S4 = 16;
    constexpr int NIT = I_IN + I_OUT + I_G + I_U + I_D + I_S1 + I_S2 + I_S3 + I_S4;
    for (int it = gw; it < NIT; it += NGW) {
        int r = it;
        if (r < I_IN) { const int kb = r / 96, nb = r % 96; transpose_item(A.in[I_WIN] + (size_t)layer * D * INC, INC, Win, D, 32 * nb, 64 * kb, 32 * nb, scr, lane); continue; } r -= I_IN;
        if (r < I_OUT) { const int kb = r / 32, nb = r % 32; transpose_item(A.in[I_WOUT] + (size_t)layer * D * D, D, Wout, D, 32 * nb, 64 * kb, 32 * nb, scr, lane); continue; } r -= I_OUT;
        if (r < I_G + I_U) { const int up = r >= I_G; if (up) r -= I_G; const int e = r / 256, q = r % 256, kb = q / 16, nb = q % 16, n0 = 32 * nb;
            const float* src = A.in[up ? I_EU : I_EG] + ((size_t)layer * NE + e) * D * DE;
            transpose_item(src, DE, Wgu, D, e * 1024 + (n0 >> 7) * 256 + up * 128 + (n0 & 127), 64 * kb, n0, scr, lane); continue; } r -= I_G + I_U;
        if (r < I_D) { const int e = r / 256, q = r % 256, kb = q / 32, nb = q % 32;
            transpose_item(A.in[I_ED] + ((size_t)layer * NE + e) * DE * D, D, Wdn, DE, e * 1024 + 32 * nb, 64 * kb, 32 * nb, scr, lane); continue; } r -= I_D;
        if (r < I_S1) { transpose_item(A.in[I_WUP] + (size_t)layer * 64 * RW, RW, WupT, 64, 32 * r, 0, 32 * r, scr, lane); continue; } r -= I_S1;
        if (r < I_S2) { transpose_item(A.in[I_AUP] + (size_t)layer * 64 * RW, RW, AupT, 64, 32 * r, 0, 32 * r, scr, lane); continue; } r -= I_S2;
        if (r < I_S3) { const int kb = r / 12, nb = r % 12; transpose_item(A.in[I_GUP] + (size_t)layer * 128 * RW, RW, GupT, 128, 32 * nb, 64 * kb, 32 * nb, scr, lane); continue; } r -= I_S3;
        { const int x = r >> 3, gq = (r >> 1) & 3, nb = r & 1;
          transpose_item(A.in[x ? I_WX : I_WA] + ((size_t)layer * LB + gq) * 4096, 64, GupT + 384 * 128 + x * 16384, 64, gq * 64 + 32 * nb, 0, 32 * nb, scr, lane); }
    }
    if (layer == 0) {
        const f32x4* x4 = (const f32x4*)A.in[I_X]; u32x4* o = (u32x4*)(ws + WS_XB);
        const size_t n8 = (size_t)M * D / 8;
        for (size_t i = (size_t)vcu * NTHR + tid; i < n8; i += (size_t)G * NTHR) { const f32x4 a = x4[2 * i], b = x4[2 * i + 1]; o[i] = pg8::pack8(a, b); }
    }
}

typedef short v4i16_t __attribute__((ext_vector_type(4)));
template <bool MASK>
__device__ __forceinline__ void attn_tile(const bf16* Ks, const bf16* Vs, const bf16x8 (&qr)[4], f32x16& o0, f32x16& o1, float& Rrun, const int k0, const int qmine, const int r, const int hh, const int vtr_off) {
    f32x16 p0 = {}, p1 = {};
#pragma unroll
    for (int s = 0; s < 4; ++s) {
        const bf16x8 ka = *(const bf16x8*)(Ks + r * 72 + 16 * s + 8 * hh);
        const bf16x8 kb = *(const bf16x8*)(Ks + (32 + r) * 72 + 16 * s + 8 * hh);
        p0 = __builtin_amdgcn_mfma_f32_32x32x16_bf16(ka, qr[s], p0, 0, 0, 0);
        p1 = __builtin_amdgcn_mfma_f32_32x32x16_bf16(kb, qr[s], p1, 0, 0, 0);
    }
    float pa[8]; f32x2 va[8], vb[8];
#pragma unroll
    for (int g = 0; g < 8; ++g) {
        float z[4];
#pragma unroll
        for (int i = 0; i < 4; ++i) z[i] = (g < 4) ? p0[4 * g + i] : p1[4 * (g - 4) + i];
        const f32x2 eA = {__builtin_amdgcn_exp2f(z[0]), __builtin_amdgcn_exp2f(z[1])}, eB = {__builtin_amdgcn_exp2f(z[2]), __builtin_amdgcn_exp2f(z[3])};
        const f32x2 dA = eA + 1.0f, dB = eB + 1.0f;
        f32x2 kA = {__builtin_amdgcn_rcpf(dA[0]), __builtin_amdgcn_rcpf(dA[1])}, kB = {__builtin_amdgcn_rcpf(dB[0]), __builtin_amdgcn_rcpf(dB[1])};
        if (MASK) { const int key = k0 + 32 * (g >> 2) + 8 * (g & 3) + 4 * hh;
            kA[0] = (key + 0 >= qmine) ? 1.0f : kA[0]; kA[1] = (key + 1 >= qmine) ? 1.0f : kA[1]; kB[0] = (key + 2 >= qmine) ? 1.0f : kB[0]; kB[1] = (key + 3 >= qmine) ? 1.0f : kB[1]; }
        const f32x2 sA = 1.0f - kA, sB = 1.0f - kB;
        const float x1 = kB[1] * kB[0], x0 = x1 * kA[1];
        pa[g] = x0 * kA[0];
        va[g] = sA * (f32x2){x0, x1}; vb[g] = sB * (f32x2){kB[1], 1.0f};
    }
    float pi[16];
#pragma unroll
    for (int g = 0; g < 8; ++g) { const auto rr = __builtin_amdgcn_permlane32_swap(__float_as_uint(pa[g]), __float_as_uint(pa[g]), false, false);
        pi[2 * g] = __uint_as_float(rr[0]); pi[2 * g + 1] = __uint_as_float(rr[1]); }
    float S[16];
    S[15] = Rrun;
#pragma unroll
    for (int j = 14; j >= 0; --j) S[j] = S[j + 1] * pi[j + 1];
    Rrun = S[0] * pi[0];
#pragma unroll
    for (int g = 0; g < 8; ++g) {
        const float re = hh ? S[2 * g + 1] : S[2 * g];
        va[g] = va[g] * re; vb[g] = vb[g] * re;
    }
#pragma unroll
    for (int s = 0; s < 4; ++s) {
        u32x4 pw;
        pw.x = pk2(va[2 * s][0], va[2 * s][1]); pw.y = pk2(vb[2 * s][0], vb[2 * s][1]); pw.z = pk2(va[2 * s + 1][0], va[2 * s + 1][1]); pw.w = pk2(vb[2 * s + 1][0], vb[2 * s + 1][1]);
        const bf16x8 pf = __builtin_bit_cast(bf16x8, pw);
        const bf16* vbp = Vs + 16 * s * 72 + vtr_off;
        { const v4i16_t lo = __builtin_amdgcn_ds_read_tr16_b64_v4i16((LAS v4i16_t*)(vbp)), hi = __builtin_amdgcn_ds_read_tr16_b64_v4i16((LAS v4i16_t*)(vbp + 8 * 72));
          const bf16x8 vf = __builtin_shufflevector(lo, hi, 0, 1, 2, 3, 4, 5, 6, 7);
          o0 = __builtin_amdgcn_mfma_f32_32x32x16_bf16(vf, pf, o0, 0, 0, 0); }
        { const v4i16_t lo = __builtin_amdgcn_ds_read_tr16_b64_v4i16((LAS v4i16_t*)(vbp + 32)), hi = __builtin_amdgcn_ds_read_tr16_b64_v4i16((LAS v4i16_t*)(vbp + 8 * 72 + 32));
          const bf16x8 vf = __builtin_shufflevector(lo, hi, 0, 1, 2, 3, 4, 5, 6, 7);
          o1 = __builtin_amdgcn_mfma_f32_32x32x16_bf16(vf, pf, o1, 0, 0, 0); }
    }
}
__device__ __forceinline__ void attn_unit(const int tid_in, const Args& A, int layer, int bh, int qb, unsigned char* lds) {
    int tid = tid_in; asm volatile("" : "+v"(tid));
    const int lane = tid & 63, wave = __builtin_amdgcn_readfirstlane(tid >> 6), r = lane & 31, hh = lane >> 5;
    const int b = bh / SH, h = bh % SH;
    const bf16* P = (const bf16*)(A.ws + WS_P) + (size_t)b * SEQ * INC;
    bf16* MIX = (bf16*)(A.ws + WS_MIX) + (size_t)b * SEQ * D;
    bf16* KV = (bf16*)lds;
    constexpr int SLOT = 2 * 64 * 72;
    const int q0w = qb * 256 + wave * 32;
    bf16x8 qr[4];
#pragma unroll
    for (int s = 0; s < 4; ++s) qr[s] = *(const bf16x8*)(P + (size_t)(q0w + r) * INC + PC_SQ + h * 64 + 16 * s + 8 * hh);
    f32x16 o0 = {}, o1 = {};
    float Rrun = 1.0f;
    const int qmine = q0w + r;
    const int lkey = tid >> 3, lch = (tid & 7) * 8;
    const int NT = 4 * qb + 4;
    const int g16 = lane >> 4, i16 = lane & 15;
    const int vtr_off = (4 * (g16 >> 1) + (i16 >> 2)) * 72 + 16 * (g16 & 1) + 4 * (i16 & 3);
    u32x4 kreg, vreg;
    { const int jt0 = NT - 1;
      kreg = *(const u32x4*)(P + (size_t)(64 * jt0 + lkey) * INC + PC_SK + h * 64 + lch);
      vreg = *(const u32x4*)(P + (size_t)(64 * jt0 + lkey) * INC + PC_SV + h * 64 + lch); }
    __syncthreads();
    { bf16* s0 = KV + ((NT - 1) & 1) * SLOT; *(u32x4*)(s0 + lkey * 72 + lch) = kreg; *(u32x4*)(s0 + 64 * 72 + lkey * 72 + lch) = vreg; }
    if (NT >= 2) { const int jt1 = NT - 2;
      kreg = *(const u32x4*)(P + (size_t)(64 * jt1 + lkey) * INC + PC_SK + h * 64 + lch);
      vreg = *(const u32x4*)(P + (size_t)(64 * jt1 + lkey) * INC + PC_SV + h * 64 + lch); }
    asm volatile("s_waitcnt lgkmcnt(0)\n\ts_barrier" ::: "memory");
    for (int jt = NT - 1; jt >= 0; --jt) {
        const bf16* Ks = KV + (jt & 1) * SLOT; const bf16* Vs = Ks + 64 * 72;
        if (jt >= 1) {
            bf16* sn = KV + ((jt - 1) & 1) * SLOT;
            *(u32x4*)(sn + lkey * 72 + lch) = kreg; *(u32x4*)(sn + 64 * 72 + lkey * 72 + lch) = vreg;
            if (jt >= 2) {
                kreg = *(const u32x4*)(P + (size_t)(64 * (jt - 2) + lkey) * INC + PC_SK + h * 64 + lch);
                vreg = *(const u32x4*)(P + (size_t)(64 * (jt - 2) + lkey) * INC + PC_SV + h * 64 + lch);
            }
        }
        const int k0 = 64 * jt;
        if (k0 < q0w + 31) {
            if (k0 + 63 >= q0w) attn_tile<true>(Ks, Vs, qr, o0, o1, Rrun, k0, qmine, r, hh, vtr_off);
            else attn_tile<false>(Ks, Vs, qr, o0, o1, Rrun, k0, qmine, r, hh, vtr_off);
        }
        asm volatile("s_waitcnt lgkmcnt(0)\n\ts_barrier" ::: "memory");
    }
    float ss = 0.f;
#pragma unroll
    for (int i = 0; i < 16; ++i) ss += o0[i] * o0[i] + o1[i] * o1[i];
    ss += __shfl_xor(ss, 32);
    const float sc = rsqrtf(ss * (1.0f / 64.0f) + RMS_EPS);
    const float* ng = A.in[I_SBAG] + layer * SW + h * 64;
    bf16* orow = MIX + (size_t)(q0w + r) * D + MIX_S + h * 64;
#pragma unroll
    for (int g = 0; g < 4; ++g) {
        const int d = 8 * g + 4 * hh;
        const f32x4 g0 = *(const f32x4*)(ng + d), g1 = *(const f32x4*)(ng + 32 + d);
        u32x2 w0, w1;
        w0.x = pk2(o0[4 * g] * sc * g0[0], o0[4 * g + 1] * sc * g0[1]); w0.y = pk2(o0[4 * g + 2] * sc * g0[2], o0[4 * g + 3] * sc * g0[3]);
        w1.x = pk2(o1[4 * g] * sc * g1[0], o1[4 * g + 1] * sc * g1[1]); w1.y = pk2(o1[4 * g + 2] * sc * g1[2], o1[4 * g + 3] * sc * g1[3]);
        *(u32x2*)(orow + d) = w0; *(u32x2*)(orow + 32 + d) = w1;
    }
}

constexpr int CP = 72;
constexpr size_t SC_MP = 0, SC_NN = 48 * MiB, SC_QH = 96 * MiB, SC_OL = 144 * MiB;
constexpr size_t WS_G = 836 * MiB, WS_RHO = 884 * MiB, WS_GC = 886 * MiB;
__device__ __forceinline__ f32x16 mm32(const bf16* X, const bf16* Y, int lane, f32x16 acc) {
    const int r = lane & 31, hh = lane >> 5;
#pragma unroll
    for (int s_ = 0; s_ < 4; ++s_) {
        const bf16x8 a = *(const bf16x8*)(X + r * CP + 16 * s_ + 8 * hh);
        const bf16x8 b = *(const bf16x8*)(Y + r * CP + 16 * s_ + 8 * hh);
        acc = __builtin_amdgcn_mfma_f32_32x32x16_bf16(a, b, acc, 0, 0, 0);
    }
    return acc;
}
__device__ __forceinline__ u32x4 packfrag(const f32x16& a, int sp) {
    u32x4 w;
    if (sp == 0) { w.x = pk2(a[0], a[1]); w.y = pk2(a[2], a[3]); w.z = pk2(a[4], a[5]); w.w = pk2(a[6], a[7]); }
    else { w.x = pk2(a[8], a[9]); w.y = pk2(a[10], a[11]); w.z = pk2(a[12], a[13]); w.w = pk2(a[14], a[15]); }
    return w;
}
struct R1Pre { u32x4 cu[4], pv[4]; };
__device__ __forceinline__ void rwkv_r1_prefetch(const int tid, const Args& A, int b, int c, R1Pre& pf) {
    const int t0 = c * 64;
    const bf16* P = (const bf16*)(A.ws + WS_P) + (size_t)b * SEQ * INC;
#pragma unroll
    for (int q = 0; q < 4; ++q) {
        const int item = tid + NTHR * q, tok = item >> 5, cc = (item & 31) * 8, pc = PC_DW + cc, t = t0 + tok;
        pf.cu[q] = *(const u32x4*)(P + (size_t)t * INC + pc);
        pf.pv[q] = (u32x4){0u, 0u, 0u, 0u};
        if (t > 0) pf.pv[q] = *(const u32x4*)(P + (size_t)(t - 1) * INC + pc);
    }
}
__device__ __forceinline__ void rwkv_r1_unit(const int tid_in, const Args& A, int layer, int uidx, unsigned char* lds, R1Pre& pf, const bool first, const int stop = 99) {
    int tid = tid_in; asm volatile("" : "+v"(tid));
    const int lane = tid & 63, wave = __builtin_amdgcn_readfirstlane(tid >> 6), r31 = lane & 31, hh = lane >> 5;
    const int head = uidx >> 6, c = uidx & 63, b = head / RH, h = head % RH, t0 = c * 64;
    const size_t brow = (size_t)b * SEQ;
    const bf16* P = (const bf16*)(A.ws + WS_P) + brow * INC;
    float* wS = (float*)lds; float* aS = wS + 4096; float* gS = aS + 4096;
    bf16* AAB = (bf16*)lds; bf16* AAK = AAB + 64 * CP; bf16* ARB = AAK + 64 * CP; bf16* ARK = ARB + 64 * CP;
    bf16* TM = ARK + 64 * CP; bf16* TMt = TM + 64 * CP; bf16* X1t = TMt + 64 * CP;
    unsigned char* ob = lds + 7 * 64 * CP * 2;
    bf16* AL = (bf16*)ob;
    bf16* AH = (bf16*)ob; bf16* QT = AH + 64 * CP; bf16* BH = QT + 64 * CP; bf16* KH = BH + 64 * CP;
    bf16* BHt = KH + 64 * CP; bf16* KHt = BHt + 64 * CP; bf16* Vt = KHt + 64 * CP; bf16* AHt = Vt + 64 * CP;
    bf16* WTt = KH; bf16* UTt = AH;
    float* segT = (float*)(ob + 8 * 64 * CP * 2);
    float* gCs = segT + 512;
    bf16* PTs = (bf16*)(gCs + 64);
    const float* mu = A.in[I_MU] + layer * RCOLS;
    const int c4 = (tid & 15) * 4, tkA = tid >> 4, ch = h * 64 + c4;
    u32x2 g_cr[2], g_ck[2], g_cv[2], g_pr[2], g_pk[2], g_pv[2];
#pragma unroll
    for (int q = 0; q < 2; ++q) {
        const int t = t0 + 2 * tkA + q; const bf16* pr = P + (size_t)t * INC;
        g_cr[q] = *(const u32x2*)(pr + PC_R + ch); g_ck[q] = *(const u32x2*)(pr + PC_K + ch); g_cv[q] = *(const u32x2*)(pr + PC_V + ch);
        g_pr[q] = (u32x2){0u, 0u}; g_pk[q] = (u32x2){0u, 0u}; g_pv[q] = (u32x2){0u, 0u};
        if (t > 0) { g_pr[q] = *(const u32x2*)(pr - INC + PC_R + ch); g_pk[q] = *(const u32x2*)(pr - INC + PC_K + ch); g_pv[q] = *(const u32x2*)(pr - INC + PC_V + ch); }
    }
    bf16x8 fw[2], fa[2], fg[4];
    {   const bf16* WupT = (const bf16*)(A.ws + WS_WSM); const bf16* AupT = WupT + 384 * 64; const bf16* GupT = AupT + 384 * 64;
        const int rowj = h * 64 + 16 * (wave & 3) + (lane & 15), kq8 = 8 * (lane >> 4);
#pragma unroll
        for (int ks = 0; ks < 2; ++ks) { fw[ks] = *(const bf16x8*)(WupT + (size_t)rowj * 64 + 32 * ks + kq8); fa[ks] = *(const bf16x8*)(AupT + (size_t)rowj * 64 + 32 * ks + kq8); }
#pragma unroll
        for (int ks = 0; ks < 4; ++ks) fg[ks] = *(const bf16x8*)(GupT + (size_t)rowj * 128 + 32 * ks + kq8);
    }
#pragma unroll
    for (int q = 0; q < 4; ++q) {
        const int item = tid + NTHR * q, tok = item >> 5, cc = (item & 31) * 8, pc = PC_DW + cc;
        if (first) {
            const u32x4 cu = pf.cu[q], pv = pf.pv[q];
            const f32x4 m0 = *(const f32x4*)(mu + pc), m1 = *(const f32x4*)(mu + pc + 4);
            float v[8];
            { float c_, p_;
              c_ = lo16(cu.x); p_ = lo16(pv.x); v[0] = c_ + m0[0] * (p_ - c_); c_ = hi16(cu.x); p_ = hi16(pv.x); v[1] = c_ + m0[1] * (p_ - c_);
              c_ = lo16(cu.y); p_ = lo16(pv.y); v[2] = c_ + m0[2] * (p_ - c_); c_ = hi16(cu.y); p_ = hi16(pv.y); v[3] = c_ + m0[3] * (p_ - c_);
              c_ = lo16(cu.z); p_ = lo16(pv.z); v[4] = c_ + m1[0] * (p_ - c_); c_ = hi16(cu.z); p_ = hi16(pv.z); v[5] = c_ + m1[1] * (p_ - c_);
              c_ = lo16(cu.w); p_ = lo16(pv.w); v[6] = c_ + m1[2] * (p_ - c_); c_ = hi16(cu.w); p_ = hi16(pv.w); v[7] = c_ + m1[3] * (p_ - c_); }
            if (cc < 64) {
#pragma unroll
                for (int i = 0; i < 8; ++i) { const float e2 = __expf(2.0f * v[i]); v[i] = 1.0f - 2.0f * __builtin_amdgcn_rcpf(e2 + 1.0f); }
            } else if (cc >= 128) {
#pragma unroll
                for (int i = 0; i < 8; ++i) v[i] = sigmoidf_(v[i]);
            }
            u32x4 w; w.x = pk2(v[0], v[1]); w.y = pk2(v[2], v[3]); w.z = pk2(v[4], v[5]); w.w = pk2(v[6], v[7]);
            pf.cu[q] = w;
        }
        *(u32x4*)(AL + tok * 264 + cc) = pf.cu[q];
    }
    __syncthreads();
    if (stop <= 1) return;
    {
        const int jt = wave & 3, kq8 = 8 * (lane >> 4);
#pragma unroll
        for (int q = 0; q < 2; ++q) {
            const int tt = 2 * (wave >> 2) + q;
            const bf16* bl = AL + (16 * tt + (lane & 15)) * 264 + kq8;
            f32x4 accw = {0.f, 0.f, 0.f, 0.f}, acca = accw, accg = accw;
#pragma unroll
            for (int ks = 0; ks < 2; ++ks) { accw = __builtin_amdgcn_mfma_f32_16x16x32_bf16(fw[ks], *(const bf16x8*)(bl + 32 * ks), accw, 0, 0, 0);
                                            acca = __builtin_amdgcn_mfma_f32_16x16x32_bf16(fa[ks], *(const bf16x8*)(bl + 64 + 32 * ks), acca, 0, 0, 0); }
#pragma unroll
            for (int ks = 0; ks < 4; ++ks) accg = __builtin_amdgcn_mfma_f32_16x16x32_bf16(fg[ks], *(const bf16x8*)(bl + 128 + 32 * ks), accg, 0, 0, 0);
            const int o_ = (16 * tt + (lane & 15)) * 64 + 16 * jt + 4 * (lane >> 4);
            *(f32x4*)(wS + o_) = accw; *(f32x4*)(aS + o_) = acca; *(f32x4*)(gS + o_) = accg;
        }
    }
    __syncthreads();
    if (stop <= 2) return;
    f32x4 rs[2], kts[2], kkn[2], avs[2], lws[2], vvs[2];
    {
        const f32x4 w0v = *(const f32x4*)(A.in[I_W0] + layer * RW + ch), a0v = *(const f32x4*)(A.in[I_A0] + layer * RW + ch);
        const f32x4 kkv = *(const f32x4*)(A.in[I_KK] + layer * RW + ch), kav = *(const f32x4*)(A.in[I_KA] + layer * RW + ch), rkv = *(const f32x4*)(A.in[I_RK] + layer * RW + ch);
        const f32x4 mur = *(const f32x4*)(mu + PC_R + ch), muk = *(const f32x4*)(mu + PC_K + ch), muv = *(const f32x4*)(mu + PC_V + ch);
        bf16* Gs = (bf16*)(A.ws + WS_G); float* RHOs = (float*)(A.ws + WS_RHO);
#pragma unroll
        for (int q = 0; q < 2; ++q) {
            const int tok = 2 * tkA + q, t = t0 + tok;
            const u32x2 cr = g_cr[q], ck = g_ck[q], cv = g_cv[q], qr_ = g_pr[q], qk_ = g_pk[q], qv_ = g_pv[q];
            f32x4 rc = {lo16(cr.x), hi16(cr.x), lo16(cr.y), hi16(cr.y)}, rp_ = {lo16(qr_.x), hi16(qr_.x), lo16(qr_.y), hi16(qr_.y)};
            f32x4 kc = {lo16(ck.x), hi16(ck.x), lo16(ck.y), hi16(ck.y)}, kp_ = {lo16(qk_.x), hi16(qk_.x), lo16(qk_.y), hi16(qk_.y)};
            f32x4 vc = {lo16(cv.x), hi16(cv.x), lo16(cv.y), hi16(cv.y)}, vp_ = {lo16(qv_.x), hi16(qv_.x), lo16(qv_.y), hi16(qv_.y)};
            const f32x4 rv = rc + mur * (rp_ - rc), kv = kc + muk * (kp_ - kc), vv = vc + muv * (vp_ - vc);
            const f32x4 wp = *(const f32x4*)(wS + tok * 64 + c4), ap = *(const f32x4*)(aS + tok * 64 + c4), gp = *(const f32x4*)(gS + tok * 64 + c4);
            f32x4 lw, av, kkx, kt; float n2 = 0.f, rpv = 0.f;
#pragma unroll
            for (int i = 0; i < 4; ++i) {
                const float x = w0v[i] + wp[i];
                lw[i] = -(__builtin_amdgcn_rcpf(1.0f + __expf(-x)) * 0.6065306597126334f);
                av[i] = sigmoidf_(a0v[i] + ap[i]);
                kkx[i] = kv[i] * kkv[i]; n2 += kkx[i] * kkx[i];
                kt[i] = kv[i] * (1.0f + (av[i] - 1.0f) * kav[i]);
                rpv += rv[i] * kt[i] * rkv[i];
            }
            n2 = red16(n2); rpv = red16(rpv);
            const float inv = 1.0f / fmaxf(sqrtf(n2), 1e-12f);
            rs[q] = rv; kts[q] = kt; kkn[q] = kkx * inv; avs[q] = av; lws[q] = lw; vvs[q] = vv;
            *(f32x4*)(wS + tok * 64 + c4) = lw;
            u32x2 gw; gw.x = pk2(gp[0], gp[1]); gw.y = pk2(gp[2], gp[3]);
            *(u32x2*)(Gs + (brow + t) * RW + ch) = gw;
            if ((tid & 15) == 0) RHOs[(brow + t) * RH + h] = rpv;
        }
#pragma unroll
        for (int i = 0; i < 4; ++i) *(unsigned*)(Vt + (c4 + i) * CP + 2 * tkA) = pk2(vvs[0][i], vvs[1][i]);
    }
    __syncthreads();
    if (stop <= 3) return;
    { const int k = tid & 63, seg = tid >> 6; float run = 0.f;
#pragma unroll
      for (int i = 0; i < 8; ++i) { float* p = wS + (8 * seg + i) * 64 + k; run += *p; *p = run; }
      segT[seg * 64 + k] = run; }
    __syncthreads();
    if (stop <= 4) return;
    f32x4 bhs[2], khs[2], ahs[2];
    { u32x4* z = (u32x4*)TM; const u32x4 zz = {0u, 0u, 0u, 0u};
      for (int i = tid; i < 2 * 64 * CP * 2 / 16; i += NTHR) z[i] = zz;
      if (tid < 3 * 16 * 40 * 2 / 16) ((u32x4*)PTs)[tid] = zz; }
#pragma unroll
    for (int q = 0; q < 2; ++q) {
        const int tok = 2 * tkA + q, seg = tok >> 3;
        f32x4 L = *(const f32x4*)(wS + tok * 64 + c4);
        for (int s_ = 0; s_ < seg; ++s_) L = L + *(const f32x4*)(segT + s_ * 64 + c4);
        f32x4 eL, eNL, eLp;
#pragma unroll
        for (int i = 0; i < 4; ++i) { eL[i] = __expf(L[i]); eNL[i] = __expf(-L[i]); eLp[i] = __expf(L[i] - lws[q][i]); }
        const f32x4 qt = rs[q] * eL, kh = kts[q] * eNL, ah = -(kkn[q] * eLp), bh = kkn[q] * avs[q] * eNL;
        u32x2 w;
        w.x = pk2(ah[0], ah[1]); w.y = pk2(ah[2], ah[3]); *(u32x2*)(AH + tok * CP + c4) = w;
        w.x = pk2(qt[0], qt[1]); w.y = pk2(qt[2], qt[3]); *(u32x2*)(QT + tok * CP + c4) = w;
        w.x = pk2(bh[0], bh[1]); w.y = pk2(bh[2], bh[3]); *(u32x2*)(BH + tok * CP + c4) = w;
        w.x = pk2(kh[0], kh[1]); w.y = pk2(kh[2], kh[3]); *(u32x2*)(KH + tok * CP + c4) = w;
        bhs[q] = bh; khs[q] = kh; ahs[q] = ah;
        if (tok == 63) { *(f32x4*)(gCs + c4) = eL; *(f32x4*)((float*)(A.ws + WS_GC) + (size_t)uidx * 64 + c4) = eL; }
    }
#pragma unroll
    for (int i = 0; i < 4; ++i) {
        *(unsigned*)(BHt + (c4 + i) * CP + 2 * tkA) = pk2(bhs[0][i], bhs[1][i]);
        *(unsigned*)(KHt + (c4 + i) * CP + 2 * tkA) = pk2(khs[0][i], khs[1][i]);
        *(unsigned*)(AHt + (c4 + i) * CP + 2 * tkA) = pk2(ahs[0][i], ahs[1][i]);
    }
    __syncthreads();
    if (stop <= 5) return;
    {
        const int yt = wave & 3;
        const bf16* X = ((yt < 2) ? BH : KH) + 32 * (yt & 1) * CP;
#pragma unroll
        for (int q = 0; q < 2; ++q) {
            const int xt = 2 * (wave >> 2) + q;
            const bf16* Y = ((xt < 2) ? AH : QT) + 32 * (xt & 1) * CP;
            f32x16 acc = {};
            acc = mm32(X, Y, lane, acc);
            bf16* dst = (xt < 2) ? ((yt < 2) ? AAB : AAK) : ((yt < 2) ? ARB : ARK);
            const int i = 32 * (xt & 1) + r31;
#pragma unroll
            for (int g = 0; g < 4; ++g) {
                const int j0 = 32 * (yt & 1) + 8 * g + 4 * hh;
                float v[4];
#pragma unroll
                for (int e = 0; e < 4; ++e) { const int j = j0 + e; const bool keep = (xt < 2) ? (j < i) : (j <= i); v[e] = keep ? acc[4 * g + e] : 0.f; }
                { u32x2 w; w.x = pk2(v[0], v[1]); w.y = pk2(v[2], v[3]); *(u32x2*)(dst + i * CP + j0) = w; }
            }
        }
    }
    __syncthreads();
    if (stop <= 6) return;
    if (wave < 4) {
        const int mt = wave & 1, nt = wave >> 1;
        f32x16 acc = {};
        acc = mm32(AAK + 32 * mt * CP, Vt + 32 * nt * CP, lane, acc);
#pragma unroll
        for (int g = 0; g < 4; ++g) { u32x2 w; w.x = pk2(acc[4 * g], acc[4 * g + 1]); w.y = pk2(acc[4 * g + 2], acc[4 * g + 3]);
            *(u32x2*)(X1t + (32 * nt + r31) * CP + 32 * mt + 8 * g + 4 * hh) = w; }
    } else if (wave == 4) {
        const int bi = lane >> 4, cc = lane & 15;
        float x[16];
#pragma unroll
        for (int i = 0; i < 16; ++i) {
            const u32x4 a0 = *(const u32x4*)(AAB + (16 * bi + i) * CP + 16 * bi), a1 = *(const u32x4*)(AAB + (16 * bi + i) * CP + 16 * bi + 8);
            const float av_[16] = {lo16(a0.x), hi16(a0.x), lo16(a0.y), hi16(a0.y), lo16(a0.z), hi16(a0.z), lo16(a0.w), hi16(a0.w),
                                   lo16(a1.x), hi16(a1.x), lo16(a1.y), hi16(a1.y), lo16(a1.z), hi16(a1.z), lo16(a1.w), hi16(a1.w)};
            float v_ = (i == cc) ? 1.0f : 0.0f;
#pragma unroll
            for (int j = 0; j < i; ++j) v_ += av_[j] * x[j];
            x[i] = v_;
            TM[(16 * bi + i) * CP + 16 * bi + cc] = (unsigned short)(pk2(v_, 0.f) & 0xffffu);
        }
        u32x4 w0, w1;
        w0.x = pk2(x[0], x[1]); w0.y = pk2(x[2], x[3]); w0.z = pk2(x[4], x[5]); w0.w = pk2(x[6], x[7]);
        w1.x = pk2(x[8], x[9]); w1.y = pk2(x[10], x[11]); w1.z = pk2(x[12], x[13]); w1.w = pk2(x[14], x[15]);
        *(u32x4*)(TMt + (16 * bi + cc) * CP + 16 * bi) = w0; *(u32x4*)(TMt + (16 * bi + cc) * CP + 16 * bi + 8) = w1;
    }
    __syncthreads();
    if (stop <= 7) return;
    f32x16 nacc = {}, oacc = {};
    if (wave >= 4) { const int q = wave & 3;
        nacc = mm32(KHt + 32 * (q & 1) * CP, Vt + 32 * (q >> 1) * CP, lane, nacc);
        oacc = mm32(Vt + 32 * (q & 1) * CP, ARK + 32 * (q >> 1) * CP, lane, oacc); }
#pragma unroll
    for (int lvl = 1; lvl < 4; ++lvl) {
        if (wave < 4 - lvl) {
            const int bj = wave, bi = wave + lvl, l15 = lane & 15, q4 = lane >> 4;
            bf16* Pt = PTs + wave * (16 * 40);
            f32x4 acc = {0.f, 0.f, 0.f, 0.f};
#pragma unroll
            for (int ks = 0; ks < 2; ++ks)
                acc = __builtin_amdgcn_mfma_f32_16x16x32_bf16(*(const bf16x8*)(AAB + (16 * bi + l15) * CP + 32 * ks + 8 * q4), *(const bf16x8*)(TMt + (16 * bj + l15) * CP + 32 * ks + 8 * q4), acc, 0, 0, 0);
            { u32x2 w; w.x = pk2(acc[0], acc[1]); w.y = pk2(acc[2], acc[3]); *(u32x2*)(Pt + l15 * 40 + 4 * q4) = w; }
            asm volatile("s_waitcnt lgkmcnt(0)" ::: "memory");
            bf16x8 a2 = {0, 0, 0, 0, 0, 0, 0, 0};
            if (q4 < 2) a2 = *(const bf16x8*)(TM + (16 * bi + l15) * CP + 16 * bi + 8 * q4);
            const bf16x8 b2 = *(const bf16x8*)(Pt + l15 * 40 + 8 * q4);
            f32x4 xo = {0.f, 0.f, 0.f, 0.f};
            xo = __builtin_amdgcn_mfma_f32_16x16x32_bf16(a2, b2, xo, 0, 0, 0);
#pragma unroll
            for (int e = 0; e < 4; ++e) TM[(16 * bi + 4 * q4 + e) * CP + 16 * bj + l15] = (unsigned short)(pk2(xo[e], 0.f) & 0xffffu);
            { u32x2 w; w.x = pk2(xo[0], xo[1]); w.y = pk2(xo[2], xo[3]); *(u32x2*)(TMt + (16 * bj + l15) * CP + 16 * bi + 4 * q4) = w; }
        }
        __syncthreads();
    }
    {
        const int it = wave & 1, ct = (wave >> 1) & 1;
        const bf16* Y = (wave < 4) ? AHt : X1t; bf16* dst = (wave < 4) ? WTt : UTt;
        f32x16 acc = {};
        acc = mm32(TM + 32 * it * CP, Y + 32 * ct * CP, lane, acc);
#pragma unroll
        for (int g = 0; g < 4; ++g) { u32x2 w; w.x = pk2(acc[4 * g], acc[4 * g + 1]); w.y = pk2(acc[4 * g + 2], acc[4 * g + 3]);
            *(u32x2*)(dst + (32 * ct + r31) * CP + 32 * it + 8 * g + 4 * hh) = w; }
    }
    __syncthreads();
    if (stop <= 8) return;
    {
        u32x4* MPs = (u32x4*)((unsigned char*)A.out + SC_MP) + (size_t)uidx * 512;
        u32x4* NNs = (u32x4*)((unsigned char*)A.out + SC_NN) + (size_t)uidx * 512;
        u32x4* QHs = (u32x4*)((unsigned char*)A.out + SC_QH) + (size_t)uidx * 512;
        u32x4* OLs = (u32x4*)((unsigned char*)A.out + SC_OL) + (size_t)uidx * 512;
        if (wave < 2) {
            const int it = wave;
#pragma unroll
            for (int kt = 0; kt < 2; ++kt) {
                f32x16 acc = {};
                acc = mm32(WTt + 32 * kt * CP, ARB + 32 * it * CP, lane, acc);
#pragma unroll
                for (int g = 0; g < 4; ++g) { const u32x2 qv = *(const u32x2*)(QT + (32 * it + r31) * CP + 32 * kt + 8 * g + 4 * hh);
                    acc[4 * g] += lo16(qv.x); acc[4 * g + 1] += hi16(qv.x); acc[4 * g + 2] += lo16(qv.y); acc[4 * g + 3] += hi16(qv.y); }
                QHs[(it * 4 + 2 * kt) * 64 + lane] = packfrag(acc, 0); QHs[(it * 4 + 2 * kt + 1) * 64 + lane] = packfrag(acc, 1);
            }
        } else if (wave < 4) {
            const int ktp = wave - 2; const float gc = gCs[32 * ktp + r31];
#pragma unroll
            for (int kt = 0; kt < 2; ++kt) {
                f32x16 acc = {};
                acc = mm32(WTt + 32 * kt * CP, BHt + 32 * ktp * CP, lane, acc);
                acc = acc * gc;
                MPs[((ktp * 2 + kt) * 2) * 64 + lane] = packfrag(acc, 0); MPs[((ktp * 2 + kt) * 2 + 1) * 64 + lane] = packfrag(acc, 1);
            }
        } else {
            const int q = wave & 3;
            { const int kt = q & 1, vt = q >> 1;
              nacc = mm32(BHt + 32 * kt * CP, UTt + 32 * vt * CP, lane, nacc);
#pragma unroll
              for (int g = 0; g < 4; ++g) { const f32x4 gc = *(const f32x4*)(gCs + 32 * kt + 8 * g + 4 * hh);
                  nacc[4 * g] *= gc[0]; nacc[4 * g + 1] *= gc[1]; nacc[4 * g + 2] *= gc[2]; nacc[4 * g + 3] *= gc[3]; }
              NNs[((vt * 2 + kt) * 2) * 64 + lane] = packfrag(nacc, 0); NNs[((vt * 2 + kt) * 2 + 1) * 64 + lane] = packfrag(nacc, 1); }
            { const int vt = q & 1, it = q >> 1;
              oacc = mm32(UTt + 32 * vt * CP, ARB + 32 * it * CP, lane, oacc);
              OLs[((it * 2 + vt) * 2) * 64 + lane] = packfrag(oacc, 0); OLs[((it * 2 + vt) * 2 + 1) * 64 + lane] = packfrag(oacc, 1); }
        }
    }
    __syncthreads();
}
__device__ __forceinline__ void rwkv_r2_unit(const int tid_in, const Args& A, int u) {
    int tid = tid_in; asm volatile("" : "+v"(tid));
    const int lane = tid & 63, wave = __builtin_amdgcn_readfirstlane(tid >> 6), hh = lane >> 5;
    const int head = 4 * u + (wave >> 1), vt = wave & 1;
    const u32x4* MPs = (const u32x4*)((unsigned char*)A.out + SC_MP) + (size_t)head * 64 * 512;
    u32x4* NNs = (u32x4*)((unsigned char*)A.out + SC_NN) + (size_t)head * 64 * 512;
    const float* GCs = (const float*)(A.ws + WS_GC) + (size_t)head * 64 * 64;
    f32x16 acc0 = {}, acc1 = {};
    for (int c = 0; c < 64; ++c) {
        u32x4 mp[8], nn[4]; f32x4 gm[8];
#pragma unroll
        for (int i = 0; i < 8; ++i) mp[i] = MPs[(size_t)c * 512 + i * 64 + lane];
#pragma unroll
        for (int i = 0; i < 4; ++i) nn[i] = NNs[(size_t)c * 512 + vt * 256 + i * 64 + lane];
#pragma unroll
        for (int i = 0; i < 8; ++i) gm[i] = *(const f32x4*)(GCs + c * 64 + 32 * (i >> 2) + 8 * (i & 3) + 4 * hh);
        const u32x4 hb0 = packfrag(acc0, 0), hb1 = packfrag(acc0, 1), hb2 = packfrag(acc1, 0), hb3 = packfrag(acc1, 1);
#pragma unroll
        for (int g = 0; g < 4; ++g) {
            const unsigned* n0 = (const unsigned*)&nn[g >> 1]; const unsigned* n1 = (const unsigned*)&nn[2 + (g >> 1)];
            const int o_ = 2 * (g & 1);
            acc0[4 * g] = acc0[4 * g] * gm[g][0] + lo16(n0[o_]); acc0[4 * g + 1] = acc0[4 * g + 1] * gm[g][1] + hi16(n0[o_]);
            acc0[4 * g + 2] = acc0[4 * g + 2] * gm[g][2] + lo16(n0[o_ + 1]); acc0[4 * g + 3] = acc0[4 * g + 3] * gm[g][3] + hi16(n0[o_ + 1]);
            acc1[4 * g] = acc1[4 * g] * gm[4 + g][0] + lo16(n1[o_]); acc1[4 * g + 1] = acc1[4 * g + 1] * gm[4 + g][1] + hi16(n1[o_]);
            acc1[4 * g + 2] = acc1[4 * g + 2] * gm[4 + g][2] + lo16(n1[o_ + 1]); acc1[4 * g + 3] = acc1[4 * g + 3] * gm[4 + g][3] + hi16(n1[o_ + 1]);
        }
        NNs[(size_t)c * 512 + vt * 256 + 0 * 64 + lane] = hb0; NNs[(size_t)c * 512 + vt * 256 + 1 * 64 + lane] = hb1;
        NNs[(size_t)c * 512 + vt * 256 + 2 * 64 + lane] = hb2; NNs[(size_t)c * 512 + vt * 256 + 3 * 64 + lane] = hb3;
        const bf16x8 b0 = __builtin_bit_cast(bf16x8, hb0), b1 = __builtin_bit_cast(bf16x8, hb1), b2 = __builtin_bit_cast(bf16x8, hb2), b3 = __builtin_bit_cast(bf16x8, hb3);
        acc0 = __builtin_amdgcn_mfma_f32_32x32x16_bf16(__builtin_bit_cast(bf16x8, mp[0]), b0, acc0, 0, 0, 0);
        acc1 = __builtin_amdgcn_mfma_f32_32x32x16_bf16(__builtin_bit_cast(bf16x8, mp[4]), b0, acc1, 0, 0, 0);
        acc0 = __builtin_amdgcn_mfma_f32_32x32x16_bf16(__builtin_bit_cast(bf16x8, mp[1]), b1, acc0, 0, 0, 0);
        acc1 = __builtin_amdgcn_mfma_f32_32x32x16_bf16(__builtin_bit_cast(bf16x8, mp[5]), b1, acc1, 0, 0, 0);
        acc0 = __builtin_amdgcn_mfma_f32_32x32x16_bf16(__builtin_bit_cast(bf16x8, mp[2]), b2, acc0, 0, 0, 0);
        acc1 = __builtin_amdgcn_mfma_f32_32x32x16_bf16(__builtin_bit_cast(bf16x8, mp[6]), b2, acc1, 0, 0, 0);
        acc0 = __builtin_amdgcn_mfma_f32_32x32x16_bf16(__builtin_bit_cast(bf16x8, mp[3]), b3, acc0, 0, 0, 0);
        acc1 = __builtin_amdgcn_mfma_f32_32x32x16_bf16(__builtin_bit_cast(bf16x8, mp[7]), b3, acc1, 0, 0, 0);
    }
}
__device__ __forceinline__ void rwkv_r3_unit(const int tid_in, const Args& A, int layer, int u) {
    int tid = tid_in; asm volatile("" : "+v"(tid));
    const int lane = tid & 63, wave = __builtin_amdgcn_readfirstlane(tid >> 6), r31 = lane & 31, hh = lane >> 5;
    const int uidx = 4 * u + (wave >> 1), it = wave & 1;
    const int head = uidx >> 6, c = uidx & 63, b = head / RH, h = head % RH;
    const size_t trow = (size_t)b * SEQ + c * 64 + 32 * it + r31;
    const u32x4* HSs = (const u32x4*)((unsigned char*)A.out + SC_NN) + (size_t)uidx * 512;
    const u32x4* QHs = (const u32x4*)((unsigned char*)A.out + SC_QH) + (size_t)uidx * 512;
    const u32x4* OLs = (const u32x4*)((unsigned char*)A.out + SC_OL) + (size_t)uidx * 512;
    f32x16 acc[2];
#pragma unroll
    for (int vt = 0; vt < 2; ++vt) {
        const u32x4 o0 = OLs[((it * 2 + vt) * 2) * 64 + lane], o1 = OLs[((it * 2 + vt) * 2 + 1) * 64 + lane];
        acc[vt][0] = lo16(o0.x); acc[vt][1] = hi16(o0.x); acc[vt][2] = lo16(o0.y); acc[vt][3] = hi16(o0.y); acc[vt][4] = lo16(o0.z); acc[vt][5] = hi16(o0.z); acc[vt][6] = lo16(o0.w); acc[vt][7] = hi16(o0.w);
        acc[vt][8] = lo16(o1.x); acc[vt][9] = hi16(o1.x); acc[vt][10] = lo16(o1.y); acc[vt][11] = hi16(o1.y); acc[vt][12] = lo16(o1.z); acc[vt][13] = hi16(o1.z); acc[vt][14] = lo16(o1.w); acc[vt][15] = hi16(o1.w);
    }
#pragma unroll
    for (int s_ = 0; s_ < 4; ++s_) {
        const bf16x8 qf = __builtin_bit_cast(bf16x8, QHs[(it * 4 + s_) * 64 + lane]);
#pragma unroll
        for (int vt = 0; vt < 2; ++vt) {
            const bf16x8 hf = __builtin_bit_cast(bf16x8, HSs[vt * 256 + s_ * 64 + lane]);
            acc[vt] = __builtin_amdgcn_mfma_f32_32x32x16_bf16(hf, qf, acc[vt], 0, 0, 0);
        }
    }
    float sm = 0.f;
#pragma unroll
    for (int e = 0; e < 16; ++e) sm += acc[0][e] + acc[1][e];
    sm += __shfl_xor(sm, 32);
    const float mean = sm * (1.0f / 64.0f);
    float q2 = 0.f;
#pragma unroll
    for (int e = 0; e < 16; ++e) { const float d0 = acc[0][e] - mean, d1 = acc[1][e] - mean; q2 += d0 * d0 + d1 * d1; }
    q2 += __shfl_xor(q2, 32);
    const float rstd = rsqrtf(q2 * (1.0f / 64.0f) + GN_EPS);
    const float rh = ((const float*)(A.ws + WS_RHO))[trow * RH + h];
    const bf16* P = (const bf16*)(A.ws + WS_P); const bf16* Gs = (const bf16*)(A.ws + WS_G); bf16* MIX = (bf16*)(A.ws + WS_MIX);
    const bool hasprev = (c * 64 + 32 * it + r31) > 0;
#pragma unroll
    for (int vt = 0; vt < 2; ++vt)
#pragma unroll
        for (int g = 0; g < 4; ++g) {
            const int vch = h * 64 + 32 * vt + 8 * g + 4 * hh;
            const f32x4 lg = *(const f32x4*)(A.in[I_LNG] + layer * RW + vch), lb = *(const f32x4*)(A.in[I_LNB] + layer * RW + vch), muv = *(const f32x4*)(A.in[I_MU] + layer * RCOLS + PC_V + vch);
            const u32x2 cv = *(const u32x2*)(P + trow * INC + PC_V + vch);
            u32x2 pv = {0u, 0u}; if (hasprev) pv = *(const u32x2*)(P + (trow - 1) * INC + PC_V + vch);
            const u32x2 gw = *(const u32x2*)(Gs + trow * RW + vch);
            const f32x4 vc = {lo16(cv.x), hi16(cv.x), lo16(cv.y), hi16(cv.y)}, vp = {lo16(pv.x), hi16(pv.x), lo16(pv.y), hi16(pv.y)};
            const f32x4 vv = vc + muv * (vp - vc), gg = {lo16(gw.x), hi16(gw.x), lo16(gw.y), hi16(gw.y)};
            float y[4];
#pragma unroll
            for (int e = 0; e < 4; ++e) y[e] = ((acc[vt][4 * g + e] - mean) * rstd * lg[e] + lb[e] + rh * vv[e]) * gg[e];
            u32x2 w; w.x = pk2(y[0], y[1]); w.y = pk2(y[2], y[3]);
            *(u32x2*)(MIX + trow * D + MIX_R + vch) = w;
        }
}

constexpr int LT = 16;
__device__ __forceinline__ float gelu_tanh(float x) { const float u = 0.7978845608028654f * (x + 0.044715f * x * x * x); return x * __builtin_amdgcn_rcpf(1.0f + __expf(-2.0f * u)); }
__device__ __forceinline__ float neg_expm1(float x) { return (x > -0.25f) ? -x * (1.0f + x * (0.5f + x * (0.16666667f + x * (0.041666668f + x * (0.0083333338f + x * 0.0013888889f))))) : 1.0f - __expf(x); }
__device__ __forceinline__ void lru_unit(const int tid_in, const Args& A, int layer, int bg, unsigned char* lds) {
    int tid = tid_in; asm volatile("" : "+v"(tid));
    const int lane = tid & 63, wave = __builtin_amdgcn_readfirstlane(tid >> 6);
    const int b = bg / LB, g = bg % LB, c = g * 64 + lane;
    const bf16* P = (const bf16*)(A.ws + WS_P) + (size_t)b * SEQ * INC;
    bf16* MIX = (bf16*)(A.ws + WS_MIX) + (size_t)b * SEQ * D;
    bf16* WAs = (bf16*)lds;
    bf16* WXs = WAs + 64 * 72;
    float* totA = (float*)(WXs + 64 * 72);
    float* totH = totA + 8 * 64;
    float* carryS = totH + 8 * 64;
    bf16* XC = (bf16*)(carryS + 64) + wave * (LT * 72);
    float* PRE = (float*)((bf16*)(carryS + 64) + 8 * LT * 72) + wave * (2 * LT * 68);
    const bf16* LwaT = (const bf16*)(A.ws + WS_WSM) + 98304 + g * 4096; const bf16* LwxT = LwaT + 16384;
    { const int j = tid >> 3, i8 = (tid & 7) * 8;
      *(u32x4*)(WAs + j * 72 + i8) = *(const u32x4*)(LwaT + j * 64 + i8); *(u32x4*)(WXs + j * 72 + i8) = *(const u32x4*)(LwxT + j * 64 + i8); }
    const float cw0 = A.in[I_CW][(layer * 4 + 0) * LW + c], cw1 = A.in[I_CW][(layer * 4 + 1) * LW + c], cw2 = A.in[I_CW][(layer * 4 + 2) * LW + c], cw3 = A.in[I_CW][(layer * 4 + 3) * LW + c];
    const float cb = A.in[I_CB][layer * LW + c], ba = A.in[I_BA][layer * LW + c], bx = A.in[I_BX][layer * LW + c];
    const float sp8 = 8.0f * softplusf_(-A.in[I_LAM][layer * LW + c]);
    const float ng = A.in[I_LRUG][layer * LW + c];
    if (tid < 64) carryS[tid] = 0.f;
    __syncthreads();
    for (int st = 0; st < SEQ; st += 8 * LT) {
        const int T0 = st + wave * LT;
        float xm3 = (T0 >= 3) ? bf2f(P[(size_t)(T0 - 3) * INC + PC_LX + c]) : 0.f;
        float xm2 = (T0 >= 2) ? bf2f(P[(size_t)(T0 - 2) * INC + PC_LX + c]) : 0.f;
        float xm1 = (T0 >= 1) ? bf2f(P[(size_t)(T0 - 1) * INC + PC_LX + c]) : 0.f;
        float xc[LT], gin[LT];
#pragma unroll
        for (int t = 0; t < LT; ++t) { xc[t] = bf2f(P[(size_t)(T0 + t) * INC + PC_LX + c]); gin[t] = bf2f(P[(size_t)(T0 + t) * INC + PC_LG + c]); }
#pragma unroll
        for (int t = 0; t < LT; ++t) {
            const float x = xc[t];
            xc[t] = cw0 * xm3 + cw1 * xm2 + cw2 * xm1 + cw3 * x + cb;
            xm3 = xm2; xm2 = xm1; xm1 = x;
            XC[t * 72 + lane] = (unsigned short)(pk2(xc[t], 0.f) & 0xffffu);
        }
        asm volatile("s_waitcnt lgkmcnt(0)" ::: "memory");
        {
            const bf16* bl = XC + (lane & 15) * 72 + 8 * (lane >> 4);
            const bf16x8 b0 = *(const bf16x8*)(bl), b1 = *(const bf16x8*)(bl + 32);
#pragma unroll
            for (int gt = 0; gt < 2; ++gt) {
                const bf16* Ws = gt ? WXs : WAs;
#pragma unroll
                for (int jt = 0; jt < 4; ++jt) {
                    const bf16* al = Ws + (16 * jt + (lane & 15)) * 72 + 8 * (lane >> 4);
                    f32x4 acc = {0.f, 0.f, 0.f, 0.f};
                    acc = __builtin_amdgcn_mfma_f32_16x16x32_bf16(*(const bf16x8*)(al), b0, acc, 0, 0, 0);
                    acc = __builtin_amdgcn_mfma_f32_16x16x32_bf16(*(const bf16x8*)(al + 32), b1, acc, 0, 0, 0);
                    *(f32x4*)(PRE + gt * (LT * 68) + (lane & 15) * 68 + 16 * jt + 4 * (lane >> 4)) = acc;
                }
            }
        }
        asm volatile("s_waitcnt lgkmcnt(0)" ::: "memory");
        float hl[LT], Ac[LT];
        float hrun = 0.f, arun = 1.f;
#pragma unroll
        for (int t = 0; t < LT; ++t) {
            const float ga = PRE[t * 68 + lane] + ba, gx = PRE[LT * 68 + t * 68 + lane] + bx;
            const float la = -sp8 * sigmoidf_(ga);
            const float a = __expf(la);
            const float bi = sqrtf(neg_expm1(2.0f * la)) * sigmoidf_(gx) * xc[t];
            hrun = a * hrun + bi; arun *= a;
            hl[t] = hrun; Ac[t] = arun;
        }
        totA[wave * 64 + lane] = arun; totH[wave * 64 + lane] = hrun;
        __syncthreads();
        float cin = carryS[lane];
        for (int u = 0; u < wave; ++u) cin = totA[u * 64 + lane] * cin + totH[u * 64 + lane];
        float cout = cin;
        if (wave == 7) cout = totA[7 * 64 + lane] * cin + totH[7 * 64 + lane];
#pragma unroll
        for (int t = 0; t < LT; ++t) {
            const float hv = hl[t] + Ac[t] * cin;
            const float y = gelu_tanh(gin[t]) * hv;
            const float ss = red64(y * y);
            const float o = y * rsqrtf(ss * (1.0f / 64.0f) + RMS_EPS) * ng;
            ((unsigned short*)MIX)[(size_t)(T0 + t) * D + MIX_L + c] = (unsigned short)(pk2(o, 0.f) & 0xffffu);
        }
        __syncthreads();
        if (wave == 7) carryS[lane] = cout;
        __syncthreads();
    }
}

__device__ __forceinline__ void phase_mixers(const int tid, const Args& A, int layer, int sub, unsigned char* lds, volatile LAS unsigned* misc, const int umask = 7, const int qslot = 0, const int r1stop = 99) {
    unsigned* qhead = (unsigned*)(A.ws + WS_CTL) + CW_Q + layer * 64 + sub * 8 + qslot;
    constexpr int R1B = RH;
    const int a0 = (sub == 0) ? 0 : (sub == 1) ? 288 : 384, a1 = (sub == 0) ? 288 : (sub == 1) ? 384 : 1536, nA = a1 - a0;
    const int nHead = (sub == 0) ? 64 : (sub == 1) ? 24 : 0;
    const int nTail = (sub == 0) ? 6144 / R1B : (sub == 2) ? 1536 : 0;
    const int NU = nHead + nA + nTail;
#ifndef CUMASK
#define CUMASK 7
#endif
    for (;;) {
        __syncthreads();
        if (tid == 0) misc[4] = __hip_atomic_fetch_add(qhead, 1u, __ATOMIC_RELAXED, __HIP_MEMORY_SCOPE_AGENT);
        __syncthreads();
        const int u = (int)misc[4];
        if (u >= NU) break;
        if (u < nHead) {
            if (sub == 0) { if ((CUMASK & 2) && (umask & 2)) lru_unit(tid, A, layer, u, lds); }
            else { if ((CUMASK & 1) && (umask & 1)) rwkv_r2_unit(tid, A, u); }
        } else if (u < nHead + nA) {
            const int a = a0 + (u - nHead); if ((CUMASK & 4) && (umask & 4)) attn_unit(tid, A, layer, a % 96, 15 - a / 96, lds);
        } else {
            const int v = u - nHead - nA;
            if (sub == 0) { if ((CUMASK & 1) && (umask & 1)) { R1Pre pf; const int bb = v >> 6, cc_ = v & 63; rwkv_r1_prefetch(tid, A, bb, cc_, pf);
                    for (int hq = 0; hq < RH; ++hq) rwkv_r1_unit(tid, A, layer, (bb * RH + hq) * 64 + cc_, lds, pf, hq == 0, r1stop); } }
            else { if ((CUMASK & 1) && (umask & 1)) rwkv_r3_unit(tid, A, layer, v); }
        }
    }
}

__device__ __forceinline__ void phase_ln1_router(const int tid, const Args& A, int layer, unsigned char* lds, int vcu, int G) {
    const int lane = tid & 63, wave = tid >> 6;
    float* rwT = (float*)lds;
    int* hist = (int*)(lds + 65536);
    int* rowinfo = (int*)(lds + 65536 + 256);
    bf16* X1 = (bf16*)(A.ws + WS_X1);
    int* list = (int*)(A.ws + WS_LIST); float* gate = (float*)(A.ws + WS_GATE);
    unsigned* gcnt = (unsigned*)(A.ws + WS_CTL) + CW_CNT + layer * 64;
    const float* rw = A.in[I_RW];
    for (int i = tid; i < 16 * 1024; i += NTHR) { const int c = i >> 4, e = i & 15; rwT[e * 1024 + c] = rw[i]; }
    float rb[16];
#pragma unroll
    for (int e = 0; e < 16; ++e) rb[e] = A.in[I_RB][e];
    const float* g1 = A.in[I_LN1G] + layer * D; const float* b1 = A.in[I_LN1B] + layer * D;
    const int rows_per = M / G;
    for (int chunk = 0; chunk < rows_per / 256; ++chunk) {
        const int base = vcu * rows_per + chunk * 256;
        if (tid < 16) hist[tid] = 0;
        __syncthreads();
        for (int rp = 0; rp < 16; ++rp) {
            const int lr = wave * 32 + rp * 2;
            float y[2][16];
#pragma unroll
            for (int q = 0; q < 2; ++q) {
                const bf16* xr = X1 + (size_t)(base + lr + q) * D;
                float v[16]; float sm = 0.f;
#pragma unroll
                for (int i = 0; i < 16; ++i) { v[i] = bf2f(xr[lane + 64 * i]); sm += v[i]; }
                const float mean = red64(sm) * (1.0f / D); float s2 = 0.f;
#pragma unroll
                for (int i = 0; i < 16; ++i) { v[i] -= mean; s2 += v[i] * v[i]; }
                const float rstd = rsqrtf(red64(s2) * (1.0f / D) + LN_EPS);
#pragma unroll
                for (int i = 0; i < 16; ++i) y[q][i] = v[i] * rstd * g1[lane + 64 * i] + b1[lane + 64 * i];
                bf16* xo = X1 + (size_t)(base + lr + q) * D;
#pragma unroll
                for (int i = 0; i < 16; ++i) xo[lane + 64 * i] = (unsigned short)(pk2(y[q][i], 0.f) & 0xffffu);
            }
            float lg[2][16];
#pragma unroll
            for (int e = 0; e < 16; ++e) { float a0 = 0.f, a1 = 0.f;
#pragma unroll
                for (int i = 0; i < 16; ++i) { const float w = rwT[e * 1024 + lane + 64 * i]; a0 += y[0][i] * w; a1 += y[1][i] * w; }
                lg[0][e] = red64(a0) + rb[e]; lg[1][e] = red64(a1) + rb[e]; }
#pragma unroll
            for (int q = 0; q < 2; ++q) {
                float mx = lg[q][0];
#pragma unroll
                for (int e = 1; e < 16; ++e) mx = fmaxf(mx, lg[q][e]);
                float sc[16], den = 0.f;
#pragma unroll
                for (int e = 0; e < 16; ++e) { sc[e] = __expf(lg[q][e] - mx); den += sc[e]; }
                const float inv = 1.0f / den;
#pragma unroll
                for (int e = 0; e < 16; ++e) sc[e] *= inv;
                int sel = 0; float best = -1.f;
#pragma unroll
                for (int gq = 0; gq < 4; ++gq) {
                    const float a = sc[4 * gq], b_ = sc[4 * gq + 1], c_ = sc[4 * gq + 2], d_ = sc[4 * gq + 3];
                    const float m1 = fmaxf(fmaxf(a, b_), fmaxf(c_, d_));
                    const float m2 = fmaxf(fmaxf(fminf(a, b_), fminf(c_, d_)), fminf(fmaxf(a, b_), fmaxf(c_, d_)));
                    const float gs = m1 + m2;
                    if (gs > best) { best = gs; sel = gq; }
                }
                float cd[4];
#pragma unroll
                for (int i = 0; i < 4; ++i) cd[i] = (sel == 0) ? sc[i] : (sel == 1) ? sc[4 + i] : (sel == 2) ? sc[8 + i] : sc[12 + i];
                int i0 = 0; float v0 = cd[0];
#pragma unroll
                for (int i = 1; i < 4; ++i) if (cd[i] > v0) { v0 = cd[i]; i0 = i; }
                int i1 = -1; float v1 = -1.f;
#pragma unroll
                for (int i = 0; i < 4; ++i) if (i != i0 && cd[i] > v1) { v1 = cd[i]; i1 = i; }
                const int e0 = sel * 4 + i0, e1 = sel * 4 + i1;
                const float gsum = v0 + v1;
                if (lane == 0) {
                    const int row = base + lr + q;
                    gate[2 * row] = v0 / gsum; gate[2 * row + 1] = v1 / gsum;
                    const int r0 = atomicAdd(&hist[e0], 1), r1 = atomicAdd(&hist[e1], 1);
                    rowinfo[2 * (lr + q)] = e0 | (r0 << 8); rowinfo[2 * (lr + q) + 1] = e1 | (r1 << 8);
                }
            }
        }
        __syncthreads();
        if (tid < 16) hist[16 + tid] = (int)__hip_atomic_fetch_add(gcnt + tid, (unsigned)hist[tid], __ATOMIC_RELAXED, __HIP_MEMORY_SCOPE_AGENT);
        __syncthreads();
        { const int info = rowinfo[tid]; const int e = info & 255, rk = info >> 8, pos = hist[16 + e] + rk, a = (base + (tid >> 1)) * 2 + (tid & 1);
          list[(size_t)e * LCAP + pos] = a; ((int*)(A.ws + WS_EINFO))[a] = e | (pos << 8); }
        __syncthreads();
    }
}

__device__ __forceinline__ void phase_ln2(const int tid, const Args& A, int layer, int vcu, int G, const LAS int* tab) {
    const int lane = tid & 63, wave = tid >> 6;
    const bf16* X1 = (const bf16*)(A.ws + WS_X1); const bf16* YM = (const bf16*)(A.ws + WS_YM);
    bf16* XB = (bf16*)(A.ws + WS_XB);
    const float* g2 = A.in[I_LN2G] + layer * D; const float* b2 = A.in[I_LN2B] + layer * D;
    f32x4 gg[4], bb[4];
#pragma unroll
    for (int j = 0; j < 4; ++j) { gg[j] = *(const f32x4*)(g2 + 4 * lane + 256 * j); bb[j] = *(const f32x4*)(b2 + 4 * lane + 256 * j); }
    const int gw = vcu * NWAVES + wave, NGW = G * NWAVES;
    const int* einfo = (const int*)(A.ws + WS_EINFO); const float* gate = (const float*)(A.ws + WS_GATE);
    for (int row = gw; row < M; row += NGW) {
        const int i0 = einfo[2 * row], i1 = einfo[2 * row + 1];
        const size_t yr0 = ((size_t)tab[i0 & 255] << 8) + (size_t)(i0 >> 8), yr1 = ((size_t)tab[i1 & 255] << 8) + (size_t)(i1 >> 8);
        const float g0 = gate[2 * row], g1 = gate[2 * row + 1];
        f32x4 v[4]; float sm = 0.f;
#pragma unroll
        for (int j = 0; j < 4; ++j) {
            const u32x2 a = *(const u32x2*)(X1 + (size_t)row * D + 4 * lane + 256 * j);
            const u32x2 y0 = *(const u32x2*)(YM + yr0 * D + 4 * lane + 256 * j);
            const u32x2 y1 = *(const u32x2*)(YM + yr1 * D + 4 * lane + 256 * j);
            v[j][0] = ALPHA * lo16(a.x) + g0 * lo16(y0.x) + g1 * lo16(y1.x); v[j][1] = ALPHA * hi16(a.x) + g0 * hi16(y0.x) + g1 * hi16(y1.x);
            v[j][2] = ALPHA * lo16(a.y) + g0 * lo16(y0.y) + g1 * lo16(y1.y); v[j][3] = ALPHA * hi16(a.y) + g0 * hi16(y0.y) + g1 * hi16(y1.y);
            sm += (v[j][0] + v[j][1]) + (v[j][2] + v[j][3]);
        }
        const float mean = red64(sm) * (1.0f / D); float s2 = 0.f;
#pragma unroll
        for (int j = 0; j < 4; ++j) { v[j] = v[j] - mean; s2 += (v[j][0] * v[j][0] + v[j][1] * v[j][1]) + (v[j][2] * v[j][2] + v[j][3] * v[j][3]); }
        const float rstd = rsqrtf(red64(s2) * (1.0f / D) + LN_EPS);
#pragma unroll
        for (int j = 0; j < 4; ++j) {
            const f32x4 o = v[j] * rstd * gg[j] + bb[j];
            if (layer == DEPTH - 1) *(f32x4*)(A.out + (size_t)row * D + 4 * lane + 256 * j) = o;
            else { u32x2 w; w.x = pk2(o[0], o[1]); w.y = pk2(o[2], o[3]); *(u32x2*)(XB + (size_t)row * D + 4 * lane + 256 * j) = w; }
        }
    }
}

__device__ __forceinline__ void moe_table(const int tid, const Args& A, int layer, LAS int* tab) {
    if (tid == 0) {
        const unsigned* gcnt = (const unsigned*)(A.ws + WS_CTL) + CW_CNT + layer * 64;
        int acc = 0;
        for (int e = 0; e < 16; ++e) { const int c = (int)__hip_atomic_load(gcnt + e, __ATOMIC_RELAXED, __HIP_MEMORY_SCOPE_AGENT); tab[e] = acc; tab[32 + e] = c; acc += (c + 255) >> 8; }
        tab[16] = acc;
    }
    __syncthreads();
}

__global__ void __launch_bounds__(NTHR, 2) fwd_kernel(Args args) {
    extern __shared__ __attribute__((aligned(16))) unsigned char lds[];
    LAS unsigned char* ldsl = (LAS unsigned char*)lds;
    volatile LAS unsigned* misc = (volatile LAS unsigned*)(ldsl + MISC_OFF);
    const int wave_s = __builtin_amdgcn_readfirstlane((int)threadIdx.x >> 6);
#define MKTID() ({ unsigned z_ = 0u; asm volatile("" : "+v"(z_)); (int)(wave_s * 64 + (int)__builtin_amdgcn_mbcnt_hi(~0u, __builtin_amdgcn_mbcnt_lo(~0u, z_))); })
    { const int tid = MKTID(); for (int u = tid; u < (LDS_BYTES - MISC_OFF) / 4; u += NTHR) misc[u] = 0u; }
    __syncthreads();
    const int G = gridDim.x, bx = blockIdx.x;
    const int vcu = (G % 8 == 0) ? (bx % 8) * (G / 8) + bx / 8 : bx;
    unsigned* ctl = (unsigned*)(args.ws + WS_CTL);
    XcdBarrier bar; bar.bar = ctl + CW_BAR; bar.x = 0; bar.st = nullptr;
    if (args.use_bar) bar = xcd_barrier_post(MKTID(), ctl + CW_BAR, misc + 8);
    LAS int* tab = (LAS int*)(ldsl + MISC_OFF + 256);
    const int lo = args.ph_lo, hi = args.ph_hi;
#ifndef PHMASK
#define PHMASK 0x3FF
#endif
#define IN(k) (((PHMASK >> (k)) & 1) && lo <= (k) && (k) < hi)
#define SEAM(k) do { if (args.use_bar && (REP_PH || !((k) == NPH - 1 && layer == args.l_hi - 1))) xcd_barrier(MKTID(), bar); } while (0)
#ifndef REP_PH
#define REP_PH 0
#endif
#ifndef REP_UMASK
#define REP_UMASK 7
#endif
    for (int layer = args.l_lo; layer < args.l_hi; ++layer) {
      {
#define RUN(k) if (IN(k)) for (int rep = 0; rep < ((((REP_PH) >> (k)) & 1) ? 2 : 1); ++rep)
        RUN(0) { phase_convert(MKTID(), args, layer, (float*)lds, vcu, G); SEAM(0); }
        RUN(1) {
            pg8::DenseOrder S; S.init(M, INC, D, G, bx, args.ws + WS_WIN);
            pg8::EpiIn E{(bf16*)(args.ws + WS_P)};
            pg8::gemm_phase<pg8::EpiIn, pg8::DenseOrder, true>(MKTID(), ldsl, (const char*)(args.ws + WS_XB), D, S, E);
            SEAM(1);
        }
#ifndef R1STOP
#define R1STOP 99
#endif
        RUN(2) { const bool probe = ((REP_PH >> 2) & 1) && rep == 0; phase_mixers(MKTID(), args, layer, 0, lds, misc, probe ? REP_UMASK : 7, rep * 4, probe ? R1STOP : 99); SEAM(2); }
        RUN(3) { phase_mixers(MKTID(), args, layer, 1, lds, misc, rep ? REP_UMASK : 7, rep * 4); SEAM(3); }
        RUN(4) { phase_mixers(MKTID(), args, layer, 2, lds, misc, rep ? REP_UMASK : 7, rep * 4); SEAM(4); }
        RUN(5) {
            pg8::DenseOrder S; S.init(M, D, D, G, bx, args.ws + WS_WOUT);
            pg8::EpiOut E{(const bf16*)(args.ws + WS_XB), (bf16*)(args.ws + WS_X1)};
            pg8::gemm_phase<pg8::EpiOut, pg8::DenseOrder, true>(MKTID(), ldsl, (const char*)(args.ws + WS_MIX), D, S, E);
            SEAM(5);
        }
        RUN(6) { phase_ln1_router(MKTID(), args, layer, lds, vcu, G); SEAM(6); }
        RUN(7) {
            moe_table(MKTID(), args, layer, tab);
            pg8::MoeOrder<true> S{tab, G, vcu, D, 4, (const char*)(args.ws + WS_WGU), (size_t)1024 * D * 2, (const int*)(args.ws + WS_LIST)};
            pg8::EpiMoe1 E{(bf16*)(args.ws + WS_H)};
            pg8::gemm_phase<pg8::EpiMoe1, pg8::MoeOrder<true>, true>(MKTID(), ldsl, (const char*)(args.ws + WS_X1), D, S, E);
            SEAM(7);
        }
        RUN(8) {
            moe_table(MKTID(), args, layer, tab);
            pg8::MoeOrder<false> S{tab, G, vcu, DE, 4, (const char*)(args.ws + WS_WDN), (size_t)1024 * DE * 2, (const int*)(args.ws + WS_LIST)};
            pg8::EpiMoe2 E{(bf16*)(args.ws + WS_YM)};
            pg8::gemm_phase<pg8::EpiMoe2, pg8::MoeOrder<false>, true>(MKTID(), ldsl, (const char*)(args.ws + WS_H), DE, S, E);
            SEAM(8);
        }
        RUN(9) { moe_table(MKTID(), args, layer, tab); phase_ln2(MKTID(), args, layer, vcu, G, tab); SEAM(9); }
#undef RUN
      }
    }
#undef IN
#undef SEAM
}

extern "C" void kernel_launch(void* const* d_in, const int* in_sizes, int n_in, void* d_out, int out_size, void* d_ws, size_t ws_size, hipStream_t stream) {
    static int grid = 0;
    if (grid == 0) {
        if (n_in != 32 || out_size != M * D || ws_size < WS_END) { fprintf(stderr, "kernel_launch: unexpected shapes (n_in %d out %d ws %zu)\n", n_in, out_size, ws_size); grid = -1; return; }
        int dev = 0, cus = 0;
        if (hipGetDevice(&dev) != hipSuccess || hipDeviceGetAttribute(&cus, hipDeviceAttributeMultiprocessorCount, dev) != hipSuccess) { grid = -1; return; }
        if (hipFuncSetAttribute((const void*)fwd_kernel, hipFuncAttributeMaxDynamicSharedMemorySize, LDS_BYTES) != hipSuccess) { fprintf(stderr, "kernel_launch: hipFuncSetAttribute failed\n"); grid = -1; return; }
        int per_cu = 0;
        (void)hipOccupancyMaxActiveBlocksPerMultiprocessor(&per_cu, (const void*)fwd_kernel, NTHR, LDS_BYTES);
        (void)hipGetLastError();
        if (per_cu < 1) fprintf(stderr, "kernel_launch: occupancy query reports %d\n", per_cu);
        grid = cus;
    }
    if (grid < 0) return;
    (void)hipMemsetAsync((char*)d_ws + WS_CTL, 0, CTL_BYTES, stream);
    Args a{};
    for (int i = 0; i < 32; ++i) a.in[i] = (const float*)d_in[i];
    a.out = (float*)d_out; a.ws = (unsigned char*)d_ws;
#if MK_ONE_LAUNCH
    a.l_lo = 0; a.l_hi = DEPTH; a.ph_lo = 0; a.ph_hi = NPH; a.use_bar = 1; a.pad = 0;
    hipLaunchKernelGGL(fwd_kernel, dim3(grid), dim3(NTHR), LDS_BYTES, stream, a);
#else
    for (int l = 0; l < DEPTH; ++l)
        for (int p = 0; p < NPH; ++p) {
            a.l_lo = l; a.l_hi = l + 1; a.ph_lo = p; a.ph_hi = p + 1; a.use_bar = 0; a.pad = 0;
            hipLaunchKernelGGL(fwd_kernel, dim3(grid), dim3(NTHR), LDS_BYTES, stream, a);
        }
#endif
}
```

```cpp
#include <hip/hip_runtime.h>
#include <cstdio>
#include <cstdint>

#ifndef MK_ONE_LAUNCH
#define MK_ONE_LAUNCH 1
#endif

#define LAS __attribute__((address_space(3)))
#define GAS __attribute__((address_space(1)))
typedef unsigned short bf16;
typedef short bf16x8 __attribute__((ext_vector_type(8)));
typedef short s16x4 __attribute__((ext_vector_type(4)));
typedef float f32x4 __attribute__((ext_vector_type(4)));
typedef float f32x2 __attribute__((ext_vector_type(2)));
typedef float f32x16 __attribute__((ext_vector_type(16)));
typedef unsigned u32x4 __attribute__((ext_vector_type(4)));
typedef unsigned u32x2 __attribute__((ext_vector_type(2)));
typedef __bf16 bf16x2_t __attribute__((ext_vector_type(2)));

constexpr int D = 1024, BATCH = 16, SEQ = 4096, DEPTH = 4, M = BATCH * SEQ;
constexpr int HD = 64, RW = 384, LW = 256, SW = 384, RH = 6, LB = 4, SH = 6;
constexpr int RCOLS = 1408, INC = 3072;
constexpr int PC_R = 0, PC_K = 384, PC_V = 768, PC_DW = 1152, PC_DA = 1216, PC_DG = 1280;
constexpr int PC_LG = 1408, PC_LX = 1664, PC_SQ = 1920, PC_SK = 2304, PC_SV = 2688;
constexpr int MIX_R = 0, MIX_L = 384, MIX_S = 640;
constexpr int NE = 16, DE = 512, LCAP = 2 * M;
constexpr float ALPHA = 1.6817928305074290f;
constexpr float LN_EPS = 1e-5f, RMS_EPS = 1e-6f, GN_EPS = 64e-5f;
constexpr float C2 = 0.125f * 1.4426950408889634f;

constexpr size_t MiB = 1u << 20;
constexpr size_t WS_CTL = 0, CTL_BYTES = 1 * MiB;
constexpr size_t WS_WIN = 1 * MiB;
constexpr size_t WS_WOUT = 7 * MiB;
constexpr size_t WS_WGU = 9 * MiB;
constexpr size_t WS_WDN = 41 * MiB;
constexpr size_t WS_WSM = 57 * MiB;
constexpr size_t WS_LIST = 58 * MiB;
constexpr size_t WS_GATE = 66 * MiB;
constexpr size_t WS_EINFO = 67 * MiB;
constexpr size_t WS_XB = 68 * MiB;
constexpr size_t WS_X1 = 196 * MiB;
constexpr size_t WS_P = 324 * MiB;
constexpr size_t WS_MIX = 708 * MiB;
constexpr size_t WS_H = 324 * MiB;
constexpr size_t WS_YM = 460 * MiB;
constexpr size_t WS_END = 888 * MiB;
static_assert(WS_H + (size_t)(2 * M + NE * 256) * DE * 2 <= WS_YM && WS_YM + (size_t)2 * M * D * 2 <= WS_END, "ws map");

constexpr int CW_BAR = 0;
constexpr int CW_CNT = 8192;
constexpr int CW_Q = 8192 + 1024;

constexpr int NTHR = 512, NWAVES = 8;
constexpr int LDS_BYTES = 155648;
constexpr int GEMM_LDS = 131072;
constexpr int MISC_OFF = 147456;

__device__ __forceinline__ float bf2f(unsigned short b) { return __uint_as_float((unsigned)b << 16); }
__device__ __forceinline__ unsigned pk2(float lo, float hi) { f32x2 v = {lo, hi}; bf16x2_t b = __builtin_convertvector(v, bf16x2_t); return __builtin_bit_cast(unsigned, b); }
__device__ __forceinline__ float lo16(unsigned u) { return __uint_as_float(u << 16); }
__device__ __forceinline__ float hi16(unsigned u) { return __uint_as_float(u & 0xffff0000u); }
#define DPP(v, ctrl) __builtin_bit_cast(float, __builtin_amdgcn_update_dpp(__builtin_bit_cast(int, v), __builtin_bit_cast(int, v), (ctrl), 0xF, 0xF, false))
__device__ __forceinline__ float red8(float v) { v += DPP(v, 0xB1); v += DPP(v, 0x4E); v += DPP(v, 0x141); return v; }
__device__ __forceinline__ float red16(float v) { v = red8(v); v += DPP(v, 0x140); return v; }
__device__ __forceinline__ float red64(float v) { v = red16(v); v += __shfl_xor(v, 16); v += __shfl_xor(v, 32); return v; }
__device__ __forceinline__ float sigmoidf_(float x) { return __builtin_amdgcn_rcpf(1.0f + __expf(-x)); }
__device__ __forceinline__ float log1p_fast(float y) { return (y < 0.06f) ? y * (1.0f + y * (-0.5f + y * (0.33333334f + y * (-0.25f + y * (0.2f - y * 0.16666667f))))) : __logf(1.0f + y); }
__device__ __forceinline__ float softplusf_(float x) { return x > 20.f ? x : log1p_fast(__expf(x)); }

#define XB_TMO      128
#define XB_XCNT(j)  (256  + 64 * (j))
#define XB_XSUB(j)  (1280 + 64 * (j))
#define XB_XGEN(j)  (2304 + 64 * (j))
#define XB_TOP      3328
#define XB_TOPGEN   3392
#define XCD_BAR_WORDS 3456
#define XB_SPIN_CAP (1u << 22)
__device__ __forceinline__ unsigned xb_ld(unsigned* p)              { return __hip_atomic_load(p, __ATOMIC_RELAXED, __HIP_MEMORY_SCOPE_AGENT); }
__device__ __forceinline__ unsigned xb_add(unsigned* p, unsigned v) { return __hip_atomic_fetch_add(p, v, __ATOMIC_RELAXED, __HIP_MEMORY_SCOPE_AGENT); }
__device__ __forceinline__ unsigned xb_xcc_id() { return (unsigned)__builtin_amdgcn_s_getreg((3 << 11) | 20) & 0xFu; }
#define XB_SPIN(cond, bar) do { unsigned _sp = 0; while (cond) { __builtin_amdgcn_s_sleep(1); \
    if ((++_sp & 255u) == 0u) { if (xb_ld(&(bar)[XB_TMO])) break; if (_sp > XB_SPIN_CAP) { atomicAdd(&(bar)[XB_TMO], 1u); break; } } } } while (0)
struct XcdBarrier { unsigned* bar; unsigned x; volatile LAS unsigned* st; };
__device__ __forceinline__ XcdBarrier xcd_barrier_post(const int tid, unsigned* bar, volatile LAS unsigned* st) {
    XcdBarrier b; b.bar = bar; b.x = xb_xcc_id(); b.st = st;
    if (tid == 0) (void)xb_add(&bar[XB_XCNT(b.x)], 1u);
    return b;
}
__device__ __forceinline__ void xcd_barrier_complete(unsigned* bar, unsigned x, unsigned& nloc, unsigned& nx) {
    const unsigned G = gridDim.x * gridDim.y * gridDim.z;
    unsigned sum, cnt, mine, sp = 0u;
    for (;;) {
        sum = 0u; cnt = 0u; mine = 0u;
#pragma unroll
        for (unsigned j = 0; j < 16; ++j) { const unsigned c = xb_ld(&bar[XB_XCNT(j)]); sum += c; cnt += (c > 0u) ? 1u : 0u; mine = (j == x) ? c : mine; }
        if (sum == G) break;
        __builtin_amdgcn_s_sleep(1);
        if ((++sp & 255u) == 0u) { if (xb_ld(&bar[XB_TMO])) break; if (sp > XB_SPIN_CAP) { atomicAdd(&bar[XB_TMO], 1u); break; } }
    }
    nloc = mine > 0u ? mine : 1u; nx = cnt > 0u ? cnt : 1u;
}
__device__ __forceinline__ void xcd_barrier(const int tid, const XcdBarrier& b) {
    asm volatile("s_waitcnt vmcnt(0)" ::: "memory");
    __syncthreads();
    if (tid == 0) {
        unsigned* bar = b.bar;
        __builtin_amdgcn_s_waitcnt(0);
        unsigned nloc = b.st[0], nx = b.st[1];
        if (nloc == 0u) { xcd_barrier_complete(bar, b.x, nloc, nx); b.st[0] = nloc; b.st[1] = nx; }
        const unsigned old = xb_add(&bar[XB_XSUB(b.x)], 1u);
        const unsigned gen = old / nloc;
        if (old + 1u == (gen + 1u) * nloc) {
            __builtin_amdgcn_fence(__ATOMIC_RELEASE, "agent");
            asm volatile("s_waitcnt vmcnt(0)" ::: "memory");
            const unsigned og = xb_add(&bar[XB_TOP], 1u);
            const unsigned tg = og / nx;
            if (og + 1u == (tg + 1u) * nx) xb_add(&bar[XB_TOPGEN], 1u);
            else XB_SPIN(xb_ld(&bar[XB_TOPGEN]) == tg, bar);
            __builtin_amdgcn_fence(__ATOMIC_ACQUIRE, "agent");
            xb_add(&bar[XB_XGEN(b.x)], 1u);
            asm volatile("s_waitcnt vmcnt(0)" ::: "memory");
        } else {
            XB_SPIN(xb_ld(&bar[XB_XGEN(b.x)]) == gen, bar);
            __builtin_amdgcn_fence(__ATOMIC_ACQUIRE, "agent");
            asm volatile("s_waitcnt vmcnt(0)" ::: "memory");
        }
    }
    __syncthreads();
}

namespace pg8 {
constexpr int BM = 256, BK = 64, HALF = 128, HTB = HALF * BK * 2, STAGE_BYTES = 8 * HTB;
__host__ __device__ __forceinline__ int lds_byte(int r, int c) { const int st = (r >> 4) * 2 + (c >> 5), rr = r & 15, cc = c & 31, ob = rr * 64 + cc * 2; return st * 1024 + (ob ^ (((ob >> 9) & 1) << 5)); }
__host__ __device__ __forceinline__ void stage_rc(int b, int& R, int& C) { const int st = b / 1024, sb = b % 1024, swz = sb ^ (((sb >> 9) & 1) << 5); R = (st >> 1) * 16 + swz / 64; C = (st & 1) * 32 + (swz % 64) / 2; }
__host__ __device__ __forceinline__ int perm32(int rho) { const int n = rho >> 4, i = rho & 15; return 8 * (i >> 2) + 4 * n + (i & 3); }

struct Unit { int pm, pn, e, j; };
template <class Epi, class Sched, bool ALIGN_EPI>
__device__ __forceinline__ void gemm_phase(const int tid, LAS unsigned char* lds, const char* Abase, const int K, const Sched& S, const Epi& E) {
    const int wid = __builtin_amdgcn_readfirstlane(tid >> 6), lane = tid & 63, wr = wid >> 2, wc = wid & 3, fr = lane & 15, fq = lane >> 4;
    const int nt = K / BK;
    int R0, C0; stage_rc(tid * 16, R0, C0);
    const int Rb0 = (R0 & ~31) + perm32(R0 & 31);
    unsigned voffB[2]; voffB[0] = (unsigned)(Rb0 * K + C0) * 2u; voffB[1] = (unsigned)((Rb0 + 64) * K + C0) * 2u;
    unsigned voffA[2]; voffA[0] = (unsigned)(R0 * K + C0) * 2u; voffA[1] = (unsigned)((R0 + 64) * K + C0) * 2u;
    const unsigned colA = (unsigned)C0 * 2u;
    const size_t kstep = (size_t)(BK * 2);
    const size_t hstepB = (size_t)HALF * K * 2, hstepA = hstepB;
    const unsigned ldsw = (unsigned)wid * 1024u;
    const int aoff = lds_byte(wr * 64 + fr, fq * 8), boff = lds_byte(wc * 32 + fr, fq * 8);
#define PG8_SA(b, h) (((b) * 2 + (h)) * HTB)
#define PG8_SB(b, h) ((4 + (b) * 2 + (h)) * HTB)
#define PG8_STAGE_B(bufoff, gbase) do { _Pragma("unroll") for (int _i = 0; _i < 2; ++_i) \
        __builtin_amdgcn_global_load_lds((const unsigned*)((const char*)(gbase) + voffB[_i]), (LAS unsigned*)(lds + (bufoff) + ldsw + _i * 8192), 16, 0, 0); } while (0)
#define PG8_STAGE_A(bufoff, h, kbyte, nx) do { \
        if constexpr (Sched::GATHER) { _Pragma("unroll") for (int _i = 0; _i < 2; ++_i) { const unsigned _o = (nx) ? na[h][_i] : ca[h][_i]; \
            __builtin_amdgcn_global_load_lds((const unsigned*)(Abase + (kbyte) + _o), (LAS unsigned*)(lds + (bufoff) + ldsw + _i * 8192), 16, 0, 0); } } \
        else { const char* _p = ((nx) ? nA : cA) + (kbyte) + (size_t)(h) * hstepA; _Pragma("unroll") for (int _i = 0; _i < 2; ++_i) \
            __builtin_amdgcn_global_load_lds((const unsigned*)(_p + voffA[_i]), (LAS unsigned*)(lds + (bufoff) + ldsw + _i * 8192), 16, 0, 0); } } while (0)
#define PG8_LDA(dst, b, h) do { _Pragma("unroll") for (int m = 0; m < 4; ++m) _Pragma("unroll") for (int k = 0; k < 2; ++k) dst[m][k] = *(const LAS bf16x8*)(lds + PG8_SA(b, h) + aoff + m * 2048 + k * 1024); } while (0)
#define PG8_LDB(dst, b, h) do { _Pragma("unroll") for (int n = 0; n < 2; ++n) _Pragma("unroll") for (int k = 0; k < 2; ++k) dst[n][k] = *(const LAS bf16x8*)(lds + PG8_SB(b, h) + boff + n * 2048 + k * 1024); } while (0)
#define PG8_MMA(ai, bj, At, Bt) do { __builtin_amdgcn_s_setprio(1); _Pragma("unroll") for (int m = 0; m < 4; ++m) _Pragma("unroll") for (int n = 0; n < 2; ++n) _Pragma("unroll") for (int k = 0; k < 2; ++k) \
        acc[ai][bj][m][n] = __builtin_amdgcn_mfma_f32_16x16x32_bf16(Bt[n][k], At[m][k], acc[ai][bj][m][n], 0, 0, 0); __builtin_amdgcn_s_setprio(0); } while (0)
#define PG8_WAIT_V(n) asm volatile("s_waitcnt vmcnt(" #n ")" ::: "memory")
#define PG8_WAIT_L(n) asm volatile("s_waitcnt lgkmcnt(" #n ")" ::: "memory")
#define PG8_BAR __builtin_amdgcn_s_barrier()
#define PG8_SCHED __builtin_amdgcn_sched_barrier(0)
    Unit cur, nxt; int ui = 0;
    if (!S.next(0, cur)) return;
    unsigned ca[2][2], na[2][2];
    const char* cA = Abase; const char* nA = Abase;
    if constexpr (Sched::GATHER) S.aoffs(cur, R0, colA, ca); else cA = Abase + (size_t)S.arow0(cur) * K * 2;
    f32x4 acc[2][2][4][2];
#pragma unroll
    for (int a = 0; a < 2; ++a)
#pragma unroll
        for (int b = 0; b < 2; ++b)
#pragma unroll
            for (int m = 0; m < 4; ++m)
#pragma unroll
                for (int n = 0; n < 2; ++n) acc[a][b][m][n] = (f32x4){0.f, 0.f, 0.f, 0.f};
    bf16x8 At[4][2], B0[2][2], B1[2][2];
    const char* cB = S.bbase(cur);
    PG8_STAGE_B(PG8_SB(0, 0), cB); PG8_STAGE_B(PG8_SB(0, 1), cB + hstepB); PG8_STAGE_A(PG8_SA(0, 0), 0, 0, false); PG8_STAGE_A(PG8_SA(0, 1), 1, 0, false);
    if (wr == 1) PG8_BAR;
    PG8_WAIT_V(2); PG8_BAR;
    PG8_STAGE_B(PG8_SB(1, 0), cB + kstep); PG8_STAGE_A(PG8_SA(1, 0), 0, kstep, false); PG8_STAGE_B(PG8_SB(1, 1), cB + hstepB + kstep);
    PG8_WAIT_V(6); PG8_BAR;
    for (;;) {
        const bool has_next = S.next(ui + 1, nxt);
        const char* nB = cB;
        nA = cA;
        if (has_next) { nB = S.bbase(nxt); if constexpr (Sched::GATHER) S.aoffs(nxt, R0, colA, na); else nA = Abase + (size_t)S.arow0(nxt) * K * 2; }
        else if constexpr (Sched::GATHER) { na[0][0] = ca[0][0]; na[0][1] = ca[0][1]; na[1][0] = ca[1][0]; na[1][1] = ca[1][1]; }
        for (int t = 0; t < nt; t += 2) {
            const bool last = (t == nt - 2);
            const size_t k1 = (size_t)(t + 1) * kstep;
            const size_t k2 = last ? 0 : (size_t)(t + 2) * kstep, k3 = k2 + kstep;
            const char* b2 = last ? nB : cB + (size_t)(t + 2) * kstep; const char* b3 = b2 + kstep;
            PG8_LDB(B0, 0, 0); PG8_LDB(B1, 0, 1); PG8_SCHED; PG8_LDA(At, 0, 0); PG8_STAGE_A(PG8_SA(1, 1), 1, k1, false);
            PG8_WAIT_V(8); PG8_WAIT_L(0); PG8_BAR; PG8_MMA(0, 0, At, B0); PG8_MMA(0, 1, At, B1); PG8_BAR; PG8_SCHED;
            PG8_LDA(At, 0, 1); PG8_STAGE_B(PG8_SB(0, 0), b2); PG8_STAGE_B(PG8_SB(0, 1), b2 + hstepB); PG8_STAGE_A(PG8_SA(0, 0), 0, k2, last);
            PG8_WAIT_V(8); PG8_WAIT_L(0); PG8_BAR; PG8_MMA(1, 0, At, B0); PG8_MMA(1, 1, At, B1); PG8_BAR; PG8_SCHED;
            PG8_LDB(B0, 1, 0); PG8_LDB(B1, 1, 1); PG8_SCHED; PG8_LDA(At, 1, 0); PG8_STAGE_A(PG8_SA(0, 1), 1, k2, last);
            PG8_WAIT_V(8); PG8_WAIT_L(0); PG8_BAR; PG8_MMA(0, 0, At, B0); PG8_MMA(0, 1, At, B1); PG8_BAR; PG8_SCHED;
            PG8_LDA(At, 1, 1); PG8_STAGE_B(PG8_SB(1, 0), b3); PG8_STAGE_B(PG8_SB(1, 1), b3 + hstepB); PG8_STAGE_A(PG8_SA(1, 0), 0, k3, last);
            PG8_WAIT_V(8); PG8_WAIT_L(0); PG8_BAR; PG8_MMA(1, 0, At, B0); PG8_MMA(1, 1, At, B1); PG8_BAR; PG8_SCHED;
        }
        if constexpr (ALIGN_EPI) { if (wr == 0) PG8_BAR; }
        E(acc, cur, wr, wc, fr, fq);
        if (!has_next) break;
#pragma unroll
        for (int a = 0; a < 2; ++a)
#pragma unroll
            for (int b = 0; b < 2; ++b)
#pragma unroll
                for (int m = 0; m < 4; ++m)
#pragma unroll
                    for (int n = 0; n < 2; ++n) acc[a][b][m][n] = (f32x4){0.f, 0.f, 0.f, 0.f};
        cur = nxt; cB = nB; cA = nA; ++ui;
        if constexpr (Sched::GATHER) { ca[0][0] = na[0][0]; ca[0][1] = na[0][1]; ca[1][0] = na[1][0]; ca[1][1] = na[1][1]; }
        if constexpr (ALIGN_EPI) { if (wr == 1) PG8_BAR; }
    }
    PG8_WAIT_V(0);
    if constexpr (!ALIGN_EPI) { if (wr == 0) PG8_BAR; }
    PG8_BAR;
#undef PG8_SA
#undef PG8_SB
#undef PG8_STAGE_A
#undef PG8_STAGE_B
#undef PG8_LDA
#undef PG8_LDB
#undef PG8_MMA
#undef PG8_WAIT_V
#undef PG8_WAIT_L
#undef PG8_BAR
#undef PG8_SCHED
}

struct DenseOrder {
    static constexpr bool GATHER = false;
    int nM, nN, nwg, G, c, K; const char* Bt;
    __device__ __forceinline__ int arow0(const Unit& u) const { return u.pm * BM; }
    __device__ __forceinline__ void init(int M_, int N_, int K_, int G_, int c_, const void* Bt_) { nM = M_ / BM; nN = N_ / BM; nwg = nM * nN; G = G_; c = c_; K = K_; Bt = (const char*)Bt_; }
    __device__ __forceinline__ bool next(int i, Unit& u) const {
        const long L = (long)i * G + c; if (L >= nwg) return false;
        int wgid = (int)L; { const int q = nwg / 8, r = nwg % 8, xcd = wgid % 8, off = wgid / 8; wgid = (xcd < r ? xcd * (q + 1) : r * (q + 1) + (xcd - r) * q) + off; }
        const int nig = 8 * nN, gid = wgid / nig, fm = gid * 8, gsz = (nM - fm) < 8 ? (nM - fm) : 8;
        u.pm = fm + ((wgid % nig) % gsz); u.pn = (wgid % nig) / gsz; u.e = 0; u.j = 0; return true;
    }
    __device__ __forceinline__ void aoffs(const Unit& u, int R0, unsigned colA, unsigned (&o)[2][2]) const {
#pragma unroll
        for (int h = 0; h < 2; ++h)
#pragma unroll
            for (int i = 0; i < 2; ++i) o[h][i] = (unsigned)(u.pm * BM + h * HALF + R0 + 64 * i) * (unsigned)(K * 2) + colA;
    }
    __device__ __forceinline__ const char* bbase(const Unit& u) const { return Bt + (size_t)u.pn * BM * K * 2; }
};
template <bool GATHER_>
struct MoeOrder {
    static constexpr bool GATHER = GATHER_;
    __device__ __forceinline__ int arow0(const Unit& u) const { return u.pm * BM; }
    const LAS int* tab;
    int G, c, K, nN; const char* Bt; size_t estride;
    const int* list;
    __device__ __forceinline__ bool next(int i, Unit& u) const {
        const int L = i * G + c; const int nb = tab[16];
        if (L >= nb * nN) return false;
        const int rb = L / nN; u.pn = L % nN; u.pm = rb;
        int e = 0;
#pragma unroll
        for (int k = 1; k < 16; ++k) e += (rb >= tab[k]) ? 1 : 0;
        u.e = e; u.j = rb - tab[e]; return true;
    }
    __device__ __forceinline__ void aoffs(const Unit& u, int R0, unsigned colA, unsigned (&o)[2][2]) const {
        const int cnt = tab[32 + u.e];
#pragma unroll
        for (int h = 0; h < 2; ++h)
#pragma unroll
            for (int i = 0; i < 2; ++i) {
                const int r = h * HALF + R0 + 64 * i;
                const int pos = u.j * BM + r; const unsigned row = (pos < cnt) ? (unsigned)(list[(size_t)u.e * LCAP + pos] >> 1) : 0u;
                o[h][i] = row * (unsigned)(K * 2) + colA;
            }
    }
    __device__ __forceinline__ const char* bbase(const Unit& u) const { return Bt + (size_t)u.e * estride + (size_t)u.pn * BM * K * 2; }
};

__device__ __forceinline__ u32x4 pack8(const f32x4 v0, const f32x4 v1) { u32x4 w; w.x = pk2(v0[0], v0[1]); w.y = pk2(v0[2], v0[3]); w.z = pk2(v1[0], v1[1]); w.w = pk2(v1[2], v1[3]); return w; }
struct EpiIn {
    bf16* O;
    __device__ __forceinline__ void operator()(const f32x4 (&acc)[2][2][4][2], const Unit& u, int wr, int wc, int fr, int fq) const {
        const int row0 = u.pm * BM + wr * 64 + fr, col0 = u.pn * BM + wc * 32 + 8 * fq;
#pragma unroll
        for (int ai = 0; ai < 2; ++ai)
#pragma unroll
            for (int m = 0; m < 4; ++m) { bf16* rowp = O + (size_t)(row0 + ai * HALF + m * 16) * INC + col0;
#pragma unroll
                for (int bj = 0; bj < 2; ++bj) { const int c = col0 + bj * HALF; const float sc = (c >= PC_SQ && c < PC_SK) ? C2 : 1.0f;
                    *(u32x4*)(rowp + bj * HALF) = pack8(acc[ai][bj][m][0] * sc, acc[ai][bj][m][1] * sc); } }
    }
};
struct EpiOut {
    const bf16* X; bf16* O;
    __device__ __forceinline__ void operator()(const f32x4 (&acc)[2][2][4][2], const Unit& u, int wr, int wc, int fr, int fq) const {
        const int row0 = u.pm * BM + wr * 64 + fr, col0 = u.pn * BM + wc * 32 + 8 * fq;
#pragma unroll
        for (int ai = 0; ai < 2; ++ai)
#pragma unroll
            for (int m = 0; m < 4; ++m) { const size_t off = (size_t)(row0 + ai * HALF + m * 16) * D + col0;
#pragma unroll
                for (int bj = 0; bj < 2; ++bj) { const u32x4 xv = *(const u32x4*)(X + off + bj * HALF);
                    f32x4 v0 = acc[ai][bj][m][0], v1 = acc[ai][bj][m][1];
                    v0[0] += ALPHA * lo16(xv.x); v0[1] += ALPHA * hi16(xv.x); v0[2] += ALPHA * lo16(xv.y); v0[3] += ALPHA * hi16(xv.y);
                    v1[0] += ALPHA * lo16(xv.z); v1[1] += ALPHA * hi16(xv.z); v1[2] += ALPHA * lo16(xv.w); v1[3] += ALPHA * hi16(xv.w);
                    *(u32x4*)(O + off + bj * HALF) = pack8(v0, v1); } }
    }
};
struct EpiMoe1 {
    bf16* Hb;
    __device__ __forceinline__ void operator()(const f32x4 (&acc)[2][2][4][2], const Unit& u, int wr, int wc, int fr, int fq) const {
        const int row0 = u.pm * BM + wr * 64 + fr, col0 = u.pn * HALF + wc * 32 + 8 * fq;
#pragma unroll
        for (int ai = 0; ai < 2; ++ai)
#pragma unroll
            for (int m = 0; m < 4; ++m) {
                f32x4 g0 = acc[ai][0][m][0], g1 = acc[ai][0][m][1]; const f32x4 u0 = acc[ai][1][m][0], u1 = acc[ai][1][m][1];
#pragma unroll
                for (int q = 0; q < 4; ++q) { g0[q] = g0[q] * sigmoidf_(g0[q]) * u0[q]; g1[q] = g1[q] * sigmoidf_(g1[q]) * u1[q]; }
                *(u32x4*)(Hb + (size_t)(row0 + ai * HALF + m * 16) * DE + col0) = pack8(g0, g1); }
    }
};
struct EpiMoe2 {
    bf16* Y;
    __device__ __forceinline__ void operator()(const f32x4 (&acc)[2][2][4][2], const Unit& u, int wr, int wc, int fr, int fq) const {
        const int row0 = u.pm * BM + wr * 64 + fr, col0 = u.pn * BM + wc * 32 + 8 * fq;
#pragma unroll
        for (int ai = 0; ai < 2; ++ai)
#pragma unroll
            for (int m = 0; m < 4; ++m) { bf16* rowp = Y + (size_t)(row0 + ai * HALF + m * 16) * D + col0;
#pragma unroll
                for (int bj = 0; bj < 2; ++bj) *(u32x4*)(rowp + bj * HALF) = pack8(acc[ai][bj][m][0], acc[ai][bj][m][1]); }
    }
};
}

struct Args {
    const float* in[32]; float* out; unsigned char* ws;
    int l_lo, l_hi, ph_lo, ph_hi;
    int use_bar, pad;
};
enum { I_X = 0, I_WIN, I_MU, I_W0, I_WUP, I_A0, I_AUP, I_GUP, I_KK, I_KA, I_RK, I_LNG, I_LNB, I_CW, I_CB, I_WA, I_BA, I_WX, I_BX, I_LAM, I_LRUG, I_SBAG,
       I_WOUT, I_LN1G, I_LN1B, I_LN2G, I_LN2B, I_RW, I_RB, I_EG, I_EU, I_ED };
constexpr int NPH = 10;

__device__ __forceinline__ void transpose_item(const float* W, int N, bf16* WT, int pitch, int drow0, int k0, int n0, float* scr, int lane) {
#pragma unroll 8
    for (int i = 0; i < 32; ++i) { const int kk = 2 * i + (lane >> 5); scr[kk * 33 + (lane & 31)] = W[(size_t)(k0 + kk) * N + n0 + (lane & 31)]; }
    asm volatile("s_waitcnt lgkmcnt(0)" ::: "memory");
    const int c = lane & 7;
#pragma unroll
    for (int j = 0; j < 4; ++j) { const int n = (lane >> 3) + 8 * j; const float* s = scr + (8 * c) * 33 + n;
        u32x4 o; o.x = pk2(s[0 * 33], s[1 * 33]); o.y = pk2(s[2 * 33], s[3 * 33]); o.z = pk2(s[4 * 33], s[5 * 33]); o.w = pk2(s[6 * 33], s[7 * 33]);
        *(u32x4*)(WT + (size_t)(drow0 + n) * pitch + k0 + 8 * c) = o; }
    asm volatile("s_waitcnt lgkmcnt(0)" ::: "memory");
}
__device__ __forceinline__ void phase_convert(const int tid, const Args& A, int layer, float* ldsf, int vcu, int G) {
    const int lane = tid & 63, wave = tid >> 6;
    float* scr = ldsf + wave * 4096;
    unsigned char* ws = A.ws;
    bf16* Win = (bf16*)(ws + WS_WIN); bf16* Wout = (bf16*)(ws + WS_WOUT); bf16* Wgu = (bf16*)(ws + WS_WGU); bf16* Wdn = (bf16*)(ws + WS_WDN);
    bf16* WupT = (bf16*)(ws + WS_WSM); bf16* AupT = WupT + 384 * 64; bf16* GupT = AupT + 384 * 64;
    const int gw = vcu * NWAVES + wave, NGW = G * NWAVES;
    constexpr int I_IN = 16 * 96, I_OUT = 16 * 32, I_G = 16 * 256, I_U = 16 * 256, I_D = 16 * 256, I_S1 = 12, I_S2 = 12, I_S3 = 24, I_S4 = 16;
    constexpr int NIT = I_IN + I_OUT + I_G + I_U + I_D + I_S1 + I_S2 + I_S3 + I_S4;
    for (int it = gw; it < NIT; it += NGW) {
        int r = it;
        if (r < I_IN) { const int kb = r / 96, nb = r % 96; transpose_item(A.in[I_WIN] + (size_t)layer * D * INC, INC, Win, D, 32 * nb, 64 * kb, 32 * nb, scr, lane); continue; } r -= I_IN;
        if (r < I_OUT) { const int kb = r / 32, nb = r % 32; transpose_item(A.in[I_WOUT] + (size_t)layer * D * D, D, Wout, D, 32 * nb, 64 * kb, 32 * nb, scr, lane); continue; } r -= I_OUT;
        if (r < I_G + I_U) { const int up = r >= I_G; if (up) r -= I_G; const int e = r / 256, q = r % 256, kb = q / 16, nb = q % 16, n0 = 32 * nb;
            const float* src = A.in[up ? I_EU : I_EG] + ((size_t)layer * NE + e) * D * DE;
            transpose_item(src, DE, Wgu, D, e * 1024 + (n0 >> 7) * 256 + up * 128 + (n0 & 127), 64 * kb, n0, scr, lane); continue; } r -= I_G + I_U;
        if (r < I_D) { const int e = r / 256, q = r % 256, kb = q / 32, nb = q % 32;
            transpose_item(A.in[I_ED] + ((size_t)layer * NE + e) * DE * D, D, Wdn, DE, e * 1024 + 32 * nb, 64 * kb, 32 * nb, scr, lane); continue; } r -= I_D;
        if (r < I_S1) { transpose_item(A.in[I_WUP] + (size_t)layer * 64 * RW, RW, WupT, 64, 32 * r, 0, 32 * r, scr, lane); continue; } r -= I_S1;
        if (r < I_S2) { transpose_item(A.in[I_AUP] + (size_t)layer * 64 * RW, RW, AupT, 64, 32 * r, 0, 32 * r, scr, lane); continue; } r -= I_S2;
        if (r < I_S3) { const int kb = r / 12, nb = r % 12; transpose_item(A.in[I_GUP] + (size_t)layer * 128 * RW, RW, GupT, 128, 32 * nb, 64 * kb, 32 * nb, scr, lane); continue; } r -= I_S3;
        { const int x = r >> 3, gq = (r >> 1) & 3, nb = r & 1;
          transpose_item(A.in[x ? I_WX : I_WA] + ((size_t)layer * LB + gq) * 4096, 64, GupT + 384 * 128 + x * 16384, 64, gq * 64 + 32 * nb, 0, 32 * nb, scr, lane); }
    }
    if (layer == 0) {
        const f32x4* x4 = (const f32x4*)A.in[I_X]; u32x4* o = (u32x4*)(ws + WS_XB);
        const size_t n8 = (size_t)M * D / 8;
        for (size_t i = (size_t)vcu * NTHR + tid; i < n8; i += (size_t)G * NTHR) { const f32x4 a = x4[2 * i], b = x4[2 * i + 1]; o[i] = pg8::pack8(a, b); }
    }
}

typedef short v4i16_t __attribute__((ext_vector_type(4)));
template <bool MASK>
__device__ __forceinline__ void attn_tile(const bf16* Ks, const bf16* Vs, const bf16x8 (&qr)[4], f32x16& o0, f32x16& o1, float& Rrun, const int k0, const int qmine, const int r, const int hh, const int vtr_off) {
    f32x16 p0 = {}, p1 = {};
#pragma unroll
    for (int s = 0; s < 4; ++s) {
        const bf16x8 ka = *(const bf16x8*)(Ks + r * 72 + 16 * s + 8 * hh);
        const bf16x8 kb = *(const bf16x8*)(Ks + (32 + r) * 72 + 16 * s + 8 * hh);
        p0 = __builtin_amdgcn_mfma_f32_32x32x16_bf16(ka, qr[s], p0, 0, 0, 0);
        p1 = __builtin_amdgcn_mfma_f32_32x32x16_bf16(kb, qr[s], p1, 0, 0, 0);
    }
    float pa[8]; f32x2 va[8], vb[8];
#pragma unroll
    for (int g = 0; g < 8; ++g) {
        float z[4];
#pragma unroll
        for (int i = 0; i < 4; ++i) z[i] = (g < 4) ? p0[4 * g + i] : p1[4 * (g - 4) + i];
        const f32x2 eA = {__builtin_amdgcn_exp2f(z[0]), __builtin_amdgcn_exp2f(z[1])}, eB = {__builtin_amdgcn_exp2f(z[2]), __builtin_amdgcn_exp2f(z[3])};
        const f32x2 dA = eA + 1.0f, dB = eB + 1.0f;
        f32x2 kA = {__builtin_amdgcn_rcpf(dA[0]), __builtin_amdgcn_rcpf(dA[1])}, kB = {__builtin_amdgcn_rcpf(dB[0]), __builtin_amdgcn_rcpf(dB[1])};
        if (MASK) { const int key = k0 + 32 * (g >> 2) + 8 * (g & 3) + 4 * hh;
            kA[0] = (key + 0 >= qmine) ? 1.0f : kA[0]; kA[1] = (key + 1 >= qmine) ? 1.0f : kA[1]; kB[0] = (key + 2 >= qmine) ? 1.0f : kB[0]; kB[1] = (key + 3 >= qmine) ? 1.0f : kB[1]; }
        const f32x2 sA = 1.0f - kA, sB = 1.0f - kB;
        const float x1 = kB[1] * kB[0], x0 = x1 * kA[1];
        pa[g] = x0 * kA[0];
        va[g] = sA * (f32x2){x0, x1}; vb[g] = sB * (f32x2){kB[1], 1.0f};
    }
    float pi[16];
#pragma unroll
    for (int g = 0; g < 8; ++g) { const auto rr = __builtin_amdgcn_permlane32_swap(__float_as_uint(pa[g]), __float_as_uint(pa[g]), false, false);
        pi[2 * g] = __uint_as_float(rr[0]); pi[2 * g + 1] = __uint_as_float(rr[1]); }
    float S[16];
    S[15] = Rrun;
#pragma unroll
    for (int j = 14; j >= 0; --j) S[j] = S[j + 1] * pi[j + 1];
    Rrun = S[0] * pi[0];
#pragma unroll
    for (int g = 0; g < 8; ++g) {
        const float re = hh ? S[2 * g + 1] : S[2 * g];
        va[g] = va[g] * re; vb[g] = vb[g] * re;
    }
#pragma unroll
    for (int s = 0; s < 4; ++s) {
        u32x4 pw;
        pw.x = pk2(va[2 * s][0], va[2 * s][1]); pw.y = pk2(vb[2 * s][0], vb[2 * s][1]); pw.z = pk2(va[2 * s + 1][0], va[2 * s + 1][1]); pw.w = pk2(vb[2 * s + 1][0], vb[2 * s + 1][1]);
        const bf16x8 pf = __builtin_bit_cast(bf16x8, pw);
        const bf16* vbp = Vs + 16 * s * 72 + vtr_off;
        { const v4i16_t lo = __builtin_amdgcn_ds_read_tr16_b64_v4i16((LAS v4i16_t*)(vbp)), hi = __builtin_amdgcn_ds_read_tr16_b64_v4i16((LAS v4i16_t*)(vbp + 8 * 72));
          const bf16x8 vf = __builtin_shufflevector(lo, hi, 0, 1, 2, 3, 4, 5, 6, 7);
          o0 = __builtin_amdgcn_mfma_f32_32x32x16_bf16(vf, pf, o0, 0, 0, 0); }
        { const v4i16_t lo = __builtin_amdgcn_ds_read_tr16_b64_v4i16((LAS v4i16_t*)(vbp + 32)), hi = __builtin_amdgcn_ds_read_tr16_b64_v4i16((LAS v4i16_t*)(vbp + 8 * 72 + 32));
          const bf16x8 vf = __builtin_shufflevector(lo, hi, 0, 1, 2, 3, 4, 5, 6, 7);
          o1 = __builtin_amdgcn_mfma_f32_32x32x16_bf16(vf, pf, o1, 0, 0, 0); }
    }
}
__device__ __forceinline__ void attn_unit(const int tid_in, const Args& A, int layer, int bh, int qb, unsigned char* lds) {
    int tid = tid_in; asm volatile("" : "+v"(tid));
    const int lane = tid & 63, wave = __builtin_amdgcn_readfirstlane(tid >> 6), r = lane & 31, hh = lane >> 5;
    const int b = bh / SH, h = bh % SH;
    const bf16* P = (const bf16*)(A.ws + WS_P) + (size_t)b * SEQ * INC;
    bf16* MIX = (bf16*)(A.ws + WS_MIX) + (size_t)b * SEQ * D;
    bf16* KV = (bf16*)lds;
    constexpr int SLOT = 2 * 64 * 72;
    const int q0w = qb * 256 + wave * 32;
    bf16x8 qr[4];
#pragma unroll
    for (int s = 0; s < 4; ++s) qr[s] = *(const bf16x8*)(P + (size_t)(q0w + r) * INC + PC_SQ + h * 64 + 16 * s + 8 * hh);
    f32x16 o0 = {}, o1 = {};
    float Rrun = 1.0f;
    const int qmine = q0w + r;
    const int lkey = tid >> 3, lch = (tid & 7) * 8;
    const int NT = 4 * qb + 4;
    const int g16 = lane >> 4, i16 = lane & 15;
    const int vtr_off = (4 * (g16 >> 1) + (i16 >> 2)) * 72 + 16 * (g16 & 1) + 4 * (i16 & 3);
    u32x4 kreg, vreg;
    { const int jt0 = NT - 1;
      kreg = *(const u32x4*)(P + (size_t)(64 * jt0 + lkey) * INC + PC_SK + h * 64 + lch);
      vreg = *(const u32x4*)(P + (size_t)(64 * jt0 + lkey) * INC + PC_SV + h * 64 + lch); }
    __syncthreads();
    { bf16* s0 = KV + ((NT - 1) & 1) * SLOT; *(u32x4*)(s0 + lkey * 72 + lch) = kreg; *(u32x4*)(s0 + 64 * 72 + lkey * 72 + lch) = vreg; }
    if (NT >= 2) { const int jt1 = NT - 2;
      kreg = *(const u32x4*)(P + (size_t)(64 * jt1 + lkey) * INC + PC_SK + h * 64 + lch);
      vreg = *(const u32x4*)(P + (size_t)(64 * jt1 + lkey) * INC + PC_SV + h * 64 + lch); }
    asm volatile("s_waitcnt lgkmcnt(0)\n\ts_barrier" ::: "memory");
    for (int jt = NT - 1; jt >= 0; --jt) {
        const bf16* Ks = KV + (jt & 1) * SLOT; const bf16* Vs = Ks + 64 * 72;
        if (jt >= 1) {
            bf16* sn = KV + ((jt - 1) & 1) * SLOT;
            *(u32x4*)(sn + lkey * 72 + lch) = kreg; *(u32x4*)(sn + 64 * 72 + lkey * 72 + lch) = vreg;
            if (jt >= 2) {
                kreg = *(const u32x4*)(P + (size_t)(64 * (jt - 2) + lkey) * INC + PC_SK + h * 64 + lch);
                vreg = *(const u32x4*)(P + (size_t)(64 * (jt - 2) + lkey) * INC + PC_SV + h * 64 + lch);
            }
        }
        const int k0 = 64 * jt;
        if (k0 < q0w + 31) {
            if (k0 + 63 >= q0w) attn_tile<true>(Ks, Vs, qr, o0, o1, Rrun, k0, qmine, r, hh, vtr_off);
            else attn_tile<false>(Ks, Vs, qr, o0, o1, Rrun, k0, qmine, r, hh, vtr_off);
        }
        int* dflag = (int*)(KV + 2 * SLOT) + (jt & 1) * 8;
        { const bool mydone = __all(Rrun == 0.0f); if (lane == 0) dflag[wave] = mydone ? 1 : 0; }
        asm volatile("s_waitcnt lgkmcnt(0)\n\ts_barrier" ::: "memory");
        { const u32x4 f0 = *(const u32x4*)dflag, f1 = *(const u32x4*)(dflag + 4);
          if ((f0.x & f0.y & f0.z & f0.w & f1.x & f1.y & f1.z & f1.w) != 0u) break; }
    }
    float ss = 0.f;
#pragma unroll
    for (int i = 0; i < 16; ++i) ss += o0[i] * o0[i] + o1[i] * o1[i];
    ss += __shfl_xor(ss, 32);
    const float sc = rsqrtf(ss * (1.0f / 64.0f) + RMS_EPS);
    const float* ng = A.in[I_SBAG] + layer * SW + h * 64;
    bf16* orow = MIX + (size_t)(q0w + r) * D + MIX_S + h * 64;
#pragma unroll
    for (int g = 0; g < 4; ++g) {
        const int d = 8 * g + 4 * hh;
        const f32x4 g0 = *(const f32x4*)(ng + d), g1 = *(const f32x4*)(ng + 32 + d);
        u32x2 w0, w1;
        w0.x = pk2(o0[4 * g] * sc * g0[0], o0[4 * g + 1] * sc * g0[1]); w0.y = pk2(o0[4 * g + 2] * sc * g0[2], o0[4 * g + 3] * sc * g0[3]);
        w1.x = pk2(o1[4 * g] * sc * g1[0], o1[4 * g + 1] * sc * g1[1]); w1.y = pk2(o1[4 * g + 2] * sc * g1[2], o1[4 * g + 3] * sc * g1[3]);
        *(u32x2*)(orow + d) = w0; *(u32x2*)(orow + 32 + d) = w1;
    }
}

constexpr int CP = 72;
constexpr size_t SC_MP = 0, SC_NN = 48 * MiB, SC_QH = 96 * MiB, SC_OL = 144 * MiB;
constexpr size_t WS_G = 836 * MiB, WS_RHO = 884 * MiB, WS_GC = 886 * MiB;
__device__ __forceinline__ f32x16 mm32(const bf16* X, const bf16* Y, int lane, f32x16 acc) {
    const int r = lane & 31, hh = lane >> 5;
#pragma unroll
    for (int s_ = 0; s_ < 4; ++s_) {
        const bf16x8 a = *(const bf16x8*)(X + r * CP + 16 * s_ + 8 * hh);
        const bf16x8 b = *(const bf16x8*)(Y + r * CP + 16 * s_ + 8 * hh);
        acc = __builtin_amdgcn_mfma_f32_32x32x16_bf16(a, b, acc, 0, 0, 0);
    }
    return acc;
}
__device__ __forceinline__ u32x4 packfrag(const f32x16& a, int sp) {
    u32x4 w;
    if (sp == 0) { w.x = pk2(a[0], a[1]); w.y = pk2(a[2], a[3]); w.z = pk2(a[4], a[5]); w.w = pk2(a[6], a[7]); }
    else { w.x = pk2(a[8], a[9]); w.y = pk2(a[10], a[11]); w.z = pk2(a[12], a[13]); w.w = pk2(a[14], a[15]); }
    return w;
}
struct R1Pre { u32x4 cu[4], pv[4]; };
__device__ __forceinline__ void rwkv_r1_prefetch(const int tid, const Args& A, int b, int c, R1Pre& pf) {
    const int t0 = c * 64;
    const bf16* P = (const bf16*)(A.ws + WS_P) + (size_t)b * SEQ * INC;
#pragma unroll
    for (int q = 0; q < 4; ++q) {
        const int item = tid + NTHR * q, tok = item >> 5, cc = (item & 31) * 8, pc = PC_DW + cc, t = t0 + tok;
        pf.cu[q] = *(const u32x4*)(P + (size_t)t * INC + pc);
        pf.pv[q] = (u32x4){0u, 0u, 0u, 0u};
        if (t > 0) pf.pv[q] = *(const u32x4*)(P + (size_t)(t - 1) * INC + pc);
    }
}
__device__ __forceinline__ void rwkv_r1_unit(const int tid_in, const Args& A, int layer, int uidx, unsigned char* lds, R1Pre& pf, const bool first, const int stop = 99) {
    int tid = tid_in; asm volatile("" : "+v"(tid));
    const int lane = tid & 63, wave = __builtin_amdgcn_readfirstlane(tid >> 6), r31 = lane & 31, hh = lane >> 5;
    const int head = uidx >> 6, c = uidx & 63, b = head / RH, h = head % RH, t0 = c * 64;
    const size_t brow = (size_t)b * SEQ;
    const bf16* P = (const bf16*)(A.ws + WS_P) + brow * INC;
    float* wS = (float*)lds; float* aS = wS + 4096; float* gS = aS + 4096;
    bf16* AAB = (bf16*)lds; bf16* AAK = AAB + 64 * CP; bf16* ARB = AAK + 64 * CP; bf16* ARK = ARB + 64 * CP;
    bf16* TM = ARK + 64 * CP; bf16* TMt = TM + 64 * CP; bf16* X1t = TMt + 64 * CP;
    unsigned char* ob = lds + 7 * 64 * CP * 2;
    bf16* AL = (bf16*)ob;
    bf16* AH = (bf16*)ob; bf16* QT = AH + 64 * CP; bf16* BH = QT + 64 * CP; bf16* KH = BH + 64 * CP;
    bf16* BHt = KH + 64 * CP; bf16* KHt = BHt + 64 * CP; bf16* Vt = KHt + 64 * CP; bf16* AHt = Vt + 64 * CP;
    bf16* WTt = KH; bf16* UTt = AH;
    float* segT = (float*)(ob + 8 * 64 * CP * 2);
    float* gCs = segT + 512;
    bf16* PTs = (bf16*)(gCs + 64);
    const float* mu = A.in[I_MU] + layer * RCOLS;
    const int c4 = (tid & 15) * 4, tkA = tid >> 4, ch = h * 64 + c4;
    u32x2 g_cr[2], g_ck[2], g_cv[2], g_pr[2], g_pk[2], g_pv[2];
#pragma unroll
    for (int q = 0; q < 2; ++q) {
        const int t = t0 + 2 * tkA + q; const bf16* pr = P + (size_t)t * INC;
        g_cr[q] = *(const u32x2*)(pr + PC_R + ch); g_ck[q] = *(const u32x2*)(pr + PC_K + ch); g_cv[q] = *(const u32x2*)(pr + PC_V + ch);
        g_pr[q] = (u32x2){0u, 0u}; g_pk[q] = (u32x2){0u, 0u}; g_pv[q] = (u32x2){0u, 0u};
        if (t > 0) { g_pr[q] = *(const u32x2*)(pr - INC + PC_R + ch); g_pk[q] = *(const u32x2*)(pr - INC + PC_K + ch); g_pv[q] = *(const u32x2*)(pr - INC + PC_V + ch); }
    }
    bf16x8 fw[2], fa[2], fg[4];
    {   const bf16* WupT = (const bf16*)(A.ws + WS_WSM); const bf16* AupT = WupT + 384 * 64; const bf16* GupT = AupT + 384 * 64;
        const int rowj = h * 64 + 16 * (wave & 3) + (lane & 15), kq8 = 8 * (lane >> 4);
#pragma unroll
        for (int ks = 0; ks < 2; ++ks) { fw[ks] = *(const bf16x8*)(WupT + (size_t)rowj * 64 + 32 * ks + kq8); fa[ks] = *(const bf16x8*)(AupT + (size_t)rowj * 64 + 32 * ks + kq8); }
#pragma unroll
        for (int ks = 0; ks < 4; ++ks) fg[ks] = *(const bf16x8*)(GupT + (size_t)rowj * 128 + 32 * ks + kq8);
    }
#pragma unroll
    for (int q = 0; q < 4; ++q) {
        const int item = tid + NTHR * q, tok = item >> 5, cc = (item & 31) * 8, pc = PC_DW + cc;
        if (first) {
            const u32x4 cu = pf.cu[q], pv = pf.pv[q];
            const f32x4 m0 = *(const f32x4*)(mu + pc), m1 = *(const f32x4*)(mu + pc + 4);
            float v[8];
            { float c_, p_;
              c_ = lo16(cu.x); p_ = lo16(pv.x); v[0] = c_ + m0[0] * (p_ - c_); c_ = hi16(cu.x); p_ = hi16(pv.x); v[1] = c_ + m0[1] * (p_ - c_);
              c_ = lo16(cu.y); p_ = lo16(pv.y); v[2] = c_ + m0[2] * (p_ - c_); c_ = hi16(cu.y); p_ = hi16(pv.y); v[3] = c_ + m0[3] * (p_ - c_);
              c_ = lo16(cu.z); p_ = lo16(pv.z); v[4] = c_ + m1[0] * (p_ - c_); c_ = hi16(cu.z); p_ = hi16(pv.z); v[5] = c_ + m1[1] * (p_ - c_);
              c_ = lo16(cu.w); p_ = lo16(pv.w); v[6] = c_ + m1[2] * (p_ - c_); c_ = hi16(cu.w); p_ = hi16(pv.w); v[7] = c_ + m1[3] * (p_ - c_); }
            if (cc < 64) {
#pragma unroll
                for (int i = 0; i < 8; ++i) { const float e2 = __expf(2.0f * v[i]); v[i] = 1.0f - 2.0f * __builtin_amdgcn_rcpf(e2 + 1.0f); }
            } else if (cc >= 128) {
#pragma unroll
                for (int i = 0; i < 8; ++i) v[i] = sigmoidf_(v[i]);
            }
            u32x4 w; w.x = pk2(v[0], v[1]); w.y = pk2(v[2], v[3]); w.z = pk2(v[4], v[5]); w.w = pk2(v[6], v[7]);
            pf.cu[q] = w;
        }
        *(u32x4*)(AL + tok * 264 + cc) = pf.cu[q];
    }
    __syncthreads();
    if (stop <= 1) return;
    {
        const int jt = wave & 3, kq8 = 8 * (lane >> 4);
#pragma unroll
        for (int q = 0; q < 2; ++q) {
            const int tt = 2 * (wave >> 2) + q;
            const bf16* bl = AL + (16 * tt + (lane & 15)) * 264 + kq8;
            f32x4 accw = {0.f, 0.f, 0.f, 0.f}, acca = accw, accg = accw;
#pragma unroll
            for (int ks = 0; ks < 2; ++ks) { accw = __builtin_amdgcn_mfma_f32_16x16x32_bf16(fw[ks], *(const bf16x8*)(bl + 32 * ks), accw, 0, 0, 0);
                                            acca = __builtin_amdgcn_mfma_f32_16x16x32_bf16(fa[ks], *(const bf16x8*)(bl + 64 + 32 * ks), acca, 0, 0, 0); }
#pragma unroll
            for (int ks = 0; ks < 4; ++ks) accg = __builtin_amdgcn_mfma_f32_16x16x32_bf16(fg[ks], *(const bf16x8*)(bl + 128 + 32 * ks), accg, 0, 0, 0);
            const int o_ = (16 * tt + (lane & 15)) * 64 + 16 * jt + 4 * (lane >> 4);
            *(f32x4*)(wS + o_) = accw; *(f32x4*)(aS + o_) = acca; *(f32x4*)(gS + o_) = accg;
        }
    }
    __syncthreads();
    if (stop <= 2) return;
    f32x4 rs[2], kts[2], kkn[2], avs[2], lws[2], vvs[2];
    {
        const f32x4 w0v = *(const f32x4*)(A.in[I_W0] + layer * RW + ch), a0v = *(const f32x4*)(A.in[I_A0] + layer * RW + ch);
        const f32x4 kkv = *(const f32x4*)(A.in[I_KK] + layer * RW + ch), kav = *(const f32x4*)(A.in[I_KA] + layer * RW + ch), rkv = *(const f32x4*)(A.in[I_RK] + layer * RW + ch);
        const f32x4 mur = *(const f32x4*)(mu + PC_R + ch), muk = *(const f32x4*)(mu + PC_K + ch), muv = *(const f32x4*)(mu + PC_V + ch);
        bf16* Gs = (bf16*)(A.ws + WS_G); float* RHOs = (float*)(A.ws + WS_RHO);
#pragma unroll
        for (int q = 0; q < 2; ++q) {
            const int tok = 2 * tkA + q, t = t0 + tok;
            const u32x2 cr = g_cr[q], ck = g_ck[q], cv = g_cv[q], qr_ = g_pr[q], qk_ = g_pk[q], qv_ = g_pv[q];
            f32x4 rc = {lo16(cr.x), hi16(cr.x), lo16(cr.y), hi16(cr.y)}, rp_ = {lo16(qr_.x), hi16(qr_.x), lo16(qr_.y), hi16(qr_.y)};
            f32x4 kc = {lo16(ck.x), hi16(ck.x), lo16(ck.y), hi16(ck.y)}, kp_ = {lo16(qk_.x), hi16(qk_.x), lo16(qk_.y), hi16(qk_.y)};
            f32x4 vc = {lo16(cv.x), hi16(cv.x), lo16(cv.y), hi16(cv.y)}, vp_ = {lo16(qv_.x), hi16(qv_.x), lo16(qv_.y), hi16(qv_.y)};
            const f32x4 rv = rc + mur * (rp_ - rc), kv = kc + muk * (kp_ - kc), vv = vc + muv * (vp_ - vc);
            const f32x4 wp = *(const f32x4*)(wS + tok * 64 + c4), ap = *(const f32x4*)(aS + tok * 64 + c4), gp = *(const f32x4*)(gS + tok * 64 + c4);
            f32x4 lw, av, kkx, kt; float n2 = 0.f, rpv = 0.f;
#pragma unroll
            for (int i = 0; i < 4; ++i) {
                const float x = w0v[i] + wp[i];
                lw[i] = -(__builtin_amdgcn_rcpf(1.0f + __expf(-x)) * 0.6065306597126334f);
                av[i] = sigmoidf_(a0v[i] + ap[i]);
                kkx[i] = kv[i] * kkv[i]; n2 += kkx[i] * kkx[i];
                kt[i] = kv[i] * (1.0f + (av[i] - 1.0f) * kav[i]);
                rpv += rv[i] * kt[i] * rkv[i];
            }
            n2 = red16(n2); rpv = red16(rpv);
            const float inv = (n2 > 1e-24f) ? __builtin_amdgcn_rsqf(n2) : 1e12f;
            rs[q] = rv; kts[q] = kt; kkn[q] = kkx * inv; avs[q] = av; lws[q] = lw; vvs[q] = vv;
            *(f32x4*)(wS + tok * 64 + c4) = lw;
            u32x2 gw; gw.x = pk2(gp[0], gp[1]); gw.y = pk2(gp[2], gp[3]);
            *(u32x2*)(Gs + (brow + t) * RW + ch) = gw;
            if ((tid & 15) == 0) RHOs[(brow + t) * RH + h] = rpv;
        }
#pragma unroll
        for (int i = 0; i < 4; ++i) *(unsigned*)(Vt + (c4 + i) * CP + 2 * tkA) = pk2(vvs[0][i], vvs[1][i]);
    }
    __syncthreads();
    if (stop <= 3) return;
    { const int k = tid & 63, seg = tid >> 6; float run = 0.f;
#pragma unroll
      for (int i = 0; i < 8; ++i) { float* p = wS + (8 * seg + i) * 64 + k; run += *p; *p = run; }
      segT[seg * 64 + k] = run; }
    __syncthreads();
    if (stop <= 4) return;
    f32x4 bhs[2], khs[2], ahs[2];
    { u32x4* z = (u32x4*)TM; const u32x4 zz = {0u, 0u, 0u, 0u};
      for (int i = tid; i < 2 * 64 * CP * 2 / 16; i += NTHR) z[i] = zz;
      if (tid < 3 * 16 * 40 * 2 / 16) ((u32x4*)PTs)[tid] = zz; }
#pragma unroll
    for (int q = 0; q < 2; ++q) {
        const int tok = 2 * tkA + q, seg = tok >> 3;
        f32x4 L = *(const f32x4*)(wS + tok * 64 + c4);
        for (int s_ = 0; s_ < seg; ++s_) L = L + *(const f32x4*)(segT + s_ * 64 + c4);
        f32x4 eL, eNL, eLp;
#pragma unroll
        for (int i = 0; i < 4; ++i) { eL[i] = __expf(L[i]); eNL[i] = __expf(-L[i]); eLp[i] = __expf(L[i] - lws[q][i]); }
        const f32x4 qt = rs[q] * eL, kh = kts[q] * eNL, ah = -(kkn[q] * eLp), bh = kkn[q] * avs[q] * eNL;
        u32x2 w;
        w.x = pk2(ah[0], ah[1]); w.y = pk2(ah[2], ah[3]); *(u32x2*)(AH + tok * CP + c4) = w;
        w.x = pk2(qt[0], qt[1]); w.y = pk2(qt[2], qt[3]); *(u32x2*)(QT + tok * CP + c4) = w;
        w.x = pk2(bh[0], bh[1]); w.y = pk2(bh[2], bh[3]); *(u32x2*)(BH + tok * CP + c4) = w;
        w.x = pk2(kh[0], kh[1]); w.y = pk2(kh[2], kh[3]); *(u32x2*)(KH + tok * CP + c4) = w;
        bhs[q] = bh; khs[q] = kh; ahs[q] = ah;
        if (tok == 63) { *(f32x4*)(gCs + c4) = eL; *(f32x4*)((float*)(A.ws + WS_GC) + (size_t)uidx * 64 + c4) = eL; }
    }
#pragma unroll
    for (int i = 0; i < 4; ++i) {
        *(unsigned*)(BHt + (c4 + i) * CP + 2 * tkA) = pk2(bhs[0][i], bhs[1][i]);
        *(unsigned*)(KHt + (c4 + i) * CP + 2 * tkA) = pk2(khs[0][i], khs[1][i]);
        *(unsigned*)(AHt + (c4 + i) * CP + 2 * tkA) = pk2(ahs[0][i], ahs[1][i]);
    }
    __syncthreads();
    if (stop <= 5) return;
    {
        const int yt = wave & 3;
        const bf16* X = ((yt < 2) ? BH : KH) + 32 * (yt & 1) * CP;
#pragma unroll
        for (int q = 0; q < 2; ++q) {
            const int xt = 2 * (wave >> 2) + q;
            const bf16* Y = ((xt < 2) ? AH : QT) + 32 * (xt & 1) * CP;
            f32x16 acc = {};
            acc = mm32(X, Y, lane, acc);
            bf16* dst = (xt < 2) ? ((yt < 2) ? AAB : AAK) : ((yt < 2) ? ARB : ARK);
            const int i = 32 * (xt & 1) + r31;
#pragma unroll
            for (int g = 0; g < 4; ++g) {
                const int j0 = 32 * (yt & 1) + 8 * g + 4 * hh;
                float v[4];
#pragma unroll
                for (int e = 0; e < 4; ++e) { const int j = j0 + e; const bool keep = (xt < 2) ? (j < i) : (j <= i); v[e] = keep ? acc[4 * g + e] : 0.f; }
                { u32x2 w; w.x = pk2(v[0], v[1]); w.y = pk2(v[2], v[3]); *(u32x2*)(dst + i * CP + j0) = w; }
            }
        }
    }
    __syncthreads();
    if (stop <= 6) return;
    if (wave < 4) {
        const int mt = wave & 1, nt = wave >> 1;
        f32x16 acc = {};
        acc = mm32(AAK + 32 * mt * CP, Vt + 32 * nt * CP, lane, acc);
#pragma unroll
        for (int g = 0; g < 4; ++g) { u32x2 w; w.x = pk2(acc[4 * g], acc[4 * g + 1]); w.y = pk2(acc[4 * g + 2], acc[4 * g + 3]);
            *(u32x2*)(X1t + (32 * nt + r31) * CP + 32 * mt + 8 * g + 4 * hh) = w; }
    } else if (wave == 4) {
        const int bi = lane >> 4, cc = lane & 15;
        float x[16];
#pragma unroll
        for (int i = 0; i < 16; ++i) {
            const u32x4 a0 = *(const u32x4*)(AAB + (16 * bi + i) * CP + 16 * bi), a1 = *(const u32x4*)(AAB + (16 * bi + i) * CP + 16 * bi + 8);
            const float av_[16] = {lo16(a0.x), hi16(a0.x), lo16(a0.y), hi16(a0.y), lo16(a0.z), hi16(a0.z), lo16(a0.w), hi16(a0.w),
                                   lo16(a1.x), hi16(a1.x), lo16(a1.y), hi16(a1.y), lo16(a1.z), hi16(a1.z), lo16(a1.w), hi16(a1.w)};
            float v_ = (i == cc) ? 1.0f : 0.0f;
#pragma unroll
            for (int j = 0; j < i; ++j) v_ += av_[j] * x[j];
            x[i] = v_;
            TM[(16 * bi + i) * CP + 16 * bi + cc] = (unsigned short)(pk2(v_, 0.f) & 0xffffu);
        }
        u32x4 w0, w1;
        w0.x = pk2(x[0], x[1]); w0.y = pk2(x[2], x[3]); w0.z = pk2(x[4], x[5]); w0.w = pk2(x[6], x[7]);
        w1.x = pk2(x[8], x[9]); w1.y = pk2(x[10], x[11]); w1.z = pk2(x[12], x[13]); w1.w = pk2(x[14], x[15]);
        *(u32x4*)(TMt + (16 * bi + cc) * CP + 16 * bi) = w0; *(u32x4*)(TMt + (16 * bi + cc) * CP + 16 * bi + 8) = w1;
    }
    __syncthreads();
    if (stop <= 7) return;
    f32x16 nacc = {}, oacc = {};
    if (wave >= 4) { const int q = wave & 3;
        nacc = mm32(KHt + 32 * (q & 1) * CP, Vt + 32 * (q >> 1) * CP, lane, nacc);
        oacc = mm32(Vt + 32 * (q & 1) * CP, ARK + 32 * (q >> 1) * CP, lane, oacc); }
#pragma unroll
    for (int lvl = 1; lvl < 4; ++lvl) {
        if (wave < 4 - lvl) {
            const int bj = wave, bi = wave + lvl, l15 = lane & 15, q4 = lane >> 4;
            bf16* Pt = PTs + wave * (16 * 40);
            f32x4 acc = {0.f, 0.f, 0.f, 0.f};
#pragma unroll
            for (int ks = 0; ks < 2; ++ks)
                acc = __builtin_amdgcn_mfma_f32_16x16x32_bf16(*(const bf16x8*)(AAB + (16 * bi + l15) * CP + 32 * ks + 8 * q4), *(const bf16x8*)(TMt + (16 * bj + l15) * CP + 32 * ks + 8 * q4), acc, 0, 0, 0);
            { u32x2 w; w.x = pk2(acc[0], acc[1]); w.y = pk2(acc[2], acc[3]); *(u32x2*)(Pt + l15 * 40 + 4 * q4) = w; }
            asm volatile("s_waitcnt lgkmcnt(0)" ::: "memory");
            bf16x8 a2 = {0, 0, 0, 0, 0, 0, 0, 0};
            if (q4 < 2) a2 = *(const bf16x8*)(TM + (16 * bi + l15) * CP + 16 * bi + 8 * q4);
            const bf16x8 b2 = *(const bf16x8*)(Pt + l15 * 40 + 8 * q4);
            f32x4 xo = {0.f, 0.f, 0.f, 0.f};
            xo = __builtin_amdgcn_mfma_f32_16x16x32_bf16(a2, b2, xo, 0, 0, 0);
#pragma unroll
            for (int e = 0; e < 4; ++e) TM[(16 * bi + 4 * q4 + e) * CP + 16 * bj + l15] = (unsigned short)(pk2(xo[e], 0.f) & 0xffffu);
            { u32x2 w; w.x = pk2(xo[0], xo[1]); w.y = pk2(xo[2], xo[3]); *(u32x2*)(TMt + (16 * bj + l15) * CP + 16 * bi + 4 * q4) = w; }
        }
        __syncthreads();
    }
    {
        const int it = wave & 1, ct = (wave >> 1) & 1;
        const bf16* Y = (wave < 4) ? AHt : X1t; bf16* dst = (wave < 4) ? WTt : UTt;
        f32x16 acc = {};
        acc = mm32(TM + 32 * it * CP, Y + 32 * ct * CP, lane, acc);
#pragma unroll
        for (int g = 0; g < 4; ++g) { u32x2 w; w.x = pk2(acc[4 * g], acc[4 * g + 1]); w.y = pk2(acc[4 * g + 2], acc[4 * g + 3]);
            *(u32x2*)(dst + (32 * ct + r31) * CP + 32 * it + 8 * g + 4 * hh) = w; }
    }
    __syncthreads();
    if (stop <= 8) return;
    {
        u32x4* MPs = (u32x4*)((unsigned char*)A.out + SC_MP) + (size_t)uidx * 512;
        u32x4* NNs = (u32x4*)((unsigned char*)A.out + SC_NN) + (size_t)uidx * 512;
        u32x4* QHs = (u32x4*)((unsigned char*)A.out + SC_QH) + (size_t)uidx * 512;
        u32x4* OLs = (u32x4*)((unsigned char*)A.out + SC_OL) + (size_t)uidx * 512;
        if (wave < 2) {
            const int it = wave;
#pragma unroll
            for (int kt = 0; kt < 2; ++kt) {
                f32x16 acc = {};
                acc = mm32(WTt + 32 * kt * CP, ARB + 32 * it * CP, lane, acc);
#pragma unroll
                for (int g = 0; g < 4; ++g) { const u32x2 qv = *(const u32x2*)(QT + (32 * it + r31) * CP + 32 * kt + 8 * g + 4 * hh);
                    acc[4 * g] += lo16(qv.x); acc[4 * g + 1] += hi16(qv.x); acc[4 * g + 2] += lo16(qv.y); acc[4 * g + 3] += hi16(qv.y); }
                QHs[(it * 4 + 2 * kt) * 64 + lane] = packfrag(acc, 0); QHs[(it * 4 + 2 * kt + 1) * 64 + lane] = packfrag(acc, 1);
            }
        } else if (wave < 4) {
            const int ktp = wave - 2; const float gc = gCs[32 * ktp + r31];
#pragma unroll
            for (int kt = 0; kt < 2; ++kt) {
                f32x16 acc = {};
                acc = mm32(WTt + 32 * kt * CP, BHt + 32 * ktp * CP, lane, acc);
                acc = acc * gc;
                MPs[((ktp * 2 + kt) * 2) * 64 + lane] = packfrag(acc, 0); MPs[((ktp * 2 + kt) * 2 + 1) * 64 + lane] = packfrag(acc, 1);
            }
        } else {
            const int q = wave & 3;
            { const int kt = q & 1, vt = q >> 1;
              nacc = mm32(BHt + 32 * kt * CP, UTt + 32 * vt * CP, lane, nacc);
#pragma unroll
              for (int g = 0; g < 4; ++g) { const f32x4 gc = *(const f32x4*)(gCs + 32 * kt + 8 * g + 4 * hh);
                  nacc[4 * g] *= gc[0]; nacc[4 * g + 1] *= gc[1]; nacc[4 * g + 2] *= gc[2]; nacc[4 * g + 3] *= gc[3]; }
              NNs[((vt * 2 + kt) * 2) * 64 + lane] = packfrag(nacc, 0); NNs[((vt * 2 + kt) * 2 + 1) * 64 + lane] = packfrag(nacc, 1); }
            { const int vt = q & 1, it = q >> 1;
              oacc = mm32(UTt + 32 * vt * CP, ARB + 32 * it * CP, lane, oacc);
              OLs[((it * 2 + vt) * 2) * 64 + lane] = packfrag(oacc, 0); OLs[((it * 2 + vt) * 2 + 1) * 64 + lane] = packfrag(oacc, 1); }
        }
    }
    __syncthreads();
}
__device__ __forceinline__ void rwkv_r2_unit(const int tid_in, const Args& A, int u) {
    int tid = tid_in; asm volatile("" : "+v"(tid));
    const int lane = tid & 63, wave = __builtin_amdgcn_readfirstlane(tid >> 6), hh = lane >> 5;
    const int head = 4 * u + (wave >> 1), vt = wave & 1;
    const u32x4* MPs = (const u32x4*)((unsigned char*)A.out + SC_MP) + (size_t)head * 64 * 512;
    u32x4* NNs = (u32x4*)((unsigned char*)A.out + SC_NN) + (size_t)head * 64 * 512;
    const float* GCs = (const float*)(A.ws + WS_GC) + (size_t)head * 64 * 64;
    f32x16 acc0 = {}, acc1 = {};
    for (int c = 0; c < 64; ++c) {
        u32x4 mp[8], nn[4]; f32x4 gm[8];
#pragma unroll
        for (int i = 0; i < 8; ++i) mp[i] = MPs[(size_t)c * 512 + i * 64 + lane];
#pragma unroll
        for (int i = 0; i < 4; ++i) nn[i] = NNs[(size_t)c * 512 + vt * 256 + i * 64 + lane];
#pragma unroll
        for (int i = 0; i < 8; ++i) gm[i] = *(const f32x4*)(GCs + c * 64 + 32 * (i >> 2) + 8 * (i & 3) + 4 * hh);
        const u32x4 hb0 = packfrag(acc0, 0), hb1 = packfrag(acc0, 1), hb2 = packfrag(acc1, 0), hb3 = packfrag(acc1, 1);
#pragma unroll
        for (int g = 0; g < 4; ++g) {
            const unsigned* n0 = (const unsigned*)&nn[g >> 1]; const unsigned* n1 = (const unsigned*)&nn[2 + (g >> 1)];
            const int o_ = 2 * (g & 1);
            acc0[4 * g] = acc0[4 * g] * gm[g][0] + lo16(n0[o_]); acc0[4 * g + 1] = acc0[4 * g + 1] * gm[g][1] + hi16(n0[o_]);
            acc0[4 * g + 2] = acc0[4 * g + 2] * gm[g][2] + lo16(n0[o_ + 1]); acc0[4 * g + 3] = acc0[4 * g + 3] * gm[g][3] + hi16(n0[o_ + 1]);
            acc1[4 * g] = acc1[4 * g] * gm[4 + g][0] + lo16(n1[o_]); acc1[4 * g + 1] = acc1[4 * g + 1] * gm[4 + g][1] + hi16(n1[o_]);
            acc1[4 * g + 2] = acc1[4 * g + 2] * gm[4 + g][2] + lo16(n1[o_ + 1]); acc1[4 * g + 3] = acc1[4 * g + 3] * gm[4 + g][3] + hi16(n1[o_ + 1]);
        }
        NNs[(size_t)c * 512 + vt * 256 + 0 * 64 + lane] = hb0; NNs[(size_t)c * 512 + vt * 256 + 1 * 64 + lane] = hb1;
        NNs[(size_t)c * 512 + vt * 256 + 2 * 64 + lane] = hb2; NNs[(size_t)c * 512 + vt * 256 + 3 * 64 + lane] = hb3;
        const bf16x8 b0 = __builtin_bit_cast(bf16x8, hb0), b1 = __builtin_bit_cast(bf16x8, hb1), b2 = __builtin_bit_cast(bf16x8, hb2), b3 = __builtin_bit_cast(bf16x8, hb3);
        acc0 = __builtin_amdgcn_mfma_f32_32x32x16_bf16(__builtin_bit_cast(bf16x8, mp[0]), b0, acc0, 0, 0, 0);
        acc1 = __builtin_amdgcn_mfma_f32_32x32x16_bf16(__builtin_bit_cast(bf16x8, mp[4]), b0, acc1, 0, 0, 0);
        acc0 = __builtin_amdgcn_mfma_f32_32x32x16_bf16(__builtin_bit_cast(bf16x8, mp[1]), b1, acc0, 0, 0, 0);
        acc1 = __builtin_amdgcn_mfma_f32_32x32x16_bf16(__builtin_bit_cast(bf16x8, mp[5]), b1, acc1, 0, 0, 0);
        acc0 = __builtin_amdgcn_mfma_f32_32x32x16_bf16(__builtin_bit_cast(bf16x8, mp[2]), b2, acc0, 0, 0, 0);
        acc1 = __builtin_amdgcn_mfma_f32_32x32x16_bf16(__builtin_bit_cast(bf16x8, mp[6]), b2, acc1, 0, 0, 0);
        acc0 = __builtin_amdgcn_mfma_f32_32x32x16_bf16(__builtin_bit_cast(bf16x8, mp[3]), b3, acc0, 0, 0, 0);
        acc1 = __builtin_amdgcn_mfma_f32_32x32x16_bf16(__builtin_bit_cast(bf16x8, mp[7]), b3, acc1, 0, 0, 0);
    }
}
__device__ __forceinline__ void rwkv_r3_unit(const int tid_in, const Args& A, int layer, int u) {
    int tid = tid_in; asm volatile("" : "+v"(tid));
    const int lane = tid & 63, wave = __builtin_amdgcn_readfirstlane(tid >> 6), r31 = lane & 31, hh = lane >> 5;
    const int uidx = 4 * u + (wave >> 1), it = wave & 1;
    const int head = uidx >> 6, c = uidx & 63, b = head / RH, h = head % RH;
    const size_t trow = (size_t)b * SEQ + c * 64 + 32 * it + r31;
    const u32x4* HSs = (const u32x4*)((unsigned char*)A.out + SC_NN) + (size_t)uidx * 512;
    const u32x4* QHs = (const u32x4*)((unsigned char*)A.out + SC_QH) + (size_t)uidx * 512;
    const u32x4* OLs = (const u32x4*)((unsigned char*)A.out + SC_OL) + (size_t)uidx * 512;
    const bf16* P = (const bf16*)(A.ws + WS_P); const bf16* Gs = (const bf16*)(A.ws + WS_G); bf16* MIX = (bf16*)(A.ws + WS_MIX);
    const bool hasprev = (c * 64 + 32 * it + r31) > 0;
    u32x4 ol[4], qf4[4], hs[8];
#pragma unroll
    for (int i = 0; i < 4; ++i) { ol[i] = OLs[((it * 2 + (i >> 1)) * 2 + (i & 1)) * 64 + lane]; qf4[i] = QHs[(it * 4 + i) * 64 + lane]; }
#pragma unroll
    for (int i = 0; i < 8; ++i) hs[i] = HSs[(i >> 2) * 256 + (i & 3) * 64 + lane];
    u32x2 cvv[8], pvv[8], gwv[8];
#pragma unroll
    for (int i = 0; i < 8; ++i) { const int vch = h * 64 + 32 * (i >> 2) + 8 * (i & 3) + 4 * hh;
        cvv[i] = *(const u32x2*)(P + trow * INC + PC_V + vch);
        pvv[i] = (u32x2){0u, 0u}; if (hasprev) pvv[i] = *(const u32x2*)(P + (trow - 1) * INC + PC_V + vch);
        gwv[i] = *(const u32x2*)(Gs + trow * RW + vch); }
    const float rh = ((const float*)(A.ws + WS_RHO))[trow * RH + h];
    f32x16 acc[2];
#pragma unroll
    for (int vt = 0; vt < 2; ++vt) {
        const u32x4 o0 = ol[2 * vt], o1 = ol[2 * vt + 1];
        acc[vt][0] = lo16(o0.x); acc[vt][1] = hi16(o0.x); acc[vt][2] = lo16(o0.y); acc[vt][3] = hi16(o0.y); acc[vt][4] = lo16(o0.z); acc[vt][5] = hi16(o0.z); acc[vt][6] = lo16(o0.w); acc[vt][7] = hi16(o0.w);
        acc[vt][8] = lo16(o1.x); acc[vt][9] = hi16(o1.x); acc[vt][10] = lo16(o1.y); acc[vt][11] = hi16(o1.y); acc[vt][12] = lo16(o1.z); acc[vt][13] = hi16(o1.z); acc[vt][14] = lo16(o1.w); acc[vt][15] = hi16(o1.w);
    }
#pragma unroll
    for (int s_ = 0; s_ < 4; ++s_) {
        const bf16x8 qf = __builtin_bit_cast(bf16x8, qf4[s_]);
#pragma unroll
        for (int vt = 0; vt < 2; ++vt) acc[vt] = __builtin_amdgcn_mfma_f32_32x32x16_bf16(__builtin_bit_cast(bf16x8, hs[vt * 4 + s_]), qf, acc[vt], 0, 0, 0);
    }
    float sm = 0.f;
#pragma unroll
    for (int e = 0; e < 16; ++e) sm += acc[0][e] + acc[1][e];
    sm += __shfl_xor(sm, 32);
    const float mean = sm * (1.0f / 64.0f);
    float q2 = 0.f;
#pragma unroll
    for (int e = 0; e < 16; ++e) { const float d0 = acc[0][e] - mean, d1 = acc[1][e] - mean; q2 += d0 * d0 + d1 * d1; }
    q2 += __shfl_xor(q2, 32);
    const float rstd = rsqrtf(q2 * (1.0f / 64.0f) + GN_EPS);
#pragma unroll
    for (int vt = 0; vt < 2; ++vt)
#pragma unroll
        for (int g = 0; g < 4; ++g) {
            const int vch = h * 64 + 32 * vt + 8 * g + 4 * hh;
            const f32x4 lg = *(const f32x4*)(A.in[I_LNG] + layer * RW + vch), lb = *(const f32x4*)(A.in[I_LNB] + layer * RW + vch), muv = *(const f32x4*)(A.in[I_MU] + layer * RCOLS + PC_V + vch);
            const u32x2 cv = cvv[vt * 4 + g], pv = pvv[vt * 4 + g], gw = gwv[vt * 4 + g];
            const f32x4 vc = {lo16(cv.x), hi16(cv.x), lo16(cv.y), hi16(cv.y)}, vp = {lo16(pv.x), hi16(pv.x), lo16(pv.y), hi16(pv.y)};
            const f32x4 vv = vc + muv * (vp - vc), gg = {lo16(gw.x), hi16(gw.x), lo16(gw.y), hi16(gw.y)};
            float y[4];
#pragma unroll
            for (int e = 0; e < 4; ++e) y[e] = ((acc[vt][4 * g + e] - mean) * rstd * lg[e] + lb[e] + rh * vv[e]) * gg[e];
            u32x2 w; w.x = pk2(y[0], y[1]); w.y = pk2(y[2], y[3]);
            *(u32x2*)(MIX + trow * D + MIX_R + vch) = w;
        }
}

constexpr int LT = 16;
__device__ __forceinline__ float gelu_tanh(float x) { const float u = 0.7978845608028654f * (x + 0.044715f * x * x * x); return x * __builtin_amdgcn_rcpf(1.0f + __expf(-2.0f * u)); }
__device__ __forceinline__ float neg_expm1(float x) { return (x > -0.25f) ? -x * (1.0f + x * (0.5f + x * (0.16666667f + x * (0.041666668f + x * (0.0083333338f + x * 0.0013888889f))))) : 1.0f - __expf(x); }
__device__ __forceinline__ void lru_unit(const int tid_in, const Args& A, int layer, int bg, unsigned char* lds) {
    int tid = tid_in; asm volatile("" : "+v"(tid));
    const int lane = tid & 63, wave = __builtin_amdgcn_readfirstlane(tid >> 6);
    const int b = bg / LB, g = bg % LB, c = g * 64 + lane;
    const bf16* P = (const bf16*)(A.ws + WS_P) + (size_t)b * SEQ * INC;
    bf16* MIX = (bf16*)(A.ws + WS_MIX) + (size_t)b * SEQ * D;
    bf16* WAs = (bf16*)lds;
    bf16* WXs = WAs + 64 * 72;
    float* totA = (float*)(WXs + 64 * 72);
    float* totH = totA + 8 * 64;
    float* carryS = totH + 8 * 64;
    bf16* XC = (bf16*)(carryS + 64) + wave * (LT * 72);
    float* PRE = (float*)((bf16*)(carryS + 64) + 8 * LT * 72) + wave * (2 * LT * 68);
    const bf16* LwaT = (const bf16*)(A.ws + WS_WSM) + 98304 + g * 4096; const bf16* LwxT = LwaT + 16384;
    { const int j = tid >> 3, i8 = (tid & 7) * 8;
      *(u32x4*)(WAs + j * 72 + i8) = *(const u32x4*)(LwaT + j * 64 + i8); *(u32x4*)(WXs + j * 72 + i8) = *(const u32x4*)(LwxT + j * 64 + i8); }
    const float cw0 = A.in[I_CW][(layer * 4 + 0) * LW + c], cw1 = A.in[I_CW][(layer * 4 + 1) * LW + c], cw2 = A.in[I_CW][(layer * 4 + 2) * LW + c], cw3 = A.in[I_CW][(layer * 4 + 3) * LW + c];
    const float cb = A.in[I_CB][layer * LW + c], ba = A.in[I_BA][layer * LW + c], bx = A.in[I_BX][layer * LW + c];
    const float sp8 = 8.0f * softplusf_(-A.in[I_LAM][layer * LW + c]);
    const float ng = A.in[I_LRUG][layer * LW + c];
    if (tid < 64) carryS[tid] = 0.f;
    __syncthreads();
    for (int st = 0; st < SEQ; st += 8 * LT) {
        const int T0 = st + wave * LT;
        float xm3 = (T0 >= 3) ? bf2f(P[(size_t)(T0 - 3) * INC + PC_LX + c]) : 0.f;
        float xm2 = (T0 >= 2) ? bf2f(P[(size_t)(T0 - 2) * INC + PC_LX + c]) : 0.f;
        float xm1 = (T0 >= 1) ? bf2f(P[(size_t)(T0 - 1) * INC + PC_LX + c]) : 0.f;
        float xc[LT], gin[LT];
#pragma unroll
        for (int t = 0; t < LT; ++t) { xc[t] = bf2f(P[(size_t)(T0 + t) * INC + PC_LX + c]); gin[t] = bf2f(P[(size_t)(T0 + t) * INC + PC_LG + c]); }
#pragma unroll
        for (int t = 0; t < LT; ++t) {
            const float x = xc[t];
            xc[t] = cw0 * xm3 + cw1 * xm2 + cw2 * xm1 + cw3 * x + cb;
            xm3 = xm2; xm2 = xm1; xm1 = x;
            XC[t * 72 + lane] = (unsigned short)(pk2(xc[t], 0.f) & 0xffffu);
        }
        asm volatile("s_waitcnt lgkmcnt(0)" ::: "memory");
        {
            const bf16* bl = XC + (lane & 15) * 72 + 8 * (lane >> 4);
            const bf16x8 b0 = *(const bf16x8*)(bl), b1 = *(const bf16x8*)(bl + 32);
#pragma unroll
            for (int gt = 0; gt < 2; ++gt) {
                const bf16* Ws = gt ? WXs : WAs;
#pragma unroll
                for (int jt = 0; jt < 4; ++jt) {
                    const bf16* al = Ws + (16 * jt + (lane & 15)) * 72 + 8 * (lane >> 4);
                    f32x4 acc = {0.f, 0.f, 0.f, 0.f};
                    acc = __builtin_amdgcn_mfma_f32_16x16x32_bf16(*(const bf16x8*)(al), b0, acc, 0, 0, 0);
                    acc = __builtin_amdgcn_mfma_f32_16x16x32_bf16(*(const bf16x8*)(al + 32), b1, acc, 0, 0, 0);
                    *(f32x4*)(PRE + gt * (LT * 68) + (lane & 15) * 68 + 16 * jt + 4 * (lane >> 4)) = acc;
                }
            }
        }
        asm volatile("s_waitcnt lgkmcnt(0)" ::: "memory");
        float hl[LT], Ac[LT];
        float hrun = 0.f, arun = 1.f;
#pragma unroll
        for (int t = 0; t < LT; ++t) {
            const float ga = PRE[t * 68 + lane] + ba, gx = PRE[LT * 68 + t * 68 + lane] + bx;
            const float la = -sp8 * sigmoidf_(ga);
            const float a = __expf(la);
            const float bi = __builtin_amdgcn_sqrtf(neg_expm1(2.0f * la)) * sigmoidf_(gx) * xc[t];
            hrun = a * hrun + bi; arun *= a;
            hl[t] = hrun; Ac[t] = arun;
        }
        totA[wave * 64 + lane] = arun; totH[wave * 64 + lane] = hrun;
        __syncthreads();
        float cin = carryS[lane];
        for (int u = 0; u < wave; ++u) cin = totA[u * 64 + lane] * cin + totH[u * 64 + lane];
        float cout = cin;
        if (wave == 7) cout = totA[7 * 64 + lane] * cin + totH[7 * 64 + lane];
#pragma unroll
        for (int t = 0; t < LT; ++t) {
            const float hv = hl[t] + Ac[t] * cin;
            const float y = gelu_tanh(gin[t]) * hv;
            const float ss = red64(y * y);
            const float o = y * rsqrtf(ss * (1.0f / 64.0f) + RMS_EPS) * ng;
            ((unsigned short*)MIX)[(size_t)(T0 + t) * D + MIX_L + c] = (unsigned short)(pk2(o, 0.f) & 0xffffu);
        }
        __syncthreads();
        if (wave == 7) carryS[lane] = cout;
        __syncthreads();
    }
}

__device__ __forceinline__ void phase_mixers(const int tid, const Args& A, int layer, int sub, unsigned char* lds, volatile LAS unsigned* misc, const int umask = 7, const int qslot = 0, const int r1stop = 99) {
    unsigned* qhead = (unsigned*)(A.ws + WS_CTL) + CW_Q + layer * 64 + sub * 8 + qslot;
    constexpr int R1B = RH;
#ifndef ATT_A
#define ATT_A 0
#endif
#ifndef ATT_B
#define ATT_B 1152
#endif
    const int a0 = (sub == 0) ? 0 : (sub == 1) ? ATT_A : ATT_B, a1 = (sub == 0) ? ATT_A : (sub == 1) ? ATT_B : 1536, nA = a1 - a0;
    const int nHead = (sub == 0) ? 64 : (sub == 1) ? 24 : 0;
    const int nTail = (sub == 0) ? 6144 / R1B : (sub == 2) ? 1536 : 0;
    const int NU = nHead + nA + nTail;
#ifndef CUMASK
#define CUMASK 7
#endif
    for (;;) {
        __syncthreads();
        if (tid == 0) misc[4] = __hip_atomic_fetch_add(qhead, 1u, __ATOMIC_RELAXED, __HIP_MEMORY_SCOPE_AGENT);
        __syncthreads();
        const int u = (int)misc[4];
        if (u >= NU) break;
        if (u < nHead) {
            if (sub == 0) { if ((CUMASK & 2) && (umask & 2)) lru_unit(tid, A, layer, u, lds); }
            else { if ((CUMASK & 1) && (umask & 1)) rwkv_r2_unit(tid, A, u); }
        } else if (u < nHead + nA) {
            const int a = a0 + (u - nHead); if ((CUMASK & 4) && (umask & 4)) attn_unit(tid, A, layer, a % 96, 15 - a / 96, lds);
        } else {
            const int v = u - nHead - nA;
            if (sub == 0) { if ((CUMASK & 1) && (umask & 1)) { R1Pre pf; const int bb = v >> 6, cc_ = v & 63; rwkv_r1_prefetch(tid, A, bb, cc_, pf);
                    for (int hq = 0; hq < RH; ++hq) rwkv_r1_unit(tid, A, layer, (bb * RH + hq) * 64 + cc_, lds, pf, hq == 0, r1stop); } }
            else { if ((CUMASK & 1) && (umask & 1)) rwkv_r3_unit(tid, A, layer, v); }
        }
    }
}

__device__ __forceinline__ void phase_ln1_router(const int tid, const Args& A, int layer, unsigned char* lds, int vcu, int G) {
    const int lane = tid & 63, wave = tid >> 6;
    float* rwT = (float*)lds;
    float* part = (float*)(lds + 65536) + wave * 1024;
    float* lgS = (float*)(lds + 98304) + wave * 64;
    int* hist = (int*)(lds + 100352);
    int* rowinfo = (int*)(lds + 100352 + 256);
    bf16* X1 = (bf16*)(A.ws + WS_X1);
    int* list = (int*)(A.ws + WS_LIST); float* gate = (float*)(A.ws + WS_GATE);
    unsigned* gcnt = (unsigned*)(A.ws + WS_CTL) + CW_CNT + layer * 64;
    const float* rw = A.in[I_RW];
    for (int i = tid; i < 16 * 1024; i += NTHR) { const int c = i >> 4, e = i & 15; rwT[e * 1024 + c] = rw[i]; }
    const float rbv = A.in[I_RB][lane & 15];
    const float* g1 = A.in[I_LN1G] + layer * D; const float* b1 = A.in[I_LN1B] + layer * D;
    f32x4 gg[4], bb[4];
#pragma unroll
    for (int j = 0; j < 4; ++j) { gg[j] = *(const f32x4*)(g1 + 4 * lane + 256 * j); bb[j] = *(const f32x4*)(b1 + 4 * lane + 256 * j); }
    const int rows_per = M / G;
    for (int chunk = 0; chunk < rows_per / 256; ++chunk) {
        const int base = vcu * rows_per + chunk * 256;
        if (tid < 16) hist[tid] = 0;
        __syncthreads();
        for (int pass = 0; pass < 8; ++pass) {
            const int lr0 = wave * 32 + pass * 4;
            f32x4 y[4][4];
#pragma unroll
            for (int q = 0; q < 4; ++q) {
                bf16* xr = X1 + (size_t)(base + lr0 + q) * D;
                float sm = 0.f;
#pragma unroll
                for (int j = 0; j < 4; ++j) { const u32x2 a = *(const u32x2*)(xr + 4 * lane + 256 * j);
                    y[q][j] = (f32x4){lo16(a.x), hi16(a.x), lo16(a.y), hi16(a.y)}; sm += (y[q][j][0] + y[q][j][1]) + (y[q][j][2] + y[q][j][3]); }
                const float mean = red64(sm) * (1.0f / D); float s2 = 0.f;
#pragma unroll
                for (int j = 0; j < 4; ++j) { y[q][j] = y[q][j] - mean; s2 += (y[q][j][0] * y[q][j][0] + y[q][j][1] * y[q][j][1]) + (y[q][j][2] * y[q][j][2] + y[q][j][3] * y[q][j][3]); }
                const float rstd = rsqrtf(red64(s2) * (1.0f / D) + LN_EPS);
#pragma unroll
                for (int j = 0; j < 4; ++j) { y[q][j] = y[q][j] * rstd * gg[j] + bb[j];
                    u32x2 w; w.x = pk2(y[q][j][0], y[q][j][1]); w.y = pk2(y[q][j][2], y[q][j][3]); *(u32x2*)(xr + 4 * lane + 256 * j) = w; }
            }
#pragma unroll
            for (int e = 0; e < 16; ++e) {
                float a0 = 0.f, a1 = 0.f, a2 = 0.f, a3 = 0.f;
#pragma unroll
                for (int j = 0; j < 4; ++j) { const f32x4 w = *(const f32x4*)(rwT + e * 1024 + 4 * lane + 256 * j);
                    a0 += (y[0][j][0] * w[0] + y[0][j][1] * w[1]) + (y[0][j][2] * w[2] + y[0][j][3] * w[3]);
                    a1 += (y[1][j][0] * w[0] + y[1][j][1] * w[1]) + (y[1][j][2] * w[2] + y[1][j][3] * w[3]);
                    a2 += (y[2][j][0] * w[0] + y[2][j][1] * w[1]) + (y[2][j][2] * w[2] + y[2][j][3] * w[3]);
                    a3 += (y[3][j][0] * w[0] + y[3][j][1] * w[1]) + (y[3][j][2] * w[2] + y[3][j][3] * w[3]); }
                a0 += DPP(a0, 0xB1); a0 += DPP(a0, 0x4E); a1 += DPP(a1, 0xB1); a1 += DPP(a1, 0x4E);
                a2 += DPP(a2, 0xB1); a2 += DPP(a2, 0x4E); a3 += DPP(a3, 0xB1); a3 += DPP(a3, 0x4E);
                if ((lane & 3) == 0) { part[(0 * 16 + e) * 16 + (lane >> 2)] = a0; part[(1 * 16 + e) * 16 + (lane >> 2)] = a1;
                                       part[(2 * 16 + e) * 16 + (lane >> 2)] = a2; part[(3 * 16 + e) * 16 + (lane >> 2)] = a3; }
            }
            asm volatile("s_waitcnt lgkmcnt(0)" ::: "memory");
            { const f32x4 p0 = *(const f32x4*)(part + lane * 16), p1 = *(const f32x4*)(part + lane * 16 + 4), p2 = *(const f32x4*)(part + lane * 16 + 8), p3 = *(const f32x4*)(part + lane * 16 + 12);
              const f32x4 ps = (p0 + p1) + (p2 + p3);
              lgS[lane] = (ps[0] + ps[1]) + (ps[2] + ps[3]) + rbv; }
            asm volatile("s_waitcnt lgkmcnt(0)" ::: "memory");
            const int rr = lane >> 4;
            float lg[16];
#pragma unroll
            for (int j = 0; j < 4; ++j) { const f32x4 v = *(const f32x4*)(lgS + rr * 16 + 4 * j); lg[4 * j] = v[0]; lg[4 * j + 1] = v[1]; lg[4 * j + 2] = v[2]; lg[4 * j + 3] = v[3]; }
            asm volatile("s_waitcnt lgkmcnt(0)" ::: "memory");
            {
                float mx = lg[0];
#pragma unroll
                for (int e = 1; e < 16; ++e) mx = fmaxf(mx, lg[e]);
                float sc[16], den = 0.f;
#pragma unroll
                for (int e = 0; e < 16; ++e) { sc[e] = __expf(lg[e] - mx); den += sc[e]; }
                const float inv = __builtin_amdgcn_rcpf(den);
#pragma unroll
                for (int e = 0; e < 16; ++e) sc[e] *= inv;
                int sel = 0; float best = -1.f;
#pragma unroll
                for (int gq = 0; gq < 4; ++gq) {
                    const float a = sc[4 * gq], b_ = sc[4 * gq + 1], c_ = sc[4 * gq + 2], d_ = sc[4 * gq + 3];
                    const float m1 = fmaxf(fmaxf(a, b_), fmaxf(c_, d_));
                    const float m2 = fmaxf(fmaxf(fminf(a, b_), fminf(c_, d_)), fminf(fmaxf(a, b_), fmaxf(c_, d_)));
                    const float gs = m1 + m2;
                    if (gs > best) { best = gs; sel = gq; }
                }
                float cd[4];
#pragma unroll
                for (int i = 0; i < 4; ++i) cd[i] = (sel == 0) ? sc[i] : (sel == 1) ? sc[4 + i] : (sel == 2) ? sc[8 + i] : sc[12 + i];
                int i0 = 0; float v0 = cd[0];
#pragma unroll
                for (int i = 1; i < 4; ++i) if (cd[i] > v0) { v0 = cd[i]; i0 = i; }
                int i1 = -1; float v1 = -1.f;
#pragma unroll
                for (int i = 0; i < 4; ++i) if (i != i0 && cd[i] > v1) { v1 = cd[i]; i1 = i; }
                const int e0 = sel * 4 + i0, e1 = sel * 4 + i1;
                const float gsum = v0 + v1;
                if ((lane & 15) == 0) {
                    const int row = base + lr0 + rr;
                    gate[2 * row] = v0 / gsum; gate[2 * row + 1] = v1 / gsum;
                    const int r0 = atomicAdd(&hist[e0], 1), r1 = atomicAdd(&hist[e1], 1);
                    rowinfo[2 * (lr0 + rr)] = e0 | (r0 << 8); rowinfo[2 * (lr0 + rr) + 1] = e1 | (r1 << 8);
                }
            }
        }
        __syncthreads();
        if (tid < 16) hist[16 + tid] = (int)__hip_atomic_fetch_add(gcnt + tid, (unsigned)hist[tid], __ATOMIC_RELAXED, __HIP_MEMORY_SCOPE_AGENT);
        __syncthreads();
        { const int info = rowinfo[tid]; const int e = info & 255, rk = info >> 8, pos = hist[16 + e] + rk, a = (base + (tid >> 1)) * 2 + (tid & 1);
          list[(size_t)e * LCAP + pos] = a; ((int*)(A.ws + WS_EINFO))[a] = e | (pos << 8); }
        __syncthreads();
    }
}

__device__ __forceinline__ void phase_ln2(const int tid, const Args& A, int layer, int vcu, int G, const LAS int* tab) {
    const int lane = tid & 63, wave = tid >> 6;
    const bf16* X1 = (const bf16*)(A.ws + WS_X1); const bf16* YM = (const bf16*)(A.ws + WS_YM);
    bf16* XB = (bf16*)(A.ws + WS_XB);
    const float* g2 = A.in[I_LN2G] + layer * D; const float* b2 = A.in[I_LN2B] + layer * D;
    f32x4 gg[4], bb[4];
#pragma unroll
    for (int j = 0; j < 4; ++j) { gg[j] = *(const f32x4*)(g2 + 4 * lane + 256 * j); bb[j] = *(const f32x4*)(b2 + 4 * lane + 256 * j); }
    const int gw = vcu * NWAVES + wave, NGW = G * NWAVES;
    const int* einfo = (const int*)(A.ws + WS_EINFO); const float* gate = (const float*)(A.ws + WS_GATE);
    for (int row = gw; row < M; row += NGW) {
        const int i0 = einfo[2 * row], i1 = einfo[2 * row + 1];
        const size_t yr0 = ((size_t)tab[i0 & 255] << 8) + (size_t)(i0 >> 8), yr1 = ((size_t)tab[i1 & 255] << 8) + (size_t)(i1 >> 8);
        const float g0 = gate[2 * row], g1 = gate[2 * row + 1];
        f32x4 v[4]; float sm = 0.f;
#pragma unroll
        for (int j = 0; j < 4; ++j) {
            const u32x2 a = *(const u32x2*)(X1 + (size_t)row * D + 4 * lane + 256 * j);
            const u32x2 y0 = *(const u32x2*)(YM + yr0 * D + 4 * lane + 256 * j);
            const u32x2 y1 = *(const u32x2*)(YM + yr1 * D + 4 * lane + 256 * j);
            v[j][0] = ALPHA * lo16(a.x) + g0 * lo16(y0.x) + g1 * lo16(y1.x); v[j][1] = ALPHA * hi16(a.x) + g0 * hi16(y0.x) + g1 * hi16(y1.x);
            v[j][2] = ALPHA * lo16(a.y) + g0 * lo16(y0.y) + g1 * lo16(y1.y); v[j][3] = ALPHA * hi16(a.y) + g0 * hi16(y0.y) + g1 * hi16(y1.y);
            sm += (v[j][0] + v[j][1]) + (v[j][2] + v[j][3]);
        }
        const float mean = red64(sm) * (1.0f / D); float s2 = 0.f;
#pragma unroll
        for (int j = 0; j < 4; ++j) { v[j] = v[j] - mean; s2 += (v[j][0] * v[j][0] + v[j][1] * v[j][1]) + (v[j][2] * v[j][2] + v[j][3] * v[j][3]); }
        const float rstd = rsqrtf(red64(s2) * (1.0f / D) + LN_EPS);
#pragma unroll
        for (int j = 0; j < 4; ++j) {
            const f32x4 o = v[j] * rstd * gg[j] + bb[j];
            if (layer == DEPTH - 1) *(f32x4*)(A.out + (size_t)row * D + 4 * lane + 256 * j) = o;
            else { u32x2 w; w.x = pk2(o[0], o[1]); w.y = pk2(o[2], o[3]); *(u32x2*)(XB + (size_t)row * D + 4 * lane + 256 * j) = w; }
        }
    }
}

__device__ __forceinline__ void moe_table(const int tid, const Args& A, int layer, LAS int* tab) {
    if (tid == 0) {
        const unsigned* gcnt = (const unsigned*)(A.ws + WS_CTL) + CW_CNT + layer * 64;
        int acc = 0;
        for (int e = 0; e < 16; ++e) { const int c = (int)__hip_atomic_load(gcnt + e, __ATOMIC_RELAXED, __HIP_MEMORY_SCOPE_AGENT); tab[e] = acc; tab[32 + e] = c; acc += (c + 255) >> 8; }
        tab[16] = acc;
    }
    __syncthreads();
}

__global__ void __launch_bounds__(NTHR, 2) fwd_kernel(Args args) {
    extern __shared__ __attribute__((aligned(16))) unsigned char lds[];
    LAS unsigned char* ldsl = (LAS unsigned char*)lds;
    volatile LAS unsigned* misc = (volatile LAS unsigned*)(ldsl + MISC_OFF);
    const int wave_s = __builtin_amdgcn_readfirstlane((int)threadIdx.x >> 6);
#define MKTID() ({ unsigned z_ = 0u; asm volatile("" : "+v"(z_)); (int)(wave_s * 64 + (int)__builtin_amdgcn_mbcnt_hi(~0u, __builtin_amdgcn_mbcnt_lo(~0u, z_))); })
    { const int tid = MKTID(); for (int u = tid; u < (LDS_BYTES - MISC_OFF) / 4; u += NTHR) misc[u] = 0u; }
    __syncthreads();
    const int G = gridDim.x, bx = blockIdx.x;
    const int vcu = (G % 8 == 0) ? (bx % 8) * (G / 8) + bx / 8 : bx;
    unsigned* ctl = (unsigned*)(args.ws + WS_CTL);
    XcdBarrier bar; bar.bar = ctl + CW_BAR; bar.x = 0; bar.st = nullptr;
    if (args.use_bar) bar = xcd_barrier_post(MKTID(), ctl + CW_BAR, misc + 8);
    LAS int* tab = (LAS int*)(ldsl + MISC_OFF + 256);
    const int lo = args.ph_lo, hi = args.ph_hi;
#ifndef PHMASK
#define PHMASK 0x3FF
#endif
#define IN(k) (((PHMASK >> (k)) & 1) && lo <= (k) && (k) < hi)
#define SEAM(k) do { if (args.use_bar && (REP_PH || !((k) == NPH - 1 && layer == args.l_hi - 1))) xcd_barrier(MKTID(), bar); } while (0)
#ifndef REP_PH
#define REP_PH 0
#endif
#ifndef REP_UMASK
#define REP_UMASK 7
#endif
    for (int layer = args.l_lo; layer < args.l_hi; ++layer) {
      {
#define RUN(k) if (IN(k)) for (int rep = 0; rep < ((((REP_PH) >> (k)) & 1) ? 2 : 1); ++rep)
        RUN(0) { phase_convert(MKTID(), args, layer, (float*)lds, vcu, G); SEAM(0); }
        RUN(1) {
            pg8::DenseOrder S; S.init(M, INC, D, G, bx, args.ws + WS_WIN);
            pg8::EpiIn E{(bf16*)(args.ws + WS_P)};
            pg8::gemm_phase<pg8::EpiIn, pg8::DenseOrder, true>(MKTID(), ldsl, (const char*)(args.ws + WS_XB), D, S, E);
            SEAM(1);
        }
#ifndef R1STOP
#define R1STOP 99
#endif
        RUN(2) { const bool probe = ((REP_PH >> 2) & 1) && rep == 0; phase_mixers(MKTID(), args, layer, 0, lds, misc, probe ? REP_UMASK : 7, rep * 4, probe ? R1STOP : 99); SEAM(2); }
        RUN(3) { phase_mixers(MKTID(), args, layer, 1, lds, misc, rep ? REP_UMASK : 7, rep * 4); SEAM(3); }
        RUN(4) { phase_mixers(MKTID(), args, layer, 2, lds, misc, rep ? REP_UMASK : 7, rep * 4); SEAM(4); }
        RUN(5) {
            pg8::DenseOrder S; S.init(M, D, D, G, bx, args.ws + WS_WOUT);
            pg8::EpiOut E{(const bf16*)(args.ws + WS_XB), (bf16*)(args.ws + WS_X1)};
            pg8::gemm_phase<pg8::EpiOut, pg8::DenseOrder, true>(MKTID(), ldsl, (const char*)(args.ws + WS_MIX), D, S, E);
            SEAM(5);
        }
        RUN(6) { phase_ln1_router(MKTID(), args, layer, lds, vcu, G); SEAM(6); }
        RUN(7) {
            moe_table(MKTID(), args, layer, tab);
            pg8::MoeOrder<true> S{tab, G, vcu, D, 4, (const char*)(args.ws + WS_WGU), (size_t)1024 * D * 2, (const int*)(args.ws + WS_LIST)};
            pg8::EpiMoe1 E{(bf16*)(args.ws + WS_H)};
            pg8::gemm_phase<pg8::EpiMoe1, pg8::MoeOrder<true>, true>(MKTID(), ldsl, (const char*)(args.ws + WS_X1), D, S, E);
            SEAM(7);
        }
        RUN(8) {
            moe_table(MKTID(), args, layer, tab);
            pg8::MoeOrder<false> S{tab, G, vcu, DE, 4, (const char*)(args.ws + WS_WDN), (size_t)1024 * DE * 2, (const int*)(args.ws + WS_LIST)};
            pg8::EpiMoe2 E{(bf16*)(args.ws + WS_YM)};
            pg8::gemm_phase<pg8::EpiMoe2, pg8::MoeOrder<false>, true>(MKTID(), ldsl, (const char*)(args.ws + WS_H), DE, S, E);
            SEAM(8);
        }
        RUN(9) { moe_table(MKTID(), args, layer, tab); phase_ln2(MKTID(), args, layer, vcu, G, tab); SEAM(9); }
#undef RUN
      }
    }
#undef IN
#undef SEAM
}

extern "C" void kernel_launch(void* const* d_in, const int* in_sizes, int n_in, void* d_out, int out_size, void* d_ws, size_t ws_size, hipStream_t stream) {
    static int grid = 0;
    if (grid == 0) {
        if (n_in != 32 || out_size != M * D || ws_size < WS_END) { fprintf(stderr, "kernel_launch: unexpected shapes (n_in %d out %d ws %zu)\n", n_in, out_size, ws_size); grid = -1; return; }
        int dev = 0, cus = 0;
        if (hipGetDevice(&dev) != hipSuccess || hipDeviceGetAttribute(&cus, hipDeviceAttributeMultiprocessorCount, dev) != hipSuccess) { grid = -1; return; }
        if (hipFuncSetAttribute((const void*)fwd_kernel, hipFuncAttributeMaxDynamicSharedMemorySize, LDS_BYTES) != hipSuccess) { fprintf(stderr, "kernel_launch: hipFuncSetAttribute failed\n"); grid = -1; return; }
        int per_cu = 0;
        (void)hipOccupancyMaxActiveBlocksPerMultiprocessor(&per_cu, (const void*)fwd_kernel, NTHR, LDS_BYTES);
        (void)hipGetLastError();
        if (per_cu < 1) fprintf(stderr, "kernel_launch: occupancy query reports %d\n", per_cu);
        grid = cus;
    }
    if (grid < 0) return;
    (void)hipMemsetAsync((char*)d_ws + WS_CTL, 0, CTL_BYTES, stream);
    Args a{};
    for (int i = 0; i < 32; ++i) a.in[i] = (const float*)d_in[i];
    a.out = (float*)d_out; a.ws = (unsigned char*)d_ws;
#if MK_ONE_LAUNCH
    a.l_lo = 0; a.l_hi = DEPTH; a.ph_lo = 0; a.ph_hi = NPH; a.use_bar = 1; a.pad = 0;
    hipLaunchKernelGGL(fwd_kernel, dim3(grid), dim3(NTHR), LDS_BYTES, stream, a);
#else
    for (int l = 0; l < DEPTH; ++l)
        for (int p = 0; p < NPH; ++p) {
            a.l_lo = l; a.l_hi = l + 1; a.ph_lo = p; a.ph_hi = p + 1; a.use_bar = 0; a.pad = 0;
            hipLaunchKernelGGL(fwd_kernel, dim3(grid), dim3(NTHR), LDS_BYTES, stream, a);
        }
#endif
}
```

```cpp
#include <hip/hip_runtime.h>
#include <cstdio>
#include <cstdint>

#ifndef MK_ONE_LAUNCH
#define MK_ONE_LAUNCH 1
#endif

#define LAS __attribute__((address_space(3)))
#define GAS __attribute__((address_space(1)))
typedef unsigned short bf16;
typedef short bf16x8 __attribute__((ext_vector_type(8)));
typedef short s16x4 __attribute__((ext_vector_type(4)));
typedef float f32x4 __attribute__((ext_vector_type(4)));
typedef float f32x2 __attribute__((ext_vector_type(2)));
typedef float f32x16 __attribute__((ext_vector_type(16)));
typedef unsigned u32x4 __attribute__((ext_vector_type(4)));
typedef unsigned u32x2 __attribute__((ext_vector_type(2)));
typedef __bf16 bf16x2_t __attribute__((ext_vector_type(2)));

constexpr int D = 1024, BATCH = 16, SEQ = 4096, DEPTH = 4, M = BATCH * SEQ;
constexpr int HD = 64, RW = 384, LW = 256, SW = 384, RH = 6, LB = 4, SH = 6;
constexpr int RCOLS = 1408, INC = 3072;
constexpr int PC_R = 0, PC_K = 384, PC_V = 768, PC_DW = 1152, PC_DA = 1216, PC_DG = 1280;
constexpr int PC_LG = 1408, PC_LX = 1664, PC_SQ = 1920, PC_SK = 2304, PC_SV = 2688;
constexpr int MIX_R = 0, MIX_L = 384, MIX_S = 640;
constexpr int NE = 16, DE = 512, LCAP = 2 * M;
constexpr float ALPHA = 1.6817928305074290f;
constexpr float LN_EPS = 1e-5f, RMS_EPS = 1e-6f, GN_EPS = 64e-5f;
constexpr float C2 = 0.125f * 1.4426950408889634f;

constexpr size_t MiB = 1u << 20;
constexpr size_t WS_CTL = 0, CTL_BYTES = 1 * MiB;
constexpr size_t WS_WIN = 1 * MiB;
constexpr size_t WS_WOUT = 7 * MiB;
constexpr size_t WS_WGU = 9 * MiB;
constexpr size_t WS_WDN = 41 * MiB;
constexpr size_t WS_WSM = 57 * MiB;
constexpr size_t WS_LIST = 58 * MiB;
constexpr size_t WS_GATE = 66 * MiB;
constexpr size_t WS_EINFO = 67 * MiB;
constexpr size_t WS_XB = 68 * MiB;
constexpr size_t WS_X1 = 196 * MiB;
constexpr size_t WS_P = 324 * MiB;
constexpr size_t WS_MIX = 708 * MiB;
constexpr size_t WS_H = 324 * MiB;
constexpr size_t WS_YM = 460 * MiB;
constexpr size_t WS_END = 888 * MiB;
static_assert(WS_H + (size_t)(2 * M + NE * 256) * DE * 2 <= WS_YM && WS_YM + (size_t)2 * M * D * 2 <= WS_END, "ws map");

constexpr int CW_BAR = 0;
constexpr int CW_CNT = 8192;
constexpr int CW_Q = 8192 + 1024;

constexpr int NTHR = 512, NWAVES = 8;
constexpr int LDS_BYTES = 155648;
constexpr int GEMM_LDS = 131072;
constexpr int MISC_OFF = 147456;

__device__ __forceinline__ float bf2f(unsigned short b) { return __uint_as_float((unsigned)b << 16); }
__device__ __forceinline__ unsigned pk2(float lo, float hi) { f32x2 v = {lo, hi}; bf16x2_t b = __builtin_convertvector(v, bf16x2_t); return __builtin_bit_cast(unsigned, b); }
__device__ __forceinline__ float lo16(unsigned u) { return __uint_as_float(u << 16); }
__device__ __forceinline__ float hi16(unsigned u) { return __uint_as_float(u & 0xffff0000u); }
#define DPP(v, ctrl) __builtin_bit_cast(float, __builtin_amdgcn_update_dpp(__builtin_bit_cast(int, v), __builtin_bit_cast(int, v), (ctrl), 0xF, 0xF, false))
__device__ __forceinline__ float red8(float v) { v += DPP(v, 0xB1); v += DPP(v, 0x4E); v += DPP(v, 0x141); return v; }
__device__ __forceinline__ float red16(float v) { v = red8(v); v += DPP(v, 0x140); return v; }
__device__ __forceinline__ float red64(float v) { v = red16(v); v += __shfl_xor(v, 16); v += __shfl_xor(v, 32); return v; }
__device__ __forceinline__ float sigmoidf_(float x) { return __builtin_amdgcn_rcpf(1.0f + __expf(-x)); }
__device__ __forceinline__ float log1p_fast(float y) { return (y < 0.06f) ? y * (1.0f + y * (-0.5f + y * (0.33333334f + y * (-0.25f + y * (0.2f - y * 0.16666667f))))) : __logf(1.0f + y); }
__device__ __forceinline__ float softplusf_(float x) { return x > 20.f ? x : log1p_fast(__expf(x)); }

#define XB_TMO      128
#define XB_XCNT(j)  (256  + 64 * (j))
#define XB_XSUB(j)  (1280 + 64 * (j))
#define XB_XGEN(j)  (2304 + 64 * (j))
#define XB_TOP      3328
#define XB_TOPGEN   3392
#define XCD_BAR_WORDS 3456
#define XB_SPIN_CAP (1u << 22)
__device__ __forceinline__ unsigned xb_ld(unsigned* p)              { return __hip_atomic_load(p, __ATOMIC_RELAXED, __HIP_MEMORY_SCOPE_AGENT); }
__device__ __forceinline__ unsigned xb_add(unsigned* p, unsigned v) { return __hip_atomic_fetch_add(p, v, __ATOMIC_RELAXED, __HIP_MEMORY_SCOPE_AGENT); }
__device__ __forceinline__ unsigned xb_xcc_id() { return (unsigned)__builtin_amdgcn_s_getreg((3 << 11) | 20) & 0xFu; }
#define XB_SPIN(cond, bar) do { unsigned _sp = 0; while (cond) { __builtin_amdgcn_s_sleep(1); \
    if ((++_sp & 255u) == 0u) { if (xb_ld(&(bar)[XB_TMO])) break; if (_sp > XB_SPIN_CAP) { atomicAdd(&(bar)[XB_TMO], 1u); break; } } } } while (0)
struct XcdBarrier { unsigned* bar; unsigned x; volatile LAS unsigned* st; };
__device__ __forceinline__ XcdBarrier xcd_barrier_post(const int tid, unsigned* bar, volatile LAS unsigned* st) {
    XcdBarrier b; b.bar = bar; b.x = xb_xcc_id(); b.st = st;
    if (tid == 0) (void)xb_add(&bar[XB_XCNT(b.x)], 1u);
    return b;
}
__device__ __forceinline__ void xcd_barrier_complete(unsigned* bar, unsigned x, unsigned& nloc, unsigned& nx) {
    const unsigned G = gridDim.x * gridDim.y * gridDim.z;
    unsigned sum, cnt, mine, sp = 0u;
    for (;;) {
        sum = 0u; cnt = 0u; mine = 0u;
#pragma unroll
        for (unsigned j = 0; j < 16; ++j) { const unsigned c = xb_ld(&bar[XB_XCNT(j)]); sum += c; cnt += (c > 0u) ? 1u : 0u; mine = (j == x) ? c : mine; }
        if (sum == G) break;
        __builtin_amdgcn_s_sleep(1);
        if ((++sp & 255u) == 0u) { if (xb_ld(&bar[XB_TMO])) break; if (sp > XB_SPIN_CAP) { atomicAdd(&bar[XB_TMO], 1u); break; } }
    }
    nloc = mine > 0u ? mine : 1u; nx = cnt > 0u ? cnt : 1u;
}
__device__ __forceinline__ void xcd_barrier(const int tid, const XcdBarrier& b) {
    asm volatile("s_waitcnt vmcnt(0)" ::: "memory");
    __syncthreads();
    if (tid == 0) {
        unsigned* bar = b.bar;
        __builtin_amdgcn_s_waitcnt(0);
        unsigned nloc = b.st[0], nx = b.st[1];
        if (nloc == 0u) { xcd_barrier_complete(bar, b.x, nloc, nx); b.st[0] = nloc; b.st[1] = nx; }
        const unsigned old = xb_add(&bar[XB_XSUB(b.x)], 1u);
        const unsigned gen = old / nloc;
        if (old + 1u == (gen + 1u) * nloc) {
            __builtin_amdgcn_fence(__ATOMIC_RELEASE, "agent");
            asm volatile("s_waitcnt vmcnt(0)" ::: "memory");
            const unsigned og = xb_add(&bar[XB_TOP], 1u);
            const unsigned tg = og / nx;
            if (og + 1u == (tg + 1u) * nx) xb_add(&bar[XB_TOPGEN], 1u);
            else XB_SPIN(xb_ld(&bar[XB_TOPGEN]) == tg, bar);
            __builtin_amdgcn_fence(__ATOMIC_ACQUIRE, "agent");
            xb_add(&bar[XB_XGEN(b.x)], 1u);
            asm volatile("s_waitcnt vmcnt(0)" ::: "memory");
        } else {
            XB_SPIN(xb_ld(&bar[XB_XGEN(b.x)]) == gen, bar);
            __builtin_amdgcn_fence(__ATOMIC_ACQUIRE, "agent");
            asm volatile("s_waitcnt vmcnt(0)" ::: "memory");
        }
    }
    __syncthreads();
}

namespace pg8 {
constexpr int BM = 256, BK = 64, HALF = 128, HTB = HALF * BK * 2, STAGE_BYTES = 8 * HTB;
__host__ __device__ __forceinline__ int lds_byte(int r, int c) { const int st = (r >> 4) * 2 + (c >> 5), rr = r & 15, cc = c & 31, ob = rr * 64 + cc * 2; return st * 1024 + (ob ^ (((ob >> 9) & 1) << 5)); }
__host__ __device__ __forceinline__ void stage_rc(int b, int& R, int& C) { const int st = b / 1024, sb = b % 1024, swz = sb ^ (((sb >> 9) & 1) << 5); R = (st >> 1) * 16 + swz / 64; C = (st & 1) * 32 + (swz % 64) / 2; }
__host__ __device__ __forceinline__ int perm32(int rho) { const int n = rho >> 4, i = rho & 15; return 8 * (i >> 2) + 4 * n + (i & 3); }

struct Unit { int pm, pn, e, j; };
template <class Epi, class Sched, bool ALIGN_EPI>
__device__ __forceinline__ void gemm_phase(const int tid, LAS unsigned char* lds, const char* Abase, const int K, const Sched& S, const Epi& E) {
    const int wid = __builtin_amdgcn_readfirstlane(tid >> 6), lane = tid & 63, wr = wid >> 2, wc = wid & 3, fr = lane & 15, fq = lane >> 4;
    const int nt = K / BK;
    int R0, C0; stage_rc(tid * 16, R0, C0);
    const int Rb0 = (R0 & ~31) + perm32(R0 & 31);
    unsigned voffB[2]; voffB[0] = (unsigned)(Rb0 * K + C0) * 2u; voffB[1] = (unsigned)((Rb0 + 64) * K + C0) * 2u;
    unsigned voffA[2]; voffA[0] = (unsigned)(R0 * K + C0) * 2u; voffA[1] = (unsigned)((R0 + 64) * K + C0) * 2u;
    const unsigned colA = (unsigned)C0 * 2u;
    const size_t kstep = (size_t)(BK * 2);
    const size_t hstepB = (size_t)HALF * K * 2, hstepA = hstepB;
    const unsigned ldsw = (unsigned)wid * 1024u;
    const int aoff = lds_byte(wr * 64 + fr, fq * 8), boff = lds_byte(wc * 32 + fr, fq * 8);
#define PG8_SA(b, h) (((b) * 2 + (h)) * HTB)
#define PG8_SB(b, h) ((4 + (b) * 2 + (h)) * HTB)
#define PG8_STAGE_B(bufoff, gbase) do { _Pragma("unroll") for (int _i = 0; _i < 2; ++_i) \
        __builtin_amdgcn_global_load_lds((const unsigned*)((const char*)(gbase) + voffB[_i]), (LAS unsigned*)(lds + (bufoff) + ldsw + _i * 8192), 16, 0, 0); } while (0)
#define PG8_STAGE_A(bufoff, h, kbyte, nx) do { \
        if constexpr (Sched::GATHER) { _Pragma("unroll") for (int _i = 0; _i < 2; ++_i) { const unsigned _o = (nx) ? na[h][_i] : ca[h][_i]; \
            __builtin_amdgcn_global_load_lds((const unsigned*)(Abase + (kbyte) + _o), (LAS unsigned*)(lds + (bufoff) + ldsw + _i * 8192), 16, 0, 0); } } \
        else { const char* _p = ((nx) ? nA : cA) + (kbyte) + (size_t)(h) * hstepA; _Pragma("unroll") for (int _i = 0; _i < 2; ++_i) \
            __builtin_amdgcn_global_load_lds((const unsigned*)(_p + voffA[_i]), (LAS unsigned*)(lds + (bufoff) + ldsw + _i * 8192), 16, 0, 0); } } while (0)
#define PG8_LDA(dst, b, h) do { _Pragma("unroll") for (int m = 0; m < 4; ++m) _Pragma("unroll") for (int k = 0; k < 2; ++k) dst[m][k] = *(const LAS bf16x8*)(lds + PG8_SA(b, h) + aoff + m * 2048 + k * 1024); } while (0)
#define PG8_LDB(dst, b, h) do { _Pragma("unroll") for (int n = 0; n < 2; ++n) _Pragma("unroll") for (int k = 0; k < 2; ++k) dst[n][k] = *(const LAS bf16x8*)(lds + PG8_SB(b, h) + boff + n * 2048 + k * 1024); } while (0)
#define PG8_MMA(ai, bj, At, Bt) do { __builtin_amdgcn_s_setprio(1); _Pragma("unroll") for (int m = 0; m < 4; ++m) _Pragma("unroll") for (int n = 0; n < 2; ++n) _Pragma("unroll") for (int k = 0; k < 2; ++k) \
        acc[ai][bj][m][n] = __builtin_amdgcn_mfma_f32_16x16x32_bf16(Bt[n][k], At[m][k], acc[ai][bj][m][n], 0, 0, 0); __builtin_amdgcn_s_setprio(0); } while (0)
#define PG8_WAIT_V(n) asm volatile("s_waitcnt vmcnt(" #n ")" ::: "memory")
#define PG8_WAIT_L(n) asm volatile("s_waitcnt lgkmcnt(" #n ")" ::: "memory")
#define PG8_BAR __builtin_amdgcn_s_barrier()
#define PG8_SCHED __builtin_amdgcn_sched_barrier(0)
    Unit cur, nxt; int ui = 0;
    if (!S.next(0, cur)) return;
    unsigned ca[2][2], na[2][2];
    const char* cA = Abase; const char* nA = Abase;
    if constexpr (Sched::GATHER) S.aoffs(cur, R0, colA, ca); else cA = Abase + (size_t)S.arow0(cur) * K * 2;
    f32x4 acc[2][2][4][2];
#pragma unroll
    for (int a = 0; a < 2; ++a)
#pragma unroll
        for (int b = 0; b < 2; ++b)
#pragma unroll
            for (int m = 0; m < 4; ++m)
#pragma unroll
                for (int n = 0; n < 2; ++n) acc[a][b][m][n] = (f32x4){0.f, 0.f, 0.f, 0.f};
    bf16x8 At[4][2], B0[2][2], B1[2][2];
    const char* cB = S.bbase(cur);
    PG8_STAGE_B(PG8_SB(0, 0), cB); PG8_STAGE_B(PG8_SB(0, 1), cB + hstepB); PG8_STAGE_A(PG8_SA(0, 0), 0, 0, false); PG8_STAGE_A(PG8_SA(0, 1), 1, 0, false);
    if (wr == 1) PG8_BAR;
    PG8_WAIT_V(2); PG8_BAR;
    PG8_STAGE_B(PG8_SB(1, 0), cB + kstep); PG8_STAGE_A(PG8_SA(1, 0), 0, kstep, false); PG8_STAGE_B(PG8_SB(1, 1), cB + hstepB + kstep);
    PG8_WAIT_V(6); PG8_BAR;
    for (;;) {
        const bool has_next = S.next(ui + 1, nxt);
        const char* nB = cB;
        nA = cA;
        if (has_next) { nB = S.bbase(nxt); if constexpr (Sched::GATHER) S.aoffs(nxt, R0, colA, na); else nA = Abase + (size_t)S.arow0(nxt) * K * 2; }
        else if constexpr (Sched::GATHER) { na[0][0] = ca[0][0]; na[0][1] = ca[0][1]; na[1][0] = ca[1][0]; na[1][1] = ca[1][1]; }
        for (int t = 0; t < nt; t += 2) {
            const bool last = (t == nt - 2);
            const size_t k1 = (size_t)(t + 1) * kstep;
            const size_t k2 = last ? 0 : (size_t)(t + 2) * kstep, k3 = k2 + kstep;
            const char* b2 = last ? nB : cB + (size_t)(t + 2) * kstep; const char* b3 = b2 + kstep;
            PG8_LDB(B0, 0, 0); PG8_LDB(B1, 0, 1); PG8_SCHED; PG8_LDA(At, 0, 0); PG8_STAGE_A(PG8_SA(1, 1), 1, k1, false);
            PG8_WAIT_V(8); PG8_WAIT_L(0); PG8_BAR; PG8_MMA(0, 0, At, B0); PG8_MMA(0, 1, At, B1); PG8_BAR; PG8_SCHED;
            PG8_LDA(At, 0, 1); PG8_STAGE_B(PG8_SB(0, 0), b2); PG8_STAGE_B(PG8_SB(0, 1), b2 + hstepB); PG8_STAGE_A(PG8_SA(0, 0), 0, k2, last);
            PG8_WAIT_V(8); PG8_WAIT_L(0); PG8_BAR; PG8_MMA(1, 0, At, B0); PG8_MMA(1, 1, At, B1); PG8_BAR; PG8_SCHED;
            PG8_LDB(B0, 1, 0); PG8_LDB(B1, 1, 1); PG8_SCHED; PG8_LDA(At, 1, 0); PG8_STAGE_A(PG8_SA(0, 1), 1, k2, last);
            PG8_WAIT_V(8); PG8_WAIT_L(0); PG8_BAR; PG8_MMA(0, 0, At, B0); PG8_MMA(0, 1, At, B1); PG8_BAR; PG8_SCHED;
            PG8_LDA(At, 1, 1); PG8_STAGE_B(PG8_SB(1, 0), b3); PG8_STAGE_B(PG8_SB(1, 1), b3 + hstepB); PG8_STAGE_A(PG8_SA(1, 0), 0, k3, last);
            PG8_WAIT_V(8); PG8_WAIT_L(0); PG8_BAR; PG8_MMA(1, 0, At, B0); PG8_MMA(1, 1, At, B1); PG8_BAR; PG8_SCHED;
        }
        if constexpr (ALIGN_EPI) { if (wr == 0) PG8_BAR; }
        E(acc, cur, wr, wc, fr, fq);
        if (!has_next) break;
#pragma unroll
        for (int a = 0; a < 2; ++a)
#pragma unroll
            for (int b = 0; b < 2; ++b)
#pragma unroll
                for (int m = 0; m < 4; ++m)
#pragma unroll
                    for (int n = 0; n < 2; ++n) acc[a][b][m][n] = (f32x4){0.f, 0.f, 0.f, 0.f};
        cur = nxt; cB = nB; cA = nA; ++ui;
        if constexpr (Sched::GATHER) { ca[0][0] = na[0][0]; ca[0][1] = na[0][1]; ca[1][0] = na[1][0]; ca[1][1] = na[1][1]; }
        if constexpr (ALIGN_EPI) { if (wr == 1) PG8_BAR; }
    }
    PG8_WAIT_V(0);
    if constexpr (!ALIGN_EPI) { if (wr == 0) PG8_BAR; }
    PG8_BAR;
#undef PG8_SA
#undef PG8_SB
#undef PG8_STAGE_A
#undef PG8_STAGE_B
#undef PG8_LDA
#undef PG8_LDB
#undef PG8_MMA
#undef PG8_WAIT_V
#undef PG8_WAIT_L
#undef PG8_BAR
#undef PG8_SCHED
}

struct DenseOrder {
    static constexpr bool GATHER = false;
    int nM, nN, nwg, G, c, K; const char* Bt;
    __device__ __forceinline__ int arow0(const Unit& u) const { return u.pm * BM; }
    __device__ __forceinline__ void init(int M_, int N_, int K_, int G_, int c_, const void* Bt_) { nM = M_ / BM; nN = N_ / BM; nwg = nM * nN; G = G_; c = c_; K = K_; Bt = (const char*)Bt_; }
    __device__ __forceinline__ bool next(int i, Unit& u) const {
        const long L = (long)i * G + c; if (L >= nwg) return false;
        int wgid = (int)L; { const int q = nwg / 8, r = nwg % 8, xcd = wgid % 8, off = wgid / 8; wgid = (xcd < r ? xcd * (q + 1) : r * (q + 1) + (xcd - r) * q) + off; }
        const int nig = 8 * nN, gid = wgid / nig, fm = gid * 8, gsz = (nM - fm) < 8 ? (nM - fm) : 8;
        u.pm = fm + ((wgid % nig) % gsz); u.pn = (wgid % nig) / gsz; u.e = 0; u.j = 0; return true;
    }
    __device__ __forceinline__ void aoffs(const Unit& u, int R0, unsigned colA, unsigned (&o)[2][2]) const {
#pragma unroll
        for (int h = 0; h < 2; ++h)
#pragma unroll
            for (int i = 0; i < 2; ++i) o[h][i] = (unsigned)(u.pm * BM + h * HALF + R0 + 64 * i) * (unsigned)(K * 2) + colA;
    }
    __device__ __forceinline__ const char* bbase(const Unit& u) const { return Bt + (size_t)u.pn * BM * K * 2; }
};
template <bool GATHER_>
struct MoeOrder {
    static constexpr bool GATHER = GATHER_;
    __device__ __forceinline__ int arow0(const Unit& u) const { return u.pm * BM; }
    const LAS int* tab;
    int G, c, K, nN; const char* Bt; size_t estride;
    const int* list;
    __device__ __forceinline__ bool next(int i, Unit& u) const {
        const int L = i * G + c; const int nb = tab[16];
        if (L >= nb * nN) return false;
        const int rb = L / nN; u.pn = L % nN; u.pm = rb;
        int e = 0;
#pragma unroll
        for (int k = 1; k < 16; ++k) e += (rb >= tab[k]) ? 1 : 0;
        u.e = e; u.j = rb - tab[e]; return true;
    }
    __device__ __forceinline__ void aoffs(const Unit& u, int R0, unsigned colA, unsigned (&o)[2][2]) const {
        const int cnt = tab[32 + u.e];
#pragma unroll
        for (int h = 0; h < 2; ++h)
#pragma unroll
            for (int i = 0; i < 2; ++i) {
                const int r = h * HALF + R0 + 64 * i;
                const int pos = u.j * BM + r; const unsigned row = (pos < cnt) ? (unsigned)(list[(size_t)u.e * LCAP + pos] >> 1) : 0u;
                o[h][i] = row * (unsigned)(K * 2) + colA;
            }
    }
    __device__ __forceinline__ const char* bbase(const Unit& u) const { return Bt + (size_t)u.e * estride + (size_t)u.pn * BM * K * 2; }
};

__device__ __forceinline__ u32x4 pack8(const f32x4 v0, const f32x4 v1) { u32x4 w; w.x = pk2(v0[0], v0[1]); w.y = pk2(v0[2], v0[3]); w.z = pk2(v1[0], v1[1]); w.w = pk2(v1[2], v1[3]); return w; }
struct EpiIn {
    bf16* O;
    __device__ __forceinline__ void operator()(const f32x4 (&acc)[2][2][4][2], const Unit& u, int wr, int wc, int fr, int fq) const {
        const int row0 = u.pm * BM + wr * 64 + fr, col0 = u.pn * BM + wc * 32 + 8 * fq;
#pragma unroll
        for (int ai = 0; ai < 2; ++ai)
#pragma unroll
            for (int m = 0; m < 4; ++m) { bf16* rowp = O + (size_t)(row0 + ai * HALF + m * 16) * INC + col0;
#pragma unroll
                for (int bj = 0; bj < 2; ++bj) { const int c = col0 + bj * HALF; const float sc = (c >= PC_SQ && c < PC_SK) ? C2 : 1.0f;
                    *(u32x4*)(rowp + bj * HALF) = pack8(acc[ai][bj][m][0] * sc, acc[ai][bj][m][1] * sc); } }
    }
};
struct EpiOut {
    const bf16* X; bf16* O;
    __device__ __forceinline__ void operator()(const f32x4 (&acc)[2][2][4][2], const Unit& u, int wr, int wc, int fr, int fq) const {
        const int row0 = u.pm * BM + wr * 64 + fr, col0 = u.pn * BM + wc * 32 + 8 * fq;
#pragma unroll
        for (int ai = 0; ai < 2; ++ai)
#pragma unroll
            for (int m = 0; m < 4; ++m) { const size_t off = (size_t)(row0 + ai * HALF + m * 16) * D + col0;
#pragma unroll
                for (int bj = 0; bj < 2; ++bj) { const u32x4 xv = *(const u32x4*)(X + off + bj * HALF);
                    f32x4 v0 = acc[ai][bj][m][0], v1 = acc[ai][bj][m][1];
                    v0[0] += ALPHA * lo16(xv.x); v0[1] += ALPHA * hi16(xv.x); v0[2] += ALPHA * lo16(xv.y); v0[3] += ALPHA * hi16(xv.y);
                    v1[0] += ALPHA * lo16(xv.z); v1[1] += ALPHA * hi16(xv.z); v1[2] += ALPHA * lo16(xv.w); v1[3] += ALPHA * hi16(xv.w);
                    *(u32x4*)(O + off + bj * HALF) = pack8(v0, v1); } }
    }
};
struct EpiMoe1 {
    bf16* Hb;
    __device__ __forceinline__ void operator()(const f32x4 (&acc)[2][2][4][2], const Unit& u, int wr, int wc, int fr, int fq) const {
        const int row0 = u.pm * BM + wr * 64 + fr, col0 = u.pn * HALF + wc * 32 + 8 * fq;
#pragma unroll
        for (int ai = 0; ai < 2; ++ai)
#pragma unroll
            for (int m = 0; m < 4; ++m) {
                f32x4 g0 = acc[ai][0][m][0], g1 = acc[ai][0][m][1]; const f32x4 u0 = acc[ai][1][m][0], u1 = acc[ai][1][m][1];
#pragma unroll
                for (int q = 0; q < 4; ++q) { g0[q] = g0[q] * sigmoidf_(g0[q]) * u0[q]; g1[q] = g1[q] * sigmoidf_(g1[q]) * u1[q]; }
                *(u32x4*)(Hb + (size_t)(row0 + ai * HALF + m * 16) * DE + col0) = pack8(g0, g1); }
    }
};
struct EpiMoe2 {
    bf16* Y;
    __device__ __forceinline__ void operator()(const f32x4 (&acc)[2][2][4][2], const Unit& u, int wr, int wc, int fr, int fq) const {
        const int row0 = u.pm * BM + wr * 64 + fr, col0 = u.pn * BM + wc * 32 + 8 * fq;
#pragma unroll
        for (int ai = 0; ai < 2; ++ai)
#pragma unroll
            for (int m = 0; m < 4; ++m) { bf16* rowp = Y + (size_t)(row0 + ai * HALF + m * 16) * D + col0;
#pragma unroll
                for (int bj = 0; bj < 2; ++bj) *(u32x4*)(rowp + bj * HALF) = pack8(acc[ai][bj][m][0], acc[ai][bj][m][1]); }
    }
};
}

struct Args {
    const float* in[32]; float* out; unsigned char* ws;
    int l_lo, l_hi, ph_lo, ph_hi;
    int use_bar, pad;
};
enum { I_X = 0, I_WIN, I_MU, I_W0, I_WUP, I_A0, I_AUP, I_GUP, I_KK, I_KA, I_RK, I_LNG, I_LNB, I_CW, I_CB, I_WA, I_BA, I_WX, I_BX, I_LAM, I_LRUG, I_SBAG,
       I_WOUT, I_LN1G, I_LN1B, I_LN2G, I_LN2B, I_RW, I_RB, I_EG, I_EU, I_ED };
constexpr int NPH = 10;

__device__ __forceinline__ void transpose_item(const float* W, int N, bf16* WT, int pitch, int drow0, int k0, int n0, float* scr, int lane) {
#pragma unroll 8
    for (int i = 0; i < 32; ++i) { const int kk = 2 * i + (lane >> 5); scr[kk * 33 + (lane & 31)] = W[(size_t)(k0 + kk) * N + n0 + (lane & 31)]; }
    asm volatile("s_waitcnt lgkmcnt(0)" ::: "memory");
    const int c = lane & 7;
#pragma unroll
    for (int j = 0; j < 4; ++j) { const int n = (lane >> 3) + 8 * j; const float* s = scr + (8 * c) * 33 + n;
        u32x4 o; o.x = pk2(s[0 * 33], s[1 * 33]); o.y = pk2(s[2 * 33], s[3 * 33]); o.z = pk2(s[4 * 33], s[5 * 33]); o.w = pk2(s[6 * 33], s[7 * 33]);
        *(u32x4*)(WT + (size_t)(drow0 + n) * pitch + k0 + 8 * c) = o; }
    asm volatile("s_waitcnt lgkmcnt(0)" ::: "memory");
}
__device__ __forceinline__ void phase_convert(const int tid, const Args& A, int layer, float* ldsf, int vcu, int G) {
    const int lane = tid & 63, wave = tid >> 6;
    float* scr = ldsf + wave * 4096;
    unsigned char* ws = A.ws;
    bf16* Win = (bf16*)(ws + WS_WIN); bf16* Wout = (bf16*)(ws + WS_WOUT); bf16* Wgu = (bf16*)(ws + WS_WGU); bf16* Wdn = (bf16*)(ws + WS_WDN);
    bf16* WupT = (bf16*)(ws + WS_WSM); bf16* AupT = WupT + 384 * 64; bf16* GupT = AupT + 384 * 64;
    const int gw = vcu * NWAVES + wave, NGW = G * NWAVES;
    constexpr int I_IN = 16 * 96, I_OUT = 16 * 32, I_G = 16 * 256, I_U = 16 * 256, I_D = 16 * 256, I_S1 = 12, I_S2 = 12, I_S3 = 24, I_S4 = 16;
    constexpr int NIT = I_IN + I_OUT + I_G + I_U + I_D + I_S1 + I_S2 + I_S3 + I_S4;
    for (int it = gw; it < NIT; it += NGW) {
        int r = it;
        if (r < I_IN) { const int kb = r / 96, nb = r % 96; transpose_item(A.in[I_WIN] + (size_t)layer * D * INC, INC, Win, D, 32 * nb, 64 * kb, 32 * nb, scr, lane); continue; } r -= I_IN;
        if (r < I_OUT) { const int kb = r / 32, nb = r % 32; transpose_item(A.in[I_WOUT] + (size_t)layer * D * D, D, Wout, D, 32 * nb, 64 * kb, 32 * nb, scr, lane); continue; } r -= I_OUT;
        if (r < I_G + I_U) { const int up = r >= I_G; if (up) r -= I_G; const int e = r / 256, q = r % 256, kb = q / 16, nb = q % 16, n0 = 32 * nb;
            const float* src = A.in[up ? I_EU : I_EG] + ((size_t)layer * NE + e) * D * DE;
            transpose_item(src, DE, Wgu, D, e * 1024 + (n0 >> 7) * 256 + up * 128 + (n0 & 127), 64 * kb, n0, scr, lane); continue; } r -= I_G + I_U;
        if (r < I_D) { const int e = r / 256, q = r % 256, kb = q / 32, nb = q % 32;
            transpose_item(A.in[I_ED] + ((size_t)layer * NE + e) * DE * D, D, Wdn, DE, e * 1024 + 32 * nb, 64 * kb, 32 * nb, scr, lane); continue; } r -= I_D;
        if (r < I_S1) { transpose_item(A.in[I_WUP] + (size_t)layer * 64 * RW, RW, WupT, 64, 32 * r, 0, 32 * r, scr, lane); continue; } r -= I_S1;
        if (r < I_S2) { transpose_item(A.in[I_AUP] + (size_t)layer * 64 * RW, RW, AupT, 64, 32 * r, 0, 32 * r, scr, lane); continue; } r -= I_S2;
        if (r < I_S3) { const int kb = r / 12, nb = r % 12; transpose_item(A.in[I_GUP] + (size_t)layer * 128 * RW, RW, GupT, 128, 32 * nb, 64 * kb, 32 * nb, scr, lane); continue; } r -= I_S3;
        { const int x = r >> 3, gq = (r >> 1) & 3, nb = r & 1;
          transpose_item(A.in[x ? I_WX : I_WA] + ((size_t)layer * LB + gq) * 4096, 64, GupT + 384 * 128 + x * 16384, 64, gq * 64 + 32 * nb, 0, 32 * nb, scr, lane); }
    }
    if (layer == 0) {
        const f32x4* x4 = (const f32x4*)A.in[I_X]; u32x4* o = (u32x4*)(ws + WS_XB);
        const size_t n8 = (size_t)M * D / 8;
        for (size_t i = (size_t)vcu * NTHR + tid; i < n8; i += (size_t)G * NTHR) { const f32x4 a = x4[2 * i], b = x4[2 * i + 1]; o[i] = pg8::pack8(a, b); }
    }
}

typedef short v4i16_t __attribute__((ext_vector_type(4)));
template <bool MASK>
__device__ __forceinline__ void attn_tile(const bf16* Ks, const bf16* Vs, const bf16x8 (&qr)[4], f32x16& o0, f32x16& o1, float& Rrun, const int k0, const int qmine, const int r, const int hh, const int vtr_off) {
    f32x16 p0 = {}, p1 = {};
#pragma unroll
    for (int s = 0; s < 4; ++s) {
        const bf16x8 ka = *(const bf16x8*)(Ks + r * 72 + 16 * s + 8 * hh);
        const bf16x8 kb = *(const bf16x8*)(Ks + (32 + r) * 72 + 16 * s + 8 * hh);
        p0 = __builtin_amdgcn_mfma_f32_32x32x16_bf16(ka, qr[s], p0, 0, 0, 0);
        p1 = __builtin_amdgcn_mfma_f32_32x32x16_bf16(kb, qr[s], p1, 0, 0, 0);
    }
    float pa[8]; f32x2 va[8], vb[8];
#pragma unroll
    for (int g = 0; g < 8; ++g) {
        float z[4];
#pragma unroll
        for (int i = 0; i < 4; ++i) z[i] = (g < 4) ? p0[4 * g + i] : p1[4 * (g - 4) + i];
        const f32x2 eA = {__builtin_amdgcn_exp2f(z[0]), __builtin_amdgcn_exp2f(z[1])}, eB = {__builtin_amdgcn_exp2f(z[2]), __builtin_amdgcn_exp2f(z[3])};
        const f32x2 dA = eA + 1.0f, dB = eB + 1.0f;
        f32x2 kA = {__builtin_amdgcn_rcpf(dA[0]), __builtin_amdgcn_rcpf(dA[1])}, kB = {__builtin_amdgcn_rcpf(dB[0]), __builtin_amdgcn_rcpf(dB[1])};
        if (MASK) { const int key = k0 + 32 * (g >> 2) + 8 * (g & 3) + 4 * hh;
            kA[0] = (key + 0 >= qmine) ? 1.0f : kA[0]; kA[1] = (key + 1 >= qmine) ? 1.0f : kA[1]; kB[0] = (key + 2 >= qmine) ? 1.0f : kB[0]; kB[1] = (key + 3 >= qmine) ? 1.0f : kB[1]; }
        const f32x2 sA = 1.0f - kA, sB = 1.0f - kB;
        const float x1 = kB[1] * kB[0], x0 = x1 * kA[1];
        pa[g] = x0 * kA[0];
        va[g] = sA * (f32x2){x0, x1}; vb[g] = sB * (f32x2){kB[1], 1.0f};
    }
    float pi[16];
#pragma unroll
    for (int g = 0; g < 8; ++g) { const auto rr = __builtin_amdgcn_permlane32_swap(__float_as_uint(pa[g]), __float_as_uint(pa[g]), false, false);
        pi[2 * g] = __uint_as_float(rr[0]); pi[2 * g + 1] = __uint_as_float(rr[1]); }
    float S[16];
    S[15] = Rrun;
#pragma unroll
    for (int j = 14; j >= 0; --j) S[j] = S[j + 1] * pi[j + 1];
    Rrun = S[0] * pi[0];
#pragma unroll
    for (int g = 0; g < 8; ++g) {
        const float re = hh ? S[2 * g + 1] : S[2 * g];
        va[g] = va[g] * re; vb[g] = vb[g] * re;
    }
#pragma unroll
    for (int s = 0; s < 4; ++s) {
        u32x4 pw;
        pw.x = pk2(va[2 * s][0], va[2 * s][1]); pw.y = pk2(vb[2 * s][0], vb[2 * s][1]); pw.z = pk2(va[2 * s + 1][0], va[2 * s + 1][1]); pw.w = pk2(vb[2 * s + 1][0], vb[2 * s + 1][1]);
        const bf16x8 pf = __builtin_bit_cast(bf16x8, pw);
        const bf16* vbp = Vs + 16 * s * 72 + vtr_off;
        { const v4i16_t lo = __builtin_amdgcn_ds_read_tr16_b64_v4i16((LAS v4i16_t*)(vbp)), hi = __builtin_amdgcn_ds_read_tr16_b64_v4i16((LAS v4i16_t*)(vbp + 8 * 72));
          const bf16x8 vf = __builtin_shufflevector(lo, hi, 0, 1, 2, 3, 4, 5, 6, 7);
          o0 = __builtin_amdgcn_mfma_f32_32x32x16_bf16(vf, pf, o0, 0, 0, 0); }
        { const v4i16_t lo = __builtin_amdgcn_ds_read_tr16_b64_v4i16((LAS v4i16_t*)(vbp + 32)), hi = __builtin_amdgcn_ds_read_tr16_b64_v4i16((LAS v4i16_t*)(vbp + 8 * 72 + 32));
          const bf16x8 vf = __builtin_shufflevector(lo, hi, 0, 1, 2, 3, 4, 5, 6, 7);
          o1 = __builtin_amdgcn_mfma_f32_32x32x16_bf16(vf, pf, o1, 0, 0, 0); }
    }
}
__device__ __forceinline__ void attn_unit(const int tid_in, const Args& A, int layer, int bh, int qb, unsigned char* lds) {
    int tid = tid_in; asm volatile("" : "+v"(tid));
    const int lane = tid & 63, wave = __builtin_amdgcn_readfirstlane(tid >> 6), r = lane & 31, hh = lane >> 5;
    const int b = bh / SH, h = bh % SH;
    const bf16* P = (const bf16*)(A.ws + WS_P) + (size_t)b * SEQ * INC;
    bf16* MIX = (bf16*)(A.ws + WS_MIX) + (size_t)b * SEQ * D;
    bf16* KV = (bf16*)lds;
    constexpr int SLOT = 2 * 64 * 72;
    const int q0w = qb * 256 + wave * 32;
    bf16x8 qr[4];
#pragma unroll
    for (int s = 0; s < 4; ++s) qr[s] = *(const bf16x8*)(P + (size_t)(q0w + r) * INC + PC_SQ + h * 64 + 16 * s + 8 * hh);
    f32x16 o0 = {}, o1 = {};
    float Rrun = 1.0f;
    const int qmine = q0w + r;
    const int lkey = tid >> 3, lch = (tid & 7) * 8;
    const int NT = 4 * qb + 4;
    const int g16 = lane >> 4, i16 = lane & 15;
    const int vtr_off = (4 * (g16 >> 1) + (i16 >> 2)) * 72 + 16 * (g16 & 1) + 4 * (i16 & 3);
    u32x4 kreg, vreg;
    { const int jt0 = NT - 1;
      kreg = *(const u32x4*)(P + (size_t)(64 * jt0 + lkey) * INC + PC_SK + h * 64 + lch);
      vreg = *(const u32x4*)(P + (size_t)(64 * jt0 + lkey) * INC + PC_SV + h * 64 + lch); }
    __syncthreads();
    { bf16* s0 = KV + ((NT - 1) & 1) * SLOT; *(u32x4*)(s0 + lkey * 72 + lch) = kreg; *(u32x4*)(s0 + 64 * 72 + lkey * 72 + lch) = vreg; }
    if (NT >= 2) { const int jt1 = NT - 2;
      kreg = *(const u32x4*)(P + (size_t)(64 * jt1 + lkey) * INC + PC_SK + h * 64 + lch);
      vreg = *(const u32x4*)(P + (size_t)(64 * jt1 + lkey) * INC + PC_SV + h * 64 + lch); }
    asm volatile("s_waitcnt lgkmcnt(0)\n\ts_barrier" ::: "memory");
    for (int jt = NT - 1; jt >= 0; --jt) {
        const bf16* Ks = KV + (jt & 1) * SLOT; const bf16* Vs = Ks + 64 * 72;
        if (jt >= 1) {
            bf16* sn = KV + ((jt - 1) & 1) * SLOT;
            *(u32x4*)(sn + lkey * 72 + lch) = kreg; *(u32x4*)(sn + 64 * 72 + lkey * 72 + lch) = vreg;
            if (jt >= 2) {
                kreg = *(const u32x4*)(P + (size_t)(64 * (jt - 2) + lkey) * INC + PC_SK + h * 64 + lch);
                vreg = *(const u32x4*)(P + (size_t)(64 * (jt - 2) + lkey) * INC + PC_SV + h * 64 + lch);
            }
        }
        const int k0 = 64 * jt;
        if (k0 < q0w + 31) {
            if (k0 + 63 >= q0w) attn_tile<true>(Ks, Vs, qr, o0, o1, Rrun, k0, qmine, r, hh, vtr_off);
            else attn_tile<false>(Ks, Vs, qr, o0, o1, Rrun, k0, qmine, r, hh, vtr_off);
        }
        int* dflag = (int*)(KV + 2 * SLOT) + (jt & 1) * 8;
        { const bool mydone = __all(Rrun == 0.0f); if (lane == 0) dflag[wave] = mydone ? 1 : 0; }
        asm volatile("s_waitcnt lgkmcnt(0)\n\ts_barrier" ::: "memory");
        { const u32x4 f0 = *(const u32x4*)dflag, f1 = *(const u32x4*)(dflag + 4);
          if ((f0.x & f0.y & f0.z & f0.w & f1.x & f1.y & f1.z & f1.w) != 0u) break; }
    }
    float ss = 0.f;
#pragma unroll
    for (int i = 0; i < 16; ++i) ss += o0[i] * o0[i] + o1[i] * o1[i];
    ss += __shfl_xor(ss, 32);
    const float sc = rsqrtf(ss * (1.0f / 64.0f) + RMS_EPS);
    const float* ng = A.in[I_SBAG] + layer * SW + h * 64;
    bf16* orow = MIX + (size_t)(q0w + r) * D + MIX_S + h * 64;
#pragma unroll
    for (int g = 0; g < 4; ++g) {
        const int d = 8 * g + 4 * hh;
        const f32x4 g0 = *(const f32x4*)(ng + d), g1 = *(const f32x4*)(ng + 32 + d);
        u32x2 w0, w1;
        w0.x = pk2(o0[4 * g] * sc * g0[0], o0[4 * g + 1] * sc * g0[1]); w0.y = pk2(o0[4 * g + 2] * sc * g0[2], o0[4 * g + 3] * sc * g0[3]);
        w1.x = pk2(o1[4 * g] * sc * g1[0], o1[4 * g + 1] * sc * g1[1]); w1.y = pk2(o1[4 * g + 2] * sc * g1[2], o1[4 * g + 3] * sc * g1[3]);
        *(u32x2*)(orow + d) = w0; *(u32x2*)(orow + 32 + d) = w1;
    }
}

constexpr int CP = 72;
constexpr size_t SC_MP = 0, SC_NN = 48 * MiB, SC_QH = 96 * MiB, SC_OL = 144 * MiB, SC_HS = 192 * MiB;
constexpr size_t WS_G = 836 * MiB, WS_RHO = 884 * MiB, WS_GC = 886 * MiB;
__device__ __forceinline__ f32x16 mm32(const bf16* X, const bf16* Y, int lane, f32x16 acc) {
    const int r = lane & 31, hh = lane >> 5;
#pragma unroll
    for (int s_ = 0; s_ < 4; ++s_) {
        const bf16x8 a = *(const bf16x8*)(X + r * CP + 16 * s_ + 8 * hh);
        const bf16x8 b = *(const bf16x8*)(Y + r * CP + 16 * s_ + 8 * hh);
        acc = __builtin_amdgcn_mfma_f32_32x32x16_bf16(a, b, acc, 0, 0, 0);
    }
    return acc;
}
__device__ __forceinline__ u32x4 packfrag(const f32x16& a, int sp) {
    u32x4 w;
    if (sp == 0) { w.x = pk2(a[0], a[1]); w.y = pk2(a[2], a[3]); w.z = pk2(a[4], a[5]); w.w = pk2(a[6], a[7]); }
    else { w.x = pk2(a[8], a[9]); w.y = pk2(a[10], a[11]); w.z = pk2(a[12], a[13]); w.w = pk2(a[14], a[15]); }
    return w;
}
struct R1Pre { u32x4 cu[4], pv[4]; };
__device__ __forceinline__ void rwkv_r1_prefetch(const int tid, const Args& A, int b, int c, R1Pre& pf) {
    const int t0 = c * 64;
    const bf16* P = (const bf16*)(A.ws + WS_P) + (size_t)b * SEQ * INC;
#pragma unroll
    for (int q = 0; q < 4; ++q) {
        const int item = tid + NTHR * q, tok = item >> 5, cc = (item & 31) * 8, pc = PC_DW + cc, t = t0 + tok;
        pf.cu[q] = *(const u32x4*)(P + (size_t)t * INC + pc);
        pf.pv[q] = (u32x4){0u, 0u, 0u, 0u};
        if (t > 0) pf.pv[q] = *(const u32x4*)(P + (size_t)(t - 1) * INC + pc);
    }
}
__device__ __forceinline__ void rwkv_r1_unit(const int tid_in, const Args& A, int layer, int uidx, unsigned char* lds, R1Pre& pf, const bool first, const int stop = 99) {
    int tid = tid_in; asm volatile("" : "+v"(tid));
    const int lane = tid & 63, wave = __builtin_amdgcn_readfirstlane(tid >> 6), r31 = lane & 31, hh = lane >> 5;
    const int head = uidx >> 6, c = uidx & 63, b = head / RH, h = head % RH, t0 = c * 64;
    const size_t brow = (size_t)b * SEQ;
    const bf16* P = (const bf16*)(A.ws + WS_P) + brow * INC;
    float* wS = (float*)lds; float* aS = wS + 4096; float* gS = aS + 4096;
    bf16* AAB = (bf16*)lds; bf16* AAK = AAB + 64 * CP; bf16* ARB = AAK + 64 * CP; bf16* ARK = ARB + 64 * CP;
    bf16* TM = ARK + 64 * CP; bf16* TMt = TM + 64 * CP; bf16* X1t = TMt + 64 * CP;
    unsigned char* ob = lds + 7 * 64 * CP * 2;
    bf16* AL = (bf16*)ob;
    bf16* AH = (bf16*)ob; bf16* QT = AH + 64 * CP; bf16* BH = QT + 64 * CP; bf16* KH = BH + 64 * CP;
    bf16* BHt = KH + 64 * CP; bf16* KHt = BHt + 64 * CP; bf16* Vt = KHt + 64 * CP; bf16* AHt = Vt + 64 * CP;
    bf16* WTt = KH; bf16* UTt = AH;
    float* segT = (float*)(ob + 8 * 64 * CP * 2);
    float* gCs = segT + 512;
    bf16* PTs = (bf16*)(gCs + 64);
    const float* mu = A.in[I_MU] + layer * RCOLS;
    const int c4 = (tid & 15) * 4, tkA = tid >> 4, ch = h * 64 + c4;
    u32x2 g_cr[2], g_ck[2], g_cv[2], g_pr[2], g_pk[2], g_pv[2];
#pragma unroll
    for (int q = 0; q < 2; ++q) {
        const int t = t0 + 2 * tkA + q; const bf16* pr = P + (size_t)t * INC;
        g_cr[q] = *(const u32x2*)(pr + PC_R + ch); g_ck[q] = *(const u32x2*)(pr + PC_K + ch); g_cv[q] = *(const u32x2*)(pr + PC_V + ch);
        g_pr[q] = (u32x2){0u, 0u}; g_pk[q] = (u32x2){0u, 0u}; g_pv[q] = (u32x2){0u, 0u};
        if (t > 0) { g_pr[q] = *(const u32x2*)(pr - INC + PC_R + ch); g_pk[q] = *(const u32x2*)(pr - INC + PC_K + ch); g_pv[q] = *(const u32x2*)(pr - INC + PC_V + ch); }
    }
    bf16x8 fw[2], fa[2], fg[4];
    {   const bf16* WupT = (const bf16*)(A.ws + WS_WSM); const bf16* AupT = WupT + 384 * 64; const bf16* GupT = AupT + 384 * 64;
        const int rowj = h * 64 + 16 * (wave & 3) + (lane & 15), kq8 = 8 * (lane >> 4);
#pragma unroll
        for (int ks = 0; ks < 2; ++ks) { fw[ks] = *(const bf16x8*)(WupT + (size_t)rowj * 64 + 32 * ks + kq8); fa[ks] = *(const bf16x8*)(AupT + (size_t)rowj * 64 + 32 * ks + kq8); }
#pragma unroll
        for (int ks = 0; ks < 4; ++ks) fg[ks] = *(const bf16x8*)(GupT + (size_t)rowj * 128 + 32 * ks + kq8);
    }
#pragma unroll
    for (int q = 0; q < 4; ++q) {
        const int item = tid + NTHR * q, tok = item >> 5, cc = (item & 31) * 8, pc = PC_DW + cc;
        if (first) {
            const u32x4 cu = pf.cu[q], pv = pf.pv[q];
            const f32x4 m0 = *(const f32x4*)(mu + pc), m1 = *(const f32x4*)(mu + pc + 4);
            float v[8];
            { float c_, p_;
              c_ = lo16(cu.x); p_ = lo16(pv.x); v[0] = c_ + m0[0] * (p_ - c_); c_ = hi16(cu.x); p_ = hi16(pv.x); v[1] = c_ + m0[1] * (p_ - c_);
              c_ = lo16(cu.y); p_ = lo16(pv.y); v[2] = c_ + m0[2] * (p_ - c_); c_ = hi16(cu.y); p_ = hi16(pv.y); v[3] = c_ + m0[3] * (p_ - c_);
              c_ = lo16(cu.z); p_ = lo16(pv.z); v[4] = c_ + m1[0] * (p_ - c_); c_ = hi16(cu.z); p_ = hi16(pv.z); v[5] = c_ + m1[1] * (p_ - c_);
              c_ = lo16(cu.w); p_ = lo16(pv.w); v[6] = c_ + m1[2] * (p_ - c_); c_ = hi16(cu.w); p_ = hi16(pv.w); v[7] = c_ + m1[3] * (p_ - c_); }
            if (cc < 64) {
#pragma unroll
                for (int i = 0; i < 8; ++i) { const float e2 = __expf(2.0f * v[i]); v[i] = 1.0f - 2.0f * __builtin_amdgcn_rcpf(e2 + 1.0f); }
            } else if (cc >= 128) {
#pragma unroll
                for (int i = 0; i < 8; ++i) v[i] = sigmoidf_(v[i]);
            }
            u32x4 w; w.x = pk2(v[0], v[1]); w.y = pk2(v[2], v[3]); w.z = pk2(v[4], v[5]); w.w = pk2(v[6], v[7]);
            pf.cu[q] = w;
        }
        *(u32x4*)(AL + tok * 264 + cc) = pf.cu[q];
    }
    __syncthreads();
    if (stop <= 1) return;
    {
        const int jt = wave & 3, kq8 = 8 * (lane >> 4);
#pragma unroll
        for (int q = 0; q < 2; ++q) {
            const int tt = 2 * (wave >> 2) + q;
            const bf16* bl = AL + (16 * tt + (lane & 15)) * 264 + kq8;
            f32x4 accw = {0.f, 0.f, 0.f, 0.f}, acca = accw, accg = accw;
#pragma unroll
            for (int ks = 0; ks < 2; ++ks) { accw = __builtin_amdgcn_mfma_f32_16x16x32_bf16(fw[ks], *(const bf16x8*)(bl + 32 * ks), accw, 0, 0, 0);
                                            acca = __builtin_amdgcn_mfma_f32_16x16x32_bf16(fa[ks], *(const bf16x8*)(bl + 64 + 32 * ks), acca, 0, 0, 0); }
#pragma unroll
            for (int ks = 0; ks < 4; ++ks) accg = __builtin_amdgcn_mfma_f32_16x16x32_bf16(fg[ks], *(const bf16x8*)(bl + 128 + 32 * ks), accg, 0, 0, 0);
            const int o_ = (16 * tt + (lane & 15)) * 64 + 16 * jt + 4 * (lane >> 4);
            *(f32x4*)(wS + o_) = accw; *(f32x4*)(aS + o_) = acca; *(f32x4*)(gS + o_) = accg;
        }
    }
    __syncthreads();
    if (stop <= 2) return;
    f32x4 rs[2], kts[2], kkn[2], avs[2], lws[2], vvs[2];
    {
        const f32x4 w0v = *(const f32x4*)(A.in[I_W0] + layer * RW + ch), a0v = *(const f32x4*)(A.in[I_A0] + layer * RW + ch);
        const f32x4 kkv = *(const f32x4*)(A.in[I_KK] + layer * RW + ch), kav = *(const f32x4*)(A.in[I_KA] + layer * RW + ch), rkv = *(const f32x4*)(A.in[I_RK] + layer * RW + ch);
        const f32x4 mur = *(const f32x4*)(mu + PC_R + ch), muk = *(const f32x4*)(mu + PC_K + ch), muv = *(const f32x4*)(mu + PC_V + ch);
        bf16* Gs = (bf16*)(A.ws + WS_G); float* RHOs = (float*)(A.ws + WS_RHO);
#pragma unroll
        for (int q = 0; q < 2; ++q) {
            const int tok = 2 * tkA + q, t = t0 + tok;
            const u32x2 cr = g_cr[q], ck = g_ck[q], cv = g_cv[q], qr_ = g_pr[q], qk_ = g_pk[q], qv_ = g_pv[q];
            f32x4 rc = {lo16(cr.x), hi16(cr.x), lo16(cr.y), hi16(cr.y)}, rp_ = {lo16(qr_.x), hi16(qr_.x), lo16(qr_.y), hi16(qr_.y)};
            f32x4 kc = {lo16(ck.x), hi16(ck.x), lo16(ck.y), hi16(ck.y)}, kp_ = {lo16(qk_.x), hi16(qk_.x), lo16(qk_.y), hi16(qk_.y)};
            f32x4 vc = {lo16(cv.x), hi16(cv.x), lo16(cv.y), hi16(cv.y)}, vp_ = {lo16(qv_.x), hi16(qv_.x), lo16(qv_.y), hi16(qv_.y)};
            const f32x4 rv = rc + mur * (rp_ - rc), kv = kc + muk * (kp_ - kc), vv = vc + muv * (vp_ - vc);
            const f32x4 wp = *(const f32x4*)(wS + tok * 64 + c4), ap = *(const f32x4*)(aS + tok * 64 + c4), gp = *(const f32x4*)(gS + tok * 64 + c4);
            f32x4 lw, av, kkx, kt; float n2 = 0.f, rpv = 0.f;
#pragma unroll
            for (int i = 0; i < 4; ++i) {
                const float x = w0v[i] + wp[i];
                lw[i] = -(__builtin_amdgcn_rcpf(1.0f + __expf(-x)) * 0.6065306597126334f);
                av[i] = sigmoidf_(a0v[i] + ap[i]);
                kkx[i] = kv[i] * kkv[i]; n2 += kkx[i] * kkx[i];
                kt[i] = kv[i] * (1.0f + (av[i] - 1.0f) * kav[i]);
                rpv += rv[i] * kt[i] * rkv[i];
            }
            n2 = red16(n2); rpv = red16(rpv);
            const float inv = (n2 > 1e-24f) ? __builtin_amdgcn_rsqf(n2) : 1e12f;
            rs[q] = rv; kts[q] = kt; kkn[q] = kkx * inv; avs[q] = av; lws[q] = lw; vvs[q] = vv;
            *(f32x4*)(wS + tok * 64 + c4) = lw;
            u32x2 gw; gw.x = pk2(gp[0], gp[1]); gw.y = pk2(gp[2], gp[3]);
            *(u32x2*)(Gs + (brow + t) * RW + ch) = gw;
            if ((tid & 15) == 0) RHOs[(brow + t) * RH + h] = rpv;
        }
#pragma unroll
        for (int i = 0; i < 4; ++i) *(unsigned*)(Vt + (c4 + i) * CP + 2 * tkA) = pk2(vvs[0][i], vvs[1][i]);
    }
    __syncthreads();
    if (stop <= 3) return;
    { const int k = tid & 63, seg = tid >> 6; float run = 0.f;
#pragma unroll
      for (int i = 0; i < 8; ++i) { float* p = wS + (8 * seg + i) * 64 + k; run += *p; *p = run; }
      segT[seg * 64 + k] = run; }
    __syncthreads();
    if (stop <= 4) return;
    f32x4 bhs[2], khs[2], ahs[2];
    { u32x4* z = (u32x4*)TM; const u32x4 zz = {0u, 0u, 0u, 0u};
      for (int i = tid; i < 2 * 64 * CP * 2 / 16; i += NTHR) z[i] = zz;
      if (tid < 3 * 16 * 40 * 2 / 16) ((u32x4*)PTs)[tid] = zz; }
#pragma unroll
    for (int q = 0; q < 2; ++q) {
        const int tok = 2 * tkA + q, seg = tok >> 3;
        f32x4 L = *(const f32x4*)(wS + tok * 64 + c4);
        for (int s_ = 0; s_ < seg; ++s_) L = L + *(const f32x4*)(segT + s_ * 64 + c4);
        f32x4 eL, eNL, eLp;
#pragma unroll
        for (int i = 0; i < 4; ++i) { eL[i] = __expf(L[i]); eNL[i] = __expf(-L[i]); eLp[i] = __expf(L[i] - lws[q][i]); }
        const f32x4 qt = rs[q] * eL, kh = kts[q] * eNL, ah = -(kkn[q] * eLp), bh = kkn[q] * avs[q] * eNL;
        u32x2 w;
        w.x = pk2(ah[0], ah[1]); w.y = pk2(ah[2], ah[3]); *(u32x2*)(AH + tok * CP + c4) = w;
        w.x = pk2(qt[0], qt[1]); w.y = pk2(qt[2], qt[3]); *(u32x2*)(QT + tok * CP + c4) = w;
        w.x = pk2(bh[0], bh[1]); w.y = pk2(bh[2], bh[3]); *(u32x2*)(BH + tok * CP + c4) = w;
        w.x = pk2(kh[0], kh[1]); w.y = pk2(kh[2], kh[3]); *(u32x2*)(KH + tok * CP + c4) = w;
        bhs[q] = bh; khs[q] = kh; ahs[q] = ah;
        if (tok == 63) { *(f32x4*)(gCs + c4) = eL; *(f32x4*)((float*)(A.ws + WS_GC) + (size_t)uidx * 64 + c4) = eL; }
    }
#pragma unroll
    for (int i = 0; i < 4; ++i) {
        *(unsigned*)(BHt + (c4 + i) * CP + 2 * tkA) = pk2(bhs[0][i], bhs[1][i]);
        *(unsigned*)(KHt + (c4 + i) * CP + 2 * tkA) = pk2(khs[0][i], khs[1][i]);
        *(unsigned*)(AHt + (c4 + i) * CP + 2 * tkA) = pk2(ahs[0][i], ahs[1][i]);
    }
    __syncthreads();
    if (stop <= 5) return;
    {
        const int yt = wave & 3;
        const bf16* X = ((yt < 2) ? BH : KH) + 32 * (yt & 1) * CP;
#pragma unroll
        for (int q = 0; q < 2; ++q) {
            const int xt = 2 * (wave >> 2) + q;
            const bf16* Y = ((xt < 2) ? AH : QT) + 32 * (xt & 1) * CP;
            f32x16 acc = {};
            acc = mm32(X, Y, lane, acc);
            bf16* dst = (xt < 2) ? ((yt < 2) ? AAB : AAK) : ((yt < 2) ? ARB : ARK);
            const int i = 32 * (xt & 1) + r31;
#pragma unroll
            for (int g = 0; g < 4; ++g) {
                const int j0 = 32 * (yt & 1) + 8 * g + 4 * hh;
                float v[4];
#pragma unroll
                for (int e = 0; e < 4; ++e) { const int j = j0 + e; const bool keep = (xt < 2) ? (j < i) : (j <= i); v[e] = keep ? acc[4 * g + e] : 0.f; }
                { u32x2 w; w.x = pk2(v[0], v[1]); w.y = pk2(v[2], v[3]); *(u32x2*)(dst + i * CP + j0) = w; }
            }
        }
    }
    __syncthreads();
    if (stop <= 6) return;
    if (wave < 4) {
        const int mt = wave & 1, nt = wave >> 1;
        f32x16 acc = {};
        acc = mm32(AAK + 32 * mt * CP, Vt + 32 * nt * CP, lane, acc);
#pragma unroll
        for (int g = 0; g < 4; ++g) { u32x2 w; w.x = pk2(acc[4 * g], acc[4 * g + 1]); w.y = pk2(acc[4 * g + 2], acc[4 * g + 3]);
            *(u32x2*)(X1t + (32 * nt + r31) * CP + 32 * mt + 8 * g + 4 * hh) = w; }
    } else if (wave == 4) {
        const int bi = lane >> 4, cc = lane & 15;
        float x[16];
#pragma unroll
        for (int i = 0; i < 16; ++i) {
            const u32x4 a0 = *(const u32x4*)(AAB + (16 * bi + i) * CP + 16 * bi), a1 = *(const u32x4*)(AAB + (16 * bi + i) * CP + 16 * bi + 8);
            const float av_[16] = {lo16(a0.x), hi16(a0.x), lo16(a0.y), hi16(a0.y), lo16(a0.z), hi16(a0.z), lo16(a0.w), hi16(a0.w),
                                   lo16(a1.x), hi16(a1.x), lo16(a1.y), hi16(a1.y), lo16(a1.z), hi16(a1.z), lo16(a1.w), hi16(a1.w)};
            float v_ = (i == cc) ? 1.0f : 0.0f;
#pragma unroll
            for (int j = 0; j < i; ++j) v_ += av_[j] * x[j];
            x[i] = v_;
            TM[(16 * bi + i) * CP + 16 * bi + cc] = (unsigned short)(pk2(v_, 0.f) & 0xffffu);
        }
        u32x4 w0, w1;
        w0.x = pk2(x[0], x[1]); w0.y = pk2(x[2], x[3]); w0.z = pk2(x[4], x[5]); w0.w = pk2(x[6], x[7]);
        w1.x = pk2(x[8], x[9]); w1.y = pk2(x[10], x[11]); w1.z = pk2(x[12], x[13]); w1.w = pk2(x[14], x[15]);
        *(u32x4*)(TMt + (16 * bi + cc) * CP + 16 * bi) = w0; *(u32x4*)(TMt + (16 * bi + cc) * CP + 16 * bi + 8) = w1;
    }
    __syncthreads();
    if (stop <= 7) return;
    f32x16 nacc = {}, oacc = {};
    if (wave >= 4) { const int q = wave & 3;
        nacc = mm32(KHt + 32 * (q & 1) * CP, Vt + 32 * (q >> 1) * CP, lane, nacc);
        oacc = mm32(Vt + 32 * (q & 1) * CP, ARK + 32 * (q >> 1) * CP, lane, oacc); }
#pragma unroll
    for (int lvl = 1; lvl < 4; ++lvl) {
        if (wave < 4 - lvl) {
            const int bj = wave, bi = wave + lvl, l15 = lane & 15, q4 = lane >> 4;
            bf16* Pt = PTs + wave * (16 * 40);
            f32x4 acc = {0.f, 0.f, 0.f, 0.f};
#pragma unroll
            for (int ks = 0; ks < 2; ++ks)
                acc = __builtin_amdgcn_mfma_f32_16x16x32_bf16(*(const bf16x8*)(AAB + (16 * bi + l15) * CP + 32 * ks + 8 * q4), *(const bf16x8*)(TMt + (16 * bj + l15) * CP + 32 * ks + 8 * q4), acc, 0, 0, 0);
            { u32x2 w; w.x = pk2(acc[0], acc[1]); w.y = pk2(acc[2], acc[3]); *(u32x2*)(Pt + l15 * 40 + 4 * q4) = w; }
            asm volatile("s_waitcnt lgkmcnt(0)" ::: "memory");
            bf16x8 a2 = {0, 0, 0, 0, 0, 0, 0, 0};
            if (q4 < 2) a2 = *(const bf16x8*)(TM + (16 * bi + l15) * CP + 16 * bi + 8 * q4);
            const bf16x8 b2 = *(const bf16x8*)(Pt + l15 * 40 + 8 * q4);
            f32x4 xo = {0.f, 0.f, 0.f, 0.f};
            xo = __builtin_amdgcn_mfma_f32_16x16x32_bf16(a2, b2, xo, 0, 0, 0);
#pragma unroll
            for (int e = 0; e < 4; ++e) TM[(16 * bi + 4 * q4 + e) * CP + 16 * bj + l15] = (unsigned short)(pk2(xo[e], 0.f) & 0xffffu);
            { u32x2 w; w.x = pk2(xo[0], xo[1]); w.y = pk2(xo[2], xo[3]); *(u32x2*)(TMt + (16 * bj + l15) * CP + 16 * bi + 4 * q4) = w; }
        }
        __syncthreads();
    }
    {
        const int it = wave & 1, ct = (wave >> 1) & 1;
        const bf16* Y = (wave < 4) ? AHt : X1t; bf16* dst = (wave < 4) ? WTt : UTt;
        f32x16 acc = {};
        acc = mm32(TM + 32 * it * CP, Y + 32 * ct * CP, lane, acc);
#pragma unroll
        for (int g = 0; g < 4; ++g) { u32x2 w; w.x = pk2(acc[4 * g], acc[4 * g + 1]); w.y = pk2(acc[4 * g + 2], acc[4 * g + 3]);
            *(u32x2*)(dst + (32 * ct + r31) * CP + 32 * it + 8 * g + 4 * hh) = w; }
    }
    __syncthreads();
    if (stop <= 8) return;
    {
        u32x4* MPs = (u32x4*)((unsigned char*)A.out + SC_MP) + (size_t)uidx * 512;
        u32x4* NNs = (u32x4*)((unsigned char*)A.out + SC_NN) + (size_t)uidx * 512;
        u32x4* QHs = (u32x4*)((unsigned char*)A.out + SC_QH) + (size_t)uidx * 512;
        u32x4* OLs = (u32x4*)((unsigned char*)A.out + SC_OL) + (size_t)uidx * 512;
        if (wave < 2) {
            const int it = wave;
#pragma unroll
            for (int kt = 0; kt < 2; ++kt) {
                f32x16 acc = {};
                acc = mm32(WTt + 32 * kt * CP, ARB + 32 * it * CP, lane, acc);
#pragma unroll
                for (int g = 0; g < 4; ++g) { const u32x2 qv = *(const u32x2*)(QT + (32 * it + r31) * CP + 32 * kt + 8 * g + 4 * hh);
                    acc[4 * g] += lo16(qv.x); acc[4 * g + 1] += hi16(qv.x); acc[4 * g + 2] += lo16(qv.y); acc[4 * g + 3] += hi16(qv.y); }
                QHs[(it * 4 + 2 * kt) * 64 + lane] = packfrag(acc, 0); QHs[(it * 4 + 2 * kt + 1) * 64 + lane] = packfrag(acc, 1);
            }
        } else if (wave < 4) {
            const int ktp = wave - 2; const float gc = gCs[32 * ktp + r31];
#pragma unroll
            for (int kt = 0; kt < 2; ++kt) {
                f32x16 acc = {};
                acc = mm32(WTt + 32 * kt * CP, BHt + 32 * ktp * CP, lane, acc);
                acc = acc * gc;
                MPs[((ktp * 2 + kt) * 2) * 64 + lane] = packfrag(acc, 0); MPs[((ktp * 2 + kt) * 2 + 1) * 64 + lane] = packfrag(acc, 1);
            }
        } else {
            const int q = wave & 3;
            { const int kt = q & 1, vt = q >> 1;
              nacc = mm32(BHt + 32 * kt * CP, UTt + 32 * vt * CP, lane, nacc);
#pragma unroll
              for (int g = 0; g < 4; ++g) { const f32x4 gc = *(const f32x4*)(gCs + 32 * kt + 8 * g + 4 * hh);
                  nacc[4 * g] *= gc[0]; nacc[4 * g + 1] *= gc[1]; nacc[4 * g + 2] *= gc[2]; nacc[4 * g + 3] *= gc[3]; }
              NNs[((vt * 2 + kt) * 2) * 64 + lane] = packfrag(nacc, 0); NNs[((vt * 2 + kt) * 2 + 1) * 64 + lane] = packfrag(nacc, 1); }
            { const int vt = q & 1, it = q >> 1;
              oacc = mm32(UTt + 32 * vt * CP, ARB + 32 * it * CP, lane, oacc);
              OLs[((it * 2 + vt) * 2) * 64 + lane] = packfrag(oacc, 0); OLs[((it * 2 + vt) * 2 + 1) * 64 + lane] = packfrag(oacc, 1); }
        }
    }
    __syncthreads();
}
__device__ __forceinline__ void rwkv_r2_unit(const int tid_in, const Args& A, int u) {
    int tid = tid_in; asm volatile("" : "+v"(tid));
    const int lane = tid & 63, wave = __builtin_amdgcn_readfirstlane(tid >> 6), hh = lane >> 5;
    const int head = 4 * u + (wave >> 1), vt = wave & 1;
    const u32x4* MPs = (const u32x4*)((unsigned char*)A.out + SC_MP) + (size_t)head * 64 * 512;
    const u32x4* NNs = (const u32x4*)((unsigned char*)A.out + SC_NN) + (size_t)head * 64 * 512;
    u32x4* HSo = (u32x4*)((unsigned char*)A.out + SC_HS) + (size_t)head * 64 * 512;
    const float* GCs = (const float*)(A.ws + WS_GC) + (size_t)head * 64 * 64;
    f32x16 acc0 = {}, acc1 = {};
    u32x4 mpn[8], nnn[4]; f32x4 gmn[8];
#define R2_LOAD(cc) do { \
        _Pragma("unroll") for (int i = 0; i < 8; ++i) mpn[i] = MPs[(size_t)(cc) * 512 + i * 64 + lane]; \
        _Pragma("unroll") for (int i = 0; i < 4; ++i) nnn[i] = NNs[(size_t)(cc) * 512 + vt * 256 + i * 64 + lane]; \
        _Pragma("unroll") for (int i = 0; i < 8; ++i) gmn[i] = *(const f32x4*)(GCs + (cc) * 64 + 32 * (i >> 2) + 8 * (i & 3) + 4 * hh); } while (0)
    R2_LOAD(0);
    for (int c = 0; c < 64; ++c) {
        u32x4 mp[8], nn[4]; f32x4 gm[8];
#pragma unroll
        for (int i = 0; i < 8; ++i) { mp[i] = mpn[i]; gm[i] = gmn[i]; }
#pragma unroll
        for (int i = 0; i < 4; ++i) nn[i] = nnn[i];
        if (c + 1 < 64) R2_LOAD(c + 1);
        const u32x4 hb0 = packfrag(acc0, 0), hb1 = packfrag(acc0, 1), hb2 = packfrag(acc1, 0), hb3 = packfrag(acc1, 1);
#pragma unroll
        for (int g = 0; g < 4; ++g) {
            const unsigned* n0 = (const unsigned*)&nn[g >> 1]; const unsigned* n1 = (const unsigned*)&nn[2 + (g >> 1)];
            const int o_ = 2 * (g & 1);
            acc0[4 * g] = acc0[4 * g] * gm[g][0] + lo16(n0[o_]); acc0[4 * g + 1] = acc0[4 * g + 1] * gm[g][1] + hi16(n0[o_]);
            acc0[4 * g + 2] = acc0[4 * g + 2] * gm[g][2] + lo16(n0[o_ + 1]); acc0[4 * g + 3] = acc0[4 * g + 3] * gm[g][3] + hi16(n0[o_ + 1]);
            acc1[4 * g] = acc1[4 * g] * gm[4 + g][0] + lo16(n1[o_]); acc1[4 * g + 1] = acc1[4 * g + 1] * gm[4 + g][1] + hi16(n1[o_]);
            acc1[4 * g + 2] = acc1[4 * g + 2] * gm[4 + g][2] + lo16(n1[o_ + 1]); acc1[4 * g + 3] = acc1[4 * g + 3] * gm[4 + g][3] + hi16(n1[o_ + 1]);
        }
        HSo[(size_t)c * 512 + vt * 256 + 0 * 64 + lane] = hb0; HSo[(size_t)c * 512 + vt * 256 + 1 * 64 + lane] = hb1;
        HSo[(size_t)c * 512 + vt * 256 + 2 * 64 + lane] = hb2; HSo[(size_t)c * 512 + vt * 256 + 3 * 64 + lane] = hb3;
        const bf16x8 b0 = __builtin_bit_cast(bf16x8, hb0), b1 = __builtin_bit_cast(bf16x8, hb1), b2 = __builtin_bit_cast(bf16x8, hb2), b3 = __builtin_bit_cast(bf16x8, hb3);
        acc0 = __builtin_amdgcn_mfma_f32_32x32x16_bf16(__builtin_bit_cast(bf16x8, mp[0]), b0, acc0, 0, 0, 0);
        acc1 = __builtin_amdgcn_mfma_f32_32x32x16_bf16(__builtin_bit_cast(bf16x8, mp[4]), b0, acc1, 0, 0, 0);
        acc0 = __builtin_amdgcn_mfma_f32_32x32x16_bf16(__builtin_bit_cast(bf16x8, mp[1]), b1, acc0, 0, 0, 0);
        acc1 = __builtin_amdgcn_mfma_f32_32x32x16_bf16(__builtin_bit_cast(bf16x8, mp[5]), b1, acc1, 0, 0, 0);
        acc0 = __builtin_amdgcn_mfma_f32_32x32x16_bf16(__builtin_bit_cast(bf16x8, mp[2]), b2, acc0, 0, 0, 0);
        acc1 = __builtin_amdgcn_mfma_f32_32x32x16_bf16(__builtin_bit_cast(bf16x8, mp[6]), b2, acc1, 0, 0, 0);
        acc0 = __builtin_amdgcn_mfma_f32_32x32x16_bf16(__builtin_bit_cast(bf16x8, mp[3]), b3, acc0, 0, 0, 0);
        acc1 = __builtin_amdgcn_mfma_f32_32x32x16_bf16(__builtin_bit_cast(bf16x8, mp[7]), b3, acc1, 0, 0, 0);
    }
#undef R2_LOAD
}
__device__ __forceinline__ void rwkv_r3_unit(const int tid_in, const Args& A, int layer, int u, unsigned char* lds) {
    int tid = tid_in; asm volatile("" : "+v"(tid));
    const int lane = tid & 63, wave = __builtin_amdgcn_readfirstlane(tid >> 6), r31 = lane & 31, hh = lane >> 5;
    const int uidx = 4 * u + (wave >> 1), it = wave & 1;
    const int head = uidx >> 6, c = uidx & 63, b = head / RH, h = head % RH;
    float* PR = (float*)lds;
    if (tid < 192) { const int w_ = tid >> 6, cc = tid & 63;
        PR[tid] = (w_ == 0) ? A.in[I_LNG][layer * RW + h * 64 + cc] : (w_ == 1) ? A.in[I_LNB][layer * RW + h * 64 + cc] : A.in[I_MU][layer * RCOLS + PC_V + h * 64 + cc]; }
    const size_t trow = (size_t)b * SEQ + c * 64 + 32 * it + r31;
    const u32x4* HSs = (const u32x4*)((unsigned char*)A.out + SC_HS) + (size_t)uidx * 512;
    const u32x4* QHs = (const u32x4*)((unsigned char*)A.out + SC_QH) + (size_t)uidx * 512;
    const u32x4* OLs = (const u32x4*)((unsigned char*)A.out + SC_OL) + (size_t)uidx * 512;
    const bf16* P = (const bf16*)(A.ws + WS_P); const bf16* Gs = (const bf16*)(A.ws + WS_G); bf16* MIX = (bf16*)(A.ws + WS_MIX);
    const bool hasprev = (c * 64 + 32 * it + r31) > 0;
    u32x4 ol[4], qf4[4], hs[8];
#pragma unroll
    for (int i = 0; i < 4; ++i) { ol[i] = OLs[((it * 2 + (i >> 1)) * 2 + (i & 1)) * 64 + lane]; qf4[i] = QHs[(it * 4 + i) * 64 + lane]; }
#pragma unroll
    for (int i = 0; i < 8; ++i) hs[i] = HSs[(i >> 2) * 256 + (i & 3) * 64 + lane];
    u32x2 cvv[8], pvv[8], gwv[8];
#pragma unroll
    for (int i = 0; i < 8; ++i) { const int vch = h * 64 + 32 * (i >> 2) + 8 * (i & 3) + 4 * hh;
        cvv[i] = *(const u32x2*)(P + trow * INC + PC_V + vch);
        pvv[i] = (u32x2){0u, 0u}; if (hasprev) pvv[i] = *(const u32x2*)(P + (trow - 1) * INC + PC_V + vch);
        gwv[i] = *(const u32x2*)(Gs + trow * RW + vch); }
    const float rh = ((const float*)(A.ws + WS_RHO))[trow * RH + h];
    f32x16 acc[2];
#pragma unroll
    for (int vt = 0; vt < 2; ++vt) {
        const u32x4 o0 = ol[2 * vt], o1 = ol[2 * vt + 1];
        acc[vt][0] = lo16(o0.x); acc[vt][1] = hi16(o0.x); acc[vt][2] = lo16(o0.y); acc[vt][3] = hi16(o0.y); acc[vt][4] = lo16(o0.z); acc[vt][5] = hi16(o0.z); acc[vt][6] = lo16(o0.w); acc[vt][7] = hi16(o0.w);
        acc[vt][8] = lo16(o1.x); acc[vt][9] = hi16(o1.x); acc[vt][10] = lo16(o1.y); acc[vt][11] = hi16(o1.y); acc[vt][12] = lo16(o1.z); acc[vt][13] = hi16(o1.z); acc[vt][14] = lo16(o1.w); acc[vt][15] = hi16(o1.w);
    }
#pragma unroll
    for (int s_ = 0; s_ < 4; ++s_) {
        const bf16x8 qf = __builtin_bit_cast(bf16x8, qf4[s_]);
#pragma unroll
        for (int vt = 0; vt < 2; ++vt) acc[vt] = __builtin_amdgcn_mfma_f32_32x32x16_bf16(__builtin_bit_cast(bf16x8, hs[vt * 4 + s_]), qf, acc[vt], 0, 0, 0);
    }
    __syncthreads();
    float sm = 0.f;
#pragma unroll
    for (int e = 0; e < 16; ++e) sm += acc[0][e] + acc[1][e];
    sm += __shfl_xor(sm, 32);
    const float mean = sm * (1.0f / 64.0f);
    float q2 = 0.f;
#pragma unroll
    for (int e = 0; e < 16; ++e) { const float d0 = acc[0][e] - mean, d1 = acc[1][e] - mean; q2 += d0 * d0 + d1 * d1; }
    q2 += __shfl_xor(q2, 32);
    const float rstd = rsqrtf(q2 * (1.0f / 64.0f) + GN_EPS);
#pragma unroll
    for (int vt = 0; vt < 2; ++vt)
#pragma unroll
        for (int g = 0; g < 4; ++g) {
            const int vc0 = 32 * vt + 8 * g + 4 * hh, vch = h * 64 + vc0;
            const f32x4 lg = *(const f32x4*)(PR + vc0), lb = *(const f32x4*)(PR + 64 + vc0), muv = *(const f32x4*)(PR + 128 + vc0);
            const u32x2 cv = cvv[vt * 4 + g], pv = pvv[vt * 4 + g], gw = gwv[vt * 4 + g];
            const f32x4 vc = {lo16(cv.x), hi16(cv.x), lo16(cv.y), hi16(cv.y)}, vp = {lo16(pv.x), hi16(pv.x), lo16(pv.y), hi16(pv.y)};
            const f32x4 vv = vc + muv * (vp - vc), gg = {lo16(gw.x), hi16(gw.x), lo16(gw.y), hi16(gw.y)};
            float y[4];
#pragma unroll
            for (int e = 0; e < 4; ++e) y[e] = ((acc[vt][4 * g + e] - mean) * rstd * lg[e] + lb[e] + rh * vv[e]) * gg[e];
            u32x2 w; w.x = pk2(y[0], y[1]); w.y = pk2(y[2], y[3]);
            *(u32x2*)(MIX + trow * D + MIX_R + vch) = w;
        }
}

constexpr int LT = 16;
__device__ __forceinline__ float gelu_tanh(float x) { const float u = 0.7978845608028654f * (x + 0.044715f * x * x * x); return x * __builtin_amdgcn_rcpf(1.0f + __expf(-2.0f * u)); }
__device__ __forceinline__ float neg_expm1(float x) { return (x > -0.25f) ? -x * (1.0f + x * (0.5f + x * (0.16666667f + x * (0.041666668f + x * (0.0083333338f + x * 0.0013888889f))))) : 1.0f - __expf(x); }
__device__ __forceinline__ void lru_unit(const int tid_in, const Args& A, int layer, int bg, unsigned char* lds) {
    int tid = tid_in; asm volatile("" : "+v"(tid));
    const int lane = tid & 63, wave = __builtin_amdgcn_readfirstlane(tid >> 6);
    const int b = bg / LB, g = bg % LB, c = g * 64 + lane;
    const bf16* P = (const bf16*)(A.ws + WS_P) + (size_t)b * SEQ * INC;
    bf16* MIX = (bf16*)(A.ws + WS_MIX) + (size_t)b * SEQ * D;
    bf16* WAs = (bf16*)lds;
    bf16* WXs = WAs + 64 * 72;
    float* totA = (float*)(WXs + 64 * 72);
    float* totH = totA + 8 * 64;
    float* carryS = totH + 8 * 64;
    bf16* XC = (bf16*)(carryS + 64) + wave * (LT * 72);
    float* PRE = (float*)((bf16*)(carryS + 64) + 8 * LT * 72) + wave * (2 * LT * 68);
    const bf16* LwaT = (const bf16*)(A.ws + WS_WSM) + 98304 + g * 4096; const bf16* LwxT = LwaT + 16384;
    { const int j = tid >> 3, i8 = (tid & 7) * 8;
      *(u32x4*)(WAs + j * 72 + i8) = *(const u32x4*)(LwaT + j * 64 + i8); *(u32x4*)(WXs + j * 72 + i8) = *(const u32x4*)(LwxT + j * 64 + i8); }
    const float cw0 = A.in[I_CW][(layer * 4 + 0) * LW + c], cw1 = A.in[I_CW][(layer * 4 + 1) * LW + c], cw2 = A.in[I_CW][(layer * 4 + 2) * LW + c], cw3 = A.in[I_CW][(layer * 4 + 3) * LW + c];
    const float cb = A.in[I_CB][layer * LW + c], ba = A.in[I_BA][layer * LW + c], bx = A.in[I_BX][layer * LW + c];
    const float sp8 = 8.0f * softplusf_(-A.in[I_LAM][layer * LW + c]);
    const float ng = A.in[I_LRUG][layer * LW + c];
    if (tid < 64) carryS[tid] = 0.f;
    __syncthreads();
    for (int st = 0; st < SEQ; st += 8 * LT) {
        const int T0 = st + wave * LT;
        float xm3 = (T0 >= 3) ? bf2f(P[(size_t)(T0 - 3) * INC + PC_LX + c]) : 0.f;
        float xm2 = (T0 >= 2) ? bf2f(P[(size_t)(T0 - 2) * INC + PC_LX + c]) : 0.f;
        float xm1 = (T0 >= 1) ? bf2f(P[(size_t)(T0 - 1) * INC + PC_LX + c]) : 0.f;
        float xc[LT], gin[LT];
#pragma unroll
        for (int t = 0; t < LT; ++t) { xc[t] = bf2f(P[(size_t)(T0 + t) * INC + PC_LX + c]); gin[t] = bf2f(P[(size_t)(T0 + t) * INC + PC_LG + c]); }
#pragma unroll
        for (int t = 0; t < LT; ++t) {
            const float x = xc[t];
            xc[t] = cw0 * xm3 + cw1 * xm2 + cw2 * xm1 + cw3 * x + cb;
            xm3 = xm2; xm2 = xm1; xm1 = x;
            XC[t * 72 + lane] = (unsigned short)(pk2(xc[t], 0.f) & 0xffffu);
        }
        asm volatile("s_waitcnt lgkmcnt(0)" ::: "memory");
        {
            const bf16* bl = XC + (lane & 15) * 72 + 8 * (lane >> 4);
            const bf16x8 b0 = *(const bf16x8*)(bl), b1 = *(const bf16x8*)(bl + 32);
#pragma unroll
            for (int gt = 0; gt < 2; ++gt) {
                const bf16* Ws = gt ? WXs : WAs;
#pragma unroll
                for (int jt = 0; jt < 4; ++jt) {
                    const bf16* al = Ws + (16 * jt + (lane & 15)) * 72 + 8 * (lane >> 4);
                    f32x4 acc = {0.f, 0.f, 0.f, 0.f};
                    acc = __builtin_amdgcn_mfma_f32_16x16x32_bf16(*(const bf16x8*)(al), b0, acc, 0, 0, 0);
                    acc = __builtin_amdgcn_mfma_f32_16x16x32_bf16(*(const bf16x8*)(al + 32), b1, acc, 0, 0, 0);
                    *(f32x4*)(PRE + gt * (LT * 68) + (lane & 15) * 68 + 16 * jt + 4 * (lane >> 4)) = acc;
                }
            }
        }
        asm volatile("s_waitcnt lgkmcnt(0)" ::: "memory");
        float hl[LT], Ac[LT];
        float hrun = 0.f, arun = 1.f;
#pragma unroll
        for (int t = 0; t < LT; ++t) {
            const float ga = PRE[t * 68 + lane] + ba, gx = PRE[LT * 68 + t * 68 + lane] + bx;
            const float la = -sp8 * sigmoidf_(ga);
            const float a = __expf(la);
            const float bi = __builtin_amdgcn_sqrtf(neg_expm1(2.0f * la)) * sigmoidf_(gx) * xc[t];
            hrun = a * hrun + bi; arun *= a;
            hl[t] = hrun; Ac[t] = arun;
        }
        totA[wave * 64 + lane] = arun; totH[wave * 64 + lane] = hrun;
        __syncthreads();
        float cin = carryS[lane];
        for (int u = 0; u < wave; ++u) cin = totA[u * 64 + lane] * cin + totH[u * 64 + lane];
        float cout = cin;
        if (wave == 7) cout = totA[7 * 64 + lane] * cin + totH[7 * 64 + lane];
#pragma unroll
        for (int t = 0; t < LT; ++t) {
            const float hv = hl[t] + Ac[t] * cin;
            const float y = gelu_tanh(gin[t]) * hv;
            const float ss = red64(y * y);
            const float o = y * rsqrtf(ss * (1.0f / 64.0f) + RMS_EPS) * ng;
            ((unsigned short*)MIX)[(size_t)(T0 + t) * D + MIX_L + c] = (unsigned short)(pk2(o, 0.f) & 0xffffu);
        }
        __syncthreads();
        if (wave == 7) carryS[lane] = cout;
        __syncthreads();
    }
}

__device__ __forceinline__ void phase_mixers(const int tid, const Args& A, int layer, int sub, unsigned char* lds, volatile LAS unsigned* misc, const int umask = 7, const int qslot = 0, const int r1stop = 99) {
    unsigned* qhead = (unsigned*)(A.ws + WS_CTL) + CW_Q + layer * 64 + sub * 8 + qslot;
    constexpr int R1B = RH;
#ifndef ATT_A
#define ATT_A 0
#endif
#ifndef ATT_B
#define ATT_B 1152
#endif
    const int a0 = (sub == 0) ? 0 : (sub == 1) ? ATT_A : ATT_B, a1 = (sub == 0) ? ATT_A : (sub == 1) ? ATT_B : 1536, nA = a1 - a0;
    const int nHead = (sub == 0) ? 64 : (sub == 1) ? 24 : 0;
    const int nTail = (sub == 0) ? 6144 / R1B : (sub == 2) ? 1536 : 0;
    const int NU = nHead + nA + nTail;
#ifndef CUMASK
#define CUMASK 7
#endif
    for (;;) {
        __syncthreads();
        if (tid == 0) misc[4] = __hip_atomic_fetch_add(qhead, 1u, __ATOMIC_RELAXED, __HIP_MEMORY_SCOPE_AGENT);
        __syncthreads();
        const int u = (int)misc[4];
        if (u >= NU) break;
        if (u < nHead) {
            if (sub == 0) { if ((CUMASK & 2) && (umask & 2)) lru_unit(tid, A, layer, u, lds); }
            else { if ((CUMASK & 1) && (umask & 1)) rwkv_r2_unit(tid, A, u); }
        } else if (u < nHead + nA) {
            const int a = a0 + (u - nHead); if ((CUMASK & 4) && (umask & 4)) attn_unit(tid, A, layer, a % 96, 15 - a / 96, lds);
        } else {
            const int v = u - nHead - nA;
            if (sub == 0) { if ((CUMASK & 1) && (umask & 1)) { R1Pre pf; const int bb = v >> 6, cc_ = v & 63; rwkv_r1_prefetch(tid, A, bb, cc_, pf);
                    for (int hq = 0; hq < RH; ++hq) rwkv_r1_unit(tid, A, layer, (bb * RH + hq) * 64 + cc_, lds, pf, hq == 0, r1stop); } }
            else { if ((CUMASK & 1) && (umask & 1)) rwkv_r3_unit(tid, A, layer, v, lds); }
        }
    }
}

__device__ __forceinline__ void phase_ln1_router(const int tid, const Args& A, int layer, unsigned char* lds, int vcu, int G) {
    const int lane = tid & 63, wave = tid >> 6;
    float* rwT = (float*)lds;
    float* part = (float*)(lds + 65536) + wave * 1024;
    float* lgS = (float*)(lds + 98304) + wave * 64;
    int* hist = (int*)(lds + 100352);
    int* rowinfo = (int*)(lds + 100352 + 256);
    bf16* X1 = (bf16*)(A.ws + WS_X1);
    int* list = (int*)(A.ws + WS_LIST); float* gate = (float*)(A.ws + WS_GATE);
    unsigned* gcnt = (unsigned*)(A.ws + WS_CTL) + CW_CNT + layer * 64;
    const float* rw = A.in[I_RW];
    for (int i = tid; i < 16 * 1024; i += NTHR) { const int c = i >> 4, e = i & 15; rwT[e * 1024 + c] = rw[i]; }
    const float rbv = A.in[I_RB][lane & 15];
    const float* g1 = A.in[I_LN1G] + layer * D; const float* b1 = A.in[I_LN1B] + layer * D;
    f32x4 gg[4], bb[4];
#pragma unroll
    for (int j = 0; j < 4; ++j) { gg[j] = *(const f32x4*)(g1 + 4 * lane + 256 * j); bb[j] = *(const f32x4*)(b1 + 4 * lane + 256 * j); }
    const int rows_per = M / G;
    for (int chunk = 0; chunk < rows_per / 256; ++chunk) {
        const int base = vcu * rows_per + chunk * 256;
        if (tid < 16) hist[tid] = 0;
        __syncthreads();
        u32x2 xn[4][4];
#pragma unroll
        for (int q = 0; q < 4; ++q)
#pragma unroll
            for (int j = 0; j < 4; ++j) xn[q][j] = *(const u32x2*)(X1 + (size_t)(base + wave * 32 + q) * D + 4 * lane + 256 * j);
        for (int pass = 0; pass < 8; ++pass) {
            const int lr0 = wave * 32 + pass * 4;
            f32x4 y[4][4];
            u32x2 xc_[4][4];
#pragma unroll
            for (int q = 0; q < 4; ++q)
#pragma unroll
                for (int j = 0; j < 4; ++j) xc_[q][j] = xn[q][j];
            if (pass + 1 < 8) {
#pragma unroll
                for (int q = 0; q < 4; ++q)
#pragma unroll
                    for (int j = 0; j < 4; ++j) xn[q][j] = *(const u32x2*)(X1 + (size_t)(base + lr0 + 4 + q) * D + 4 * lane + 256 * j);
            }
#pragma unroll
            for (int q = 0; q < 4; ++q) {
                bf16* xr = X1 + (size_t)(base + lr0 + q) * D;
                float sm = 0.f;
#pragma unroll
                for (int j = 0; j < 4; ++j) { const u32x2 a = xc_[q][j];
                    y[q][j] = (f32x4){lo16(a.x), hi16(a.x), lo16(a.y), hi16(a.y)}; sm += (y[q][j][0] + y[q][j][1]) + (y[q][j][2] + y[q][j][3]); }
                const float mean = red64(sm) * (1.0f / D); float s2 = 0.f;
#pragma unroll
                for (int j = 0; j < 4; ++j) { y[q][j] = y[q][j] - mean; s2 += (y[q][j][0] * y[q][j][0] + y[q][j][1] * y[q][j][1]) + (y[q][j][2] * y[q][j][2] + y[q][j][3] * y[q][j][3]); }
                const float rstd = rsqrtf(red64(s2) * (1.0f / D) + LN_EPS);
#pragma unroll
                for (int j = 0; j < 4; ++j) { y[q][j] = y[q][j] * rstd * gg[j] + bb[j];
                    u32x2 w; w.x = pk2(y[q][j][0], y[q][j][1]); w.y = pk2(y[q][j][2], y[q][j][3]); *(u32x2*)(xr + 4 * lane + 256 * j) = w; }
            }
#pragma unroll
            for (int e = 0; e < 16; ++e) {
                float a0 = 0.f, a1 = 0.f, a2 = 0.f, a3 = 0.f;
#pragma unroll
                for (int j = 0; j < 4; ++j) { const f32x4 w = *(const f32x4*)(rwT + e * 1024 + 4 * lane + 256 * j);
                    a0 += (y[0][j][0] * w[0] + y[0][j][1] * w[1]) + (y[0][j][2] * w[2] + y[0][j][3] * w[3]);
                    a1 += (y[1][j][0] * w[0] + y[1][j][1] * w[1]) + (y[1][j][2] * w[2] + y[1][j][3] * w[3]);
                    a2 += (y[2][j][0] * w[0] + y[2][j][1] * w[1]) + (y[2][j][2] * w[2] + y[2][j][3] * w[3]);
                    a3 += (y[3][j][0] * w[0] + y[3][j][1] * w[1]) + (y[3][j][2] * w[2] + y[3][j][3] * w[3]); }
                a0 += DPP(a0, 0xB1); a0 += DPP(a0, 0x4E); a1 += DPP(a1, 0xB1); a1 += DPP(a1, 0x4E);
                a2 += DPP(a2, 0xB1); a2 += DPP(a2, 0x4E); a3 += DPP(a3, 0xB1); a3 += DPP(a3, 0x4E);
                if ((lane & 3) == 0) { part[(0 * 16 + e) * 16 + (lane >> 2)] = a0; part[(1 * 16 + e) * 16 + (lane >> 2)] = a1;
                                       part[(2 * 16 + e) * 16 + (lane >> 2)] = a2; part[(3 * 16 + e) * 16 + (lane >> 2)] = a3; }
            }
            asm volatile("s_waitcnt lgkmcnt(0)" ::: "memory");
            { const f32x4 p0 = *(const f32x4*)(part + lane * 16), p1 = *(const f32x4*)(part + lane * 16 + 4), p2 = *(const f32x4*)(part + lane * 16 + 8), p3 = *(const f32x4*)(part + lane * 16 + 12);
              const f32x4 ps = (p0 + p1) + (p2 + p3);
              lgS[lane] = (ps[0] + ps[1]) + (ps[2] + ps[3]) + rbv; }
            asm volatile("s_waitcnt lgkmcnt(0)" ::: "memory");
            const int rr = lane >> 4;
            float lg[16];
#pragma unroll
            for (int j = 0; j < 4; ++j) { const f32x4 v = *(const f32x4*)(lgS + rr * 16 + 4 * j); lg[4 * j] = v[0]; lg[4 * j + 1] = v[1]; lg[4 * j + 2] = v[2]; lg[4 * j + 3] = v[3]; }
            asm volatile("s_waitcnt lgkmcnt(0)" ::: "memory");
            {
                float mx = lg[0];
#pragma unroll
                for (int e = 1; e < 16; ++e) mx = fmaxf(mx, lg[e]);
                float sc[16], den = 0.f;
#pragma unroll
                for (int e = 0; e < 16; ++e) { sc[e] = __expf(lg[e] - mx); den += sc[e]; }
                const float inv = __builtin_amdgcn_rcpf(den);
#pragma unroll
                for (int e = 0; e < 16; ++e) sc[e] *= inv;
                int sel = 0; float best = -1.f;
#pragma unroll
                for (int gq = 0; gq < 4; ++gq) {
                    const float a = sc[4 * gq], b_ = sc[4 * gq + 1], c_ = sc[4 * gq + 2], d_ = sc[4 * gq + 3];
                    const float m1 = fmaxf(fmaxf(a, b_), fmaxf(c_, d_));
                    const float m2 = fmaxf(fmaxf(fminf(a, b_), fminf(c_, d_)), fminf(fmaxf(a, b_), fmaxf(c_, d_)));
                    const float gs = m1 + m2;
                    if (gs > best) { best = gs; sel = gq; }
                }
                float cd[4];
#pragma unroll
                for (int i = 0; i < 4; ++i) cd[i] = (sel == 0) ? sc[i] : (sel == 1) ? sc[4 + i] : (sel == 2) ? sc[8 + i] : sc[12 + i];
                int i0 = 0; float v0 = cd[0];
#pragma unroll
                for (int i = 1; i < 4; ++i) if (cd[i] > v0) { v0 = cd[i]; i0 = i; }
                int i1 = -1; float v1 = -1.f;
#pragma unroll
                for (int i = 0; i < 4; ++i) if (i != i0 && cd[i] > v1) { v1 = cd[i]; i1 = i; }
                const int e0 = sel * 4 + i0, e1 = sel * 4 + i1;
                const float gsum = v0 + v1;
                if ((lane & 15) == 0) {
                    const int row = base + lr0 + rr;
                    gate[2 * row] = v0 / gsum; gate[2 * row + 1] = v1 / gsum;
                    const int r0 = atomicAdd(&hist[e0], 1), r1 = atomicAdd(&hist[e1], 1);
                    rowinfo[2 * (lr0 + rr)] = e0 | (r0 << 8); rowinfo[2 * (lr0 + rr) + 1] = e1 | (r1 << 8);
                }
            }
        }
        __syncthreads();
        if (tid < 16) hist[16 + tid] = (int)__hip_atomic_fetch_add(gcnt + tid, (unsigned)hist[tid], __ATOMIC_RELAXED, __HIP_MEMORY_SCOPE_AGENT);
        __syncthreads();
        { const int info = rowinfo[tid]; const int e = info & 255, rk = info >> 8, pos = hist[16 + e] + rk, a = (base + (tid >> 1)) * 2 + (tid & 1);
          list[(size_t)e * LCAP + pos] = a; ((int*)(A.ws + WS_EINFO))[a] = e | (pos << 8); }
        __syncthreads();
    }
}

__device__ __forceinline__ void phase_ln2(const int tid, const Args& A, int layer, int vcu, int G, const LAS int* tab) {
    const int lane = tid & 63, wave = tid >> 6;
    const bf16* X1 = (const bf16*)(A.ws + WS_X1); const bf16* YM = (const bf16*)(A.ws + WS_YM);
    bf16* XB = (bf16*)(A.ws + WS_XB);
    const float* g2 = A.in[I_LN2G] + layer * D; const float* b2 = A.in[I_LN2B] + layer * D;
    f32x4 gg[4], bb[4];
#pragma unroll
    for (int j = 0; j < 4; ++j) { gg[j] = *(const f32x4*)(g2 + 4 * lane + 256 * j); bb[j] = *(const f32x4*)(b2 + 4 * lane + 256 * j); }
    const int gw = vcu * NWAVES + wave, NGW = G * NWAVES;
    const int* einfo = (const int*)(A.ws + WS_EINFO); const float* gate = (const float*)(A.ws + WS_GATE);
    constexpr int RB = 4;
    int nrow = gw * RB;
    int ei[2 * RB]; float gt[2 * RB];
#pragma unroll
    for (int q = 0; q < 2 * RB; ++q) { ei[q] = (nrow < M) ? einfo[2 * nrow + q] : 0; gt[q] = (nrow < M) ? gate[2 * nrow + q] : 0.f; }
    for (int row0 = nrow; row0 < M; row0 += NGW * RB) {
        size_t yr[2 * RB]; float g_[2 * RB];
#pragma unroll
        for (int q = 0; q < 2 * RB; ++q) { yr[q] = ((size_t)tab[ei[q] & 255] << 8) + (size_t)(ei[q] >> 8); g_[q] = gt[q]; }
        u32x2 xa[RB][4], y0[RB][4], y1[RB][4];
#pragma unroll
        for (int r = 0; r < RB; ++r)
#pragma unroll
            for (int j = 0; j < 4; ++j) {
                xa[r][j] = *(const u32x2*)(X1 + (size_t)(row0 + r) * D + 4 * lane + 256 * j);
                y0[r][j] = *(const u32x2*)(YM + yr[2 * r] * D + 4 * lane + 256 * j);
                y1[r][j] = *(const u32x2*)(YM + yr[2 * r + 1] * D + 4 * lane + 256 * j);
            }
        { const int nx = row0 + NGW * RB;
#pragma unroll
          for (int q = 0; q < 2 * RB; ++q) { ei[q] = (nx < M) ? einfo[2 * nx + q] : 0; gt[q] = (nx < M) ? gate[2 * nx + q] : 0.f; } }
#pragma unroll
        for (int r = 0; r < RB; ++r) {
            const int row = row0 + r; const float g0 = g_[2 * r], g1 = g_[2 * r + 1];
            f32x4 v[4]; float sm = 0.f;
#pragma unroll
            for (int j = 0; j < 4; ++j) {
                const u32x2 a = xa[r][j], ya = y0[r][j], yb = y1[r][j];
                v[j][0] = ALPHA * lo16(a.x) + g0 * lo16(ya.x) + g1 * lo16(yb.x); v[j][1] = ALPHA * hi16(a.x) + g0 * hi16(ya.x) + g1 * hi16(yb.x);
                v[j][2] = ALPHA * lo16(a.y) + g0 * lo16(ya.y) + g1 * lo16(yb.y); v[j][3] = ALPHA * hi16(a.y) + g0 * hi16(ya.y) + g1 * hi16(yb.y);
                sm += (v[j][0] + v[j][1]) + (v[j][2] + v[j][3]);
            }
            const float mean = red64(sm) * (1.0f / D); float s2 = 0.f;
#pragma unroll
            for (int j = 0; j < 4; ++j) { v[j] = v[j] - mean; s2 += (v[j][0] * v[j][0] + v[j][1] * v[j][1]) + (v[j][2] * v[j][2] + v[j][3] * v[j][3]); }
            const float rstd = rsqrtf(red64(s2) * (1.0f / D) + LN_EPS);
#pragma unroll
            for (int j = 0; j < 4; ++j) {
                const f32x4 o = v[j] * rstd * gg[j] + bb[j];
                if (layer == DEPTH - 1) *(f32x4*)(A.out + (size_t)row * D + 4 * lane + 256 * j) = o;
                else { u32x2 w; w.x = pk2(o[0], o[1]); w.y = pk2(o[2], o[3]); *(u32x2*)(XB + (size_t)row * D + 4 * lane + 256 * j) = w; }
            }
        }
    }
}

__device__ __forceinline__ void moe_table(const int tid, const Args& A, int layer, LAS int* tab) {
    if (tid == 0) {
        const unsigned* gcnt = (const unsigned*)(A.ws + WS_CTL) + CW_CNT + layer * 64;
        int acc = 0;
        for (int e = 0; e < 16; ++e) { const int c = (int)__hip_atomic_load(gcnt + e, __ATOMIC_RELAXED, __HIP_MEMORY_SCOPE_AGENT); tab[e] = acc; tab[32 + e] = c; acc += (c + 255) >> 8; }
        tab[16] = acc;
    }
    __syncthreads();
}

__global__ void __launch_bounds__(NTHR, 2) fwd_kernel(Args args) {
    extern __shared__ __attribute__((aligned(16))) unsigned char lds[];
    LAS unsigned char* ldsl = (LAS unsigned char*)lds;
    volatile LAS unsigned* misc = (volatile LAS unsigned*)(ldsl + MISC_OFF);
    const int wave_s = __builtin_amdgcn_readfirstlane((int)threadIdx.x >> 6);
#define MKTID() ({ unsigned z_ = 0u; asm volatile("" : "+v"(z_)); (int)(wave_s * 64 + (int)__builtin_amdgcn_mbcnt_hi(~0u, __builtin_amdgcn_mbcnt_lo(~0u, z_))); })
    { const int tid = MKTID(); for (int u = tid; u < (LDS_BYTES - MISC_OFF) / 4; u += NTHR) misc[u] = 0u; }
    __syncthreads();
    const int G = gridDim.x, bx = blockIdx.x;
    const int vcu = (G % 8 == 0) ? (bx % 8) * (G / 8) + bx / 8 : bx;
    unsigned* ctl = (unsigned*)(args.ws + WS_CTL);
    XcdBarrier bar; bar.bar = ctl + CW_BAR; bar.x = 0; bar.st = nullptr;
    if (args.use_bar) bar = xcd_barrier_post(MKTID(), ctl + CW_BAR, misc + 8);
    LAS int* tab = (LAS int*)(ldsl + MISC_OFF + 256);
    const int lo = args.ph_lo, hi = args.ph_hi;
#ifndef PHMASK
#define PHMASK 0x3FF
#endif
#define IN(k) (((PHMASK >> (k)) & 1) && lo <= (k) && (k) < hi)
#define SEAM(k) do { if (args.use_bar && (REP_PH || !((k) == NPH - 1 && layer == args.l_hi - 1))) xcd_barrier(MKTID(), bar); } while (0)
#ifndef REP_PH
#define REP_PH 0
#endif
#ifndef REP_UMASK
#define REP_UMASK 7
#endif
    for (int layer = args.l_lo; layer < args.l_hi; ++layer) {
      {
#define RUN(k) if (IN(k)) for (int rep = 0; rep < ((((REP_PH) >> (k)) & 1) ? 2 : 1); ++rep)
        RUN(0) { phase_convert(MKTID(), args, layer, (float*)lds, vcu, G); SEAM(0); }
        RUN(1) {
            pg8::DenseOrder S; S.init(M, INC, D, G, bx, args.ws + WS_WIN);
            pg8::EpiIn E{(bf16*)(args.ws + WS_P)};
            pg8::gemm_phase<pg8::EpiIn, pg8::DenseOrder, true>(MKTID(), ldsl, (const char*)(args.ws + WS_XB), D, S, E);
            SEAM(1);
        }
#ifndef R1STOP
#define R1STOP 99
#endif
        RUN(2) { const bool probe = ((REP_PH >> 2) & 1) && rep == 0; phase_mixers(MKTID(), args, layer, 0, lds, misc, probe ? REP_UMASK : 7, rep * 4, probe ? R1STOP : 99); SEAM(2); }
        RUN(3) { phase_mixers(MKTID(), args, layer, 1, lds, misc, rep ? REP_UMASK : 7, rep * 4); SEAM(3); }
        RUN(4) { phase_mixers(MKTID(), args, layer, 2, lds, misc, rep ? REP_UMASK : 7, rep * 4); SEAM(4); }
        RUN(5) {
            pg8::DenseOrder S; S.init(M, D, D, G, bx, args.ws + WS_WOUT);
            pg8::EpiOut E{(const bf16*)(args.ws + WS_XB), (bf16*)(args.ws + WS_X1)};
            pg8::gemm_phase<pg8::EpiOut, pg8::DenseOrder, true>(MKTID(), ldsl, (const char*)(args.ws + WS_MIX), D, S, E);
            SEAM(5);
        }
        RUN(6) { phase_ln1_router(MKTID(), args, layer, lds, vcu, G); SEAM(6); }
        RUN(7) {
            moe_table(MKTID(), args, layer, tab);
            pg8::MoeOrder<true> S{tab, G, vcu, D, 4, (const char*)(args.ws + WS_WGU), (size_t)1024 * D * 2, (const int*)(args.ws + WS_LIST)};
            pg8::EpiMoe1 E{(bf16*)(args.ws + WS_H)};
            pg8::gemm_phase<pg8::EpiMoe1, pg8::MoeOrder<true>, true>(MKTID(), ldsl, (const char*)(args.ws + WS_X1), D, S, E);
            SEAM(7);
        }
        RUN(8) {
            moe_table(MKTID(), args, layer, tab);
            pg8::MoeOrder<false> S{tab, G, vcu, DE, 4, (const char*)(args.ws + WS_WDN), (size_t)1024 * DE * 2, (const int*)(args.ws + WS_LIST)};
            pg8::EpiMoe2 E{(bf16*)(args.ws + WS_YM)};
            pg8::gemm_phase<pg8::EpiMoe2, pg8::MoeOrder<false>, true>(MKTID(), ldsl, (const char*)(args.ws + WS_H), DE, S, E);
            SEAM(8);
        }
        RUN(9) { moe_table(MKTID(), args, layer, tab); phase_ln2(MKTID(), args, layer, vcu, G, tab); SEAM(9); }
#undef RUN
      }
    }
#undef IN
#undef SEAM
}

extern "C" void kernel_launch(void* const* d_in, const int* in_sizes, int n_in, void* d_out, int out_size, void* d_ws, size_t ws_size, hipStream_t stream) {
    static int grid = 0;
    if (grid == 0) {
        if (n_in != 32 || out_size != M * D || ws_size < WS_END) { fprintf(stderr, "kernel_launch: unexpected shapes (n_in %d out %d ws %zu)\n", n_in, out_size, ws_size); grid = -1; return; }
        int dev = 0, cus = 0;
        if (hipGetDevice(&dev) != hipSuccess || hipDeviceGetAttribute(&cus, hipDeviceAttributeMultiprocessorCount, dev) != hipSuccess) { grid = -1; return; }
        if (hipFuncSetAttribute((const void*)fwd_kernel, hipFuncAttributeMaxDynamicSharedMemorySize, LDS_BYTES) != hipSuccess) { fprintf(stderr, "kernel_launch: hipFuncSetAttribute failed\n"); grid = -1; return; }
        int per_cu = 0;
        (void)hipOccupancyMaxActiveBlocksPerMultiprocessor(&per_cu, (const void*)fwd_kernel, NTHR, LDS_BYTES);
        (void)hipGetLastError();
        if (per_cu < 1) fprintf(stderr, "kernel_launch: occupancy query reports %d\n", per_cu);
        grid = cus;
    }
    if (grid < 0) return;
    (void)hipMemsetAsync((char*)d_ws + WS_CTL, 0, CTL_BYTES, stream);
    Args a{};
    for (int i = 0; i < 32; ++i) a.in[i] = (const float*)d_in[i];
    a.out = (float*)d_out; a.ws = (unsigned char*)d_ws;
#if MK_ONE_LAUNCH
    a.l_lo = 0; a.l_hi = DEPTH; a.ph_lo = 0; a.ph_hi = NPH; a.use_bar = 1; a.pad = 0;
    hipLaunchKernelGGL(fwd_kernel, dim3(grid), dim3(NTHR), LDS_BYTES, stream, a);
#else
    for (int l = 0; l < DEPTH; ++l)
        for (int p = 0; p < NPH; ++p) {
            a.l_lo = l; a.l_hi = l + 1; a.ph_lo = p; a.ph_hi = p + 1; a.use_bar = 0; a.pad = 0;
            hipLaunchKernelGGL(fwd_kernel, dim3(grid), dim3(NTHR), LDS_BYTES, stream, a);
        }
#endif
}
```

```cpp
#include <hip/hip_runtime.h>
#include <cstdio>
#include <cstdint>

#ifndef MK_ONE_LAUNCH
#define MK_ONE_LAUNCH 1
#endif

#define LAS __attribute__((address_space(3)))
#define GAS __attribute__((address_space(1)))
typedef unsigned short bf16;
typedef short bf16x8 __attribute__((ext_vector_type(8)));
typedef short s16x4 __attribute__((ext_vector_type(4)));
typedef float f32x4 __attribute__((ext_vector_type(4)));
typedef float f32x2 __attribute__((ext_vector_type(2)));
typedef float f32x16 __attribute__((ext_vector_type(16)));
typedef unsigned u32x4 __attribute__((ext_vector_type(4)));
typedef unsigned u32x2 __attribute__((ext_vector_type(2)));
typedef __bf16 bf16x2_t __attribute__((ext_vector_type(2)));

constexpr int D = 1024, BATCH = 16, SEQ = 4096, DEPTH = 4, M = BATCH * SEQ;
constexpr int HD = 64, RW = 384, LW = 256, SW = 384, RH = 6, LB = 4, SH = 6;
constexpr int RCOLS = 1408, INC = 3072;
constexpr int PC_R = 0, PC_K = 384, PC_V = 768, PC_DW = 1152, PC_DA = 1216, PC_DG = 1280;
constexpr int PC_LG = 1408, PC_LX = 1664, PC_SQ = 1920, PC_SK = 2304, PC_SV = 2688;
constexpr int MIX_R = 0, MIX_L = 384, MIX_S = 640;
constexpr int NE = 16, DE = 512, LCAP = 2 * M;
constexpr float ALPHA = 1.6817928305074290f;
constexpr float LN_EPS = 1e-5f, RMS_EPS = 1e-6f, GN_EPS = 64e-5f;
constexpr float C2 = 0.125f * 1.4426950408889634f;

constexpr size_t MiB = 1u << 20;
constexpr size_t WS_CTL = 0, CTL_BYTES = 1 * MiB;
constexpr size_t WS_WIN = 1 * MiB;
constexpr size_t WS_WOUT = 7 * MiB;
constexpr size_t WS_WGU = 9 * MiB;
constexpr size_t WS_WDN = 41 * MiB;
constexpr size_t WS_WSM = 57 * MiB;
constexpr size_t WS_LIST = 58 * MiB;
constexpr size_t WS_GATE = 66 * MiB;
constexpr size_t WS_EINFO = 67 * MiB;
constexpr size_t WS_XB = 68 * MiB;
constexpr size_t WS_X1 = 196 * MiB;
constexpr size_t WS_P = 324 * MiB;
constexpr size_t WS_MIX = 708 * MiB;
constexpr size_t WS_H = 324 * MiB;
constexpr size_t WS_YM = 460 * MiB;
constexpr size_t WS_END = 888 * MiB;
static_assert(WS_H + (size_t)(2 * M + NE * 256) * DE * 2 <= WS_YM && WS_YM + (size_t)2 * M * D * 2 <= WS_END, "ws map");

constexpr int CW_BAR = 0;
constexpr int CW_CNT = 8192;
constexpr int CW_Q = 8192 + 1024;

constexpr int NTHR = 512, NWAVES = 8;
constexpr int LDS_BYTES = 155648;
constexpr int GEMM_LDS = 131072;
constexpr int MISC_OFF = 147456;

__device__ __forceinline__ float bf2f(unsigned short b) { return __uint_as_float((unsigned)b << 16); }
__device__ __forceinline__ unsigned pk2(float lo, float hi) { f32x2 v = {lo, hi}; bf16x2_t b = __builtin_convertvector(v, bf16x2_t); return __builtin_bit_cast(unsigned, b); }
__device__ __forceinline__ float lo16(unsigned u) { return __uint_as_float(u << 16); }
__device__ __forceinline__ float hi16(unsigned u) { return __uint_as_float(u & 0xffff0000u); }
#define DPP(v, ctrl) __builtin_bit_cast(float, __builtin_amdgcn_update_dpp(__builtin_bit_cast(int, v), __builtin_bit_cast(int, v), (ctrl), 0xF, 0xF, false))
__device__ __forceinline__ float red8(float v) { v += DPP(v, 0xB1); v += DPP(v, 0x4E); v += DPP(v, 0x141); return v; }
__device__ __forceinline__ float red16(float v) { v = red8(v); v += DPP(v, 0x140); return v; }
__device__ __forceinline__ float red64(float v) { v = red16(v); v += __shfl_xor(v, 16); v += __shfl_xor(v, 32); return v; }
__device__ __forceinline__ float sigmoidf_(float x) { return __builtin_amdgcn_rcpf(1.0f + __expf(-x)); }
__device__ __forceinline__ float log1p_fast(float y) { return (y < 0.06f) ? y * (1.0f + y * (-0.5f + y * (0.33333334f + y * (-0.25f + y * (0.2f - y * 0.16666667f))))) : __logf(1.0f + y); }
__device__ __forceinline__ float softplusf_(float x) { return x > 20.f ? x : log1p_fast(__expf(x)); }

#define XB_TMO      128
#define XB_XCNT(j)  (256  + 64 * (j))
#define XB_XSUB(j)  (1280 + 64 * (j))
#define XB_XGEN(j)  (2304 + 64 * (j))
#define XB_TOP      3328
#define XB_TOPGEN   3392
#define XCD_BAR_WORDS 3456
#define XB_SPIN_CAP (1u << 22)
__device__ __forceinline__ unsigned xb_ld(unsigned* p)              { return __hip_atomic_load(p, __ATOMIC_RELAXED, __HIP_MEMORY_SCOPE_AGENT); }
__device__ __forceinline__ unsigned xb_add(unsigned* p, unsigned v) { return __hip_atomic_fetch_add(p, v, __ATOMIC_RELAXED, __HIP_MEMORY_SCOPE_AGENT); }
__device__ __forceinline__ unsigned xb_xcc_id() { return (unsigned)__builtin_amdgcn_s_getreg((3 << 11) | 20) & 0xFu; }
#define XB_SPIN(cond, bar) do { unsigned _sp = 0; while (cond) { __builtin_amdgcn_s_sleep(1); \
    if ((++_sp & 255u) == 0u) { if (xb_ld(&(bar)[XB_TMO])) break; if (_sp > XB_SPIN_CAP) { atomicAdd(&(bar)[XB_TMO], 1u); break; } } } } while (0)
struct XcdBarrier { unsigned* bar; unsigned x; volatile LAS unsigned* st; };
__device__ __forceinline__ XcdBarrier xcd_barrier_post(const int tid, unsigned* bar, volatile LAS unsigned* st) {
    XcdBarrier b; b.bar = bar; b.x = xb_xcc_id(); b.st = st;
    if (tid == 0) (void)xb_add(&bar[XB_XCNT(b.x)], 1u);
    return b;
}
__device__ __forceinline__ void xcd_barrier_complete(unsigned* bar, unsigned x, unsigned& nloc, unsigned& nx) {
    const unsigned G = gridDim.x * gridDim.y * gridDim.z;
    unsigned sum, cnt, mine, sp = 0u;
    for (;;) {
        sum = 0u; cnt = 0u; mine = 0u;
#pragma unroll
        for (unsigned j = 0; j < 16; ++j) { const unsigned c = xb_ld(&bar[XB_XCNT(j)]); sum += c; cnt += (c > 0u) ? 1u : 0u; mine = (j == x) ? c : mine; }
        if (sum == G) break;
        __builtin_amdgcn_s_sleep(1);
        if ((++sp & 255u) == 0u) { if (xb_ld(&bar[XB_TMO])) break; if (sp > XB_SPIN_CAP) { atomicAdd(&bar[XB_TMO], 1u); break; } }
    }
    nloc = mine > 0u ? mine : 1u; nx = cnt > 0u ? cnt : 1u;
}
__device__ __forceinline__ void xcd_barrier(const int tid, const XcdBarrier& b) {
    asm volatile("s_waitcnt vmcnt(0)" ::: "memory");
    __syncthreads();
    if (tid == 0) {
        unsigned* bar = b.bar;
        __builtin_amdgcn_s_waitcnt(0);
        unsigned nloc = b.st[0], nx = b.st[1];
        if (nloc == 0u) { xcd_barrier_complete(bar, b.x, nloc, nx); b.st[0] = nloc; b.st[1] = nx; }
        const unsigned old = xb_add(&bar[XB_XSUB(b.x)], 1u);
        const unsigned gen = old / nloc;
        if (old + 1u == (gen + 1u) * nloc) {
            __builtin_amdgcn_fence(__ATOMIC_RELEASE, "agent");
            asm volatile("s_waitcnt vmcnt(0)" ::: "memory");
            const unsigned og = xb_add(&bar[XB_TOP], 1u);
            const unsigned tg = og / nx;
            if (og + 1u == (tg + 1u) * nx) xb_add(&bar[XB_TOPGEN], 1u);
            else XB_SPIN(xb_ld(&bar[XB_TOPGEN]) == tg, bar);
            __builtin_amdgcn_fence(__ATOMIC_ACQUIRE, "agent");
            xb_add(&bar[XB_XGEN(b.x)], 1u);
            asm volatile("s_waitcnt vmcnt(0)" ::: "memory");
        } else {
            XB_SPIN(xb_ld(&bar[XB_XGEN(b.x)]) == gen, bar);
            __builtin_amdgcn_fence(__ATOMIC_ACQUIRE, "agent");
            asm volatile("s_waitcnt vmcnt(0)" ::: "memory");
        }
    }
    __syncthreads();
}

namespace pg8 {
constexpr int BM = 256, BK = 64, HALF = 128, HTB = HALF * BK * 2, STAGE_BYTES = 8 * HTB;
__host__ __device__ __forceinline__ int lds_byte(int r, int c) { const int st = (r >> 4) * 2 + (c >> 5), rr = r & 15, cc = c & 31, ob = rr * 64 + cc * 2; return st * 1024 + (ob ^ (((ob >> 9) & 1) << 5)); }
__host__ __device__ __forceinline__ void stage_rc(int b, int& R, int& C) { const int st = b / 1024, sb = b % 1024, swz = sb ^ (((sb >> 9) & 1) << 5); R = (st >> 1) * 16 + swz / 64; C = (st & 1) * 32 + (swz % 64) / 2; }
__host__ __device__ __forceinline__ int perm32(int rho) { const int n = rho >> 4, i = rho & 15; return 8 * (i >> 2) + 4 * n + (i & 3); }

struct Unit { int pm, pn, e, j; };
template <class Epi, class Sched, bool ALIGN_EPI>
__device__ __forceinline__ void gemm_phase(const int tid, LAS unsigned char* lds, const char* Abase, const int K, const Sched& S, const Epi& E) {
    const int wid = __builtin_amdgcn_readfirstlane(tid >> 6), lane = tid & 63, wr = wid >> 2, wc = wid & 3, fr = lane & 15, fq = lane >> 4;
    const int nt = K / BK;
    int R0, C0; stage_rc(tid * 16, R0, C0);
    const int Rb0 = (R0 & ~31) + perm32(R0 & 31);
    unsigned voffB[2]; voffB[0] = (unsigned)(Rb0 * K + C0) * 2u; voffB[1] = (unsigned)((Rb0 + 64) * K + C0) * 2u;
    unsigned voffA[2]; voffA[0] = (unsigned)(R0 * K + C0) * 2u; voffA[1] = (unsigned)((R0 + 64) * K + C0) * 2u;
    const unsigned colA = (unsigned)C0 * 2u;
    const size_t kstep = (size_t)(BK * 2);
    const size_t hstepB = (size_t)HALF * K * 2, hstepA = hstepB;
    const unsigned ldsw = (unsigned)wid * 1024u;
    const int aoff = lds_byte(wr * 64 + fr, fq * 8), boff = lds_byte(wc * 32 + fr, fq * 8);
#define PG8_SA(b, h) (((b) * 2 + (h)) * HTB)
#define PG8_SB(b, h) ((4 + (b) * 2 + (h)) * HTB)
#define PG8_STAGE_B(bufoff, gbase) do { _Pragma("unroll") for (int _i = 0; _i < 2; ++_i) \
        __builtin_amdgcn_global_load_lds((const unsigned*)((const char*)(gbase) + voffB[_i]), (LAS unsigned*)(lds + (bufoff) + ldsw + _i * 8192), 16, 0, 0); } while (0)
#define PG8_STAGE_A(bufoff, h, kbyte, nx) do { \
        if constexpr (Sched::GATHER) { _Pragma("unroll") for (int _i = 0; _i < 2; ++_i) { const unsigned _o = (nx) ? na[h][_i] : ca[h][_i]; \
            __builtin_amdgcn_global_load_lds((const unsigned*)(Abase + (kbyte) + _o), (LAS unsigned*)(lds + (bufoff) + ldsw + _i * 8192), 16, 0, 0); } } \
        else { const char* _p = ((nx) ? nA : cA) + (kbyte) + (size_t)(h) * hstepA; _Pragma("unroll") for (int _i = 0; _i < 2; ++_i) \
            __builtin_amdgcn_global_load_lds((const unsigned*)(_p + voffA[_i]), (LAS unsigned*)(lds + (bufoff) + ldsw + _i * 8192), 16, 0, 0); } } while (0)
#define PG8_LDA(dst, b, h) do { _Pragma("unroll") for (int m = 0; m < 4; ++m) _Pragma("unroll") for (int k = 0; k < 2; ++k) dst[m][k] = *(const LAS bf16x8*)(lds + PG8_SA(b, h) + aoff + m * 2048 + k * 1024); } while (0)
#define PG8_LDB(dst, b, h) do { _Pragma("unroll") for (int n = 0; n < 2; ++n) _Pragma("unroll") for (int k = 0; k < 2; ++k) dst[n][k] = *(const LAS bf16x8*)(lds + PG8_SB(b, h) + boff + n * 2048 + k * 1024); } while (0)
#define PG8_MMA(ai, bj, At, Bt) do { __builtin_amdgcn_s_setprio(1); _Pragma("unroll") for (int m = 0; m < 4; ++m) _Pragma("unroll") for (int n = 0; n < 2; ++n) _Pragma("unroll") for (int k = 0; k < 2; ++k) \
        acc[ai][bj][m][n] = __builtin_amdgcn_mfma_f32_16x16x32_bf16(Bt[n][k], At[m][k], acc[ai][bj][m][n], 0, 0, 0); __builtin_amdgcn_s_setprio(0); } while (0)
#define PG8_WAIT_V(n) asm volatile("s_waitcnt vmcnt(" #n ")" ::: "memory")
#define PG8_WAIT_L(n) asm volatile("s_waitcnt lgkmcnt(" #n ")" ::: "memory")
#define PG8_BAR __builtin_amdgcn_s_barrier()
#define PG8_SCHED __builtin_amdgcn_sched_barrier(0)
    Unit cur, nxt; int ui = 0;
    if (!S.next(0, cur)) return;
    unsigned ca[2][2], na[2][2];
    const char* cA = Abase; const char* nA = Abase;
    if constexpr (Sched::GATHER) S.aoffs(cur, R0, colA, ca); else cA = Abase + (size_t)S.arow0(cur) * K * 2;
    f32x4 acc[2][2][4][2];
#pragma unroll
    for (int a = 0; a < 2; ++a)
#pragma unroll
        for (int b = 0; b < 2; ++b)
#pragma unroll
            for (int m = 0; m < 4; ++m)
#pragma unroll
                for (int n = 0; n < 2; ++n) acc[a][b][m][n] = (f32x4){0.f, 0.f, 0.f, 0.f};
    bf16x8 At[4][2], B0[2][2], B1[2][2];
    const char* cB = S.bbase(cur);
    PG8_STAGE_B(PG8_SB(0, 0), cB); PG8_STAGE_B(PG8_SB(0, 1), cB + hstepB); PG8_STAGE_A(PG8_SA(0, 0), 0, 0, false); PG8_STAGE_A(PG8_SA(0, 1), 1, 0, false);
    if (wr == 1) PG8_BAR;
    PG8_WAIT_V(2); PG8_BAR;
    PG8_STAGE_B(PG8_SB(1, 0), cB + kstep); PG8_STAGE_A(PG8_SA(1, 0), 0, kstep, false); PG8_STAGE_B(PG8_SB(1, 1), cB + hstepB + kstep);
    PG8_WAIT_V(6); PG8_BAR;
    for (;;) {
        const bool has_next = S.next(ui + 1, nxt);
        const char* nB = cB;
        nA = cA;
        if (has_next) { nB = S.bbase(nxt); if constexpr (Sched::GATHER) S.aoffs(nxt, R0, colA, na); else nA = Abase + (size_t)S.arow0(nxt) * K * 2; }
        else if constexpr (Sched::GATHER) { na[0][0] = ca[0][0]; na[0][1] = ca[0][1]; na[1][0] = ca[1][0]; na[1][1] = ca[1][1]; }
        for (int t = 0; t < nt; t += 2) {
            const bool last = (t == nt - 2);
            const size_t k1 = (size_t)(t + 1) * kstep;
            const size_t k2 = last ? 0 : (size_t)(t + 2) * kstep, k3 = k2 + kstep;
            const char* b2 = last ? nB : cB + (size_t)(t + 2) * kstep; const char* b3 = b2 + kstep;
            PG8_LDB(B0, 0, 0); PG8_LDB(B1, 0, 1); PG8_SCHED; PG8_LDA(At, 0, 0); PG8_STAGE_A(PG8_SA(1, 1), 1, k1, false);
            PG8_WAIT_V(8); PG8_WAIT_L(0); PG8_BAR; PG8_MMA(0, 0, At, B0); PG8_MMA(0, 1, At, B1); PG8_BAR; PG8_SCHED;
            PG8_LDA(At, 0, 1); PG8_STAGE_B(PG8_SB(0, 0), b2); PG8_STAGE_B(PG8_SB(0, 1), b2 + hstepB); PG8_STAGE_A(PG8_SA(0, 0), 0, k2, last);
            PG8_WAIT_V(8); PG8_WAIT_L(0); PG8_BAR; PG8_MMA(1, 0, At, B0); PG8_MMA(1, 1, At, B1); PG8_BAR; PG8_SCHED;
            PG8_LDB(B0, 1, 0); PG8_LDB(B1, 1, 1); PG8_SCHED; PG8_LDA(At, 1, 0); PG8_STAGE_A(PG8_SA(0, 1), 1, k2, last);
            PG8_WAIT_V(8); PG8_WAIT_L(0); PG8_BAR; PG8_MMA(0, 0, At, B0); PG8_MMA(0, 1, At, B1); PG8_BAR; PG8_SCHED;
            PG8_LDA(At, 1, 1); PG8_STAGE_B(PG8_SB(1, 0), b3); PG8_STAGE_B(PG8_SB(1, 1), b3 + hstepB); PG8_STAGE_A(PG8_SA(1, 0), 0, k3, last);
            PG8_WAIT_V(8); PG8_WAIT_L(0); PG8_BAR; PG8_MMA(1, 0, At, B0); PG8_MMA(1, 1, At, B1); PG8_BAR; PG8_SCHED;
        }
        if constexpr (ALIGN_EPI) { if (wr == 0) PG8_BAR; }
        E(acc, cur, wr, wc, fr, fq);
        if (!has_next) break;
#pragma unroll
        for (int a = 0; a < 2; ++a)
#pragma unroll
            for (int b = 0; b < 2; ++b)
#pragma unroll
                for (int m = 0; m < 4; ++m)
#pragma unroll
                    for (int n = 0; n < 2; ++n) acc[a][b][m][n] = (f32x4){0.f, 0.f, 0.f, 0.f};
        cur = nxt; cB = nB; cA = nA; ++ui;
        if constexpr (Sched::GATHER) { ca[0][0] = na[0][0]; ca[0][1] = na[0][1]; ca[1][0] = na[1][0]; ca[1][1] = na[1][1]; }
        if constexpr (ALIGN_EPI) { if (wr == 1) PG8_BAR; }
    }
    PG8_WAIT_V(0);
    if constexpr (!ALIGN_EPI) { if (wr == 0) PG8_BAR; }
    PG8_BAR;
#undef PG8_SA
#undef PG8_SB
#undef PG8_STAGE_A
#undef PG8_STAGE_B
#undef PG8_LDA
#undef PG8_LDB
#undef PG8_MMA
#undef PG8_WAIT_V
#undef PG8_WAIT_L
#undef PG8_BAR
#undef PG8_SCHED
}

struct DenseOrder {
    static constexpr bool GATHER = false;
    int nM, nN, nwg, G, c, K; const char* Bt;
    __device__ __forceinline__ int arow0(const Unit& u) const { return u.pm * BM; }
    __device__ __forceinline__ void init(int M_, int N_, int K_, int G_, int c_, const void* Bt_) { nM = M_ / BM; nN = N_ / BM; nwg = nM * nN; G = G_; c = c_; K = K_; Bt = (const char*)Bt_; }
    __device__ __forceinline__ bool next(int i, Unit& u) const {
        const long L = (long)i * G + c; if (L >= nwg) return false;
        int wgid = (int)L; { const int q = nwg / 8, r = nwg % 8, xcd = wgid % 8, off = wgid / 8; wgid = (xcd < r ? xcd * (q + 1) : r * (q + 1) + (xcd - r) * q) + off; }
        const int nig = 8 * nN, gid = wgid / nig, fm = gid * 8, gsz = (nM - fm) < 8 ? (nM - fm) : 8;
        u.pm = fm + ((wgid % nig) % gsz); u.pn = (wgid % nig) / gsz; u.e = 0; u.j = 0; return true;
    }
    __device__ __forceinline__ void aoffs(const Unit& u, int R0, unsigned colA, unsigned (&o)[2][2]) const {
#pragma unroll
        for (int h = 0; h < 2; ++h)
#pragma unroll
            for (int i = 0; i < 2; ++i) o[h][i] = (unsigned)(u.pm * BM + h * HALF + R0 + 64 * i) * (unsigned)(K * 2) + colA;
    }
    __device__ __forceinline__ const char* bbase(const Unit& u) const { return Bt + (size_t)u.pn * BM * K * 2; }
};
template <bool GATHER_>
struct MoeOrder {
    static constexpr bool GATHER = GATHER_;
    __device__ __forceinline__ int arow0(const Unit& u) const { return u.pm * BM; }
    const LAS int* tab;
    int G, c, K, nN; const char* Bt; size_t estride;
    const int* list;
    __device__ __forceinline__ bool next(int i, Unit& u) const {
        const int L = i * G + c; const int nb = tab[16];
        if (L >= nb * nN) return false;
        const int rb = L / nN; u.pn = L % nN; u.pm = rb;
        int e = 0;
#pragma unroll
        for (int k = 1; k < 16; ++k) e += (rb >= tab[k]) ? 1 : 0;
        u.e = e; u.j = rb - tab[e]; return true;
    }
    __device__ __forceinline__ void aoffs(const Unit& u, int R0, unsigned colA, unsigned (&o)[2][2]) const {
        const int cnt = tab[32 + u.e];
#pragma unroll
        for (int h = 0; h < 2; ++h)
#pragma unroll
            for (int i = 0; i < 2; ++i) {
                const int r = h * HALF + R0 + 64 * i;
                const int pos = u.j * BM + r; const unsigned row = (pos < cnt) ? (unsigned)(list[(size_t)u.e * LCAP + pos] >> 1) : 0u;
                o[h][i] = row * (unsigned)(K * 2) + colA;
            }
    }
    __device__ __forceinline__ const char* bbase(const Unit& u) const { return Bt + (size_t)u.e * estride + (size_t)u.pn * BM * K * 2; }
};

__device__ __forceinline__ u32x4 pack8(const f32x4 v0, const f32x4 v1) { u32x4 w; w.x = pk2(v0[0], v0[1]); w.y = pk2(v0[2], v0[3]); w.z = pk2(v1[0], v1[1]); w.w = pk2(v1[2], v1[3]); return w; }
struct EpiIn {
    bf16* O;
    __device__ __forceinline__ void operator()(const f32x4 (&acc)[2][2][4][2], const Unit& u, int wr, int wc, int fr, int fq) const {
        const int row0 = u.pm * BM + wr * 64 + fr, col0 = u.pn * BM + wc * 32 + 8 * fq;
#pragma unroll
        for (int ai = 0; ai < 2; ++ai)
#pragma unroll
            for (int m = 0; m < 4; ++m) { bf16* rowp = O + (size_t)(row0 + ai * HALF + m * 16) * INC + col0;
#pragma unroll
                for (int bj = 0; bj < 2; ++bj) { const int c = col0 + bj * HALF; const float sc = (c >= PC_SQ && c < PC_SK) ? C2 : 1.0f;
                    *(u32x4*)(rowp + bj * HALF) = pack8(acc[ai][bj][m][0] * sc, acc[ai][bj][m][1] * sc); } }
    }
};
struct EpiOut {
    const bf16* X; bf16* O;
    __device__ __forceinline__ void operator()(const f32x4 (&acc)[2][2][4][2], const Unit& u, int wr, int wc, int fr, int fq) const {
        const int row0 = u.pm * BM + wr * 64 + fr, col0 = u.pn * BM + wc * 32 + 8 * fq;
#pragma unroll
        for (int ai = 0; ai < 2; ++ai)
#pragma unroll
            for (int m = 0; m < 4; ++m) { const size_t off = (size_t)(row0 + ai * HALF + m * 16) * D + col0;
#pragma unroll
                for (int bj = 0; bj < 2; ++bj) { const u32x4 xv = *(const u32x4*)(X + off + bj * HALF);
                    f32x4 v0 = acc[ai][bj][m][0], v1 = acc[ai][bj][m][1];
                    v0[0] += ALPHA * lo16(xv.x); v0[1] += ALPHA * hi16(xv.x); v0[2] += ALPHA * lo16(xv.y); v0[3] += ALPHA * hi16(xv.y);
                    v1[0] += ALPHA * lo16(xv.z); v1[1] += ALPHA * hi16(xv.z); v1[2] += ALPHA * lo16(xv.w); v1[3] += ALPHA * hi16(xv.w);
                    *(u32x4*)(O + off + bj * HALF) = pack8(v0, v1); } }
    }
};
struct EpiMoe1 {
    bf16* Hb;
    __device__ __forceinline__ void operator()(const f32x4 (&acc)[2][2][4][2], const Unit& u, int wr, int wc, int fr, int fq) const {
        const int row0 = u.pm * BM + wr * 64 + fr, col0 = u.pn * HALF + wc * 32 + 8 * fq;
#pragma unroll
        for (int ai = 0; ai < 2; ++ai)
#pragma unroll
            for (int m = 0; m < 4; ++m) {
                f32x4 g0 = acc[ai][0][m][0], g1 = acc[ai][0][m][1]; const f32x4 u0 = acc[ai][1][m][0], u1 = acc[ai][1][m][1];
#pragma unroll
                for (int q = 0; q < 4; ++q) { g0[q] = g0[q] * sigmoidf_(g0[q]) * u0[q]; g1[q] = g1[q] * sigmoidf_(g1[q]) * u1[q]; }
                *(u32x4*)(Hb + (size_t)(row0 + ai * HALF + m * 16) * DE + col0) = pack8(g0, g1); }
    }
};
struct EpiMoe2 {
    bf16* Y;
    __device__ __forceinline__ void operator()(const f32x4 (&acc)[2][2][4][2], const Unit& u, int wr, int wc, int fr, int fq) const {
        const int row0 = u.pm * BM + wr * 64 + fr, col0 = u.pn * BM + wc * 32 + 8 * fq;
#pragma unroll
        for (int ai = 0; ai < 2; ++ai)
#pragma unroll
            for (int m = 0; m < 4; ++m) { bf16* rowp = Y + (size_t)(row0 + ai * HALF + m * 16) * D + col0;
#pragma unroll
                for (int bj = 0; bj < 2; ++bj) *(u32x4*)(rowp + bj * HALF) = pack8(acc[ai][bj][m][0], acc[ai][bj][m][1]); }
    }
};
}

struct Args {
    const float* in[32]; float* out; unsigned char* ws;
    int l_lo, l_hi, ph_lo, ph_hi;
    int use_bar, pad;
};
enum { I_X = 0, I_WIN, I_MU, I_W0, I_WUP, I_A0, I_AUP, I_GUP, I_KK, I_KA, I_RK, I_LNG, I_LNB, I_CW, I_CB, I_WA, I_BA, I_WX, I_BX, I_LAM, I_LRUG, I_SBAG,
       I_WOUT, I_LN1G, I_LN1B, I_LN2G, I_LN2B, I_RW, I_RB, I_EG, I_EU, I_ED };
constexpr int NPH = 10;

__device__ __forceinline__ void transpose_item(const float* W, int N, bf16* WT, int pitch, int drow0, int k0, int n0, float* scr, int lane) {
#pragma unroll 8
    for (int i = 0; i < 32; ++i) { const int kk = 2 * i + (lane >> 5); scr[kk * 33 + (lane & 31)] = W[(size_t)(k0 + kk) * N + n0 + (lane & 31)]; }
    asm volatile("s_waitcnt lgkmcnt(0)" ::: "memory");
    const int c = lane & 7;
#pragma unroll
    for (int j = 0; j < 4; ++j) { const int n = (lane >> 3) + 8 * j; const float* s = scr + (8 * c) * 33 + n;
        u32x4 o; o.x = pk2(s[0 * 33], s[1 * 33]); o.y = pk2(s[2 * 33], s[3 * 33]); o.z = pk2(s[4 * 33], s[5 * 33]); o.w = pk2(s[6 * 33], s[7 * 33]);
        *(u32x4*)(WT + (size_t)(drow0 + n) * pitch + k0 + 8 * c) = o; }
    asm volatile("s_waitcnt lgkmcnt(0)" ::: "memory");
}
__device__ __forceinline__ void phase_convert(const int tid, const Args& A, int layer, float* ldsf, int vcu, int G) {
    const int lane = tid & 63, wave = tid >> 6;
    float* scr = ldsf + wave * 4096;
    unsigned char* ws = A.ws;
    bf16* Win = (bf16*)(ws + WS_WIN); bf16* Wout = (bf16*)(ws + WS_WOUT); bf16* Wgu = (bf16*)(ws + WS_WGU); bf16* Wdn = (bf16*)(ws + WS_WDN);
    bf16* WupT = (bf16*)(ws + WS_WSM); bf16* AupT = WupT + 384 * 64; bf16* GupT = AupT + 384 * 64;
    const int gw = vcu * NWAVES + wave, NGW = G * NWAVES;
    constexpr int I_IN = 16 * 96, I_OUT = 16 * 32, I_G = 16 * 256, I_U = 16 * 256, I_D = 16 * 256, I_S1 = 12, I_S2 = 12, I_S3 = 24, I_S4 = 16;
    constexpr int NIT = I_IN + I_OUT + I_G + I_U + I_D + I_S1 + I_S2 + I_S3 + I_S4;
    for (int it = gw; it < NIT; it += NGW) {
        int r = it;
        if (r < I_IN) { const int kb = r / 96, nb = r % 96; transpose_item(A.in[I_WIN] + (size_t)layer * D * INC, INC, Win, D, 32 * nb, 64 * kb, 32 * nb, scr, lane); continue; } r -= I_IN;
        if (r < I_OUT) { const int kb = r / 32, nb = r % 32; transpose_item(A.in[I_WOUT] + (size_t)layer * D * D, D, Wout, D, 32 * nb, 64 * kb, 32 * nb, scr, lane); continue; } r -= I_OUT;
        if (r < I_G + I_U) { const int up = r >= I_G; if (up) r -= I_G; const int e = r / 256, q = r % 256, kb = q / 16, nb = q % 16, n0 = 32 * nb;
            const float* src = A.in[up ? I_EU : I_EG] + ((size_t)layer * NE + e) * D * DE;
            transpose_item(src, DE, Wgu, D, e * 1024 + (n0 >> 7) * 256 + up * 128 + (n0 & 127), 64 * kb, n0, scr, lane); continue; } r -= I_G + I_U;
        if (r < I_D) { const int e = r / 256, q = r % 256, kb = q / 32, nb = q % 32;
            transpose_item(A.in[I_ED] + ((size_t)layer * NE + e) * DE * D, D, Wdn, DE, e * 1024 + 32 * nb, 64 * kb, 32 * nb, scr, lane); continue; } r -= I_D;
        if (r < I_S1) { transpose_item(A.in[I_WUP] + (size_t)layer * 64 * RW, RW, WupT, 64, 32 * r, 0, 32 * r, scr, lane); continue; } r -= I_S1;
        if (r < I_S2) { transpose_item(A.in[I_AUP] + (size_t)layer * 64 * RW, RW, AupT, 64, 32 * r, 0, 32 * r, scr, lane); continue; } r -= I_S2;
        if (r < I_S3) { const int kb = r / 12, nb = r % 12; transpose_item(A.in[I_GUP] + (size_t)layer * 128 * RW, RW, GupT, 128, 32 * nb, 64 * kb, 32 * nb, scr, lane); continue; } r -= I_S3;
        { const int x = r >> 3, gq = (r >> 1) & 3, nb = r & 1;
          transpose_item(A.in[x ? I_WX : I_WA] + ((size_t)layer * LB + gq) * 4096, 64, GupT + 384 * 128 + x * 16384, 64, gq * 64 + 32 * nb, 0, 32 * nb, scr, lane); }
    }
    if (layer == 0) {
        const f32x4* x4 = (const f32x4*)A.in[I_X]; u32x4* o = (u32x4*)(ws + WS_XB);
        const size_t n8 = (size_t)M * D / 8;
        for (size_t i = (size_t)vcu * NTHR + tid; i < n8; i += (size_t)G * NTHR) { const f32x4 a = x4[2 * i], b = x4[2 * i + 1]; o[i] = pg8::pack8(a, b); }
    }
}

typedef short v4i16_t __attribute__((ext_vector_type(4)));
template <bool MASK>
__device__ __forceinline__ void attn_tile(const bf16* Ks, const bf16* Vs, const bf16x8 (&qr)[4], f32x16& o0, f32x16& o1, float& Rrun, const int k0, const int qmine, const int r, const int hh, const int vtr_off) {
    f32x16 p0 = {}, p1 = {};
#pragma unroll
    for (int s = 0; s < 4; ++s) {
        const bf16x8 ka = *(const bf16x8*)(Ks + r * 72 + 16 * s + 8 * hh);
        const bf16x8 kb = *(const bf16x8*)(Ks + (32 + r) * 72 + 16 * s + 8 * hh);
        p0 = __builtin_amdgcn_mfma_f32_32x32x16_bf16(ka, qr[s], p0, 0, 0, 0);
        p1 = __builtin_amdgcn_mfma_f32_32x32x16_bf16(kb, qr[s], p1, 0, 0, 0);
    }
    float pa[8]; f32x2 va[8], vb[8];
#pragma unroll
    for (int g = 0; g < 8; ++g) {
        float z[4];
#pragma unroll
        for (int i = 0; i < 4; ++i) z[i] = (g < 4) ? p0[4 * g + i] : p1[4 * (g - 4) + i];
        const f32x2 eA = {__builtin_amdgcn_exp2f(z[0]), __builtin_amdgcn_exp2f(z[1])}, eB = {__builtin_amdgcn_exp2f(z[2]), __builtin_amdgcn_exp2f(z[3])};
        const f32x2 dA = eA + 1.0f, dB = eB + 1.0f;
        f32x2 kA = {__builtin_amdgcn_rcpf(dA[0]), __builtin_amdgcn_rcpf(dA[1])}, kB = {__builtin_amdgcn_rcpf(dB[0]), __builtin_amdgcn_rcpf(dB[1])};
        if (MASK) { const int key = k0 + 32 * (g >> 2) + 8 * (g & 3) + 4 * hh;
            kA[0] = (key + 0 >= qmine) ? 1.0f : kA[0]; kA[1] = (key + 1 >= qmine) ? 1.0f : kA[1]; kB[0] = (key + 2 >= qmine) ? 1.0f : kB[0]; kB[1] = (key + 3 >= qmine) ? 1.0f : kB[1]; }
        const f32x2 sA = 1.0f - kA, sB = 1.0f - kB;
        const float x1 = kB[1] * kB[0], x0 = x1 * kA[1];
        pa[g] = x0 * kA[0];
        va[g] = sA * (f32x2){x0, x1}; vb[g] = sB * (f32x2){kB[1], 1.0f};
    }
    float pi[16];
#pragma unroll
    for (int g = 0; g < 8; ++g) { const auto rr = __builtin_amdgcn_permlane32_swap(__float_as_uint(pa[g]), __float_as_uint(pa[g]), false, false);
        pi[2 * g] = __uint_as_float(rr[0]); pi[2 * g + 1] = __uint_as_float(rr[1]); }
    float S[16];
    S[15] = Rrun;
#pragma unroll
    for (int j = 14; j >= 0; --j) S[j] = S[j + 1] * pi[j + 1];
    Rrun = S[0] * pi[0];
#pragma unroll
    for (int g = 0; g < 8; ++g) {
        const float re = hh ? S[2 * g + 1] : S[2 * g];
        va[g] = va[g] * re; vb[g] = vb[g] * re;
    }
#pragma unroll
    for (int s = 0; s < 4; ++s) {
        u32x4 pw;
        pw.x = pk2(va[2 * s][0], va[2 * s][1]); pw.y = pk2(vb[2 * s][0], vb[2 * s][1]); pw.z = pk2(va[2 * s + 1][0], va[2 * s + 1][1]); pw.w = pk2(vb[2 * s + 1][0], vb[2 * s + 1][1]);
        const bf16x8 pf = __builtin_bit_cast(bf16x8, pw);
        const bf16* vbp = Vs + 16 * s * 72 + vtr_off;
        { const v4i16_t lo = __builtin_amdgcn_ds_read_tr16_b64_v4i16((LAS v4i16_t*)(vbp)), hi = __builtin_amdgcn_ds_read_tr16_b64_v4i16((LAS v4i16_t*)(vbp + 8 * 72));
          const bf16x8 vf = __builtin_shufflevector(lo, hi, 0, 1, 2, 3, 4, 5, 6, 7);
          o0 = __builtin_amdgcn_mfma_f32_32x32x16_bf16(vf, pf, o0, 0, 0, 0); }
        { const v4i16_t lo = __builtin_amdgcn_ds_read_tr16_b64_v4i16((LAS v4i16_t*)(vbp + 32)), hi = __builtin_amdgcn_ds_read_tr16_b64_v4i16((LAS v4i16_t*)(vbp + 8 * 72 + 32));
          const bf16x8 vf = __builtin_shufflevector(lo, hi, 0, 1, 2, 3, 4, 5, 6, 7);
          o1 = __builtin_amdgcn_mfma_f32_32x32x16_bf16(vf, pf, o1, 0, 0, 0); }
    }
}
__device__ __forceinline__ void attn_unit(const int tid_in, const Args& A, int layer, int bh, int qb, unsigned char* lds) {
    int tid = tid_in; asm volatile("" : "+v"(tid));
    const int lane = tid & 63, wave = __builtin_amdgcn_readfirstlane(tid >> 6), r = lane & 31, hh = lane >> 5;
    const int b = bh / SH, h = bh % SH;
    const bf16* P = (const bf16*)(A.ws + WS_P) + (size_t)b * SEQ * INC;
    bf16* MIX = (bf16*)(A.ws + WS_MIX) + (size_t)b * SEQ * D;
    bf16* KV = (bf16*)lds;
    constexpr int SLOT = 2 * 64 * 72;
    const int q0w = qb * 256 + wave * 32;
    bf16x8 qr[4];
#pragma unroll
    for (int s = 0; s < 4; ++s) qr[s] = *(const bf16x8*)(P + (size_t)(q0w + r) * INC + PC_SQ + h * 64 + 16 * s + 8 * hh);
    f32x16 o0 = {}, o1 = {};
    float Rrun = 1.0f;
    const int qmine = q0w + r;
    const int lkey = tid >> 3, lch = (tid & 7) * 8;
    const int NT = 4 * qb + 4;
    const int g16 = lane >> 4, i16 = lane & 15;
    const int vtr_off = (4 * (g16 >> 1) + (i16 >> 2)) * 72 + 16 * (g16 & 1) + 4 * (i16 & 3);
    u32x4 kreg, vreg;
    { const int jt0 = NT - 1;
      kreg = *(const u32x4*)(P + (size_t)(64 * jt0 + lkey) * INC + PC_SK + h * 64 + lch);
      vreg = *(const u32x4*)(P + (size_t)(64 * jt0 + lkey) * INC + PC_SV + h * 64 + lch); }
    __syncthreads();
    { bf16* s0 = KV + ((NT - 1) & 1) * SLOT; *(u32x4*)(s0 + lkey * 72 + lch) = kreg; *(u32x4*)(s0 + 64 * 72 + lkey * 72 + lch) = vreg; }
    if (NT >= 2) { const int jt1 = NT - 2;
      kreg = *(const u32x4*)(P + (size_t)(64 * jt1 + lkey) * INC + PC_SK + h * 64 + lch);
      vreg = *(const u32x4*)(P + (size_t)(64 * jt1 + lkey) * INC + PC_SV + h * 64 + lch); }
    asm volatile("s_waitcnt lgkmcnt(0)\n\ts_barrier" ::: "memory");
    for (int jt = NT - 1; jt >= 0; --jt) {
        const bf16* Ks = KV + (jt & 1) * SLOT; const bf16* Vs = Ks + 64 * 72;
        if (jt >= 1) {
            bf16* sn = KV + ((jt - 1) & 1) * SLOT;
            *(u32x4*)(sn + lkey * 72 + lch) = kreg; *(u32x4*)(sn + 64 * 72 + lkey * 72 + lch) = vreg;
            if (jt >= 2) {
                kreg = *(const u32x4*)(P + (size_t)(64 * (jt - 2) + lkey) * INC + PC_SK + h * 64 + lch);
                vreg = *(const u32x4*)(P + (size_t)(64 * (jt - 2) + lkey) * INC + PC_SV + h * 64 + lch);
            }
        }
        const int k0 = 64 * jt;
        if (k0 < q0w + 31) {
            if (k0 + 63 >= q0w) attn_tile<true>(Ks, Vs, qr, o0, o1, Rrun, k0, qmine, r, hh, vtr_off);
            else attn_tile<false>(Ks, Vs, qr, o0, o1, Rrun, k0, qmine, r, hh, vtr_off);
        }
        int* dflag = (int*)(KV + 2 * SLOT) + (jt & 1) * 8;
        { const bool mydone = __all(Rrun == 0.0f); if (lane == 0) dflag[wave] = mydone ? 1 : 0; }
        asm volatile("s_waitcnt lgkmcnt(0)\n\ts_barrier" ::: "memory");
        { const u32x4 f0 = *(const u32x4*)dflag, f1 = *(const u32x4*)(dflag + 4);
          if ((f0.x & f0.y & f0.z & f0.w & f1.x & f1.y & f1.z & f1.w) != 0u) break; }
    }
    float ss = 0.f;
#pragma unroll
    for (int i = 0; i < 16; ++i) ss += o0[i] * o0[i] + o1[i] * o1[i];
    ss += __shfl_xor(ss, 32);
    const float sc = rsqrtf(ss * (1.0f / 64.0f) + RMS_EPS);
    const float* ng = A.in[I_SBAG] + layer * SW + h * 64;
    bf16* orow = MIX + (size_t)(q0w + r) * D + MIX_S + h * 64;
#pragma unroll
    for (int g = 0; g < 4; ++g) {
        const int d = 8 * g + 4 * hh;
        const f32x4 g0 = *(const f32x4*)(ng + d), g1 = *(const f32x4*)(ng + 32 + d);
        u32x2 w0, w1;
        w0.x = pk2(o0[4 * g] * sc * g0[0], o0[4 * g + 1] * sc * g0[1]); w0.y = pk2(o0[4 * g + 2] * sc * g0[2], o0[4 * g + 3] * sc * g0[3]);
        w1.x = pk2(o1[4 * g] * sc * g1[0], o1[4 * g + 1] * sc * g1[1]); w1.y = pk2(o1[4 * g + 2] * sc * g1[2], o1[4 * g + 3] * sc * g1[3]);
        *(u32x2*)(orow + d) = w0; *(u32x2*)(orow + 32 + d) = w1;
    }
}

constexpr int CP = 72;
constexpr size_t SC_MP = 0, SC_NN = 48 * MiB, SC_QH = 96 * MiB, SC_OL = 144 * MiB, SC_HS = 192 * MiB;
constexpr size_t WS_G = 836 * MiB, WS_RHO = 884 * MiB, WS_GC = 886 * MiB;
__device__ __forceinline__ f32x16 mm32(const bf16* X, const bf16* Y, int lane, f32x16 acc) {
    const int r = lane & 31, hh = lane >> 5;
#pragma unroll
    for (int s_ = 0; s_ < 4; ++s_) {
        const bf16x8 a = *(const bf16x8*)(X + r * CP + 16 * s_ + 8 * hh);
        const bf16x8 b = *(const bf16x8*)(Y + r * CP + 16 * s_ + 8 * hh);
        acc = __builtin_amdgcn_mfma_f32_32x32x16_bf16(a, b, acc, 0, 0, 0);
    }
    return acc;
}
__device__ __forceinline__ u32x4 packfrag(const f32x16& a, int sp) {
    u32x4 w;
    if (sp == 0) { w.x = pk2(a[0], a[1]); w.y = pk2(a[2], a[3]); w.z = pk2(a[4], a[5]); w.w = pk2(a[6], a[7]); }
    else { w.x = pk2(a[8], a[9]); w.y = pk2(a[10], a[11]); w.z = pk2(a[12], a[13]); w.w = pk2(a[14], a[15]); }
    return w;
}
struct R1Pre { u32x4 cu[4], pv[4]; };
__device__ __forceinline__ void rwkv_r1_prefetch(const int tid, const Args& A, int b, int c, R1Pre& pf) {
    const int t0 = c * 64;
    const bf16* P = (const bf16*)(A.ws + WS_P) + (size_t)b * SEQ * INC;
#pragma unroll
    for (int q = 0; q < 4; ++q) {
        const int item = tid + NTHR * q, tok = item >> 5, cc = (item & 31) * 8, pc = PC_DW + cc, t = t0 + tok;
        pf.cu[q] = *(const u32x4*)(P + (size_t)t * INC + pc);
        pf.pv[q] = (u32x4){0u, 0u, 0u, 0u};
        if (t > 0) pf.pv[q] = *(const u32x4*)(P + (size_t)(t - 1) * INC + pc);
    }
}
__device__ __forceinline__ void rwkv_r1_unit(const int tid_in, const Args& A, int layer, int uidx, unsigned char* lds, R1Pre& pf, const bool first, const int stop = 99) {
    int tid = tid_in; asm volatile("" : "+v"(tid));
    const int lane = tid & 63, wave = __builtin_amdgcn_readfirstlane(tid >> 6), r31 = lane & 31, hh = lane >> 5;
    const int head = uidx >> 6, c = uidx & 63, b = head / RH, h = head % RH, t0 = c * 64;
    const size_t brow = (size_t)b * SEQ;
    const bf16* P = (const bf16*)(A.ws + WS_P) + brow * INC;
    float* wS = (float*)lds; float* aS = wS + 4096; float* gS = aS + 4096;
    bf16* AAB = (bf16*)lds; bf16* AAK = AAB + 64 * CP; bf16* ARB = AAK + 64 * CP; bf16* ARK = ARB + 64 * CP;
    bf16* TM = ARK + 64 * CP; bf16* TMt = TM + 64 * CP; bf16* X1t = TMt + 64 * CP;
    unsigned char* ob = lds + 7 * 64 * CP * 2;
    bf16* AL = (bf16*)ob;
    bf16* AH = (bf16*)ob; bf16* QT = AH + 64 * CP; bf16* BH = QT + 64 * CP; bf16* KH = BH + 64 * CP;
    bf16* BHt = KH + 64 * CP; bf16* KHt = BHt + 64 * CP; bf16* Vt = KHt + 64 * CP; bf16* AHt = Vt + 64 * CP;
    bf16* WTt = KH; bf16* UTt = AH;
    float* segT = (float*)(ob + 8 * 64 * CP * 2);
    float* gCs = segT + 512;
    bf16* PTs = (bf16*)(gCs + 64);
    const float* mu = A.in[I_MU] + layer * RCOLS;
    const int c4 = (tid & 15) * 4, tkA = tid >> 4, ch = h * 64 + c4;
    u32x2 g_cr[2], g_ck[2], g_cv[2], g_pr[2], g_pk[2], g_pv[2];
#pragma unroll
    for (int q = 0; q < 2; ++q) {
        const int t = t0 + 2 * tkA + q; const bf16* pr = P + (size_t)t * INC;
        g_cr[q] = *(const u32x2*)(pr + PC_R + ch); g_ck[q] = *(const u32x2*)(pr + PC_K + ch); g_cv[q] = *(const u32x2*)(pr + PC_V + ch);
        g_pr[q] = (u32x2){0u, 0u}; g_pk[q] = (u32x2){0u, 0u}; g_pv[q] = (u32x2){0u, 0u};
        if (t > 0) { g_pr[q] = *(const u32x2*)(pr - INC + PC_R + ch); g_pk[q] = *(const u32x2*)(pr - INC + PC_K + ch); g_pv[q] = *(const u32x2*)(pr - INC + PC_V + ch); }
    }
    bf16x8 fw[2], fa[2], fg[4];
    {   const bf16* WupT = (const bf16*)(A.ws + WS_WSM); const bf16* AupT = WupT + 384 * 64; const bf16* GupT = AupT + 384 * 64;
        const int rowj = h * 64 + 16 * (wave & 3) + (lane & 15), kq8 = 8 * (lane >> 4);
#pragma unroll
        for (int ks = 0; ks < 2; ++ks) { fw[ks] = *(const bf16x8*)(WupT + (size_t)rowj * 64 + 32 * ks + kq8); fa[ks] = *(const bf16x8*)(AupT + (size_t)rowj * 64 + 32 * ks + kq8); }
#pragma unroll
        for (int ks = 0; ks < 4; ++ks) fg[ks] = *(const bf16x8*)(GupT + (size_t)rowj * 128 + 32 * ks + kq8);
    }
#pragma unroll
    for (int q = 0; q < 4; ++q) {
        const int item = tid + NTHR * q, tok = item >> 5, cc = (item & 31) * 8, pc = PC_DW + cc;
        if (first) {
            const u32x4 cu = pf.cu[q], pv = pf.pv[q];
            const f32x4 m0 = *(const f32x4*)(mu + pc), m1 = *(const f32x4*)(mu + pc + 4);
            float v[8];
            { float c_, p_;
              c_ = lo16(cu.x); p_ = lo16(pv.x); v[0] = c_ + m0[0] * (p_ - c_); c_ = hi16(cu.x); p_ = hi16(pv.x); v[1] = c_ + m0[1] * (p_ - c_);
              c_ = lo16(cu.y); p_ = lo16(pv.y); v[2] = c_ + m0[2] * (p_ - c_); c_ = hi16(cu.y); p_ = hi16(pv.y); v[3] = c_ + m0[3] * (p_ - c_);
              c_ = lo16(cu.z); p_ = lo16(pv.z); v[4] = c_ + m1[0] * (p_ - c_); c_ = hi16(cu.z); p_ = hi16(pv.z); v[5] = c_ + m1[1] * (p_ - c_);
              c_ = lo16(cu.w); p_ = lo16(pv.w); v[6] = c_ + m1[2] * (p_ - c_); c_ = hi16(cu.w); p_ = hi16(pv.w); v[7] = c_ + m1[3] * (p_ - c_); }
            if (cc < 64) {
#pragma unroll
                for (int i = 0; i < 8; ++i) { const float e2 = __expf(2.0f * v[i]); v[i] = 1.0f - 2.0f * __builtin_amdgcn_rcpf(e2 + 1.0f); }
            } else if (cc >= 128) {
#pragma unroll
                for (int i = 0; i < 8; ++i) v[i] = sigmoidf_(v[i]);
            }
            u32x4 w; w.x = pk2(v[0], v[1]); w.y = pk2(v[2], v[3]); w.z = pk2(v[4], v[5]); w.w = pk2(v[6], v[7]);
            pf.cu[q] = w;
        }
        *(u32x4*)(AL + tok * 264 + cc) = pf.cu[q];
    }
    __syncthreads();
    if (stop <= 1) return;
    {
        const int jt = wave & 3, kq8 = 8 * (lane >> 4);
#pragma unroll
        for (int q = 0; q < 2; ++q) {
            const int tt = 2 * (wave >> 2) + q;
            const bf16* bl = AL + (16 * tt + (lane & 15)) * 264 + kq8;
            f32x4 accw = {0.f, 0.f, 0.f, 0.f}, acca = accw, accg = accw;
#pragma unroll
            for (int ks = 0; ks < 2; ++ks) { accw = __builtin_amdgcn_mfma_f32_16x16x32_bf16(fw[ks], *(const bf16x8*)(bl + 32 * ks), accw, 0, 0, 0);
                                            acca = __builtin_amdgcn_mfma_f32_16x16x32_bf16(fa[ks], *(const bf16x8*)(bl + 64 + 32 * ks), acca, 0, 0, 0); }
#pragma unroll
            for (int ks = 0; ks < 4; ++ks) accg = __builtin_amdgcn_mfma_f32_16x16x32_bf16(fg[ks], *(const bf16x8*)(bl + 128 + 32 * ks), accg, 0, 0, 0);
            const int o_ = (16 * tt + (lane & 15)) * 64 + 16 * jt + 4 * (lane >> 4);
            *(f32x4*)(wS + o_) = accw; *(f32x4*)(aS + o_) = acca; *(f32x4*)(gS + o_) = accg;
        }
    }
    __syncthreads();
    if (stop <= 2) return;
    f32x4 rs[2], kts[2], kkn[2], avs[2], lws[2], vvs[2];
    {
        const f32x4 w0v = *(const f32x4*)(A.in[I_W0] + layer * RW + ch), a0v = *(const f32x4*)(A.in[I_A0] + layer * RW + ch);
        const f32x4 kkv = *(const f32x4*)(A.in[I_KK] + layer * RW + ch), kav = *(const f32x4*)(A.in[I_KA] + layer * RW + ch), rkv = *(const f32x4*)(A.in[I_RK] + layer * RW + ch);
        const f32x4 mur = *(const f32x4*)(mu + PC_R + ch), muk = *(const f32x4*)(mu + PC_K + ch), muv = *(const f32x4*)(mu + PC_V + ch);
        bf16* Gs = (bf16*)(A.ws + WS_G); float* RHOs = (float*)(A.ws + WS_RHO);
#pragma unroll
        for (int q = 0; q < 2; ++q) {
            const int tok = 2 * tkA + q, t = t0 + tok;
            const u32x2 cr = g_cr[q], ck = g_ck[q], cv = g_cv[q], qr_ = g_pr[q], qk_ = g_pk[q], qv_ = g_pv[q];
            f32x4 rc = {lo16(cr.x), hi16(cr.x), lo16(cr.y), hi16(cr.y)}, rp_ = {lo16(qr_.x), hi16(qr_.x), lo16(qr_.y), hi16(qr_.y)};
            f32x4 kc = {lo16(ck.x), hi16(ck.x), lo16(ck.y), hi16(ck.y)}, kp_ = {lo16(qk_.x), hi16(qk_.x), lo16(qk_.y), hi16(qk_.y)};
            f32x4 vc = {lo16(cv.x), hi16(cv.x), lo16(cv.y), hi16(cv.y)}, vp_ = {lo16(qv_.x), hi16(qv_.x), lo16(qv_.y), hi16(qv_.y)};
            const f32x4 rv = rc + mur * (rp_ - rc), kv = kc + muk * (kp_ - kc), vv = vc + muv * (vp_ - vc);
            const f32x4 wp = *(const f32x4*)(wS + tok * 64 + c4), ap = *(const f32x4*)(aS + tok * 64 + c4), gp = *(const f32x4*)(gS + tok * 64 + c4);
            f32x4 lw, av, kkx, kt; float n2 = 0.f, rpv = 0.f;
#pragma unroll
            for (int i = 0; i < 4; ++i) {
                const float x = w0v[i] + wp[i];
                lw[i] = -(__builtin_amdgcn_rcpf(1.0f + __expf(-x)) * 0.6065306597126334f);
                av[i] = sigmoidf_(a0v[i] + ap[i]);
                kkx[i] = kv[i] * kkv[i]; n2 += kkx[i] * kkx[i];
                kt[i] = kv[i] * (1.0f + (av[i] - 1.0f) * kav[i]);
                rpv += rv[i] * kt[i] * rkv[i];
            }
            n2 = red16(n2); rpv = red16(rpv);
            const float inv = (n2 > 1e-24f) ? __builtin_amdgcn_rsqf(n2) : 1e12f;
            rs[q] = rv; kts[q] = kt; kkn[q] = kkx * inv; avs[q] = av; lws[q] = lw; vvs[q] = vv;
            *(f32x4*)(wS + tok * 64 + c4) = lw;
            u32x2 gw; gw.x = pk2(gp[0], gp[1]); gw.y = pk2(gp[2], gp[3]);
            *(u32x2*)(Gs + (brow + t) * RW + ch) = gw;
            if ((tid & 15) == 0) RHOs[(brow + t) * RH + h] = rpv;
        }
#pragma unroll
        for (int i = 0; i < 4; ++i) *(unsigned*)(Vt + (c4 + i) * CP + 2 * tkA) = pk2(vvs[0][i], vvs[1][i]);
    }
    __syncthreads();
    if (stop <= 3) return;
    { const int k = tid & 63, seg = tid >> 6; float run = 0.f;
#pragma unroll
      for (int i = 0; i < 8; ++i) { float* p = wS + (8 * seg + i) * 64 + k; run += *p; *p = run; }
      segT[seg * 64 + k] = run; }
    __syncthreads();
    if (stop <= 4) return;
    f32x4 bhs[2], khs[2], ahs[2];
    { u32x4* z = (u32x4*)TM; const u32x4 zz = {0u, 0u, 0u, 0u};
      for (int i = tid; i < 2 * 64 * CP * 2 / 16; i += NTHR) z[i] = zz;
      if (tid < 3 * 16 * 40 * 2 / 16) ((u32x4*)PTs)[tid] = zz; }
#pragma unroll
    for (int q = 0; q < 2; ++q) {
        const int tok = 2 * tkA + q, seg = tok >> 3;
        f32x4 L = *(const f32x4*)(wS + tok * 64 + c4);
        for (int s_ = 0; s_ < seg; ++s_) L = L + *(const f32x4*)(segT + s_ * 64 + c4);
        f32x4 eL, eNL, eLp;
#pragma unroll
        for (int i = 0; i < 4; ++i) { eL[i] = __expf(L[i]); eNL[i] = __expf(-L[i]); eLp[i] = __expf(L[i] - lws[q][i]); }
        const f32x4 qt = rs[q] * eL, kh = kts[q] * eNL, ah = -(kkn[q] * eLp), bh = kkn[q] * avs[q] * eNL;
        u32x2 w;
        w.x = pk2(ah[0], ah[1]); w.y = pk2(ah[2], ah[3]); *(u32x2*)(AH + tok * CP + c4) = w;
        w.x = pk2(qt[0], qt[1]); w.y = pk2(qt[2], qt[3]); *(u32x2*)(QT + tok * CP + c4) = w;
        w.x = pk2(bh[0], bh[1]); w.y = pk2(bh[2], bh[3]); *(u32x2*)(BH + tok * CP + c4) = w;
        w.x = pk2(kh[0], kh[1]); w.y = pk2(kh[2], kh[3]); *(u32x2*)(KH + tok * CP + c4) = w;
        bhs[q] = bh; khs[q] = kh; ahs[q] = ah;
        if (tok == 63) { *(f32x4*)(gCs + c4) = eL; *(f32x4*)((float*)(A.ws + WS_GC) + (size_t)uidx * 64 + c4) = eL; }
    }
#pragma unroll
    for (int i = 0; i < 4; ++i) {
        *(unsigned*)(BHt + (c4 + i) * CP + 2 * tkA) = pk2(bhs[0][i], bhs[1][i]);
        *(unsigned*)(KHt + (c4 + i) * CP + 2 * tkA) = pk2(khs[0][i], khs[1][i]);
        *(unsigned*)(AHt + (c4 + i) * CP + 2 * tkA) = pk2(ahs[0][i], ahs[1][i]);
    }
    __syncthreads();
    if (stop <= 5) return;
    {
        const int yt = wave & 3;
        const bf16* X = ((yt < 2) ? BH : KH) + 32 * (yt & 1) * CP;
#pragma unroll
        for (int q = 0; q < 2; ++q) {
            const int xt = 2 * (wave >> 2) + q;
            const bf16* Y = ((xt < 2) ? AH : QT) + 32 * (xt & 1) * CP;
            f32x16 acc = {};
            acc = mm32(X, Y, lane, acc);
            bf16* dst = (xt < 2) ? ((yt < 2) ? AAB : AAK) : ((yt < 2) ? ARB : ARK);
            const int i = 32 * (xt & 1) + r31;
#pragma unroll
            for (int g = 0; g < 4; ++g) {
                const int j0 = 32 * (yt & 1) + 8 * g + 4 * hh;
                float v[4];
#pragma unroll
                for (int e = 0; e < 4; ++e) { const int j = j0 + e; const bool keep = (xt < 2) ? (j < i) : (j <= i); v[e] = keep ? acc[4 * g + e] : 0.f; }
                { u32x2 w; w.x = pk2(v[0], v[1]); w.y = pk2(v[2], v[3]); *(u32x2*)(dst + i * CP + j0) = w; }
            }
        }
    }
    __syncthreads();
    if (stop <= 6) return;
    if (wave < 4) {
        const int mt = wave & 1, nt = wave >> 1;
        f32x16 acc = {};
        acc = mm32(AAK + 32 * mt * CP, Vt + 32 * nt * CP, lane, acc);
#pragma unroll
        for (int g = 0; g < 4; ++g) { u32x2 w; w.x = pk2(acc[4 * g], acc[4 * g + 1]); w.y = pk2(acc[4 * g + 2], acc[4 * g + 3]);
            *(u32x2*)(X1t + (32 * nt + r31) * CP + 32 * mt + 8 * g + 4 * hh) = w; }
    } else if (wave == 4) {
        const int bi = lane >> 4, cc = lane & 15;
        float x[16];
#pragma unroll
        for (int i = 0; i < 16; ++i) {
            const u32x4 a0 = *(const u32x4*)(AAB + (16 * bi + i) * CP + 16 * bi), a1 = *(const u32x4*)(AAB + (16 * bi + i) * CP + 16 * bi + 8);
            const float av_[16] = {lo16(a0.x), hi16(a0.x), lo16(a0.y), hi16(a0.y), lo16(a0.z), hi16(a0.z), lo16(a0.w), hi16(a0.w),
                                   lo16(a1.x), hi16(a1.x), lo16(a1.y), hi16(a1.y), lo16(a1.z), hi16(a1.z), lo16(a1.w), hi16(a1.w)};
            float v_ = (i == cc) ? 1.0f : 0.0f;
#pragma unroll
            for (int j = 0; j < i; ++j) v_ += av_[j] * x[j];
            x[i] = v_;
            TM[(16 * bi + i) * CP + 16 * bi + cc] = (unsigned short)(pk2(v_, 0.f) & 0xffffu);
        }
        u32x4 w0, w1;
        w0.x = pk2(x[0], x[1]); w0.y = pk2(x[2], x[3]); w0.z = pk2(x[4], x[5]); w0.w = pk2(x[6], x[7]);
        w1.x = pk2(x[8], x[9]); w1.y = pk2(x[10], x[11]); w1.z = pk2(x[12], x[13]); w1.w = pk2(x[14], x[15]);
        *(u32x4*)(TMt + (16 * bi + cc) * CP + 16 * bi) = w0; *(u32x4*)(TMt + (16 * bi + cc) * CP + 16 * bi + 8) = w1;
    }
    __syncthreads();
    if (stop <= 7) return;
    f32x16 nacc = {}, oacc = {};
    if (wave >= 4) { const int q = wave & 3;
        nacc = mm32(KHt + 32 * (q & 1) * CP, Vt + 32 * (q >> 1) * CP, lane, nacc);
        oacc = mm32(Vt + 32 * (q & 1) * CP, ARK + 32 * (q >> 1) * CP, lane, oacc); }
#pragma unroll
    for (int lvl = 1; lvl < 4; ++lvl) {
        if (wave < 4 - lvl) {
            const int bj = wave, bi = wave + lvl, l15 = lane & 15, q4 = lane >> 4;
            bf16* Pt = PTs + wave * (16 * 40);
            f32x4 acc = {0.f, 0.f, 0.f, 0.f};
#pragma unroll
            for (int ks = 0; ks < 2; ++ks)
                acc = __builtin_amdgcn_mfma_f32_16x16x32_bf16(*(const bf16x8*)(AAB + (16 * bi + l15) * CP + 32 * ks + 8 * q4), *(const bf16x8*)(TMt + (16 * bj + l15) * CP + 32 * ks + 8 * q4), acc, 0, 0, 0);
            { u32x2 w; w.x = pk2(acc[0], acc[1]); w.y = pk2(acc[2], acc[3]); *(u32x2*)(Pt + l15 * 40 + 4 * q4) = w; }
            asm volatile("s_waitcnt lgkmcnt(0)" ::: "memory");
            bf16x8 a2 = {0, 0, 0, 0, 0, 0, 0, 0};
            if (q4 < 2) a2 = *(const bf16x8*)(TM + (16 * bi + l15) * CP + 16 * bi + 8 * q4);
            const bf16x8 b2 = *(const bf16x8*)(Pt + l15 * 40 + 8 * q4);
            f32x4 xo = {0.f, 0.f, 0.f, 0.f};
            xo = __builtin_amdgcn_mfma_f32_16x16x32_bf16(a2, b2, xo, 0, 0, 0);
#pragma unroll
            for (int e = 0; e < 4; ++e) TM[(16 * bi + 4 * q4 + e) * CP + 16 * bj + l15] = (unsigned short)(pk2(xo[e], 0.f) & 0xffffu);
            { u32x2 w; w.x = pk2(xo[0], xo[1]); w.y = pk2(xo[2], xo[3]); *(u32x2*)(TMt + (16 * bj + l15) * CP + 16 * bi + 4 * q4) = w; }
        }
        __syncthreads();
    }
    {
        const int it = wave & 1, ct = (wave >> 1) & 1;
        const bf16* Y = (wave < 4) ? AHt : X1t; bf16* dst = (wave < 4) ? WTt : UTt;
        f32x16 acc = {};
        acc = mm32(TM + 32 * it * CP, Y + 32 * ct * CP, lane, acc);
#pragma unroll
        for (int g = 0; g < 4; ++g) { u32x2 w; w.x = pk2(acc[4 * g], acc[4 * g + 1]); w.y = pk2(acc[4 * g + 2], acc[4 * g + 3]);
            *(u32x2*)(dst + (32 * ct + r31) * CP + 32 * it + 8 * g + 4 * hh) = w; }
    }
    __syncthreads();
    if (stop <= 8) return;
    {
        u32x4* MPs = (u32x4*)((unsigned char*)A.out + SC_MP) + (size_t)uidx * 512;
        u32x4* NNs = (u32x4*)((unsigned char*)A.out + SC_NN) + (size_t)uidx * 512;
        u32x4* QHs = (u32x4*)((unsigned char*)A.out + SC_QH) + (size_t)uidx * 512;
        u32x4* OLs = (u32x4*)((unsigned char*)A.out + SC_OL) + (size_t)uidx * 512;
        if (wave < 2) {
            const int it = wave;
#pragma unroll
            for (int kt = 0; kt < 2; ++kt) {
                f32x16 acc = {};
                acc = mm32(WTt + 32 * kt * CP, ARB + 32 * it * CP, lane, acc);
#pragma unroll
                for (int g = 0; g < 4; ++g) { const u32x2 qv = *(const u32x2*)(QT + (32 * it + r31) * CP + 32 * kt + 8 * g + 4 * hh);
                    acc[4 * g] += lo16(qv.x); acc[4 * g + 1] += hi16(qv.x); acc[4 * g + 2] += lo16(qv.y); acc[4 * g + 3] += hi16(qv.y); }
                QHs[(it * 4 + 2 * kt) * 64 + lane] = packfrag(acc, 0); QHs[(it * 4 + 2 * kt + 1) * 64 + lane] = packfrag(acc, 1);
            }
        } else if (wave < 4) {
            const int ktp = wave - 2; const float gc = gCs[32 * ktp + r31];
#pragma unroll
            for (int kt = 0; kt < 2; ++kt) {
                f32x16 acc = {};
                acc = mm32(WTt + 32 * kt * CP, BHt + 32 * ktp * CP, lane, acc);
                acc = acc * gc;
                MPs[((ktp * 2 + kt) * 2) * 64 + lane] = packfrag(acc, 0); MPs[((ktp * 2 + kt) * 2 + 1) * 64 + lane] = packfrag(acc, 1);
            }
        } else {
            const int q = wave & 3;
            { const int kt = q & 1, vt = q >> 1;
              nacc = mm32(BHt + 32 * kt * CP, UTt + 32 * vt * CP, lane, nacc);
#pragma unroll
              for (int g = 0; g < 4; ++g) { const f32x4 gc = *(const f32x4*)(gCs + 32 * kt + 8 * g + 4 * hh);
                  nacc[4 * g] *= gc[0]; nacc[4 * g + 1] *= gc[1]; nacc[4 * g + 2] *= gc[2]; nacc[4 * g + 3] *= gc[3]; }
              NNs[((vt * 2 + kt) * 2) * 64 + lane] = packfrag(nacc, 0); NNs[((vt * 2 + kt) * 2 + 1) * 64 + lane] = packfrag(nacc, 1); }
            { const int vt = q & 1, it = q >> 1;
              oacc = mm32(UTt + 32 * vt * CP, ARB + 32 * it * CP, lane, oacc);
              OLs[((it * 2 + vt) * 2) * 64 + lane] = packfrag(oacc, 0); OLs[((it * 2 + vt) * 2 + 1) * 64 + lane] = packfrag(oacc, 1); }
        }
    }
    __syncthreads();
}
__device__ __forceinline__ void rwkv_r2_unit(const int tid_in, const Args& A, int u) {
    int tid = tid_in; asm volatile("" : "+v"(tid));
    const int lane = tid & 63, wave = __builtin_amdgcn_readfirstlane(tid >> 6), hh = lane >> 5;
    const int head = 4 * u + (wave >> 1), vt = wave & 1;
    const u32x4* MPs = (const u32x4*)((unsigned char*)A.out + SC_MP) + (size_t)head * 64 * 512;
    const u32x4* NNs = (const u32x4*)((unsigned char*)A.out + SC_NN) + (size_t)head * 64 * 512;
    u32x4* HSo = (u32x4*)((unsigned char*)A.out + SC_HS) + (size_t)head * 64 * 512;
    const float* GCs = (const float*)(A.ws + WS_GC) + (size_t)head * 64 * 64;
    f32x16 acc0 = {}, acc1 = {};
    u32x4 mpn[8], nnn[4]; f32x4 gmn[8];
#define R2_LOAD(cc) do { \
        _Pragma("unroll") for (int i = 0; i < 8; ++i) mpn[i] = MPs[(size_t)(cc) * 512 + i * 64 + lane]; \
        _Pragma("unroll") for (int i = 0; i < 4; ++i) nnn[i] = NNs[(size_t)(cc) * 512 + vt * 256 + i * 64 + lane]; \
        _Pragma("unroll") for (int i = 0; i < 8; ++i) gmn[i] = *(const f32x4*)(GCs + (cc) * 64 + 32 * (i >> 2) + 8 * (i & 3) + 4 * hh); } while (0)
    R2_LOAD(0);
    for (int c = 0; c < 64; ++c) {
        u32x4 mp[8], nn[4]; f32x4 gm[8];
#pragma unroll
        for (int i = 0; i < 8; ++i) { mp[i] = mpn[i]; gm[i] = gmn[i]; }
#pragma unroll
        for (int i = 0; i < 4; ++i) nn[i] = nnn[i];
        if (c + 1 < 64) R2_LOAD(c + 1);
        const u32x4 hb0 = packfrag(acc0, 0), hb1 = packfrag(acc0, 1), hb2 = packfrag(acc1, 0), hb3 = packfrag(acc1, 1);
#pragma unroll
        for (int g = 0; g < 4; ++g) {
            const unsigned* n0 = (const unsigned*)&nn[g >> 1]; const unsigned* n1 = (const unsigned*)&nn[2 + (g >> 1)];
            const int o_ = 2 * (g & 1);
            acc0[4 * g] = acc0[4 * g] * gm[g][0] + lo16(n0[o_]); acc0[4 * g + 1] = acc0[4 * g + 1] * gm[g][1] + hi16(n0[o_]);
            acc0[4 * g + 2] = acc0[4 * g + 2] * gm[g][2] + lo16(n0[o_ + 1]); acc0[4 * g + 3] = acc0[4 * g + 3] * gm[g][3] + hi16(n0[o_ + 1]);
            acc1[4 * g] = acc1[4 * g] * gm[4 + g][0] + lo16(n1[o_]); acc1[4 * g + 1] = acc1[4 * g + 1] * gm[4 + g][1] + hi16(n1[o_]);
            acc1[4 * g + 2] = acc1[4 * g + 2] * gm[4 + g][2] + lo16(n1[o_ + 1]); acc1[4 * g + 3] = acc1[4 * g + 3] * gm[4 + g][3] + hi16(n1[o_ + 1]);
        }
        HSo[(size_t)c * 512 + vt * 256 + 0 * 64 + lane] = hb0; HSo[(size_t)c * 512 + vt * 256 + 1 * 64 + lane] = hb1;
        HSo[(size_t)c * 512 + vt * 256 + 2 * 64 + lane] = hb2; HSo[(size_t)c * 512 + vt * 256 + 3 * 64 + lane] = hb3;
        const bf16x8 b0 = __builtin_bit_cast(bf16x8, hb0), b1 = __builtin_bit_cast(bf16x8, hb1), b2 = __builtin_bit_cast(bf16x8, hb2), b3 = __builtin_bit_cast(bf16x8, hb3);
        acc0 = __builtin_amdgcn_mfma_f32_32x32x16_bf16(__builtin_bit_cast(bf16x8, mp[0]), b0, acc0, 0, 0, 0);
        acc1 = __builtin_amdgcn_mfma_f32_32x32x16_bf16(__builtin_bit_cast(bf16x8, mp[4]), b0, acc1, 0, 0, 0);
        acc0 = __builtin_amdgcn_mfma_f32_32x32x16_bf16(__builtin_bit_cast(bf16x8, mp[1]), b1, acc0, 0, 0, 0);
        acc1 = __builtin_amdgcn_mfma_f32_32x32x16_bf16(__builtin_bit_cast(bf16x8, mp[5]), b1, acc1, 0, 0, 0);
        acc0 = __builtin_amdgcn_mfma_f32_32x32x16_bf16(__builtin_bit_cast(bf16x8, mp[2]), b2, acc0, 0, 0, 0);
        acc1 = __builtin_amdgcn_mfma_f32_32x32x16_bf16(__builtin_bit_cast(bf16x8, mp[6]), b2, acc1, 0, 0, 0);
        acc0 = __builtin_amdgcn_mfma_f32_32x32x16_bf16(__builtin_bit_cast(bf16x8, mp[3]), b3, acc0, 0, 0, 0);
        acc1 = __builtin_amdgcn_mfma_f32_32x32x16_bf16(__builtin_bit_cast(bf16x8, mp[7]), b3, acc1, 0, 0, 0);
    }
#undef R2_LOAD
}
__device__ __forceinline__ void rwkv_r3_unit(const int tid_in, const Args& A, int layer, int u, unsigned char* lds) {
    int tid = tid_in; asm volatile("" : "+v"(tid));
    const int lane = tid & 63, wave = __builtin_amdgcn_readfirstlane(tid >> 6), r31 = lane & 31, hh = lane >> 5;
    const int uidx = 4 * u + (wave >> 1), it = wave & 1;
    const int head = uidx >> 6, c = uidx & 63, b = head / RH, h = head % RH;
    float* PR = (float*)lds;
    if (tid < 192) { const int w_ = tid >> 6, cc = tid & 63;
        PR[tid] = (w_ == 0) ? A.in[I_LNG][layer * RW + h * 64 + cc] : (w_ == 1) ? A.in[I_LNB][layer * RW + h * 64 + cc] : A.in[I_MU][layer * RCOLS + PC_V + h * 64 + cc]; }
    const size_t trow = (size_t)b * SEQ + c * 64 + 32 * it + r31;
    const u32x4* HSs = (const u32x4*)((unsigned char*)A.out + SC_HS) + (size_t)uidx * 512;
    const u32x4* QHs = (const u32x4*)((unsigned char*)A.out + SC_QH) + (size_t)uidx * 512;
    const u32x4* OLs = (const u32x4*)((unsigned char*)A.out + SC_OL) + (size_t)uidx * 512;
    const bf16* P = (const bf16*)(A.ws + WS_P); const bf16* Gs = (const bf16*)(A.ws + WS_G); bf16* MIX = (bf16*)(A.ws + WS_MIX);
    const bool hasprev = (c * 64 + 32 * it + r31) > 0;
    u32x4 ol[4], qf4[4], hs[8];
#pragma unroll
    for (int i = 0; i < 4; ++i) { ol[i] = OLs[((it * 2 + (i >> 1)) * 2 + (i & 1)) * 64 + lane]; qf4[i] = QHs[(it * 4 + i) * 64 + lane]; }
#pragma unroll
    for (int i = 0; i < 8; ++i) hs[i] = HSs[(i >> 2) * 256 + (i & 3) * 64 + lane];
    u32x2 cvv[8], pvv[8], gwv[8];
#pragma unroll
    for (int i = 0; i < 8; ++i) { const int vch = h * 64 + 32 * (i >> 2) + 8 * (i & 3) + 4 * hh;
        cvv[i] = *(const u32x2*)(P + trow * INC + PC_V + vch);
        pvv[i] = (u32x2){0u, 0u}; if (hasprev) pvv[i] = *(const u32x2*)(P + (trow - 1) * INC + PC_V + vch);
        gwv[i] = *(const u32x2*)(Gs + trow * RW + vch); }
    const float rh = ((const float*)(A.ws + WS_RHO))[trow * RH + h];
    f32x16 acc[2];
#pragma unroll
    for (int vt = 0; vt < 2; ++vt) {
        const u32x4 o0 = ol[2 * vt], o1 = ol[2 * vt + 1];
        acc[vt][0] = lo16(o0.x); acc[vt][1] = hi16(o0.x); acc[vt][2] = lo16(o0.y); acc[vt][3] = hi16(o0.y); acc[vt][4] = lo16(o0.z); acc[vt][5] = hi16(o0.z); acc[vt][6] = lo16(o0.w); acc[vt][7] = hi16(o0.w);
        acc[vt][8] = lo16(o1.x); acc[vt][9] = hi16(o1.x); acc[vt][10] = lo16(o1.y); acc[vt][11] = hi16(o1.y); acc[vt][12] = lo16(o1.z); acc[vt][13] = hi16(o1.z); acc[vt][14] = lo16(o1.w); acc[vt][15] = hi16(o1.w);
    }
#pragma unroll
    for (int s_ = 0; s_ < 4; ++s_) {
        const bf16x8 qf = __builtin_bit_cast(bf16x8, qf4[s_]);
#pragma unroll
        for (int vt = 0; vt < 2; ++vt) acc[vt] = __builtin_amdgcn_mfma_f32_32x32x16_bf16(__builtin_bit_cast(bf16x8, hs[vt * 4 + s_]), qf, acc[vt], 0, 0, 0);
    }
    __syncthreads();
    float sm = 0.f;
#pragma unroll
    for (int e = 0; e < 16; ++e) sm += acc[0][e] + acc[1][e];
    sm += __shfl_xor(sm, 32);
    const float mean = sm * (1.0f / 64.0f);
    float q2 = 0.f;
#pragma unroll
    for (int e = 0; e < 16; ++e) { const float d0 = acc[0][e] - mean, d1 = acc[1][e] - mean; q2 += d0 * d0 + d1 * d1; }
    q2 += __shfl_xor(q2, 32);
    const float rstd = rsqrtf(q2 * (1.0f / 64.0f) + GN_EPS);
#pragma unroll
    for (int vt = 0; vt < 2; ++vt)
#pragma unroll
        for (int g = 0; g < 4; ++g) {
            const int vc0 = 32 * vt + 8 * g + 4 * hh, vch = h * 64 + vc0;
            const f32x4 lg = *(const f32x4*)(PR + vc0), lb = *(const f32x4*)(PR + 64 + vc0), muv = *(const f32x4*)(PR + 128 + vc0);
            const u32x2 cv = cvv[vt * 4 + g], pv = pvv[vt * 4 + g], gw = gwv[vt * 4 + g];
            const f32x4 vc = {lo16(cv.x), hi16(cv.x), lo16(cv.y), hi16(cv.y)}, vp = {lo16(pv.x), hi16(pv.x), lo16(pv.y), hi16(pv.y)};
            const f32x4 vv = vc + muv * (vp - vc), gg = {lo16(gw.x), hi16(gw.x), lo16(gw.y), hi16(gw.y)};
            float y[4];
#pragma unroll
            for (int e = 0; e < 4; ++e) y[e] = ((acc[vt][4 * g + e] - mean) * rstd * lg[e] + lb[e] + rh * vv[e]) * gg[e];
            u32x2 w; w.x = pk2(y[0], y[1]); w.y = pk2(y[2], y[3]);
            *(u32x2*)(MIX + trow * D + MIX_R + vch) = w;
        }
}

constexpr int LT = 16;
__device__ __forceinline__ float gelu_tanh(float x) { const float u = 0.7978845608028654f * (x + 0.044715f * x * x * x); return x * __builtin_amdgcn_rcpf(1.0f + __expf(-2.0f * u)); }
__device__ __forceinline__ float neg_expm1(float x) { return (x > -0.25f) ? -x * (1.0f + x * (0.5f + x * (0.16666667f + x * (0.041666668f + x * (0.0083333338f + x * 0.0013888889f))))) : 1.0f - __expf(x); }
__device__ __forceinline__ void lru_unit(const int tid_in, const Args& A, int layer, int bg, unsigned char* lds) {
    int tid = tid_in; asm volatile("" : "+v"(tid));
    const int lane = tid & 63, wave = __builtin_amdgcn_readfirstlane(tid >> 6);
    const int b = bg / LB, g = bg % LB, c = g * 64 + lane;
    const bf16* P = (const bf16*)(A.ws + WS_P) + (size_t)b * SEQ * INC;
    bf16* MIX = (bf16*)(A.ws + WS_MIX) + (size_t)b * SEQ * D;
    bf16* WAs = (bf16*)lds;
    bf16* WXs = WAs + 64 * 72;
    float* totA = (float*)(WXs + 64 * 72);
    float* totH = totA + 8 * 64;
    float* carryS = totH + 8 * 64;
    bf16* XC = (bf16*)(carryS + 64) + wave * (LT * 72);
    float* PRE = (float*)((bf16*)(carryS + 64) + 8 * LT * 72) + wave * (2 * LT * 68);
    const bf16* LwaT = (const bf16*)(A.ws + WS_WSM) + 98304 + g * 4096; const bf16* LwxT = LwaT + 16384;
    { const int j = tid >> 3, i8 = (tid & 7) * 8;
      *(u32x4*)(WAs + j * 72 + i8) = *(const u32x4*)(LwaT + j * 64 + i8); *(u32x4*)(WXs + j * 72 + i8) = *(const u32x4*)(LwxT + j * 64 + i8); }
    const float cw0 = A.in[I_CW][(layer * 4 + 0) * LW + c], cw1 = A.in[I_CW][(layer * 4 + 1) * LW + c], cw2 = A.in[I_CW][(layer * 4 + 2) * LW + c], cw3 = A.in[I_CW][(layer * 4 + 3) * LW + c];
    const float cb = A.in[I_CB][layer * LW + c], ba = A.in[I_BA][layer * LW + c], bx = A.in[I_BX][layer * LW + c];
    const float sp8 = 8.0f * softplusf_(-A.in[I_LAM][layer * LW + c]);
    const float ng = A.in[I_LRUG][layer * LW + c];
    if (tid < 64) carryS[tid] = 0.f;
    __syncthreads();
    unsigned short nx[LT + 3], ng_[LT];
#define LRU_LOAD(T0_) do { \
        _Pragma("unroll") for (int t = 0; t < LT + 3; ++t) nx[t] = ((T0_) + t - 3 >= 0) ? P[(size_t)((T0_) + t - 3) * INC + PC_LX + c] : (unsigned short)0; \
        _Pragma("unroll") for (int t = 0; t < LT; ++t) ng_[t] = P[(size_t)((T0_) + t) * INC + PC_LG + c]; } while (0)
    LRU_LOAD(wave * LT);
    for (int st = 0; st < SEQ; st += 8 * LT) {
        const int T0 = st + wave * LT;
        float xm3 = bf2f(nx[0]), xm2 = bf2f(nx[1]), xm1 = bf2f(nx[2]);
        float xc[LT], gin[LT];
#pragma unroll
        for (int t = 0; t < LT; ++t) { xc[t] = bf2f(nx[t + 3]); gin[t] = bf2f(ng_[t]); }
        if (st + 8 * LT < SEQ) LRU_LOAD(T0 + 8 * LT);
#pragma unroll
        for (int t = 0; t < LT; ++t) {
            const float x = xc[t];
            xc[t] = cw0 * xm3 + cw1 * xm2 + cw2 * xm1 + cw3 * x + cb;
            xm3 = xm2; xm2 = xm1; xm1 = x;
            XC[t * 72 + lane] = (unsigned short)(pk2(xc[t], 0.f) & 0xffffu);
        }
        asm volatile("s_waitcnt lgkmcnt(0)" ::: "memory");
        {
            const bf16* bl = XC + (lane & 15) * 72 + 8 * (lane >> 4);
            const bf16x8 b0 = *(const bf16x8*)(bl), b1 = *(const bf16x8*)(bl + 32);
#pragma unroll
            for (int gt = 0; gt < 2; ++gt) {
                const bf16* Ws = gt ? WXs : WAs;
#pragma unroll
                for (int jt = 0; jt < 4; ++jt) {
                    const bf16* al = Ws + (16 * jt + (lane & 15)) * 72 + 8 * (lane >> 4);
                    f32x4 acc = {0.f, 0.f, 0.f, 0.f};
                    acc = __builtin_amdgcn_mfma_f32_16x16x32_bf16(*(const bf16x8*)(al), b0, acc, 0, 0, 0);
                    acc = __builtin_amdgcn_mfma_f32_16x16x32_bf16(*(const bf16x8*)(al + 32), b1, acc, 0, 0, 0);
                    *(f32x4*)(PRE + gt * (LT * 68) + (lane & 15) * 68 + 16 * jt + 4 * (lane >> 4)) = acc;
                }
            }
        }
        asm volatile("s_waitcnt lgkmcnt(0)" ::: "memory");
        float hl[LT], Ac[LT];
        float hrun = 0.f, arun = 1.f;
#pragma unroll
        for (int t = 0; t < LT; ++t) {
            const float ga = PRE[t * 68 + lane] + ba, gx = PRE[LT * 68 + t * 68 + lane] + bx;
            const float la = -sp8 * sigmoidf_(ga);
            const float a = __expf(la);
            const float bi = __builtin_amdgcn_sqrtf(neg_expm1(2.0f * la)) * sigmoidf_(gx) * xc[t];
            hrun = a * hrun + bi; arun *= a;
            hl[t] = hrun; Ac[t] = arun;
        }
        totA[wave * 64 + lane] = arun; totH[wave * 64 + lane] = hrun;
        __syncthreads();
        float cin = carryS[lane];
        for (int u = 0; u < wave; ++u) cin = totA[u * 64 + lane] * cin + totH[u * 64 + lane];
        float cout = cin;
        if (wave == 7) cout = totA[7 * 64 + lane] * cin + totH[7 * 64 + lane];
#pragma unroll
        for (int t = 0; t < LT; ++t) {
            const float hv = hl[t] + Ac[t] * cin;
            const float y = gelu_tanh(gin[t]) * hv;
            const float ss = red64(y * y);
            const float o = y * rsqrtf(ss * (1.0f / 64.0f) + RMS_EPS) * ng;
            ((unsigned short*)MIX)[(size_t)(T0 + t) * D + MIX_L + c] = (unsigned short)(pk2(o, 0.f) & 0xffffu);
        }
        __syncthreads();
        if (wave == 7) carryS[lane] = cout;
        __syncthreads();
    }
#undef LRU_LOAD
}

__device__ __forceinline__ void phase_mixers(const int tid, const Args& A, int layer, int sub, unsigned char* lds, volatile LAS unsigned* misc, const int umask = 7, const int qslot = 0, const int r1stop = 99) {
    unsigned* qhead = (unsigned*)(A.ws + WS_CTL) + CW_Q + layer * 64 + sub * 8 + qslot;
    constexpr int R1B = RH;
#ifndef ATT_A
#define ATT_A 0
#endif
#ifndef ATT_B
#define ATT_B 1152
#endif
    const int a0 = (sub == 0) ? 0 : (sub == 1) ? ATT_A : ATT_B, a1 = (sub == 0) ? ATT_A : (sub == 1) ? ATT_B : 1536, nA = a1 - a0;
    const int nHead = (sub == 0) ? 64 : (sub == 1) ? 24 : 0;
    const int nTail = (sub == 0) ? 6144 / R1B : (sub == 2) ? 1536 : 0;
    const int NU = nHead + nA + nTail;
#ifndef CUMASK
#define CUMASK 7
#endif
    for (;;) {
        __syncthreads();
        if (tid == 0) misc[4] = __hip_atomic_fetch_add(qhead, 1u, __ATOMIC_RELAXED, __HIP_MEMORY_SCOPE_AGENT);
        __syncthreads();
        const int u = (int)misc[4];
        if (u >= NU) break;
        if (u < nHead) {
            if (sub == 0) { if ((CUMASK & 2) && (umask & 2)) lru_unit(tid, A, layer, u, lds); }
            else { if ((CUMASK & 1) && (umask & 1)) rwkv_r2_unit(tid, A, u); }
        } else if (u < nHead + nA) {
            const int a = a0 + (u - nHead); if ((CUMASK & 4) && (umask & 4)) attn_unit(tid, A, layer, a % 96, 15 - a / 96, lds);
        } else {
            const int v = u - nHead - nA;
            if (sub == 0) { if ((CUMASK & 1) && (umask & 1)) { R1Pre pf; const int bb = v >> 6, cc_ = v & 63; rwkv_r1_prefetch(tid, A, bb, cc_, pf);
                    for (int hq = 0; hq < RH; ++hq) rwkv_r1_unit(tid, A, layer, (bb * RH + hq) * 64 + cc_, lds, pf, hq == 0, r1stop); } }
            else { if ((CUMASK & 1) && (umask & 1)) rwkv_r3_unit(tid, A, layer, v, lds); }
        }
    }
}

__device__ __forceinline__ void phase_ln1_router(const int tid, const Args& A, int layer, unsigned char* lds, int vcu, int G) {
    const int lane = tid & 63, wave = tid >> 6;
    float* rwT = (float*)lds;
    float* part = (float*)(lds + 65536) + wave * 1024;
    float* lgS = (float*)(lds + 98304) + wave * 64;
    int* hist = (int*)(lds + 100352);
    int* rowinfo = (int*)(lds + 100352 + 256);
    bf16* X1 = (bf16*)(A.ws + WS_X1);
    int* list = (int*)(A.ws + WS_LIST); float* gate = (float*)(A.ws + WS_GATE);
    unsigned* gcnt = (unsigned*)(A.ws + WS_CTL) + CW_CNT + layer * 64;
    const float* rw = A.in[I_RW];
    for (int i = tid; i < 16 * 1024; i += NTHR) { const int c = i >> 4, e = i & 15; rwT[e * 1024 + c] = rw[i]; }
    const float rbv = A.in[I_RB][lane & 15];
    const float* g1 = A.in[I_LN1G] + layer * D; const float* b1 = A.in[I_LN1B] + layer * D;
    f32x4 gg[4], bb[4];
#pragma unroll
    for (int j = 0; j < 4; ++j) { gg[j] = *(const f32x4*)(g1 + 4 * lane + 256 * j); bb[j] = *(const f32x4*)(b1 + 4 * lane + 256 * j); }
    const int rows_per = M / G;
    for (int chunk = 0; chunk < rows_per / 256; ++chunk) {
        const int base = vcu * rows_per + chunk * 256;
        if (tid < 16) hist[tid] = 0;
        __syncthreads();
        u32x2 xn[4][4];
#pragma unroll
        for (int q = 0; q < 4; ++q)
#pragma unroll
            for (int j = 0; j < 4; ++j) xn[q][j] = *(const u32x2*)(X1 + (size_t)(base + wave * 32 + q) * D + 4 * lane + 256 * j);
        for (int pass = 0; pass < 8; ++pass) {
            const int lr0 = wave * 32 + pass * 4;
            f32x4 y[4][4];
            u32x2 xc_[4][4];
#pragma unroll
            for (int q = 0; q < 4; ++q)
#pragma unroll
                for (int j = 0; j < 4; ++j) xc_[q][j] = xn[q][j];
            if (pass + 1 < 8) {
#pragma unroll
                for (int q = 0; q < 4; ++q)
#pragma unroll
                    for (int j = 0; j < 4; ++j) xn[q][j] = *(const u32x2*)(X1 + (size_t)(base + lr0 + 4 + q) * D + 4 * lane + 256 * j);
            }
#pragma unroll
            for (int q = 0; q < 4; ++q) {
                bf16* xr = X1 + (size_t)(base + lr0 + q) * D;
                float sm = 0.f;
#pragma unroll
                for (int j = 0; j < 4; ++j) { const u32x2 a = xc_[q][j];
                    y[q][j] = (f32x4){lo16(a.x), hi16(a.x), lo16(a.y), hi16(a.y)}; sm += (y[q][j][0] + y[q][j][1]) + (y[q][j][2] + y[q][j][3]); }
                const float mean = red64(sm) * (1.0f / D); float s2 = 0.f;
#pragma unroll
                for (int j = 0; j < 4; ++j) { y[q][j] = y[q][j] - mean; s2 += (y[q][j][0] * y[q][j][0] + y[q][j][1] * y[q][j][1]) + (y[q][j][2] * y[q][j][2] + y[q][j][3] * y[q][j][3]); }
                const float rstd = rsqrtf(red64(s2) * (1.0f / D) + LN_EPS);
#pragma unroll
                for (int j = 0; j < 4; ++j) { y[q][j] = y[q][j] * rstd * gg[j] + bb[j];
                    u32x2 w; w.x = pk2(y[q][j][0], y[q][j][1]); w.y = pk2(y[q][j][2], y[q][j][3]); *(u32x2*)(xr + 4 * lane + 256 * j) = w; }
            }
#pragma unroll
            for (int e = 0; e < 16; ++e) {
                float a0 = 0.f, a1 = 0.f, a2 = 0.f, a3 = 0.f;
#pragma unroll
                for (int j = 0; j < 4; ++j) { const f32x4 w = *(const f32x4*)(rwT + e * 1024 + 4 * lane + 256 * j);
                    a0 += (y[0][j][0] * w[0] + y[0][j][1] * w[1]) + (y[0][j][2] * w[2] + y[0][j][3] * w[3]);
                    a1 += (y[1][j][0] * w[0] + y[1][j][1] * w[1]) + (y[1][j][2] * w[2] + y[1][j][3] * w[3]);
                    a2 += (y[2][j][0] * w[0] + y[2][j][1] * w[1]) + (y[2][j][2] * w[2] + y[2][j][3] * w[3]);
                    a3 += (y[3][j][0] * w[0] + y[3][j][1] * w[1]) + (y[3][j][2] * w[2] + y[3][j][3] * w[3]); }
                a0 += DPP(a0, 0xB1); a0 += DPP(a0, 0x4E); a1 += DPP(a1, 0xB1); a1 += DPP(a1, 0x4E);
                a2 += DPP(a2, 0xB1); a2 += DPP(a2, 0x4E); a3 += DPP(a3, 0xB1); a3 += DPP(a3, 0x4E);
                if ((lane & 3) == 0) { part[(0 * 16 + e) * 16 + (lane >> 2)] = a0; part[(1 * 16 + e) * 16 + (lane >> 2)] = a1;
                                       part[(2 * 16 + e) * 16 + (lane >> 2)] = a2; part[(3 * 16 + e) * 16 + (lane >> 2)] = a3; }
            }
            asm volatile("s_waitcnt lgkmcnt(0)" ::: "memory");
            { const f32x4 p0 = *(const f32x4*)(part + lane * 16), p1 = *(const f32x4*)(part + lane * 16 + 4), p2 = *(const f32x4*)(part + lane * 16 + 8), p3 = *(const f32x4*)(part + lane * 16 + 12);
              const f32x4 ps = (p0 + p1) + (p2 + p3);
              lgS[lane] = (ps[0] + ps[1]) + (ps[2] + ps[3]) + rbv; }
            asm volatile("s_waitcnt lgkmcnt(0)" ::: "memory");
            const int rr = lane >> 4;
            float lg[16];
#pragma unroll
            for (int j = 0; j < 4; ++j) { const f32x4 v = *(const f32x4*)(lgS + rr * 16 + 4 * j); lg[4 * j] = v[0]; lg[4 * j + 1] = v[1]; lg[4 * j + 2] = v[2]; lg[4 * j + 3] = v[3]; }
            asm volatile("s_waitcnt lgkmcnt(0)" ::: "memory");
            {
                float mx = lg[0];
#pragma unroll
                for (int e = 1; e < 16; ++e) mx = fmaxf(mx, lg[e]);
                float sc[16], den = 0.f;
#pragma unroll
                for (int e = 0; e < 16; ++e) { sc[e] = __expf(lg[e] - mx); den += sc[e]; }
                const float inv = __builtin_amdgcn_rcpf(den);
#pragma unroll
                for (int e = 0; e < 16; ++e) sc[e] *= inv;
                int sel = 0; float best = -1.f;
#pragma unroll
                for (int gq = 0; gq < 4; ++gq) {
                    const float a = sc[4 * gq], b_ = sc[4 * gq + 1], c_ = sc[4 * gq + 2], d_ = sc[4 * gq + 3];
                    const float m1 = fmaxf(fmaxf(a, b_), fmaxf(c_, d_));
                    const float m2 = fmaxf(fmaxf(fminf(a, b_), fminf(c_, d_)), fminf(fmaxf(a, b_), fmaxf(c_, d_)));
                    const float gs = m1 + m2;
                    if (gs > best) { best = gs; sel = gq; }
                }
                float cd[4];
#pragma unroll
                for (int i = 0; i < 4; ++i) cd[i] = (sel == 0) ? sc[i] : (sel == 1) ? sc[4 + i] : (sel == 2) ? sc[8 + i] : sc[12 + i];
                int i0 = 0; float v0 = cd[0];
#pragma unroll
                for (int i = 1; i < 4; ++i) if (cd[i] > v0) { v0 = cd[i]; i0 = i; }
                int i1 = -1; float v1 = -1.f;
#pragma unroll
                for (int i = 0; i < 4; ++i) if (i != i0 && cd[i] > v1) { v1 = cd[i]; i1 = i; }
                const int e0 = sel * 4 + i0, e1 = sel * 4 + i1;
                const float gsum = v0 + v1;
                if ((lane & 15) == 0) {
                    const int row = base + lr0 + rr;
                    gate[2 * row] = v0 / gsum; gate[2 * row + 1] = v1 / gsum;
                    const int r0 = atomicAdd(&hist[e0], 1), r1 = atomicAdd(&hist[e1], 1);
                    rowinfo[2 * (lr0 + rr)] = e0 | (r0 << 8); rowinfo[2 * (lr0 + rr) + 1] = e1 | (r1 << 8);
                }
            }
        }
        __syncthreads();
        if (tid < 16) hist[16 + tid] = (int)__hip_atomic_fetch_add(gcnt + tid, (unsigned)hist[tid], __ATOMIC_RELAXED, __HIP_MEMORY_SCOPE_AGENT);
        __syncthreads();
        { const int info = rowinfo[tid]; const int e = info & 255, rk = info >> 8, pos = hist[16 + e] + rk, a = (base + (tid >> 1)) * 2 + (tid & 1);
          list[(size_t)e * LCAP + pos] = a; ((int*)(A.ws + WS_EINFO))[a] = e | (pos << 8); }
        __syncthreads();
    }
}

__device__ __forceinline__ void phase_ln2(const int tid, const Args& A, int layer, int vcu, int G, const LAS int* tab) {
    const int lane = tid & 63, wave = tid >> 6;
    const bf16* X1 = (const bf16*)(A.ws + WS_X1); const bf16* YM = (const bf16*)(A.ws + WS_YM);
    bf16* XB = (bf16*)(A.ws + WS_XB);
    const float* g2 = A.in[I_LN2G] + layer * D; const float* b2 = A.in[I_LN2B] + layer * D;
    f32x4 gg[4], bb[4];
#pragma unroll
    for (int j = 0; j < 4; ++j) { gg[j] = *(const f32x4*)(g2 + 4 * lane + 256 * j); bb[j] = *(const f32x4*)(b2 + 4 * lane + 256 * j); }
    const int gw = vcu * NWAVES + wave, NGW = G * NWAVES;
    const int* einfo = (const int*)(A.ws + WS_EINFO); const float* gate = (const float*)(A.ws + WS_GATE);
    constexpr int RB = 4;
    int nrow = gw * RB;
    int ei[2 * RB]; float gt[2 * RB];
#pragma unroll
    for (int q = 0; q < 2 * RB; ++q) { ei[q] = (nrow < M) ? einfo[2 * nrow + q] : 0; gt[q] = (nrow < M) ? gate[2 * nrow + q] : 0.f; }
    for (int row0 = nrow; row0 < M; row0 += NGW * RB) {
        size_t yr[2 * RB]; float g_[2 * RB];
#pragma unroll
        for (int q = 0; q < 2 * RB; ++q) { yr[q] = ((size_t)tab[ei[q] & 255] << 8) + (size_t)(ei[q] >> 8); g_[q] = gt[q]; }
        u32x2 xa[RB][4], y0[RB][4], y1[RB][4];
#pragma unroll
        for (int r = 0; r < RB; ++r)
#pragma unroll
            for (int j = 0; j < 4; ++j) {
                xa[r][j] = *(const u32x2*)(X1 + (size_t)(row0 + r) * D + 4 * lane + 256 * j);
                y0[r][j] = *(const u32x2*)(YM + yr[2 * r] * D + 4 * lane + 256 * j);
                y1[r][j] = *(const u32x2*)(YM + yr[2 * r + 1] * D + 4 * lane + 256 * j);
            }
        { const int nx = row0 + NGW * RB;
#pragma unroll
          for (int q = 0; q < 2 * RB; ++q) { ei[q] = (nx < M) ? einfo[2 * nx + q] : 0; gt[q] = (nx < M) ? gate[2 * nx + q] : 0.f; } }
#pragma unroll
        for (int r = 0; r < RB; ++r) {
            const int row = row0 + r; const float g0 = g_[2 * r], g1 = g_[2 * r + 1];
            f32x4 v[4]; float sm = 0.f;
#pragma unroll
            for (int j = 0; j < 4; ++j) {
                const u32x2 a = xa[r][j], ya = y0[r][j], yb = y1[r][j];
                v[j][0] = ALPHA * lo16(a.x) + g0 * lo16(ya.x) + g1 * lo16(yb.x); v[j][1] = ALPHA * hi16(a.x) + g0 * hi16(ya.x) + g1 * hi16(yb.x);
                v[j][2] = ALPHA * lo16(a.y) + g0 * lo16(ya.y) + g1 * lo16(yb.y); v[j][3] = ALPHA * hi16(a.y) + g0 * hi16(ya.y) + g1 * hi16(yb.y);
                sm += (v[j][0] + v[j][1]) + (v[j][2] + v[j][3]);
            }
            const float mean = red64(sm) * (1.0f / D); float s2 = 0.f;
#pragma unroll
            for (int j = 0; j < 4; ++j) { v[j] = v[j] - mean; s2 += (v[j][0] * v[j][0] + v[j][1] * v[j][1]) + (v[j][2] * v[j][2] + v[j][3] * v[j][3]); }
            const float rstd = rsqrtf(red64(s2) * (1.0f / D) + LN_EPS);
#pragma unroll
            for (int j = 0; j < 4; ++j) {
                const f32x4 o = v[j] * rstd * gg[j] + bb[j];
                if (layer == DEPTH - 1) *(f32x4*)(A.out + (size_t)row * D + 4 * lane + 256 * j) = o;
                else { u32x2 w; w.x = pk2(o[0], o[1]); w.y = pk2(o[2], o[3]); *(u32x2*)(XB + (size_t)row * D + 4 * lane + 256 * j) = w; }
            }
        }
    }
}

__device__ __forceinline__ void moe_table(const int tid, const Args& A, int layer, LAS int* tab) {
    if (tid == 0) {
        const unsigned* gcnt = (const unsigned*)(A.ws + WS_CTL) + CW_CNT + layer * 64;
        int acc = 0;
        for (int e = 0; e < 16; ++e) { const int c = (int)__hip_atomic_load(gcnt + e, __ATOMIC_RELAXED, __HIP_MEMORY_SCOPE_AGENT); tab[e] = acc; tab[32 + e] = c; acc += (c + 255) >> 8; }
        tab[16] = acc;
    }
    __syncthreads();
}

__global__ void __launch_bounds__(NTHR, 2) fwd_kernel(Args args) {
    extern __shared__ __attribute__((aligned(16))) unsigned char lds[];
    LAS unsigned char* ldsl = (LAS unsigned char*)lds;
    volatile LAS unsigned* misc = (volatile LAS unsigned*)(ldsl + MISC_OFF);
    const int wave_s = __builtin_amdgcn_readfirstlane((int)threadIdx.x >> 6);
#define MKTID() ({ unsigned z_ = 0u; asm volatile("" : "+v"(z_)); (int)(wave_s * 64 + (int)__builtin_amdgcn_mbcnt_hi(~0u, __builtin_amdgcn_mbcnt_lo(~0u, z_))); })
    { const int tid = MKTID(); for (int u = tid; u < (LDS_BYTES - MISC_OFF) / 4; u += NTHR) misc[u] = 0u; }
    __syncthreads();
    const int G = gridDim.x, bx = blockIdx.x;
    const int vcu = (G % 8 == 0) ? (bx % 8) * (G / 8) + bx / 8 : bx;
    unsigned* ctl = (unsigned*)(args.ws + WS_CTL);
    XcdBarrier bar; bar.bar = ctl + CW_BAR; bar.x = 0; bar.st = nullptr;
    if (args.use_bar) bar = xcd_barrier_post(MKTID(), ctl + CW_BAR, misc + 8);
    LAS int* tab = (LAS int*)(ldsl + MISC_OFF + 256);
    const int lo = args.ph_lo, hi = args.ph_hi;
#ifndef PHMASK
#define PHMASK 0x3FF
#endif
#define IN(k) (((PHMASK >> (k)) & 1) && lo <= (k) && (k) < hi)
#define SEAM(k) do { if (args.use_bar && (REP_PH || !((k) == NPH - 1 && layer == args.l_hi - 1))) xcd_barrier(MKTID(), bar); } while (0)
#ifndef REP_PH
#define REP_PH 0
#endif
#ifndef REP_UMASK
#define REP_UMASK 7
#endif
    for (int layer = args.l_lo; layer < args.l_hi; ++layer) {
      {
#define RUN(k) if (IN(k)) for (int rep = 0; rep < ((((REP_PH) >> (k)) & 1) ? 2 : 1); ++rep)
        RUN(0) { phase_convert(MKTID(), args, layer, (float*)lds, vcu, G); SEAM(0); }
        RUN(1) {
            pg8::DenseOrder S; S.init(M, INC, D, G, bx, args.ws + WS_WIN);
            pg8::EpiIn E{(bf16*)(args.ws + WS_P)};
            pg8::gemm_phase<pg8::EpiIn, pg8::DenseOrder, true>(MKTID(), ldsl, (const char*)(args.ws + WS_XB), D, S, E);
            SEAM(1);
        }
#ifndef R1STOP
#define R1STOP 99
#endif
        RUN(2) { const bool probe = ((REP_PH >> 2) & 1) && rep == 0; phase_mixers(MKTID(), args, layer, 0, lds, misc, probe ? REP_UMASK : 7, rep * 4, probe ? R1STOP : 99); SEAM(2); }
        RUN(3) { phase_mixers(MKTID(), args, layer, 1, lds, misc, rep ? REP_UMASK : 7, rep * 4); SEAM(3); }
        RUN(4) { phase_mixers(MKTID(), args, layer, 2, lds, misc, rep ? REP_UMASK : 7, rep * 4); SEAM(4); }
        RUN(5) {
            pg8::DenseOrder S; S.init(M, D, D, G, bx, args.ws + WS_WOUT);
            pg8::EpiOut E{(const bf16*)(args.ws + WS_XB), (bf16*)(args.ws + WS_X1)};
            pg8::gemm_phase<pg8::EpiOut, pg8::DenseOrder, true>(MKTID(), ldsl, (const char*)(args.ws + WS_MIX), D, S, E);
            SEAM(5);
        }
        RUN(6) { phase_ln1_router(MKTID(), args, layer, lds, vcu, G); SEAM(6); }
        RUN(7) {
            moe_table(MKTID(), args, layer, tab);
            pg8::MoeOrder<true> S{tab, G, vcu, D, 4, (const char*)(args.ws + WS_WGU), (size_t)1024 * D * 2, (const int*)(args.ws + WS_LIST)};
            pg8::EpiMoe1 E{(bf16*)(args.ws + WS_H)};
            pg8::gemm_phase<pg8::EpiMoe1, pg8::MoeOrder<true>, true>(MKTID(), ldsl, (const char*)(args.ws + WS_X1), D, S, E);
            SEAM(7);
        }
        RUN(8) {
            moe_table(MKTID(), args, layer, tab);
            pg8::MoeOrder<false> S{tab, G, vcu, DE, 4, (const char*)(args.ws + WS_WDN), (size_t)1024 * DE * 2, (const int*)(args.ws + WS_LIST)};
            pg8::EpiMoe2 E{(bf16*)(args.ws + WS_YM)};
            pg8::gemm_phase<pg8::EpiMoe2, pg8::MoeOrder<false>, true>(MKTID(), ldsl, (const char*)(args.ws + WS_H), DE, S, E);
            SEAM(8);
        }
        RUN(9) { moe_table(MKTID(), args, layer, tab); phase_ln2(MKTID(), args, layer, vcu, G, tab); SEAM(9); }
#undef RUN
      }
    }
#undef IN
#undef SEAM
}

extern "C" void kernel_launch(void* const* d_in, const int* in_sizes, int n_in, void* d_out, int out_size, void* d_ws, size_t ws_size, hipStream_t stream) {
    static int grid = 0;
    if (grid == 0) {
        if (n_in != 32 || out_size != M * D || ws_size < WS_END) { fprintf(stderr, "kernel_launch: unexpected shapes (n_in %d out %d ws %zu)\n", n_in, out_size, ws_size); grid = -1; return; }
        int dev = 0, cus = 0;
        if (hipGetDevice(&dev) != hipSuccess || hipDeviceGetAttribute(&cus, hipDeviceAttributeMultiprocessorCount, dev) != hipSuccess) { grid = -1; return; }
        if (hipFuncSetAttribute((const void*)fwd_kernel, hipFuncAttributeMaxDynamicSharedMemorySize, LDS_BYTES) != hipSuccess) { fprintf(stderr, "kernel_launch: hipFuncSetAttribute failed\n"); grid = -1; return; }
        int per_cu = 0;
        (void)hipOccupancyMaxActiveBlocksPerMultiprocessor(&per_cu, (const void*)fwd_kernel, NTHR, LDS_BYTES);
        (void)hipGetLastError();
        if (per_cu < 1) fprintf(stderr, "kernel_launch: occupancy query reports %d\n", per_cu);
        grid = cus;
    }
    if (grid < 0) return;
    (void)hipMemsetAsync((char*)d_ws + WS_CTL, 0, CTL_BYTES, stream);
    Args a{};
    for (int i = 0; i < 32; ++i) a.in[i] = (const float*)d_in[i];
    a.out = (float*)d_out; a.ws = (unsigned char*)d_ws;
#if MK_ONE_LAUNCH
    a.l_lo = 0; a.l_hi = DEPTH; a.ph_lo = 0; a.ph_hi = NPH; a.use_bar = 1; a.pad = 0;
    hipLaunchKernelGGL(fwd_kernel, dim3(grid), dim3(NTHR), LDS_BYTES, stream, a);
#else
    for (int l = 0; l < DEPTH; ++l)
        for (int p = 0; p < NPH; ++p) {
            a.l_lo = l; a.l_hi = l + 1; a.ph_lo = p; a.ph_hi = p + 1; a.use_bar = 0; a.pad = 0;
            hipLaunchKernelGGL(fwd_kernel, dim3(grid), dim3(NTHR), LDS_BYTES, stream, a);
        }
#endif
}
```

```cpp
#include <hip/hip_runtime.h>
#include <cstdio>
#include <cstdint>

#ifndef MK_ONE_LAUNCH
#define MK_ONE_LAUNCH 1
#endif

#define LAS __attribute__((address_space(3)))
#define GAS __attribute__((address_space(1)))
typedef unsigned short bf16;
typedef short bf16x8 __attribute__((ext_vector_type(8)));
typedef short s16x4 __attribute__((ext_vector_type(4)));
typedef float f32x4 __attribute__((ext_vector_type(4)));
typedef float f32x2 __attribute__((ext_vector_type(2)));
typedef float f32x16 __attribute__((ext_vector_type(16)));
typedef unsigned u32x4 __attribute__((ext_vector_type(4)));
typedef unsigned u32x2 __attribute__((ext_vector_type(2)));
typedef __bf16 bf16x2_t __attribute__((ext_vector_type(2)));

constexpr int D = 1024, BATCH = 16, SEQ = 4096, DEPTH = 4, M = BATCH * SEQ;
constexpr int HD = 64, RW = 384, LW = 256, SW = 384, RH = 6, LB = 4, SH = 6;
constexpr int RCOLS = 1408, INC = 3072;
constexpr int PC_R = 0, PC_K = 384, PC_V = 768, PC_DW = 1152, PC_DA = 1216, PC_DG = 1280;
constexpr int PC_LG = 1408, PC_LX = 1664, PC_SQ = 1920, PC_SK = 2304, PC_SV = 2688;
constexpr int MIX_R = 0, MIX_L = 384, MIX_S = 640;
constexpr int NE = 16, DE = 512, LCAP = 2 * M;
constexpr float ALPHA = 1.6817928305074290f;
constexpr float LN_EPS = 1e-5f, RMS_EPS = 1e-6f, GN_EPS = 64e-5f;
constexpr float C2 = 0.125f * 1.4426950408889634f;

constexpr size_t MiB = 1u << 20;
constexpr size_t WS_CTL = 0, CTL_BYTES = 1 * MiB;
constexpr size_t WS_WIN = 1 * MiB;
constexpr size_t WS_WOUT = 7 * MiB;
constexpr size_t WS_WGU = 9 * MiB;
constexpr size_t WS_WDN = 41 * MiB;
constexpr size_t WS_WSM = 57 * MiB;
constexpr size_t WS_LIST = 58 * MiB;
constexpr size_t WS_GATE = 66 * MiB;
constexpr size_t WS_EINFO = 67 * MiB;
constexpr size_t WS_XB = 68 * MiB;
constexpr size_t WS_X1 = 196 * MiB;
constexpr size_t WS_P = 324 * MiB;
constexpr size_t WS_MIX = 708 * MiB;
constexpr size_t WS_H = 324 * MiB;
constexpr size_t WS_YM = 460 * MiB;
constexpr size_t WS_END = 888 * MiB;
static_assert(WS_H + (size_t)(2 * M + NE * 256) * DE * 2 <= WS_YM && WS_YM + (size_t)2 * M * D * 2 <= WS_END, "ws map");

constexpr int CW_BAR = 0;
constexpr int CW_CNT = 8192;
constexpr int CW_Q = 8192 + 1024;

constexpr int NTHR = 512, NWAVES = 8;
constexpr int LDS_BYTES = 155648;
constexpr int GEMM_LDS = 131072;
constexpr int MISC_OFF = 147456;

__device__ __forceinline__ float bf2f(unsigned short b) { return __uint_as_float((unsigned)b << 16); }
__device__ __forceinline__ unsigned pk2(float lo, float hi) { f32x2 v = {lo, hi}; bf16x2_t b = __builtin_convertvector(v, bf16x2_t); return __builtin_bit_cast(unsigned, b); }
__device__ __forceinline__ u32x4 pair16(u32x2 a, u32x2 b) {
    const auto rx = __builtin_amdgcn_permlane32_swap(a.x, b.x, false, false), ry = __builtin_amdgcn_permlane32_swap(a.y, b.y, false, false);
    u32x4 w; w.x = rx[0]; w.y = ry[0]; w.z = rx[1]; w.w = ry[1]; return w;
}
__device__ __forceinline__ void unpair16(const u32x4 L, u32x2& a, u32x2& b) {
    const auto rx = __builtin_amdgcn_permlane32_swap(L.x, L.z, false, false), ry = __builtin_amdgcn_permlane32_swap(L.y, L.w, false, false);
    a.x = rx[0]; a.y = ry[0]; b.x = rx[1]; b.y = ry[1];
}
__device__ __forceinline__ float lo16(unsigned u) { return __uint_as_float(u << 16); }
__device__ __forceinline__ float hi16(unsigned u) { return __uint_as_float(u & 0xffff0000u); }
#define DPP(v, ctrl) __builtin_bit_cast(float, __builtin_amdgcn_update_dpp(__builtin_bit_cast(int, v), __builtin_bit_cast(int, v), (ctrl), 0xF, 0xF, false))
__device__ __forceinline__ float red8(float v) { v += DPP(v, 0xB1); v += DPP(v, 0x4E); v += DPP(v, 0x141); return v; }
__device__ __forceinline__ float red16(float v) { v = red8(v); v += DPP(v, 0x140); return v; }
__device__ __forceinline__ float red64(float v) { v = red16(v); v += __shfl_xor(v, 16); v += __shfl_xor(v, 32); return v; }
__device__ __forceinline__ float sigmoidf_(float x) { return __builtin_amdgcn_rcpf(1.0f + __expf(-x)); }
__device__ __forceinline__ float log1p_fast(float y) { return (y < 0.06f) ? y * (1.0f + y * (-0.5f + y * (0.33333334f + y * (-0.25f + y * (0.2f - y * 0.16666667f))))) : __logf(1.0f + y); }
__device__ __forceinline__ float softplusf_(float x) { return x > 20.f ? x : log1p_fast(__expf(x)); }

#define XB_TMO      128
#define XB_XCNT(j)  (256  + 64 * (j))
#define XB_XSUB(j)  (1280 + 64 * (j))
#define XB_XGEN(j)  (2304 + 64 * (j))
#define XB_TOP      3328
#define XB_TOPGEN   3392
#define XCD_BAR_WORDS 3456
#define XB_SPIN_CAP (1u << 22)
__device__ __forceinline__ unsigned xb_ld(unsigned* p)              { return __hip_atomic_load(p, __ATOMIC_RELAXED, __HIP_MEMORY_SCOPE_AGENT); }
__device__ __forceinline__ unsigned xb_add(unsigned* p, unsigned v) { return __hip_atomic_fetch_add(p, v, __ATOMIC_RELAXED, __HIP_MEMORY_SCOPE_AGENT); }
__device__ __forceinline__ unsigned xb_xcc_id() { return (unsigned)__builtin_amdgcn_s_getreg((3 << 11) | 20) & 0xFu; }
#define XB_SPIN(cond, bar) do { unsigned _sp = 0; while (cond) { __builtin_amdgcn_s_sleep(1); \
    if ((++_sp & 255u) == 0u) { if (xb_ld(&(bar)[XB_TMO])) break; if (_sp > XB_SPIN_CAP) { atomicAdd(&(bar)[XB_TMO], 1u); break; } } } } while (0)
struct XcdBarrier { unsigned* bar; unsigned x; volatile LAS unsigned* st; };
__device__ __forceinline__ XcdBarrier xcd_barrier_post(const int tid, unsigned* bar, volatile LAS unsigned* st) {
    XcdBarrier b; b.bar = bar; b.x = xb_xcc_id(); b.st = st;
    if (tid == 0) (void)xb_add(&bar[XB_XCNT(b.x)], 1u);
    return b;
}
__device__ __forceinline__ void xcd_barrier_complete(unsigned* bar, unsigned x, unsigned& nloc, unsigned& nx) {
    const unsigned G = gridDim.x * gridDim.y * gridDim.z;
    unsigned sum, cnt, mine, sp = 0u;
    for (;;) {
        sum = 0u; cnt = 0u; mine = 0u;
#pragma unroll
        for (unsigned j = 0; j < 16; ++j) { const unsigned c = xb_ld(&bar[XB_XCNT(j)]); sum += c; cnt += (c > 0u) ? 1u : 0u; mine = (j == x) ? c : mine; }
        if (sum == G) break;
        __builtin_amdgcn_s_sleep(1);
        if ((++sp & 255u) == 0u) { if (xb_ld(&bar[XB_TMO])) break; if (sp > XB_SPIN_CAP) { atomicAdd(&bar[XB_TMO], 1u); break; } }
    }
    nloc = mine > 0u ? mine : 1u; nx = cnt > 0u ? cnt : 1u;
}
__device__ __forceinline__ void xcd_barrier(const int tid, const XcdBarrier& b) {
    asm volatile("s_waitcnt vmcnt(0)" ::: "memory");
    __syncthreads();
    if (tid == 0) {
        unsigned* bar = b.bar;
        __builtin_amdgcn_s_waitcnt(0);
        unsigned nloc = b.st[0], nx = b.st[1];
        if (nloc == 0u) { xcd_barrier_complete(bar, b.x, nloc, nx); b.st[0] = nloc; b.st[1] = nx; }
        const unsigned old = xb_add(&bar[XB_XSUB(b.x)], 1u);
        const unsigned gen = old / nloc;
        if (old + 1u == (gen + 1u) * nloc) {
            __builtin_amdgcn_fence(__ATOMIC_RELEASE, "agent");
            asm volatile("s_waitcnt vmcnt(0)" ::: "memory");
            const unsigned og = xb_add(&bar[XB_TOP], 1u);
            const unsigned tg = og / nx;
            if (og + 1u == (tg + 1u) * nx) xb_add(&bar[XB_TOPGEN], 1u);
            else XB_SPIN(xb_ld(&bar[XB_TOPGEN]) == tg, bar);
            __builtin_amdgcn_fence(__ATOMIC_ACQUIRE, "agent");
            xb_add(&bar[XB_XGEN(b.x)], 1u);
            asm volatile("s_waitcnt vmcnt(0)" ::: "memory");
        } else {
            XB_SPIN(xb_ld(&bar[XB_XGEN(b.x)]) == gen, bar);
            __builtin_amdgcn_fence(__ATOMIC_ACQUIRE, "agent");
            asm volatile("s_waitcnt vmcnt(0)" ::: "memory");
        }
    }
    __syncthreads();
}

namespace pg8 {
constexpr int BM = 256, BK = 64, HALF = 128, HTB = HALF * BK * 2, STAGE_BYTES = 8 * HTB;
__host__ __device__ __forceinline__ int lds_byte(int r, int c) { const int st = (r >> 4) * 2 + (c >> 5), rr = r & 15, cc = c & 31, ob = rr * 64 + cc * 2; return st * 1024 + (ob ^ (((ob >> 9) & 1) << 5)); }
__host__ __device__ __forceinline__ void stage_rc(int b, int& R, int& C) { const int st = b / 1024, sb = b % 1024, swz = sb ^ (((sb >> 9) & 1) << 5); R = (st >> 1) * 16 + swz / 64; C = (st & 1) * 32 + (swz % 64) / 2; }
__host__ __device__ __forceinline__ int perm32(int rho) { const int n = rho >> 4, i = rho & 15; return 8 * (i >> 2) + 4 * n + (i & 3); }

struct Unit { int pm, pn, e, j, ord; };
template <class Epi, class Sched, bool ALIGN_EPI>
__device__ __forceinline__ void gemm_phase(const int tid, LAS unsigned char* lds, const char* Abase, const int K, const Sched& S, const Epi& E) {
    const int wid = __builtin_amdgcn_readfirstlane(tid >> 6), lane = tid & 63, wr = wid >> 2, wc = wid & 3, fr = lane & 15, fq = lane >> 4;
    const int nt = K / BK;
    int R0, C0; stage_rc(tid * 16, R0, C0);
    const int Rb0 = (R0 & ~31) + perm32(R0 & 31);
    unsigned voffB[2]; voffB[0] = (unsigned)(Rb0 * K + C0) * 2u; voffB[1] = (unsigned)((Rb0 + 64) * K + C0) * 2u;
    unsigned voffA[2]; voffA[0] = (unsigned)(R0 * K + C0) * 2u; voffA[1] = (unsigned)((R0 + 64) * K + C0) * 2u;
    const unsigned colA = (unsigned)C0 * 2u;
    const size_t kstep = (size_t)(BK * 2);
    const size_t hstepB = (size_t)HALF * K * 2, hstepA = hstepB;
    const unsigned ldsw = (unsigned)wid * 1024u;
    const int aoff = lds_byte(wr * 64 + fr, fq * 8), boff = lds_byte(wc * 32 + fr, fq * 8);
#define PG8_SA(b, h) (((b) * 2 + (h)) * HTB)
#define PG8_SB(b, h) ((4 + (b) * 2 + (h)) * HTB)
#define PG8_STAGE_B(bufoff, gbase) do { _Pragma("unroll") for (int _i = 0; _i < 2; ++_i) \
        __builtin_amdgcn_global_load_lds((const unsigned*)((const char*)(gbase) + voffB[_i]), (LAS unsigned*)(lds + (bufoff) + ldsw + _i * 8192), 16, 0, 0); } while (0)
#define PG8_STAGE_A(bufoff, h, kbyte, nx) do { \
        if constexpr (Sched::GATHER) { _Pragma("unroll") for (int _i = 0; _i < 2; ++_i) { const unsigned _o = (nx) ? na[h][_i] : ca[h][_i]; \
            __builtin_amdgcn_global_load_lds((const unsigned*)(Abase + (kbyte) + _o), (LAS unsigned*)(lds + (bufoff) + ldsw + _i * 8192), 16, 0, 0); } } \
        else { const char* _p = ((nx) ? nA : cA) + (kbyte) + (size_t)(h) * hstepA; _Pragma("unroll") for (int _i = 0; _i < 2; ++_i) \
            __builtin_amdgcn_global_load_lds((const unsigned*)(_p + voffA[_i]), (LAS unsigned*)(lds + (bufoff) + ldsw + _i * 8192), 16, 0, 0); } } while (0)
#define PG8_LDA(dst, b, h) do { _Pragma("unroll") for (int m = 0; m < 4; ++m) _Pragma("unroll") for (int k = 0; k < 2; ++k) dst[m][k] = *(const LAS bf16x8*)(lds + PG8_SA(b, h) + aoff + m * 2048 + k * 1024); } while (0)
#define PG8_LDB(dst, b, h) do { _Pragma("unroll") for (int n = 0; n < 2; ++n) _Pragma("unroll") for (int k = 0; k < 2; ++k) dst[n][k] = *(const LAS bf16x8*)(lds + PG8_SB(b, h) + boff + n * 2048 + k * 1024); } while (0)
#define PG8_MMA(ai, bj, At, Bt) do { __builtin_amdgcn_s_setprio(1); _Pragma("unroll") for (int m = 0; m < 4; ++m) _Pragma("unroll") for (int n = 0; n < 2; ++n) _Pragma("unroll") for (int k = 0; k < 2; ++k) \
        acc[ai][bj][m][n] = __builtin_amdgcn_mfma_f32_16x16x32_bf16(Bt[n][k], At[m][k], acc[ai][bj][m][n], 0, 0, 0); __builtin_amdgcn_s_setprio(0); } while (0)
#define PG8_WAIT_V(n) asm volatile("s_waitcnt vmcnt(" #n ")" ::: "memory")
#define PG8_WAIT_L(n) asm volatile("s_waitcnt lgkmcnt(" #n ")" ::: "memory")
#define PG8_BAR __builtin_amdgcn_s_barrier()
#define PG8_SCHED __builtin_amdgcn_sched_barrier(0)
    Unit cur, nxt; int ui = 0;
    if (!S.next(0, cur)) return;
    unsigned ca[2][2], na[2][2];
    const char* cA = Abase; const char* nA = Abase;
    if constexpr (Sched::GATHER) S.aoffs(cur, R0, colA, ca); else cA = Abase + (size_t)S.arow0(cur) * K * 2;
    f32x4 acc[2][2][4][2];
#pragma unroll
    for (int a = 0; a < 2; ++a)
#pragma unroll
        for (int b = 0; b < 2; ++b)
#pragma unroll
            for (int m = 0; m < 4; ++m)
#pragma unroll
                for (int n = 0; n < 2; ++n) acc[a][b][m][n] = (f32x4){0.f, 0.f, 0.f, 0.f};
    bf16x8 At[4][2], B0[2][2], B1[2][2];
    const char* cB = S.bbase(cur);
    PG8_STAGE_B(PG8_SB(0, 0), cB); PG8_STAGE_B(PG8_SB(0, 1), cB + hstepB); PG8_STAGE_A(PG8_SA(0, 0), 0, 0, false); PG8_STAGE_A(PG8_SA(0, 1), 1, 0, false);
    if (wr == 1) PG8_BAR;
    PG8_WAIT_V(2); PG8_BAR;
    PG8_STAGE_B(PG8_SB(1, 0), cB + kstep); PG8_STAGE_A(PG8_SA(1, 0), 0, kstep, false); PG8_STAGE_B(PG8_SB(1, 1), cB + hstepB + kstep);
    PG8_WAIT_V(6); PG8_BAR;
    for (;;) {
        const bool has_next = S.next(ui + 1, nxt);
        const char* nB = cB;
        nA = cA;
        if (has_next) { nB = S.bbase(nxt); if constexpr (Sched::GATHER) S.aoffs(nxt, R0, colA, na); else nA = Abase + (size_t)S.arow0(nxt) * K * 2; }
        else if constexpr (Sched::GATHER) { na[0][0] = ca[0][0]; na[0][1] = ca[0][1]; na[1][0] = ca[1][0]; na[1][1] = ca[1][1]; }
        for (int t = 0; t < nt; t += 2) {
            const bool last = (t == nt - 2);
            const size_t k1 = (size_t)(t + 1) * kstep;
            const size_t k2 = last ? 0 : (size_t)(t + 2) * kstep, k3 = k2 + kstep;
            const char* b2 = last ? nB : cB + (size_t)(t + 2) * kstep; const char* b3 = b2 + kstep;
            PG8_LDB(B0, 0, 0); PG8_LDB(B1, 0, 1); PG8_SCHED; PG8_LDA(At, 0, 0); PG8_STAGE_A(PG8_SA(1, 1), 1, k1, false);
            PG8_WAIT_V(8); PG8_WAIT_L(0); PG8_BAR; PG8_MMA(0, 0, At, B0); PG8_MMA(0, 1, At, B1); PG8_BAR; PG8_SCHED;
            PG8_LDA(At, 0, 1); PG8_STAGE_B(PG8_SB(0, 0), b2); PG8_STAGE_B(PG8_SB(0, 1), b2 + hstepB); PG8_STAGE_A(PG8_SA(0, 0), 0, k2, last);
            PG8_WAIT_V(8); PG8_WAIT_L(0); PG8_BAR; PG8_MMA(1, 0, At, B0); PG8_MMA(1, 1, At, B1); PG8_BAR; PG8_SCHED;
            PG8_LDB(B0, 1, 0); PG8_LDB(B1, 1, 1); PG8_SCHED; PG8_LDA(At, 1, 0); PG8_STAGE_A(PG8_SA(0, 1), 1, k2, last);
            PG8_WAIT_V(8); PG8_WAIT_L(0); PG8_BAR; PG8_MMA(0, 0, At, B0); PG8_MMA(0, 1, At, B1); PG8_BAR; PG8_SCHED;
            PG8_LDA(At, 1, 1); PG8_STAGE_B(PG8_SB(1, 0), b3); PG8_STAGE_B(PG8_SB(1, 1), b3 + hstepB); PG8_STAGE_A(PG8_SA(1, 0), 0, k3, last);
            PG8_WAIT_V(8); PG8_WAIT_L(0); PG8_BAR; PG8_MMA(1, 0, At, B0); PG8_MMA(1, 1, At, B1); PG8_BAR; PG8_SCHED;
        }
        if constexpr (ALIGN_EPI) { if (wr == 0) PG8_BAR; }
        E(acc, cur, wr, wc, fr, fq);
        if (!has_next) break;
#pragma unroll
        for (int a = 0; a < 2; ++a)
#pragma unroll
            for (int b = 0; b < 2; ++b)
#pragma unroll
                for (int m = 0; m < 4; ++m)
#pragma unroll
                    for (int n = 0; n < 2; ++n) acc[a][b][m][n] = (f32x4){0.f, 0.f, 0.f, 0.f};
        cur = nxt; cB = nB; cA = nA; ++ui;
        if constexpr (Sched::GATHER) { ca[0][0] = na[0][0]; ca[0][1] = na[0][1]; ca[1][0] = na[1][0]; ca[1][1] = na[1][1]; }
        if constexpr (ALIGN_EPI) { if (wr == 1) PG8_BAR; }
    }
    PG8_WAIT_V(0);
    if constexpr (!ALIGN_EPI) { if (wr == 0) PG8_BAR; }
    PG8_BAR;
#undef PG8_SA
#undef PG8_SB
#undef PG8_STAGE_A
#undef PG8_STAGE_B
#undef PG8_LDA
#undef PG8_LDB
#undef PG8_MMA
#undef PG8_WAIT_V
#undef PG8_WAIT_L
#undef PG8_BAR
#undef PG8_SCHED
}

struct DenseOrder {
    static constexpr bool GATHER = false;
    int nM, nN, nwg, G, c, K; const char* Bt;
    __device__ __forceinline__ int arow0(const Unit& u) const { return u.pm * BM; }
    __device__ __forceinline__ void init(int M_, int N_, int K_, int G_, int c_, const void* Bt_) { nM = M_ / BM; nN = N_ / BM; nwg = nM * nN; G = G_; c = c_; K = K_; Bt = (const char*)Bt_; }
    __device__ __forceinline__ bool next(int i, Unit& u) const {
        const long L = (long)i * G + c; if (L >= nwg) return false;
        int wgid = (int)L; { const int q = nwg / 8, r = nwg % 8, xcd = wgid % 8, off = wgid / 8; wgid = (xcd < r ? xcd * (q + 1) : r * (q + 1) + (xcd - r) * q) + off; }
        const int nig = 8 * nN, gid = wgid / nig, fm = gid * 8, gsz = (nM - fm) < 8 ? (nM - fm) : 8;
        u.pm = fm + ((wgid % nig) % gsz); u.pn = (wgid % nig) / gsz; u.e = 0; u.j = 0; u.ord = i; return true;
    }
    __device__ __forceinline__ void aoffs(const Unit& u, int R0, unsigned colA, unsigned (&o)[2][2]) const {
#pragma unroll
        for (int h = 0; h < 2; ++h)
#pragma unroll
            for (int i = 0; i < 2; ++i) o[h][i] = (unsigned)(u.pm * BM + h * HALF + R0 + 64 * i) * (unsigned)(K * 2) + colA;
    }
    __device__ __forceinline__ const char* bbase(const Unit& u) const { return Bt + (size_t)u.pn * BM * K * 2; }
};
template <bool GATHER_>
struct MoeOrder {
    static constexpr bool GATHER = GATHER_;
    __device__ __forceinline__ int arow0(const Unit& u) const { return u.pm * BM; }
    const LAS int* tab;
    int G, c, K, nN; const char* Bt; size_t estride;
    const int* list; const LAS int* lrows;
    __device__ __forceinline__ bool next(int i, Unit& u) const {
        u.ord = i;
        const int L = i * G + c; const int nb = tab[16];
        if (L >= nb * nN) return false;
        const int rb = L / nN; u.pn = L % nN; u.pm = rb;
        int e = 0;
#pragma unroll
        for (int k = 1; k < 16; ++k) e += (rb >= tab[k]) ? 1 : 0;
        u.e = e; u.j = rb - tab[e]; return true;
    }
    __device__ __forceinline__ void aoffs(const Unit& u, int R0, unsigned colA, unsigned (&o)[2][2]) const {
#pragma unroll
        for (int h = 0; h < 2; ++h)
#pragma unroll
            for (int i = 0; i < 2; ++i) o[h][i] = (unsigned)lrows[u.ord * BM + h * HALF + R0 + 64 * i] * (unsigned)(K * 2) + colA;
    }
    __device__ __forceinline__ const char* bbase(const Unit& u) const { return Bt + (size_t)u.e * estride + (size_t)u.pn * BM * K * 2; }
};

__device__ __forceinline__ u32x4 pack8(const f32x4 v0, const f32x4 v1) { u32x4 w; w.x = pk2(v0[0], v0[1]); w.y = pk2(v0[2], v0[3]); w.z = pk2(v1[0], v1[1]); w.w = pk2(v1[2], v1[3]); return w; }
struct EpiIn {
    bf16* O;
    __device__ __forceinline__ void operator()(const f32x4 (&acc)[2][2][4][2], const Unit& u, int wr, int wc, int fr, int fq) const {
        const int row0 = u.pm * BM + wr * 64 + fr, col0 = u.pn * BM + wc * 32 + 8 * fq;
#pragma unroll
        for (int ai = 0; ai < 2; ++ai)
#pragma unroll
            for (int m = 0; m < 4; ++m) { bf16* rowp = O + (size_t)(row0 + ai * HALF + m * 16) * INC + col0;
#pragma unroll
                for (int bj = 0; bj < 2; ++bj) { const int c = col0 + bj * HALF; const float sc = (c >= PC_SQ && c < PC_SK) ? C2 : 1.0f;
                    *(u32x4*)(rowp + bj * HALF) = pack8(acc[ai][bj][m][0] * sc, acc[ai][bj][m][1] * sc); } }
    }
};
struct EpiOut {
    bf16* O;
    __device__ __forceinline__ void operator()(const f32x4 (&acc)[2][2][4][2], const Unit& u, int wr, int wc, int fr, int fq) const {
        const int row0 = u.pm * BM + wr * 64 + fr, col0 = u.pn * BM + wc * 32 + 8 * fq;
#pragma unroll
        for (int ai = 0; ai < 2; ++ai)
#pragma unroll
            for (int m = 0; m < 4; ++m) { bf16* rowp = O + (size_t)(row0 + ai * HALF + m * 16) * D + col0;
#pragma unroll
                for (int bj = 0; bj < 2; ++bj) *(u32x4*)(rowp + bj * HALF) = pack8(acc[ai][bj][m][0], acc[ai][bj][m][1]); }
    }
};
struct EpiMoe1 {
    bf16* Hb;
    __device__ __forceinline__ void operator()(const f32x4 (&acc)[2][2][4][2], const Unit& u, int wr, int wc, int fr, int fq) const {
        const int row0 = u.pm * BM + wr * 64 + fr, col0 = u.pn * HALF + wc * 32 + 8 * fq;
#pragma unroll
        for (int ai = 0; ai < 2; ++ai)
#pragma unroll
            for (int m = 0; m < 4; ++m) {
                f32x4 g0 = acc[ai][0][m][0], g1 = acc[ai][0][m][1]; const f32x4 u0 = acc[ai][1][m][0], u1 = acc[ai][1][m][1];
#pragma unroll
                for (int q = 0; q < 4; ++q) { g0[q] = g0[q] * sigmoidf_(g0[q]) * u0[q]; g1[q] = g1[q] * sigmoidf_(g1[q]) * u1[q]; }
                *(u32x4*)(Hb + (size_t)(row0 + ai * HALF + m * 16) * DE + col0) = pack8(g0, g1); }
    }
};
struct EpiMoe2 {
    bf16* Y;
    __device__ __forceinline__ void operator()(const f32x4 (&acc)[2][2][4][2], const Unit& u, int wr, int wc, int fr, int fq) const {
        const int row0 = u.pm * BM + wr * 64 + fr, col0 = u.pn * BM + wc * 32 + 8 * fq;
#pragma unroll
        for (int ai = 0; ai < 2; ++ai)
#pragma unroll
            for (int m = 0; m < 4; ++m) { bf16* rowp = Y + (size_t)(row0 + ai * HALF + m * 16) * D + col0;
#pragma unroll
                for (int bj = 0; bj < 2; ++bj) *(u32x4*)(rowp + bj * HALF) = pack8(acc[ai][bj][m][0], acc[ai][bj][m][1]); }
    }
};
}

struct Args {
    const float* in[32]; float* out; unsigned char* ws;
    int l_lo, l_hi, ph_lo, ph_hi;
    int use_bar, pad;
};
enum { I_X = 0, I_WIN, I_MU, I_W0, I_WUP, I_A0, I_AUP, I_GUP, I_KK, I_KA, I_RK, I_LNG, I_LNB, I_CW, I_CB, I_WA, I_BA, I_WX, I_BX, I_LAM, I_LRUG, I_SBAG,
       I_WOUT, I_LN1G, I_LN1B, I_LN2G, I_LN2B, I_RW, I_RB, I_EG, I_EU, I_ED };
constexpr int NPH = 10;

__device__ __forceinline__ void transpose_item(const float* W, int N, bf16* WT, int pitch, int drow0, int k0, int n0, float* scr, int lane) {
#pragma unroll 8
    for (int i = 0; i < 32; ++i) { const int kk = 2 * i + (lane >> 5); scr[kk * 33 + (lane & 31)] = W[(size_t)(k0 + kk) * N + n0 + (lane & 31)]; }
    asm volatile("s_waitcnt lgkmcnt(0)" ::: "memory");
    const int c = lane & 7;
#pragma unroll
    for (int j = 0; j < 4; ++j) { const int n = (lane >> 3) + 8 * j; const float* s = scr + (8 * c) * 33 + n;
        u32x4 o; o.x = pk2(s[0 * 33], s[1 * 33]); o.y = pk2(s[2 * 33], s[3 * 33]); o.z = pk2(s[4 * 33], s[5 * 33]); o.w = pk2(s[6 * 33], s[7 * 33]);
        *(u32x4*)(WT + (size_t)(drow0 + n) * pitch + k0 + 8 * c) = o; }
    asm volatile("s_waitcnt lgkmcnt(0)" ::: "memory");
}
__device__ __forceinline__ void phase_convert(const int tid, const Args& A, int layer, float* ldsf, int vcu, int G) {
    const int lane = tid & 63, wave = tid >> 6;
    float* scr = ldsf + wave * 4096;
    unsigned char* ws = A.ws;
    bf16* Win = (bf16*)(ws + WS_WIN); bf16* Wout = (bf16*)(ws + WS_WOUT); bf16* Wgu = (bf16*)(ws + WS_WGU); bf16* Wdn = (bf16*)(ws + WS_WDN);
    bf16* WupT = (bf16*)(ws + WS_WSM); bf16* AupT = WupT + 384 * 64; bf16* GupT = AupT + 384 * 64;
    const int gw = vcu * NWAVES + wave, NGW = G * NWAVES;
    constexpr int I_IN = 16 * 96, I_OUT = 16 * 32, I_G = 16 * 256, I_U = 16 * 256, I_D = 16 * 256, I_S1 = 12, I_S2 = 12, I_S3 = 24, I_S4 = 16;
    constexpr int NIT = I_IN + I_OUT + I_G + I_U + I_D + I_S1 + I_S2 + I_S3 + I_S4;
    for (int it = gw; it < NIT; it += NGW) {
        int r = it;
        if (r < I_IN) { const int kb = r / 96, nb = r % 96; transpose_item(A.in[I_WIN] + (size_t)layer * D * INC, INC, Win, D, 32 * nb, 64 * kb, 32 * nb, scr, lane); continue; } r -= I_IN;
        if (r < I_OUT) { const int kb = r / 32, nb = r % 32; transpose_item(A.in[I_WOUT] + (size_t)layer * D * D, D, Wout, D, 32 * nb, 64 * kb, 32 * nb, scr, lane); continue; } r -= I_OUT;
        if (r < I_G + I_U) { const int up = r >= I_G; if (up) r -= I_G; const int e = r / 256, q = r % 256, kb = q / 16, nb = q % 16, n0 = 32 * nb;
            const float* src = A.in[up ? I_EU : I_EG] + ((size_t)layer * NE + e) * D * DE;
            transpose_item(src, DE, Wgu, D, e * 1024 + (n0 >> 7) * 256 + up * 128 + (n0 & 127), 64 * kb, n0, scr, lane); continue; } r -= I_G + I_U;
        if (r < I_D) { const int e = r / 256, q = r % 256, kb = q / 32, nb = q % 32;
            transpose_item(A.in[I_ED] + ((size_t)layer * NE + e) * DE * D, D, Wdn, DE, e * 1024 + 32 * nb, 64 * kb, 32 * nb, scr, lane); continue; } r -= I_D;
        if (r < I_S1) { transpose_item(A.in[I_WUP] + (size_t)layer * 64 * RW, RW, WupT, 64, 32 * r, 0, 32 * r, scr, lane); continue; } r -= I_S1;
        if (r < I_S2) { transpose_item(A.in[I_AUP] + (size_t)layer * 64 * RW, RW, AupT, 64, 32 * r, 0, 32 * r, scr, lane); continue; } r -= I_S2;
        if (r < I_S3) { const int kb = r / 12, nb = r % 12; transpose_item(A.in[I_GUP] + (size_t)layer * 128 * RW, RW, GupT, 128, 32 * nb, 64 * kb, 32 * nb, scr, lane); continue; } r -= I_S3;
        { const int x = r >> 3, gq = (r >> 1) & 3, nb = r & 1;
          transpose_item(A.in[x ? I_WX : I_WA] + ((size_t)layer * LB + gq) * 4096, 64, GupT + 384 * 128 + x * 16384, 64, gq * 64 + 32 * nb, 0, 32 * nb, scr, lane); }
    }
    if (layer == 0) {
        const f32x4* x4 = (const f32x4*)A.in[I_X]; u32x4* o = (u32x4*)(ws + WS_XB);
        const size_t n8 = (size_t)M * D / 8;
        for (size_t i = (size_t)vcu * NTHR + tid; i < n8; i += (size_t)G * NTHR) { const f32x4 a = x4[2 * i], b = x4[2 * i + 1]; o[i] = pg8::pack8(a, b); }
    }
}

typedef short v4i16_t __attribute__((ext_vector_type(4)));
template <bool MASK>
__device__ __forceinline__ void attn_tile(const bf16* Ks, const bf16* Vs, const bf16x8 (&qr)[4], f32x16& o0, f32x16& o1, float& Rrun, const int k0, const int qmine, const int r, const int hh, const int vtr_off) {
    f32x16 p0 = {}, p1 = {};
#pragma unroll
    for (int s = 0; s < 4; ++s) {
        const bf16x8 ka = *(const bf16x8*)(Ks + r * 72 + 16 * s + 8 * hh);
        const bf16x8 kb = *(const bf16x8*)(Ks + (32 + r) * 72 + 16 * s + 8 * hh);
        p0 = __builtin_amdgcn_mfma_f32_32x32x16_bf16(ka, qr[s], p0, 0, 0, 0);
        p1 = __builtin_amdgcn_mfma_f32_32x32x16_bf16(kb, qr[s], p1, 0, 0, 0);
    }
    float pa[8]; f32x2 va[8], vb[8];
#pragma unroll
    for (int g = 0; g < 8; ++g) {
        float z[4];
#pragma unroll
        for (int i = 0; i < 4; ++i) z[i] = (g < 4) ? p0[4 * g + i] : p1[4 * (g - 4) + i];
        const f32x2 eA = {__builtin_amdgcn_exp2f(z[0]), __builtin_amdgcn_exp2f(z[1])}, eB = {__builtin_amdgcn_exp2f(z[2]), __builtin_amdgcn_exp2f(z[3])};
        const f32x2 dA = eA + 1.0f, dB = eB + 1.0f;
        f32x2 kA = {__builtin_amdgcn_rcpf(dA[0]), __builtin_amdgcn_rcpf(dA[1])}, kB = {__builtin_amdgcn_rcpf(dB[0]), __builtin_amdgcn_rcpf(dB[1])};
        if (MASK) { const int key = k0 + 32 * (g >> 2) + 8 * (g & 3) + 4 * hh;
            kA[0] = (key + 0 >= qmine) ? 1.0f : kA[0]; kA[1] = (key + 1 >= qmine) ? 1.0f : kA[1]; kB[0] = (key + 2 >= qmine) ? 1.0f : kB[0]; kB[1] = (key + 3 >= qmine) ? 1.0f : kB[1]; }
        const f32x2 sA = 1.0f - kA, sB = 1.0f - kB;
        const float x1 = kB[1] * kB[0], x0 = x1 * kA[1];
        pa[g] = x0 * kA[0];
        va[g] = sA * (f32x2){x0, x1}; vb[g] = sB * (f32x2){kB[1], 1.0f};
    }
    float pi[16];
#pragma unroll
    for (int g = 0; g < 8; ++g) { const auto rr = __builtin_amdgcn_permlane32_swap(__float_as_uint(pa[g]), __float_as_uint(pa[g]), false, false);
        pi[2 * g] = __uint_as_float(rr[0]); pi[2 * g + 1] = __uint_as_float(rr[1]); }
    float S[16];
    S[15] = Rrun;
#pragma unroll
    for (int j = 14; j >= 0; --j) S[j] = S[j + 1] * pi[j + 1];
    Rrun = S[0] * pi[0];
#pragma unroll
    for (int g = 0; g < 8; ++g) {
        const float re = hh ? S[2 * g + 1] : S[2 * g];
        va[g] = va[g] * re; vb[g] = vb[g] * re;
    }
#pragma unroll
    for (int s = 0; s < 4; ++s) {
        u32x4 pw;
        pw.x = pk2(va[2 * s][0], va[2 * s][1]); pw.y = pk2(vb[2 * s][0], vb[2 * s][1]); pw.z = pk2(va[2 * s + 1][0], va[2 * s + 1][1]); pw.w = pk2(vb[2 * s + 1][0], vb[2 * s + 1][1]);
        const bf16x8 pf = __builtin_bit_cast(bf16x8, pw);
        const bf16* vbp = Vs + 16 * s * 72 + vtr_off;
        { const v4i16_t lo = __builtin_amdgcn_ds_read_tr16_b64_v4i16((LAS v4i16_t*)(vbp)), hi = __builtin_amdgcn_ds_read_tr16_b64_v4i16((LAS v4i16_t*)(vbp + 8 * 72));
          const bf16x8 vf = __builtin_shufflevector(lo, hi, 0, 1, 2, 3, 4, 5, 6, 7);
          o0 = __builtin_amdgcn_mfma_f32_32x32x16_bf16(vf, pf, o0, 0, 0, 0); }
        { const v4i16_t lo = __builtin_amdgcn_ds_read_tr16_b64_v4i16((LAS v4i16_t*)(vbp + 32)), hi = __builtin_amdgcn_ds_read_tr16_b64_v4i16((LAS v4i16_t*)(vbp + 8 * 72 + 32));
          const bf16x8 vf = __builtin_shufflevector(lo, hi, 0, 1, 2, 3, 4, 5, 6, 7);
          o1 = __builtin_amdgcn_mfma_f32_32x32x16_bf16(vf, pf, o1, 0, 0, 0); }
    }
}
__device__ __forceinline__ void attn_unit(const int tid_in, const Args& A, int layer, int bh, int qb, unsigned char* lds) {
    int tid = tid_in; asm volatile("" : "+v"(tid));
    const int lane = tid & 63, wave = __builtin_amdgcn_readfirstlane(tid >> 6), r = lane & 31, hh = lane >> 5;
    const int b = bh / SH, h = bh % SH;
    const bf16* P = (const bf16*)(A.ws + WS_P) + (size_t)b * SEQ * INC;
    bf16* MIX = (bf16*)(A.ws + WS_MIX) + (size_t)b * SEQ * D;
    bf16* KV = (bf16*)lds;
    constexpr int SLOT = 2 * 64 * 72;
    const int q0w = qb * 256 + wave * 32;
    bf16x8 qr[4];
#pragma unroll
    for (int s = 0; s < 4; ++s) qr[s] = *(const bf16x8*)(P + (size_t)(q0w + r) * INC + PC_SQ + h * 64 + 16 * s + 8 * hh);
    f32x16 o0 = {}, o1 = {};
    float Rrun = 1.0f;
    const int qmine = q0w + r;
    const int lkey = tid >> 3, lch = (tid & 7) * 8;
    const int NT = 4 * qb + 4;
    const int g16 = lane >> 4, i16 = lane & 15;
    const int vtr_off = (4 * (g16 >> 1) + (i16 >> 2)) * 72 + 16 * (g16 & 1) + 4 * (i16 & 3);
    u32x4 kreg, vreg;
    { const int jt0 = NT - 1;
      kreg = *(const u32x4*)(P + (size_t)(64 * jt0 + lkey) * INC + PC_SK + h * 64 + lch);
      vreg = *(const u32x4*)(P + (size_t)(64 * jt0 + lkey) * INC + PC_SV + h * 64 + lch); }
    __syncthreads();
    { bf16* s0 = KV + ((NT - 1) & 1) * SLOT; *(u32x4*)(s0 + lkey * 72 + lch) = kreg; *(u32x4*)(s0 + 64 * 72 + lkey * 72 + lch) = vreg; }
    if (NT >= 2) { const int jt1 = NT - 2;
      kreg = *(const u32x4*)(P + (size_t)(64 * jt1 + lkey) * INC + PC_SK + h * 64 + lch);
      vreg = *(const u32x4*)(P + (size_t)(64 * jt1 + lkey) * INC + PC_SV + h * 64 + lch); }
    asm volatile("s_waitcnt lgkmcnt(0)\n\ts_barrier" ::: "memory");
    bool wdone = false;
    for (int jt = NT - 1; jt >= 0; --jt) {
        const bf16* Ks = KV + (jt & 1) * SLOT; const bf16* Vs = Ks + 64 * 72;
        if (jt >= 1) {
            bf16* sn = KV + ((jt - 1) & 1) * SLOT;
            *(u32x4*)(sn + lkey * 72 + lch) = kreg; *(u32x4*)(sn + 64 * 72 + lkey * 72 + lch) = vreg;
            if (jt >= 2) {
                kreg = *(const u32x4*)(P + (size_t)(64 * (jt - 2) + lkey) * INC + PC_SK + h * 64 + lch);
                vreg = *(const u32x4*)(P + (size_t)(64 * (jt - 2) + lkey) * INC + PC_SV + h * 64 + lch);
            }
        }
        const int k0 = 64 * jt;
        if (k0 < q0w + 31 && !wdone) {
            if (k0 + 63 >= q0w) attn_tile<true>(Ks, Vs, qr, o0, o1, Rrun, k0, qmine, r, hh, vtr_off);
            else attn_tile<false>(Ks, Vs, qr, o0, o1, Rrun, k0, qmine, r, hh, vtr_off);
        }
        int* dflag = (int*)(KV + 2 * SLOT) + (jt & 1) * 8;
        wdone = __all(Rrun == 0.0f);
        if (lane == 0) dflag[wave] = wdone ? 1 : 0;
        asm volatile("s_waitcnt lgkmcnt(0)\n\ts_barrier" ::: "memory");
        { const u32x4 f0 = *(const u32x4*)dflag, f1 = *(const u32x4*)(dflag + 4);
          if ((f0.x & f0.y & f0.z & f0.w & f1.x & f1.y & f1.z & f1.w) != 0u) break; }
    }
    float ss = 0.f;
#pragma unroll
    for (int i = 0; i < 16; ++i) ss += o0[i] * o0[i] + o1[i] * o1[i];
    ss += __shfl_xor(ss, 32);
    const float sc = rsqrtf(ss * (1.0f / 64.0f) + RMS_EPS);
    const float* ng = A.in[I_SBAG] + layer * SW + h * 64;
    bf16* orow = MIX + (size_t)(q0w + r) * D + MIX_S + h * 64;
    f32x4 ga[4], gb[4];
#pragma unroll
    for (int g = 0; g < 4; ++g) { ga[g] = *(const f32x4*)(ng + 8 * g + 4 * hh); gb[g] = *(const f32x4*)(ng + 32 + 8 * g + 4 * hh); }
    u32x2 w0[4], w1[4];
#pragma unroll
    for (int g = 0; g < 4; ++g) {
        const f32x4 g0 = ga[g], g1 = gb[g];
        w0[g].x = pk2(o0[4 * g] * sc * g0[0], o0[4 * g + 1] * sc * g0[1]); w0[g].y = pk2(o0[4 * g + 2] * sc * g0[2], o0[4 * g + 3] * sc * g0[3]);
        w1[g].x = pk2(o1[4 * g] * sc * g1[0], o1[4 * g + 1] * sc * g1[1]); w1[g].y = pk2(o1[4 * g + 2] * sc * g1[2], o1[4 * g + 3] * sc * g1[3]);
    }
#pragma unroll
    for (int gp = 0; gp < 2; ++gp) {
        *(u32x4*)(orow + 16 * gp + 8 * hh) = pair16(w0[2 * gp], w0[2 * gp + 1]);
        *(u32x4*)(orow + 32 + 16 * gp + 8 * hh) = pair16(w1[2 * gp], w1[2 * gp + 1]);
    }
}

constexpr int CP = 72;
constexpr size_t SC_MP = 0, SC_NN = 48 * MiB, SC_QH = 96 * MiB, SC_OL = 144 * MiB, SC_HS = 192 * MiB;
constexpr size_t WS_G = 836 * MiB, WS_RHO = 884 * MiB, WS_GC = 886 * MiB;
__device__ __forceinline__ f32x16 mm32(const bf16* X, const bf16* Y, int lane, f32x16 acc) {
    const int r = lane & 31, hh = lane >> 5;
#pragma unroll
    for (int s_ = 0; s_ < 4; ++s_) {
        const bf16x8 a = *(const bf16x8*)(X + r * CP + 16 * s_ + 8 * hh);
        const bf16x8 b = *(const bf16x8*)(Y + r * CP + 16 * s_ + 8 * hh);
        acc = __builtin_amdgcn_mfma_f32_32x32x16_bf16(a, b, acc, 0, 0, 0);
    }
    return acc;
}
__device__ __forceinline__ u32x4 packfrag(const f32x16& a, int sp) {
    u32x4 w;
    if (sp == 0) { w.x = pk2(a[0], a[1]); w.y = pk2(a[2], a[3]); w.z = pk2(a[4], a[5]); w.w = pk2(a[6], a[7]); }
    else { w.x = pk2(a[8], a[9]); w.y = pk2(a[10], a[11]); w.z = pk2(a[12], a[13]); w.w = pk2(a[14], a[15]); }
    return w;
}
struct R1Pre { u32x4 cu[4], pv[4]; };
struct R1Rows { u32x2 cr[2], ck[2], cv[2], pr[2], pk[2], pv[2]; };
__device__ __forceinline__ void rwkv_r1_prefetch(const int tid, const Args& A, int b, int c, R1Pre& pf) {
    const int t0 = c * 64;
    const bf16* P = (const bf16*)(A.ws + WS_P) + (size_t)b * SEQ * INC;
#pragma unroll
    for (int q = 0; q < 4; ++q) {
        const int item = tid + NTHR * q, tok = item >> 5, cc = (item & 31) * 8, pc = PC_DW + cc, t = t0 + tok;
        pf.cu[q] = *(const u32x4*)(P + (size_t)t * INC + pc);
        pf.pv[q] = *(const u32x4*)(P + (size_t)((t > 0) ? t - 1 : 0) * INC + pc);
    }
}
__device__ __forceinline__ void rwkv_r1_unit(const int tid_in, const Args& A, int layer, int uidx, unsigned char* lds, R1Pre& pf, R1Rows& rw, const bool first, const bool lasth, const int stop = 99) {
    int tid = tid_in; asm volatile("" : "+v"(tid));
    const int lane = tid & 63, wave = __builtin_amdgcn_readfirstlane(tid >> 6), r31 = lane & 31, hh = lane >> 5;
    const int head = uidx >> 6, c = uidx & 63, b = head / RH, h = head % RH, t0 = c * 64;
    const size_t brow = (size_t)b * SEQ;
    const bf16* P = (const bf16*)(A.ws + WS_P) + brow * INC;
    constexpr int WP = 68;
    float* wS = (float*)lds; float* aS = wS + 64 * WP; float* gS = aS + 64 * WP;
    bf16* AAB = (bf16*)lds; bf16* AAK = AAB + 64 * CP; bf16* ARB = AAK + 64 * CP; bf16* ARK = ARB + 64 * CP;
    bf16* TM = ARK + 64 * CP; bf16* TMt = TM + 64 * CP; bf16* X1t = TMt + 64 * CP;
    unsigned char* ob = lds + 7 * 64 * CP * 2;
    bf16* AL = (bf16*)ob;
    bf16* AH = (bf16*)ob; bf16* QT = AH + 64 * CP; bf16* BH = QT + 64 * CP; bf16* KH = BH + 64 * CP;
    bf16* BHt = KH + 64 * CP; bf16* KHt = BHt + 64 * CP; bf16* Vt = KHt + 64 * CP; bf16* AHt = Vt + 64 * CP;
    bf16* WTt = KH; bf16* UTt = AH;
    float* segT = (float*)(ob + 8 * 64 * CP * 2);
    float* gCs = segT + 512;
    bf16* PTs = (bf16*)(gCs + 64);
    const float* mu = A.in[I_MU] + layer * RCOLS;
    const int c4 = (tid & 15) * 4, tkA = tid >> 4, ch = h * 64 + c4;
    f32x4 mm0 = {0.f, 0.f, 0.f, 0.f}, mm1 = mm0;
    if (first) { const int pc = PC_DW + (tid & 31) * 8; mm0 = *(const f32x4*)(mu + pc); mm1 = *(const f32x4*)(mu + pc + 4); }
    bf16x8 fw[2], fa[2], fg[4];
    {   const bf16* WupT = (const bf16*)(A.ws + WS_WSM); const bf16* AupT = WupT + 384 * 64; const bf16* GupT = AupT + 384 * 64;
        const int rowj = h * 64 + 16 * (wave & 3) + (lane & 15), kq8 = 8 * (lane >> 4);
#pragma unroll
        for (int ks = 0; ks < 2; ++ks) { fw[ks] = *(const bf16x8*)(WupT + (size_t)rowj * 64 + 32 * ks + kq8); fa[ks] = *(const bf16x8*)(AupT + (size_t)rowj * 64 + 32 * ks + kq8); }
#pragma unroll
        for (int ks = 0; ks < 4; ++ks) fg[ks] = *(const bf16x8*)(GupT + (size_t)rowj * 128 + 32 * ks + kq8);
    }
#define R1_ROWS(dst, chx) do { _Pragma("unroll") for (int q = 0; q < 2; ++q) { \
        const int t = t0 + 2 * tkA + q; const bf16* pr = P + (size_t)t * INC; const bf16* pp = (t > 0) ? pr - INC : pr;     \
        dst.cr[q] = *(const u32x2*)(pr + PC_R + (chx)); dst.ck[q] = *(const u32x2*)(pr + PC_K + (chx)); dst.cv[q] = *(const u32x2*)(pr + PC_V + (chx)); \
        dst.pr[q] = *(const u32x2*)(pp + PC_R + (chx)); dst.pk[q] = *(const u32x2*)(pp + PC_K + (chx)); dst.pv[q] = *(const u32x2*)(pp + PC_V + (chx)); } } while (0)
    if (first) R1_ROWS(rw, ch);
    const f32x4 w0v = *(const f32x4*)(A.in[I_W0] + layer * RW + ch), a0v = *(const f32x4*)(A.in[I_A0] + layer * RW + ch);
    const f32x4 kkv = *(const f32x4*)(A.in[I_KK] + layer * RW + ch), kav = *(const f32x4*)(A.in[I_KA] + layer * RW + ch), rkv = *(const f32x4*)(A.in[I_RK] + layer * RW + ch);
    const f32x4 mur = *(const f32x4*)(mu + PC_R + ch), muk = *(const f32x4*)(mu + PC_K + ch), muv = *(const f32x4*)(mu + PC_V + ch);
#pragma unroll
    for (int q = 0; q < 4; ++q) {
        const int item = tid + NTHR * q, tok = item >> 5, cc = (item & 31) * 8, pc = PC_DW + cc;
        if (first) {
            const u32x4 cu = pf.cu[q]; u32x4 pv = pf.pv[q]; if (t0 + tok == 0) pv = (u32x4){0u, 0u, 0u, 0u};
            const f32x4 m0 = mm0, m1 = mm1;
            float v[8];
            { float c_, p_;
              c_ = lo16(cu.x); p_ = lo16(pv.x); v[0] = c_ + m0[0] * (p_ - c_); c_ = hi16(cu.x); p_ = hi16(pv.x); v[1] = c_ + m0[1] * (p_ - c_);
              c_ = lo16(cu.y); p_ = lo16(pv.y); v[2] = c_ + m0[2] * (p_ - c_); c_ = hi16(cu.y); p_ = hi16(pv.y); v[3] = c_ + m0[3] * (p_ - c_);
              c_ = lo16(cu.z); p_ = lo16(pv.z); v[4] = c_ + m1[0] * (p_ - c_); c_ = hi16(cu.z); p_ = hi16(pv.z); v[5] = c_ + m1[1] * (p_ - c_);
              c_ = lo16(cu.w); p_ = lo16(pv.w); v[6] = c_ + m1[2] * (p_ - c_); c_ = hi16(cu.w); p_ = hi16(pv.w); v[7] = c_ + m1[3] * (p_ - c_); }
            if (cc < 64) {
#pragma unroll
                for (int i = 0; i < 8; ++i) { const float e2 = __expf(2.0f * v[i]); v[i] = 1.0f - 2.0f * __builtin_amdgcn_rcpf(e2 + 1.0f); }
            } else if (cc >= 128) {
#pragma unroll
                for (int i = 0; i < 8; ++i) v[i] = sigmoidf_(v[i]);
            }
            u32x4 w; w.x = pk2(v[0], v[1]); w.y = pk2(v[2], v[3]); w.z = pk2(v[4], v[5]); w.w = pk2(v[6], v[7]);
            pf.cu[q] = w;
        }
        *(u32x4*)(AL + tok * 264 + cc) = pf.cu[q];
    }
    asm volatile("s_waitcnt lgkmcnt(0)\n\ts_barrier" ::: "memory");
    if (stop <= 1) return;
    {
        const int jt = wave & 3, kq8 = 8 * (lane >> 4);
#pragma unroll
        for (int q = 0; q < 2; ++q) {
            const int tt = 2 * (wave >> 2) + q;
            const bf16* bl = AL + (16 * tt + (lane & 15)) * 264 + kq8;
            f32x4 accw = {0.f, 0.f, 0.f, 0.f}, acca = accw, accg = accw;
#pragma unroll
            for (int ks = 0; ks < 2; ++ks) { accw = __builtin_amdgcn_mfma_f32_16x16x32_bf16(fw[ks], *(const bf16x8*)(bl + 32 * ks), accw, 0, 0, 0);
                                            acca = __builtin_amdgcn_mfma_f32_16x16x32_bf16(fa[ks], *(const bf16x8*)(bl + 64 + 32 * ks), acca, 0, 0, 0); }
#pragma unroll
            for (int ks = 0; ks < 4; ++ks) accg = __builtin_amdgcn_mfma_f32_16x16x32_bf16(fg[ks], *(const bf16x8*)(bl + 128 + 32 * ks), accg, 0, 0, 0);
            const int o_ = (16 * tt + (lane & 15)) * WP + 16 * jt + 4 * (lane >> 4);
            *(f32x4*)(wS + o_) = accw; *(f32x4*)(aS + o_) = acca; *(f32x4*)(gS + o_) = accg;
        }
    }
    asm volatile("s_waitcnt lgkmcnt(0)\n\ts_barrier" ::: "memory");
    if (stop <= 2) return;
    f32x4 rs[2], kts[2], kkn[2], avs[2], lws[2], vvs[2];
    {
        bf16* Gs = (bf16*)(A.ws + WS_G); float* RHOs = (float*)(A.ws + WS_RHO);
#pragma unroll
        for (int q = 0; q < 2; ++q) {
            const int tok = 2 * tkA + q, t = t0 + tok;
            const u32x2 cr = rw.cr[q], ck = rw.ck[q], cv = rw.cv[q]; u32x2 qr_ = rw.pr[q], qk_ = rw.pk[q], qv_ = rw.pv[q];
            if (t == 0) { qr_ = (u32x2){0u, 0u}; qk_ = qr_; qv_ = qr_; }
            f32x4 rc = {lo16(cr.x), hi16(cr.x), lo16(cr.y), hi16(cr.y)}, rp_ = {lo16(qr_.x), hi16(qr_.x), lo16(qr_.y), hi16(qr_.y)};
            f32x4 kc = {lo16(ck.x), hi16(ck.x), lo16(ck.y), hi16(ck.y)}, kp_ = {lo16(qk_.x), hi16(qk_.x), lo16(qk_.y), hi16(qk_.y)};
            f32x4 vc = {lo16(cv.x), hi16(cv.x), lo16(cv.y), hi16(cv.y)}, vp_ = {lo16(qv_.x), hi16(qv_.x), lo16(qv_.y), hi16(qv_.y)};
            const f32x4 rv = rc + mur * (rp_ - rc), kv = kc + muk * (kp_ - kc), vv = vc + muv * (vp_ - vc);
            const f32x4 wp = *(const f32x4*)(wS + tok * WP + c4), ap = *(const f32x4*)(aS + tok * WP + c4), gp = *(const f32x4*)(gS + tok * WP + c4);
            f32x4 lw, av, kkx, kt; float n2 = 0.f, rpv = 0.f;
#pragma unroll
            for (int i = 0; i < 4; ++i) {
                const float x = w0v[i] + wp[i];
                lw[i] = -(__builtin_amdgcn_rcpf(1.0f + __expf(-x)) * 0.6065306597126334f);
                av[i] = sigmoidf_(a0v[i] + ap[i]);
                kkx[i] = kv[i] * kkv[i]; n2 += kkx[i] * kkx[i];
                kt[i] = kv[i] * (1.0f + (av[i] - 1.0f) * kav[i]);
                rpv += rv[i] * kt[i] * rkv[i];
            }
            n2 = red16(n2); rpv = red16(rpv);
            const float inv = (n2 > 1e-24f) ? __builtin_amdgcn_rsqf(n2) : 1e12f;
            rs[q] = rv; kts[q] = kt; kkn[q] = kkx * inv; avs[q] = av; lws[q] = lw; vvs[q] = vv;
            *(f32x4*)(wS + tok * WP + c4) = lw;
            u32x2 gw; gw.x = pk2(gp[0], gp[1]); gw.y = pk2(gp[2], gp[3]);
            *(u32x2*)(Gs + (brow + t) * RW + ch) = gw;
            if ((tid & 15) == 0) RHOs[(brow + t) * RH + h] = rpv;
        }
#pragma unroll
        for (int i = 0; i < 4; ++i) *(unsigned*)(Vt + (c4 + i) * CP + 2 * tkA) = pk2(vvs[0][i], vvs[1][i]);
    }
    if (!lasth) R1_ROWS(rw, ch + 64);
#undef R1_ROWS
    asm volatile("s_waitcnt lgkmcnt(0)\n\ts_barrier" ::: "memory");
    if (stop <= 3) return;
    { const int k = tid & 63, seg = tid >> 6; float run = 0.f, dv[8];
#pragma unroll
      for (int i = 0; i < 8; ++i) dv[i] = wS[(8 * seg + i) * WP + k];
#pragma unroll
      for (int i = 0; i < 8; ++i) { run += dv[i]; wS[(8 * seg + i) * WP + k] = run; }
      segT[seg * 64 + k] = run; }
    asm volatile("s_waitcnt lgkmcnt(0)\n\ts_barrier" ::: "memory");
    if (stop <= 4) return;
    f32x4 bhs[2], khs[2], ahs[2];
    { u32x4* z = (u32x4*)TM; const u32x4 zz = {0u, 0u, 0u, 0u};
      for (int i = tid; i < 2 * 64 * CP * 2 / 16; i += NTHR) z[i] = zz;
      if (tid < 3 * 16 * 40 * 2 / 16) ((u32x4*)PTs)[tid] = zz; }
#pragma unroll
    for (int q = 0; q < 2; ++q) {
        const int tok = 2 * tkA + q, seg = tok >> 3;
        f32x4 L = *(const f32x4*)(wS + tok * WP + c4);
        for (int s_ = 0; s_ < seg; ++s_) L = L + *(const f32x4*)(segT + s_ * 64 + c4);
        f32x4 eL, eNL, eLp;
#pragma unroll
        for (int i = 0; i < 4; ++i) { eL[i] = __expf(L[i]); eNL[i] = __expf(-L[i]); eLp[i] = __expf(L[i] - lws[q][i]); }
        const f32x4 qt = rs[q] * eL, kh = kts[q] * eNL, ah = -(kkn[q] * eLp), bh = kkn[q] * avs[q] * eNL;
        u32x2 w;
        w.x = pk2(ah[0], ah[1]); w.y = pk2(ah[2], ah[3]); *(u32x2*)(AH + tok * CP + c4) = w;
        w.x = pk2(qt[0], qt[1]); w.y = pk2(qt[2], qt[3]); *(u32x2*)(QT + tok * CP + c4) = w;
        w.x = pk2(bh[0], bh[1]); w.y = pk2(bh[2], bh[3]); *(u32x2*)(BH + tok * CP + c4) = w;
        w.x = pk2(kh[0], kh[1]); w.y = pk2(kh[2], kh[3]); *(u32x2*)(KH + tok * CP + c4) = w;
        bhs[q] = bh; khs[q] = kh; ahs[q] = ah;
        if (tok == 63) { *(f32x4*)(gCs + c4) = eL; *(f32x4*)((float*)(A.ws + WS_GC) + (size_t)uidx * 64 + c4) = eL; }
    }
#pragma unroll
    for (int i = 0; i < 4; ++i) {
        *(unsigned*)(BHt + (c4 + i) * CP + 2 * tkA) = pk2(bhs[0][i], bhs[1][i]);
        *(unsigned*)(KHt + (c4 + i) * CP + 2 * tkA) = pk2(khs[0][i], khs[1][i]);
        *(unsigned*)(AHt + (c4 + i) * CP + 2 * tkA) = pk2(ahs[0][i], ahs[1][i]);
    }
    asm volatile("s_waitcnt lgkmcnt(0)\n\ts_barrier" ::: "memory");
    if (stop <= 5) return;
    {
        const int yt = wave & 3;
        const bf16* X = ((yt < 2) ? BH : KH) + 32 * (yt & 1) * CP;
#pragma unroll
        for (int q = 0; q < 2; ++q) {
            const int xt = 2 * (wave >> 2) + q;
            const bf16* Y = ((xt < 2) ? AH : QT) + 32 * (xt & 1) * CP;
            f32x16 acc = {};
            acc = mm32(X, Y, lane, acc);
            bf16* dst = (xt < 2) ? ((yt < 2) ? AAB : AAK) : ((yt < 2) ? ARB : ARK);
            const int i = 32 * (xt & 1) + r31;
#pragma unroll
            for (int g = 0; g < 4; ++g) {
                const int j0 = 32 * (yt & 1) + 8 * g + 4 * hh;
                float v[4];
#pragma unroll
                for (int e = 0; e < 4; ++e) { const int j = j0 + e; const bool keep = (xt < 2) ? (j < i) : (j <= i); v[e] = keep ? acc[4 * g + e] : 0.f; }
                { u32x2 w; w.x = pk2(v[0], v[1]); w.y = pk2(v[2], v[3]); *(u32x2*)(dst + i * CP + j0) = w; }
            }
        }
    }
    asm volatile("s_waitcnt lgkmcnt(0)\n\ts_barrier" ::: "memory");
    if (stop <= 6) return;
    if (wave < 4) {
        const int mt = wave & 1, nt = wave >> 1;
        f32x16 acc = {};
        acc = mm32(AAK + 32 * mt * CP, Vt + 32 * nt * CP, lane, acc);
#pragma unroll
        for (int g = 0; g < 4; ++g) { u32x2 w; w.x = pk2(acc[4 * g], acc[4 * g + 1]); w.y = pk2(acc[4 * g + 2], acc[4 * g + 3]);
            *(u32x2*)(X1t + (32 * nt + r31) * CP + 32 * mt + 8 * g + 4 * hh) = w; }
    } else if (wave == 4) {
        const int bi = lane >> 4, cc = lane & 15;
        float x[16];
#pragma unroll
        for (int i = 0; i < 16; ++i) {
            const u32x4 a0 = *(const u32x4*)(AAB + (16 * bi + i) * CP + 16 * bi), a1 = *(const u32x4*)(AAB + (16 * bi + i) * CP + 16 * bi + 8);
            const float av_[16] = {lo16(a0.x), hi16(a0.x), lo16(a0.y), hi16(a0.y), lo16(a0.z), hi16(a0.z), lo16(a0.w), hi16(a0.w),
                                   lo16(a1.x), hi16(a1.x), lo16(a1.y), hi16(a1.y), lo16(a1.z), hi16(a1.z), lo16(a1.w), hi16(a1.w)};
            float v_ = (i == cc) ? 1.0f : 0.0f;
#pragma unroll
            for (int j = 0; j < i; ++j) v_ += av_[j] * x[j];
            x[i] = v_;
            TM[(16 * bi + i) * CP + 16 * bi + cc] = (unsigned short)(pk2(v_, 0.f) & 0xffffu);
        }
        u32x4 w0, w1;
        w0.x = pk2(x[0], x[1]); w0.y = pk2(x[2], x[3]); w0.z = pk2(x[4], x[5]); w0.w = pk2(x[6], x[7]);
        w1.x = pk2(x[8], x[9]); w1.y = pk2(x[10], x[11]); w1.z = pk2(x[12], x[13]); w1.w = pk2(x[14], x[15]);
        *(u32x4*)(TMt + (16 * bi + cc) * CP + 16 * bi) = w0; *(u32x4*)(TMt + (16 * bi + cc) * CP + 16 * bi + 8) = w1;
    }
    asm volatile("s_waitcnt lgkmcnt(0)\n\ts_barrier" ::: "memory");
    if (stop <= 7) return;
    f32x16 nacc = {}, oacc = {};
    if (wave >= 4) { const int q = wave & 3;
        nacc = mm32(KHt + 32 * (q & 1) * CP, Vt + 32 * (q >> 1) * CP, lane, nacc);
        oacc = mm32(Vt + 32 * (q & 1) * CP, ARK + 32 * (q >> 1) * CP, lane, oacc); }
    {
        if (wave == 0 || wave == 2) {
            const int bj = wave, bi = wave + 1, l15 = lane & 15, q4 = lane >> 4;
            bf16* Pt = PTs + wave * (16 * 40);
            f32x4 acc = {0.f, 0.f, 0.f, 0.f};
#pragma unroll
            for (int ks = 0; ks < 2; ++ks)
                acc = __builtin_amdgcn_mfma_f32_16x16x32_bf16(*(const bf16x8*)(AAB + (16 * bi + l15) * CP + 32 * ks + 8 * q4), *(const bf16x8*)(TMt + (16 * bj + l15) * CP + 32 * ks + 8 * q4), acc, 0, 0, 0);
            { u32x2 w; w.x = pk2(acc[0], acc[1]); w.y = pk2(acc[2], acc[3]); *(u32x2*)(Pt + l15 * 40 + 4 * q4) = w; }
            asm volatile("s_waitcnt lgkmcnt(0)" ::: "memory");
            bf16x8 a2 = {0, 0, 0, 0, 0, 0, 0, 0};
            if (q4 < 2) a2 = *(const bf16x8*)(TM + (16 * bi + l15) * CP + 16 * bi + 8 * q4);
            const bf16x8 b2 = *(const bf16x8*)(Pt + l15 * 40 + 8 * q4);
            f32x4 xo = {0.f, 0.f, 0.f, 0.f};
            xo = __builtin_amdgcn_mfma_f32_16x16x32_bf16(a2, b2, xo, 0, 0, 0);
#pragma unroll
            for (int e = 0; e < 4; ++e) TM[(16 * bi + 4 * q4 + e) * CP + 16 * bj + l15] = (unsigned short)(pk2(xo[e], 0.f) & 0xffffu);
            { u32x2 w; w.x = pk2(xo[0], xo[1]); w.y = pk2(xo[2], xo[3]); *(u32x2*)(TMt + (16 * bj + l15) * CP + 16 * bi + 4 * q4) = w; }
        }
        asm volatile("s_waitcnt lgkmcnt(0)\n\ts_barrier" ::: "memory");
        if (wave < 2) {
            const int bj = wave, l15 = lane & 15, q4 = lane >> 4;
            bf16* Pt = PTs + wave * (16 * 40);
#pragma unroll
            for (int ib = 2; ib < 4; ++ib) {
                f32x4 acc = {0.f, 0.f, 0.f, 0.f};
                acc = __builtin_amdgcn_mfma_f32_16x16x32_bf16(*(const bf16x8*)(AAB + (16 * ib + l15) * CP + 8 * q4), *(const bf16x8*)(TMt + (16 * bj + l15) * CP + 8 * q4), acc, 0, 0, 0);
                u32x2 w; w.x = pk2(acc[0], acc[1]); w.y = pk2(acc[2], acc[3]); *(u32x2*)(Pt + l15 * 40 + 16 * (ib - 2) + 4 * q4) = w;
            }
            asm volatile("s_waitcnt lgkmcnt(0)" ::: "memory");
            const bf16x8 b2 = *(const bf16x8*)(Pt + l15 * 40 + 8 * q4);
#pragma unroll
            for (int bi = 2; bi < 4; ++bi) {
                const bf16x8 a2 = *(const bf16x8*)(TM + (16 * bi + l15) * CP + 32 + 8 * q4);
                f32x4 xo = {0.f, 0.f, 0.f, 0.f};
                xo = __builtin_amdgcn_mfma_f32_16x16x32_bf16(a2, b2, xo, 0, 0, 0);
#pragma unroll
                for (int e = 0; e < 4; ++e) TM[(16 * bi + 4 * q4 + e) * CP + 16 * bj + l15] = (unsigned short)(pk2(xo[e], 0.f) & 0xffffu);
                u32x2 w; w.x = pk2(xo[0], xo[1]); w.y = pk2(xo[2], xo[3]); *(u32x2*)(TMt + (16 * bj + l15) * CP + 16 * bi + 4 * q4) = w;
            }
        }
        asm volatile("s_waitcnt lgkmcnt(0)\n\ts_barrier" ::: "memory");
    }
    {
        const int it = wave & 1, ct = (wave >> 1) & 1;
        const bf16* Y = (wave < 4) ? AHt : X1t; bf16* dst = (wave < 4) ? WTt : UTt;
        f32x16 acc = {};
        acc = mm32(TM + 32 * it * CP, Y + 32 * ct * CP, lane, acc);
#pragma unroll
        for (int g = 0; g < 4; ++g) { u32x2 w; w.x = pk2(acc[4 * g], acc[4 * g + 1]); w.y = pk2(acc[4 * g + 2], acc[4 * g + 3]);
            *(u32x2*)(dst + (32 * ct + r31) * CP + 32 * it + 8 * g + 4 * hh) = w; }
    }
    asm volatile("s_waitcnt lgkmcnt(0)\n\ts_barrier" ::: "memory");
    if (stop <= 8) return;
    {
        u32x4* MPs = (u32x4*)((unsigned char*)A.out + SC_MP) + (size_t)uidx * 512;
        u32x4* NNs = (u32x4*)((unsigned char*)A.out + SC_NN) + (size_t)uidx * 512;
        u32x4* QHs = (u32x4*)((unsigned char*)A.out + SC_QH) + (size_t)uidx * 512;
        u32x4* OLs = (u32x4*)((unsigned char*)A.out + SC_OL) + (size_t)uidx * 512;
        if (wave < 2) {
            const int it = wave;
#pragma unroll
            for (int kt = 0; kt < 2; ++kt) {
                f32x16 acc = {};
                acc = mm32(WTt + 32 * kt * CP, ARB + 32 * it * CP, lane, acc);
#pragma unroll
                for (int g = 0; g < 4; ++g) { const u32x2 qv = *(const u32x2*)(QT + (32 * it + r31) * CP + 32 * kt + 8 * g + 4 * hh);
                    acc[4 * g] += lo16(qv.x); acc[4 * g + 1] += hi16(qv.x); acc[4 * g + 2] += lo16(qv.y); acc[4 * g + 3] += hi16(qv.y); }
                QHs[(it * 4 + 2 * kt) * 64 + lane] = packfrag(acc, 0); QHs[(it * 4 + 2 * kt + 1) * 64 + lane] = packfrag(acc, 1);
            }
        } else if (wave < 4) {
            const int ktp = wave - 2; const float gc = gCs[32 * ktp + r31];
#pragma unroll
            for (int kt = 0; kt < 2; ++kt) {
                f32x16 acc = {};
                acc = mm32(WTt + 32 * kt * CP, BHt + 32 * ktp * CP, lane, acc);
                acc = acc * gc;
                MPs[((ktp * 2 + kt) * 2) * 64 + lane] = packfrag(acc, 0); MPs[((ktp * 2 + kt) * 2 + 1) * 64 + lane] = packfrag(acc, 1);
            }
        } else {
            const int q = wave & 3;
            { const int kt = q & 1, vt = q >> 1;
              nacc = mm32(BHt + 32 * kt * CP, UTt + 32 * vt * CP, lane, nacc);
#pragma unroll
              for (int g = 0; g < 4; ++g) { const f32x4 gc = *(const f32x4*)(gCs + 32 * kt + 8 * g + 4 * hh);
                  nacc[4 * g] *= gc[0]; nacc[4 * g + 1] *= gc[1]; nacc[4 * g + 2] *= gc[2]; nacc[4 * g + 3] *= gc[3]; }
              NNs[((vt * 2 + kt) * 2) * 64 + lane] = packfrag(nacc, 0); NNs[((vt * 2 + kt) * 2 + 1) * 64 + lane] = packfrag(nacc, 1); }
            { const int vt = q & 1, it = q >> 1;
              oacc = mm32(UTt + 32 * vt * CP, ARB + 32 * it * CP, lane, oacc);
              OLs[((it * 2 + vt) * 2) * 64 + lane] = packfrag(oacc, 0); OLs[((it * 2 + vt) * 2 + 1) * 64 + lane] = packfrag(oacc, 1); }
        }
    }
    asm volatile("s_waitcnt lgkmcnt(0)\n\ts_barrier" ::: "memory");
}
__device__ __forceinline__ void rwkv_r2_unit(const int tid_in, const Args& A, int u) {
    int tid = tid_in; asm volatile("" : "+v"(tid));
    const int lane = tid & 63, wave = __builtin_amdgcn_readfirstlane(tid >> 6), hh = lane >> 5;
    const int head = 4 * u + (wave >> 1), vt = wave & 1;
    const u32x4* MPs = (const u32x4*)((unsigned char*)A.out + SC_MP) + (size_t)head * 64 * 512;
    const u32x4* NNs = (const u32x4*)((unsigned char*)A.out + SC_NN) + (size_t)head * 64 * 512;
    u32x4* HSo = (u32x4*)((unsigned char*)A.out + SC_HS) + (size_t)head * 64 * 512;
    const float* GCs = (const float*)(A.ws + WS_GC) + (size_t)head * 64 * 64;
    f32x16 acc0 = {}, acc1 = {};
    u32x4 mpA[8], nnA[4], mpB[8], nnB[4]; f32x4 gmA[8], gmB[8];
#define R2_LOAD(mp, nn, gm, cc) do { \
        _Pragma("unroll") for (int i = 0; i < 8; ++i) mp[i] = MPs[(size_t)(cc) * 512 + i * 64 + lane]; \
        _Pragma("unroll") for (int i = 0; i < 4; ++i) nn[i] = NNs[(size_t)(cc) * 512 + vt * 256 + i * 64 + lane]; \
        _Pragma("unroll") for (int i = 0; i < 8; ++i) gm[i] = *(const f32x4*)(GCs + (cc) * 64 + 32 * (i >> 2) + 8 * (i & 3) + 4 * hh); } while (0)
#define R2_STEP(mp, nn, gm, c) do { \
        const u32x4 hb0 = packfrag(acc0, 0), hb1 = packfrag(acc0, 1), hb2 = packfrag(acc1, 0), hb3 = packfrag(acc1, 1); \
        _Pragma("unroll") for (int g = 0; g < 4; ++g) { \
            const unsigned* n0 = (const unsigned*)&nn[g >> 1]; const unsigned* n1 = (const unsigned*)&nn[2 + (g >> 1)]; \
            const int o_ = 2 * (g & 1); \
            acc0[4 * g] = acc0[4 * g] * gm[g][0] + lo16(n0[o_]); acc0[4 * g + 1] = acc0[4 * g + 1] * gm[g][1] + hi16(n0[o_]); \
            acc0[4 * g + 2] = acc0[4 * g + 2] * gm[g][2] + lo16(n0[o_ + 1]); acc0[4 * g + 3] = acc0[4 * g + 3] * gm[g][3] + hi16(n0[o_ + 1]); \
            acc1[4 * g] = acc1[4 * g] * gm[4 + g][0] + lo16(n1[o_]); acc1[4 * g + 1] = acc1[4 * g + 1] * gm[4 + g][1] + hi16(n1[o_]); \
            acc1[4 * g + 2] = acc1[4 * g + 2] * gm[4 + g][2] + lo16(n1[o_ + 1]); acc1[4 * g + 3] = acc1[4 * g + 3] * gm[4 + g][3] + hi16(n1[o_ + 1]); \
        } \
          \
        HSo[(size_t)(c) * 512 + vt * 256 + 0 * 64 + lane] = hb0; HSo[(size_t)(c) * 512 + vt * 256 + 1 * 64 + lane] = hb1; \
        HSo[(size_t)(c) * 512 + vt * 256 + 2 * 64 + lane] = hb2; HSo[(size_t)(c) * 512 + vt * 256 + 3 * 64 + lane] = hb3; \
        const bf16x8 b0 = __builtin_bit_cast(bf16x8, hb0), b1 = __builtin_bit_cast(bf16x8, hb1), b2 = __builtin_bit_cast(bf16x8, hb2), b3 = __builtin_bit_cast(bf16x8, hb3); \
        acc0 = __builtin_amdgcn_mfma_f32_32x32x16_bf16(__builtin_bit_cast(bf16x8, mp[0]), b0, acc0, 0, 0, 0); \
        acc1 = __builtin_amdgcn_mfma_f32_32x32x16_bf16(__builtin_bit_cast(bf16x8, mp[4]), b0, acc1, 0, 0, 0); \
        acc0 = __builtin_amdgcn_mfma_f32_32x32x16_bf16(__builtin_bit_cast(bf16x8, mp[1]), b1, acc0, 0, 0, 0); \
        acc1 = __builtin_amdgcn_mfma_f32_32x32x16_bf16(__builtin_bit_cast(bf16x8, mp[5]), b1, acc1, 0, 0, 0); \
        acc0 = __builtin_amdgcn_mfma_f32_32x32x16_bf16(__builtin_bit_cast(bf16x8, mp[2]), b2, acc0, 0, 0, 0); \
        acc1 = __builtin_amdgcn_mfma_f32_32x32x16_bf16(__builtin_bit_cast(bf16x8, mp[6]), b2, acc1, 0, 0, 0); \
        acc0 = __builtin_amdgcn_mfma_f32_32x32x16_bf16(__builtin_bit_cast(bf16x8, mp[3]), b3, acc0, 0, 0, 0); \
        acc1 = __builtin_amdgcn_mfma_f32_32x32x16_bf16(__builtin_bit_cast(bf16x8, mp[7]), b3, acc1, 0, 0, 0); } while (0)
    R2_LOAD(mpA, nnA, gmA, 0);
#pragma unroll 1
    for (int c = 0; c < 64; c += 2) {
        R2_LOAD(mpB, nnB, gmB, c + 1);
        R2_STEP(mpA, nnA, gmA, c);
        if (c + 2 < 64) R2_LOAD(mpA, nnA, gmA, c + 2);
        R2_STEP(mpB, nnB, gmB, c + 1);
    }
#undef R2_LOAD
#undef R2_STEP
}
__device__ __forceinline__ void rwkv_r3_unit(const int tid_in, const Args& A, int layer, int u, unsigned char* lds) {
    int tid = tid_in; asm volatile("" : "+v"(tid));
    const int lane = tid & 63, wave = __builtin_amdgcn_readfirstlane(tid >> 6), r31 = lane & 31, hh = lane >> 5;
    const int uidx = 4 * u + (wave >> 1), it = wave & 1;
    const int head = uidx >> 6, c = uidx & 63, b = head / RH, h = head % RH;
    float* PR = (float*)lds;
    float prv = 0.f;
    if (tid < 192) { const int w_ = tid >> 6, cc = tid & 63;
        prv = (w_ == 0) ? A.in[I_LNG][layer * RW + h * 64 + cc] : (w_ == 1) ? A.in[I_LNB][layer * RW + h * 64 + cc] : A.in[I_MU][layer * RCOLS + PC_V + h * 64 + cc]; }
    const size_t trow = (size_t)b * SEQ + c * 64 + 32 * it + r31;
    const u32x4* HSs = (const u32x4*)((unsigned char*)A.out + SC_HS) + (size_t)uidx * 512;
    const u32x4* QHs = (const u32x4*)((unsigned char*)A.out + SC_QH) + (size_t)uidx * 512;
    const u32x4* OLs = (const u32x4*)((unsigned char*)A.out + SC_OL) + (size_t)uidx * 512;
    const bf16* P = (const bf16*)(A.ws + WS_P); const bf16* Gs = (const bf16*)(A.ws + WS_G); bf16* MIX = (bf16*)(A.ws + WS_MIX);
    const bool hasprev = (c * 64 + 32 * it + r31) > 0;
    u32x4 ol[4], qf4[4], hs[8];
#pragma unroll
    for (int i = 0; i < 4; ++i) { ol[i] = OLs[((it * 2 + (i >> 1)) * 2 + (i & 1)) * 64 + lane]; qf4[i] = QHs[(it * 4 + i) * 64 + lane]; }
#pragma unroll
    for (int i = 0; i < 8; ++i) hs[i] = HSs[(i >> 2) * 256 + (i & 3) * 64 + lane];
    u32x2 cvv[8], pvv[8], gwv[8];
    u32x4 cl[4], pl[4], gl[4];
#pragma unroll
    for (int j = 0; j < 4; ++j) { const int vch = h * 64 + 32 * (j >> 1) + 16 * (j & 1) + 8 * hh;
        cl[j] = *(const u32x4*)(P + trow * INC + PC_V + vch);
        pl[j] = *(const u32x4*)(P + (hasprev ? trow - 1 : trow) * INC + PC_V + vch);
        gl[j] = *(const u32x4*)(Gs + trow * RW + vch); }
    const float rh = ((const float*)(A.ws + WS_RHO))[trow * RH + h];
    __builtin_amdgcn_sched_barrier(0);
    if (tid < 192) PR[tid] = prv;
#define R3_SPLIT() do { _Pragma("unroll") for (int j = 0; j < 4; ++j) { unpair16(cl[j], cvv[2 * j], cvv[2 * j + 1]); unpair16(pl[j], pvv[2 * j], pvv[2 * j + 1]); unpair16(gl[j], gwv[2 * j], gwv[2 * j + 1]); } } while (0)
    f32x16 acc[2];
#pragma unroll
    for (int vt = 0; vt < 2; ++vt) {
        const u32x4 o0 = ol[2 * vt], o1 = ol[2 * vt + 1];
        acc[vt][0] = lo16(o0.x); acc[vt][1] = hi16(o0.x); acc[vt][2] = lo16(o0.y); acc[vt][3] = hi16(o0.y); acc[vt][4] = lo16(o0.z); acc[vt][5] = hi16(o0.z); acc[vt][6] = lo16(o0.w); acc[vt][7] = hi16(o0.w);
        acc[vt][8] = lo16(o1.x); acc[vt][9] = hi16(o1.x); acc[vt][10] = lo16(o1.y); acc[vt][11] = hi16(o1.y); acc[vt][12] = lo16(o1.z); acc[vt][13] = hi16(o1.z); acc[vt][14] = lo16(o1.w); acc[vt][15] = hi16(o1.w);
    }
#pragma unroll
    for (int s_ = 0; s_ < 4; ++s_) {
        const bf16x8 qf = __builtin_bit_cast(bf16x8, qf4[s_]);
#pragma unroll
        for (int vt = 0; vt < 2; ++vt) acc[vt] = __builtin_amdgcn_mfma_f32_32x32x16_bf16(__builtin_bit_cast(bf16x8, hs[vt * 4 + s_]), qf, acc[vt], 0, 0, 0);
    }
    __syncthreads();
    float sm = 0.f;
#pragma unroll
    for (int e = 0; e < 16; ++e) sm += acc[0][e] + acc[1][e];
    sm += __shfl_xor(sm, 32);
    const float mean = sm * (1.0f / 64.0f);
    float q2 = 0.f;
#pragma unroll
    for (int e = 0; e < 16; ++e) { const float d0 = acc[0][e] - mean, d1 = acc[1][e] - mean; q2 += d0 * d0 + d1 * d1; }
    q2 += __shfl_xor(q2, 32);
    const float rstd = rsqrtf(q2 * (1.0f / 64.0f) + GN_EPS);
    R3_SPLIT();
#undef R3_SPLIT
    u32x2 wo[2][4];
#pragma unroll
    for (int vt = 0; vt < 2; ++vt)
#pragma unroll
        for (int g = 0; g < 4; ++g) {
            const int vc0 = 32 * vt + 8 * g + 4 * hh;
            const f32x4 lg = *(const f32x4*)(PR + vc0), lb = *(const f32x4*)(PR + 64 + vc0), muv = *(const f32x4*)(PR + 128 + vc0);
            const u32x2 cv = cvv[vt * 4 + g], gw = gwv[vt * 4 + g]; u32x2 pv = pvv[vt * 4 + g]; if (!hasprev) pv = (u32x2){0u, 0u};
            const f32x4 vc = {lo16(cv.x), hi16(cv.x), lo16(cv.y), hi16(cv.y)}, vp = {lo16(pv.x), hi16(pv.x), lo16(pv.y), hi16(pv.y)};
            const f32x4 vv = vc + muv * (vp - vc), gg = {lo16(gw.x), hi16(gw.x), lo16(gw.y), hi16(gw.y)};
            float y[4];
#pragma unroll
            for (int e = 0; e < 4; ++e) y[e] = ((acc[vt][4 * g + e] - mean) * rstd * lg[e] + lb[e] + rh * vv[e]) * gg[e];
            wo[vt][g].x = pk2(y[0], y[1]); wo[vt][g].y = pk2(y[2], y[3]);
        }
#pragma unroll
    for (int vt = 0; vt < 2; ++vt)
#pragma unroll
        for (int gp = 0; gp < 2; ++gp) *(u32x4*)(MIX + trow * D + MIX_R + h * 64 + 32 * vt + 16 * gp + 8 * hh) = pair16(wo[vt][2 * gp], wo[vt][2 * gp + 1]);
}

constexpr int LT = 16;
__device__ __forceinline__ float gelu_tanh(float x) { const float u = 0.7978845608028654f * (x + 0.044715f * x * x * x); return x * __builtin_amdgcn_rcpf(1.0f + __expf(-2.0f * u)); }
__device__ __forceinline__ float neg_expm1(float x) { return (x > -0.25f) ? -x * (1.0f + x * (0.5f + x * (0.16666667f + x * (0.041666668f + x * (0.0083333338f + x * 0.0013888889f))))) : 1.0f - __expf(x); }
__device__ __forceinline__ void lru_unit(const int tid_in, const Args& A, int layer, int bg, unsigned char* lds) {
    int tid = tid_in; asm volatile("" : "+v"(tid));
    const int lane = tid & 63, wave = __builtin_amdgcn_readfirstlane(tid >> 6);
    const int b = bg / LB, g = bg % LB, c = g * 64 + lane;
    const bf16* P = (const bf16*)(A.ws + WS_P) + (size_t)b * SEQ * INC;
    bf16* MIX = (bf16*)(A.ws + WS_MIX) + (size_t)b * SEQ * D;
    bf16* WAs = (bf16*)lds;
    bf16* WXs = WAs + 64 * 72;
    float* totA = (float*)(WXs + 64 * 72);
    float* totH = totA + 8 * 64;
    float* carryS = totH + 8 * 64;
    bf16* XC = (bf16*)(carryS + 64) + wave * (LT * 72);
    float* PRE = (float*)((bf16*)(carryS + 64) + 8 * LT * 72) + wave * (2 * LT * 68);
    const bf16* LwaT = (const bf16*)(A.ws + WS_WSM) + 98304 + g * 4096; const bf16* LwxT = LwaT + 16384;
    { const int j = tid >> 3, i8 = (tid & 7) * 8;
      *(u32x4*)(WAs + j * 72 + i8) = *(const u32x4*)(LwaT + j * 64 + i8); *(u32x4*)(WXs + j * 72 + i8) = *(const u32x4*)(LwxT + j * 64 + i8); }
    const float cw0 = A.in[I_CW][(layer * 4 + 0) * LW + c], cw1 = A.in[I_CW][(layer * 4 + 1) * LW + c], cw2 = A.in[I_CW][(layer * 4 + 2) * LW + c], cw3 = A.in[I_CW][(layer * 4 + 3) * LW + c];
    const float cb = A.in[I_CB][layer * LW + c], ba = A.in[I_BA][layer * LW + c], bx = A.in[I_BX][layer * LW + c];
    const float sp8 = 8.0f * softplusf_(-A.in[I_LAM][layer * LW + c]);
    const float ng = A.in[I_LRUG][layer * LW + c];
    if (tid < 64) carryS[tid] = 0.f;
    __syncthreads();
    unsigned short nx[LT + 3], ng_[LT];
#define LRU_LOAD(T0_) do { \
        _Pragma("unroll") for (int t = 0; t < LT + 3; ++t) nx[t] = ((T0_) + t - 3 >= 0) ? P[(size_t)((T0_) + t - 3) * INC + PC_LX + c] : (unsigned short)0; \
        _Pragma("unroll") for (int t = 0; t < LT; ++t) ng_[t] = P[(size_t)((T0_) + t) * INC + PC_LG + c]; } while (0)
    LRU_LOAD(wave * LT);
    for (int st = 0; st < SEQ; st += 8 * LT) {
        const int T0 = st + wave * LT;
        float xm3 = bf2f(nx[0]), xm2 = bf2f(nx[1]), xm1 = bf2f(nx[2]);
        float xc[LT], gin[LT];
#pragma unroll
        for (int t = 0; t < LT; ++t) { xc[t] = bf2f(nx[t + 3]); gin[t] = bf2f(ng_[t]); }
        if (st + 8 * LT < SEQ) LRU_LOAD(T0 + 8 * LT);
#pragma unroll
        for (int t = 0; t < LT; ++t) {
            const float x = xc[t];
            xc[t] = cw0 * xm3 + cw1 * xm2 + cw2 * xm1 + cw3 * x + cb;
            xm3 = xm2; xm2 = xm1; xm1 = x;
            XC[t * 72 + lane] = (unsigned short)(pk2(xc[t], 0.f) & 0xffffu);
        }
        asm volatile("s_waitcnt lgkmcnt(0)" ::: "memory");
        {
            const bf16* bl = XC + (lane & 15) * 72 + 8 * (lane >> 4);
            const bf16x8 b0 = *(const bf16x8*)(bl), b1 = *(const bf16x8*)(bl + 32);
#pragma unroll
            for (int gt = 0; gt < 2; ++gt) {
                const bf16* Ws = gt ? WXs : WAs;
#pragma unroll
                for (int jt = 0; jt < 4; ++jt) {
                    const bf16* al = Ws + (16 * jt + (lane & 15)) * 72 + 8 * (lane >> 4);
                    f32x4 acc = {0.f, 0.f, 0.f, 0.f};
                    acc = __builtin_amdgcn_mfma_f32_16x16x32_bf16(*(const bf16x8*)(al), b0, acc, 0, 0, 0);
                    acc = __builtin_amdgcn_mfma_f32_16x16x32_bf16(*(const bf16x8*)(al + 32), b1, acc, 0, 0, 0);
                    *(f32x4*)(PRE + gt * (LT * 68) + (lane & 15) * 68 + 16 * jt + 4 * (lane >> 4)) = acc;
                }
            }
        }
        asm volatile("s_waitcnt lgkmcnt(0)" ::: "memory");
        float hl[LT], Ac[LT];
        float hrun = 0.f, arun = 1.f;
#pragma unroll
        for (int t = 0; t < LT; ++t) {
            const float ga = PRE[t * 68 + lane] + ba, gx = PRE[LT * 68 + t * 68 + lane] + bx;
            const float la = -sp8 * sigmoidf_(ga);
            const float a = __expf(la);
            const float bi = __builtin_amdgcn_sqrtf(neg_expm1(2.0f * la)) * sigmoidf_(gx) * xc[t];
            hrun = a * hrun + bi; arun *= a;
            hl[t] = hrun; Ac[t] = arun;
        }
        totA[wave * 64 + lane] = arun; totH[wave * 64 + lane] = hrun;
        __syncthreads();
        float cin = carryS[lane];
        for (int u = 0; u < wave; ++u) cin = totA[u * 64 + lane] * cin + totH[u * 64 + lane];
        float cout = cin;
        if (wave == 7) cout = totA[7 * 64 + lane] * cin + totH[7 * 64 + lane];
#pragma unroll
        for (int t = 0; t < LT; ++t) {
            const float hv = hl[t] + Ac[t] * cin;
            const float y = gelu_tanh(gin[t]) * hv;
            const float ss = red64(y * y);
            const float o = y * rsqrtf(ss * (1.0f / 64.0f) + RMS_EPS) * ng;
            ((unsigned short*)MIX)[(size_t)(T0 + t) * D + MIX_L + c] = (unsigned short)(pk2(o, 0.f) & 0xffffu);
        }
        __syncthreads();
        if (wave == 7) carryS[lane] = cout;
        __syncthreads();
    }
#undef LRU_LOAD
}

__device__ __forceinline__ void phase_mixers(const int tid, const Args& A, int layer, int sub, unsigned char* lds, volatile LAS unsigned* misc, const int umask = 7, const int qslot = 0, const int r1stop = 99) {
    unsigned* qhead = (unsigned*)(A.ws + WS_CTL) + CW_Q + layer * 64 + sub * 8 + qslot;
    constexpr int R1B = RH;
#ifndef ATT_A
#define ATT_A 0
#endif
#ifndef ATT_B
#define ATT_B 1296
#endif
#ifndef ATT_T
#define ATT_T 96
#endif
    const int a0 = (sub == 0) ? 0 : (sub == 1) ? ATT_A : ATT_B, a1 = (sub == 0) ? ATT_A : (sub == 1) ? ATT_B : 1536 - ATT_T, nA = a1 - a0;
    const int nExtra = (sub == 0) ? ATT_T : 0;
    const int nHead = (sub == 0) ? 64 : (sub == 1) ? 24 : 0;
    const int nTail = (sub == 0) ? 6144 / R1B : (sub == 2) ? 1536 : 0;
    const int NU = nHead + nA + nTail + nExtra;
#ifndef CUMASK
#define CUMASK 7
#endif
    for (;;) {
        __syncthreads();
        if (tid == 0) misc[4] = __hip_atomic_fetch_add(qhead, 1u, __ATOMIC_RELAXED, __HIP_MEMORY_SCOPE_AGENT);
        __syncthreads();
        const int u = (int)misc[4];
        if (u >= NU) break;
        if (u < nHead) {
            if (sub == 0) { if ((CUMASK & 2) && (umask & 2)) lru_unit(tid, A, layer, u, lds); }
            else { if ((CUMASK & 1) && (umask & 1)) rwkv_r2_unit(tid, A, u); }
        } else if (u < nHead + nA) {
            const int a = a0 + (u - nHead); if ((CUMASK & 4) && (umask & 4)) attn_unit(tid, A, layer, a % 96, 15 - a / 96, lds);
        } else if (u >= nHead + nA + nTail) {
            const int a = 1536 - ATT_T + (u - nHead - nA - nTail); if ((CUMASK & 4) && (umask & 4)) attn_unit(tid, A, layer, a % 96, 15 - a / 96, lds);
        } else {
            const int v = u - nHead - nA;
            if (sub == 0) { if ((CUMASK & 1) && (umask & 1)) { R1Pre pf; const int bb = v >> 6, cc_ = v & 63; rwkv_r1_prefetch(tid, A, bb, cc_, pf);
                    R1Rows rw_;
                    for (int hq = 0; hq < RH; ++hq) rwkv_r1_unit(tid, A, layer, (bb * RH + hq) * 64 + cc_, lds, pf, rw_, hq == 0, hq == RH - 1, r1stop); } }
            else { if ((CUMASK & 1) && (umask & 1)) rwkv_r3_unit(tid, A, layer, v, lds); }
        }
    }
}

__device__ __forceinline__ void phase_ln1_router(const int tid, const Args& A, int layer, unsigned char* lds, int vcu, int G) {
    const int lane = tid & 63, wave = tid >> 6;
    float* rwT = (float*)lds;
    float* part = (float*)(lds + 65536) + wave * 1024;
    float* lgS = (float*)(lds + 98304) + wave * 64;
    int* hist = (int*)(lds + 100352);
    int* rowinfo = (int*)(lds + 100352 + 256);
    bf16* X1 = (bf16*)(A.ws + WS_X1); const bf16* XBr = (const bf16*)(A.ws + WS_XB);
    int* list = (int*)(A.ws + WS_LIST); float* gate = (float*)(A.ws + WS_GATE);
    unsigned* gcnt = (unsigned*)(A.ws + WS_CTL) + CW_CNT + layer * 64;
    const float* rw = A.in[I_RW];
    {   f32x4 t[8];
#pragma unroll
        for (int k = 0; k < 8; ++k) t[k] = *(const f32x4*)(rw + 4 * (tid + NTHR * k));
#pragma unroll
        for (int k = 0; k < 8; ++k) { const int i = 4 * (tid + NTHR * k), c = i >> 4, e0 = i & 15;
            float* d = rwT + e0 * 1024 + (c >> 9) * 512 + ((c >> 2) & 1) * 256 + ((c >> 3) & 63) * 4 + (c & 3);
            d[0] = t[k][0]; d[1024] = t[k][1]; d[2048] = t[k][2]; d[3072] = t[k][3]; }
    }
    const float rbv = A.in[I_RB][lane & 15];
    const float* g1 = A.in[I_LN1G] + layer * D; const float* b1 = A.in[I_LN1B] + layer * D;
    f32x4 gg[4], bb[4];
#pragma unroll
    for (int j = 0; j < 4; ++j) { gg[j] = *(const f32x4*)(g1 + 8 * lane + 512 * (j >> 1) + 4 * (j & 1)); bb[j] = *(const f32x4*)(b1 + 8 * lane + 512 * (j >> 1) + 4 * (j & 1)); }
    const int rows_per = M / G;
    for (int chunk = 0; chunk < rows_per / 256; ++chunk) {
        const int base = vcu * rows_per + chunk * 256;
        if (tid < 16) hist[tid] = 0;
        __syncthreads();
        u32x4 xn[4][2], rn[4][2];
#pragma unroll
        for (int q = 0; q < 4; ++q)
#pragma unroll
            for (int jj = 0; jj < 2; ++jj) { xn[q][jj] = __builtin_nontemporal_load((const u32x4*)(X1 + (size_t)(base + wave * 32 + q) * D + 8 * lane + 512 * jj));
                                             rn[q][jj] = __builtin_nontemporal_load((const u32x4*)(XBr + (size_t)(base + wave * 32 + q) * D + 8 * lane + 512 * jj)); }
        for (int pass = 0; pass < 8; ++pass) {
            const int lr0 = wave * 32 + pass * 4;
            f32x4 y[4][4];
#pragma unroll
            for (int q = 0; q < 4; ++q)
#pragma unroll
                for (int jj = 0; jj < 2; ++jj) { const u32x4 a = xn[q][jj], r_ = rn[q][jj];
                    y[q][2 * jj] = (f32x4){lo16(a.x) + ALPHA * lo16(r_.x), hi16(a.x) + ALPHA * hi16(r_.x), lo16(a.y) + ALPHA * lo16(r_.y), hi16(a.y) + ALPHA * hi16(r_.y)};
                    y[q][2 * jj + 1] = (f32x4){lo16(a.z) + ALPHA * lo16(r_.z), hi16(a.z) + ALPHA * hi16(r_.z), lo16(a.w) + ALPHA * lo16(r_.w), hi16(a.w) + ALPHA * hi16(r_.w)}; }
            if (pass + 1 < 8) {
#pragma unroll
                for (int q = 0; q < 4; ++q)
#pragma unroll
                    for (int jj = 0; jj < 2; ++jj) { xn[q][jj] = __builtin_nontemporal_load((const u32x4*)(X1 + (size_t)(base + lr0 + 4 + q) * D + 8 * lane + 512 * jj));
                                                     rn[q][jj] = __builtin_nontemporal_load((const u32x4*)(XBr + (size_t)(base + lr0 + 4 + q) * D + 8 * lane + 512 * jj)); }
            }
#pragma unroll
            for (int q = 0; q < 4; ++q) {
                bf16* xr = X1 + (size_t)(base + lr0 + q) * D;
                float sm = 0.f;
#pragma unroll
                for (int j = 0; j < 4; ++j) sm += (y[q][j][0] + y[q][j][1]) + (y[q][j][2] + y[q][j][3]);
                const float mean = red64(sm) * (1.0f / D); float s2 = 0.f;
#pragma unroll
                for (int j = 0; j < 4; ++j) { y[q][j] = y[q][j] - mean; s2 += (y[q][j][0] * y[q][j][0] + y[q][j][1] * y[q][j][1]) + (y[q][j][2] * y[q][j][2] + y[q][j][3] * y[q][j][3]); }
                const float rstd = rsqrtf(red64(s2) * (1.0f / D) + LN_EPS);
#pragma unroll
                for (int j = 0; j < 4; ++j) y[q][j] = y[q][j] * rstd * gg[j] + bb[j];
#pragma unroll
                for (int jj = 0; jj < 2; ++jj) { u32x4 w; w.x = pk2(y[q][2 * jj][0], y[q][2 * jj][1]); w.y = pk2(y[q][2 * jj][2], y[q][2 * jj][3]);
                    w.z = pk2(y[q][2 * jj + 1][0], y[q][2 * jj + 1][1]); w.w = pk2(y[q][2 * jj + 1][2], y[q][2 * jj + 1][3]); *(u32x4*)(xr + 8 * lane + 512 * jj) = w; }
            }
#pragma unroll
            for (int e = 0; e < 16; ++e) {
                f32x2 p0 = {0.f, 0.f}, p1 = p0, p2 = p0, p3 = p0;
#pragma unroll
                for (int j = 0; j < 4; ++j) { const f32x4 w = *(const f32x4*)(rwT + e * 1024 + 256 * j + 4 * lane);
                    const f32x2 wl = {w[0], w[1]}, wh = {w[2], w[3]};
                    p0 = __builtin_elementwise_fma((f32x2){y[0][j][0], y[0][j][1]}, wl, p0); p0 = __builtin_elementwise_fma((f32x2){y[0][j][2], y[0][j][3]}, wh, p0);
                    p1 = __builtin_elementwise_fma((f32x2){y[1][j][0], y[1][j][1]}, wl, p1); p1 = __builtin_elementwise_fma((f32x2){y[1][j][2], y[1][j][3]}, wh, p1);
                    p2 = __builtin_elementwise_fma((f32x2){y[2][j][0], y[2][j][1]}, wl, p2); p2 = __builtin_elementwise_fma((f32x2){y[2][j][2], y[2][j][3]}, wh, p2);
                    p3 = __builtin_elementwise_fma((f32x2){y[3][j][0], y[3][j][1]}, wl, p3); p3 = __builtin_elementwise_fma((f32x2){y[3][j][2], y[3][j][3]}, wh, p3); }
                float a0 = p0[0] + p0[1], a1 = p1[0] + p1[1], a2 = p2[0] + p2[1], a3 = p3[0] + p3[1];
                a0 += DPP(a0, 0xB1); a0 += DPP(a0, 0x4E); a1 += DPP(a1, 0xB1); a1 += DPP(a1, 0x4E);
                a2 += DPP(a2, 0xB1); a2 += DPP(a2, 0x4E); a3 += DPP(a3, 0xB1); a3 += DPP(a3, 0x4E);
                if ((lane & 3) == 0) { part[(0 * 16 + e) * 16 + (lane >> 2)] = a0; part[(1 * 16 + e) * 16 + (lane >> 2)] = a1;
                                       part[(2 * 16 + e) * 16 + (lane >> 2)] = a2; part[(3 * 16 + e) * 16 + (lane >> 2)] = a3; }
            }
            asm volatile("s_waitcnt lgkmcnt(0)" ::: "memory");
            { const f32x4 p0 = *(const f32x4*)(part + lane * 16), p1 = *(const f32x4*)(part + lane * 16 + 4), p2 = *(const f32x4*)(part + lane * 16 + 8), p3 = *(const f32x4*)(part + lane * 16 + 12);
              const f32x4 ps = (p0 + p1) + (p2 + p3);
              lgS[lane] = (ps[0] + ps[1]) + (ps[2] + ps[3]) + rbv; }
            asm volatile("s_waitcnt lgkmcnt(0)" ::: "memory");
            const int rr = lane >> 4;
            float lg[16];
#pragma unroll
            for (int j = 0; j < 4; ++j) { const f32x4 v = *(const f32x4*)(lgS + rr * 16 + 4 * j); lg[4 * j] = v[0]; lg[4 * j + 1] = v[1]; lg[4 * j + 2] = v[2]; lg[4 * j + 3] = v[3]; }
            asm volatile("s_waitcnt lgkmcnt(0)" ::: "memory");
            {
                float mx = lg[0];
#pragma unroll
                for (int e = 1; e < 16; ++e) mx = fmaxf(mx, lg[e]);
                float sc[16], den = 0.f;
#pragma unroll
                for (int e = 0; e < 16; ++e) { sc[e] = __expf(lg[e] - mx); den += sc[e]; }
                const float inv = __builtin_amdgcn_rcpf(den);
#pragma unroll
                for (int e = 0; e < 16; ++e) sc[e] *= inv;
                int sel = 0; float best = -1.f;
#pragma unroll
                for (int gq = 0; gq < 4; ++gq) {
                    const float a = sc[4 * gq], b_ = sc[4 * gq + 1], c_ = sc[4 * gq + 2], d_ = sc[4 * gq + 3];
                    const float m1 = fmaxf(fmaxf(a, b_), fmaxf(c_, d_));
                    const float m2 = fmaxf(fmaxf(fminf(a, b_), fminf(c_, d_)), fminf(fmaxf(a, b_), fmaxf(c_, d_)));
                    const float gs = m1 + m2;
                    if (gs > best) { best = gs; sel = gq; }
                }
                float cd[4];
#pragma unroll
                for (int i = 0; i < 4; ++i) cd[i] = (sel == 0) ? sc[i] : (sel == 1) ? sc[4 + i] : (sel == 2) ? sc[8 + i] : sc[12 + i];
                int i0 = 0; float v0 = cd[0];
#pragma unroll
                for (int i = 1; i < 4; ++i) if (cd[i] > v0) { v0 = cd[i]; i0 = i; }
                int i1 = -1; float v1 = -1.f;
#pragma unroll
                for (int i = 0; i < 4; ++i) if (i != i0 && cd[i] > v1) { v1 = cd[i]; i1 = i; }
                const int e0 = sel * 4 + i0, e1 = sel * 4 + i1;
                const float gsum = v0 + v1;
                if ((lane & 15) == 0) {
                    const int row = base + lr0 + rr;
                    gate[2 * row] = v0 / gsum; gate[2 * row + 1] = v1 / gsum;
                    const int r0 = atomicAdd(&hist[e0], 1), r1 = atomicAdd(&hist[e1], 1);
                    rowinfo[2 * (lr0 + rr)] = e0 | (r0 << 8); rowinfo[2 * (lr0 + rr) + 1] = e1 | (r1 << 8);
                }
            }
        }
        __syncthreads();
        if (tid < 16) hist[16 + tid] = (int)__hip_atomic_fetch_add(gcnt + tid, (unsigned)hist[tid], __ATOMIC_RELAXED, __HIP_MEMORY_SCOPE_AGENT);
        __syncthreads();
        { const int info = rowinfo[tid]; const int e = info & 255, rk = info >> 8, pos = hist[16 + e] + rk, a = (base + (tid >> 1)) * 2 + (tid & 1);
          list[(size_t)e * LCAP + pos] = a; ((int*)(A.ws + WS_EINFO))[a] = e | (pos << 8); }
        __syncthreads();
    }
}

__device__ __forceinline__ void phase_ln2(const int tid, const Args& A, int layer, int vcu, int G, const LAS int* tab) {
    const int lane = tid & 63, wave = tid >> 6;
    const bf16* X1 = (const bf16*)(A.ws + WS_X1); const bf16* YM = (const bf16*)(A.ws + WS_YM);
    bf16* XB = (bf16*)(A.ws + WS_XB);
    const float* g2 = A.in[I_LN2G] + layer * D; const float* b2 = A.in[I_LN2B] + layer * D;
    f32x4 gg[4], bb[4];
#pragma unroll
    for (int j = 0; j < 4; ++j) { gg[j] = *(const f32x4*)(g2 + 8 * lane + 512 * (j >> 1) + 4 * (j & 1)); bb[j] = *(const f32x4*)(b2 + 8 * lane + 512 * (j >> 1) + 4 * (j & 1)); }
    const int gw = vcu * NWAVES + wave, NGW = G * NWAVES;
    const int* einfo = (const int*)(A.ws + WS_EINFO); const float* gate = (const float*)(A.ws + WS_GATE);
    constexpr int RB = 4;
    int nrow = gw * RB;
    int ei[2 * RB]; float gt[2 * RB];
#pragma unroll
    for (int q = 0; q < 2 * RB; ++q) { ei[q] = (nrow < M) ? einfo[2 * nrow + q] : 0; gt[q] = (nrow < M) ? gate[2 * nrow + q] : 0.f; }
    for (int row0 = nrow; row0 < M; row0 += NGW * RB) {
        size_t yr[2 * RB]; float g_[2 * RB];
#pragma unroll
        for (int q = 0; q < 2 * RB; ++q) { yr[q] = ((size_t)tab[ei[q] & 255] << 8) + (size_t)(ei[q] >> 8); g_[q] = gt[q]; }
        u32x4 xa[RB][2], y0[RB][2], y1[RB][2];
#pragma unroll
        for (int r = 0; r < RB; ++r)
#pragma unroll
            for (int jj = 0; jj < 2; ++jj) {
                xa[r][jj] = *(const u32x4*)(X1 + (size_t)(row0 + r) * D + 8 * lane + 512 * jj);
                y0[r][jj] = __builtin_nontemporal_load((const u32x4*)(YM + yr[2 * r] * D + 8 * lane + 512 * jj));
                y1[r][jj] = __builtin_nontemporal_load((const u32x4*)(YM + yr[2 * r + 1] * D + 8 * lane + 512 * jj));
            }
        { const int nx = row0 + NGW * RB;
#pragma unroll
          for (int q = 0; q < 2 * RB; ++q) { ei[q] = (nx < M) ? einfo[2 * nx + q] : 0; gt[q] = (nx < M) ? gate[2 * nx + q] : 0.f; } }
#pragma unroll
        for (int r = 0; r < RB; ++r) {
            const int row = row0 + r; const float g0 = g_[2 * r], g1 = g_[2 * r + 1];
            f32x4 v[4]; float sm = 0.f;
#pragma unroll
            for (int jj = 0; jj < 2; ++jj) {
                const u32x4 a = xa[r][jj], ya = y0[r][jj], yb = y1[r][jj];
                f32x4& va = v[2 * jj]; f32x4& vb = v[2 * jj + 1];
                va[0] = ALPHA * lo16(a.x) + g0 * lo16(ya.x) + g1 * lo16(yb.x); va[1] = ALPHA * hi16(a.x) + g0 * hi16(ya.x) + g1 * hi16(yb.x);
                va[2] = ALPHA * lo16(a.y) + g0 * lo16(ya.y) + g1 * lo16(yb.y); va[3] = ALPHA * hi16(a.y) + g0 * hi16(ya.y) + g1 * hi16(yb.y);
                vb[0] = ALPHA * lo16(a.z) + g0 * lo16(ya.z) + g1 * lo16(yb.z); vb[1] = ALPHA * hi16(a.z) + g0 * hi16(ya.z) + g1 * hi16(yb.z);
                vb[2] = ALPHA * lo16(a.w) + g0 * lo16(ya.w) + g1 * lo16(yb.w); vb[3] = ALPHA * hi16(a.w) + g0 * hi16(ya.w) + g1 * hi16(yb.w);
                sm += ((va[0] + va[1]) + (va[2] + va[3])) + ((vb[0] + vb[1]) + (vb[2] + vb[3]));
            }
            const float mean = red64(sm) * (1.0f / D); float s2 = 0.f;
#pragma unroll
            for (int j = 0; j < 4; ++j) { v[j] = v[j] - mean; s2 += (v[j][0] * v[j][0] + v[j][1] * v[j][1]) + (v[j][2] * v[j][2] + v[j][3] * v[j][3]); }
            const float rstd = rsqrtf(red64(s2) * (1.0f / D) + LN_EPS);
#pragma unroll
            for (int jj = 0; jj < 2; ++jj) {
                const f32x4 oa = v[2 * jj] * rstd * gg[2 * jj] + bb[2 * jj], ob = v[2 * jj + 1] * rstd * gg[2 * jj + 1] + bb[2 * jj + 1];
                if (layer == DEPTH - 1) { float* op = A.out + (size_t)row * D + 8 * lane + 512 * jj; __builtin_nontemporal_store(oa, (f32x4*)op); __builtin_nontemporal_store(ob, (f32x4*)(op + 4)); }
                else { u32x4 w; w.x = pk2(oa[0], oa[1]); w.y = pk2(oa[2], oa[3]); w.z = pk2(ob[0], ob[1]); w.w = pk2(ob[2], ob[3]); *(u32x4*)(XB + (size_t)row * D + 8 * lane + 512 * jj) = w; }
            }
        }
    }
}

__device__ __forceinline__ void moe_table(const int tid, const Args& A, int layer, LAS int* tab) {
    if (tid < 16) {
        const unsigned* gcnt = (const unsigned*)(A.ws + WS_CTL) + CW_CNT + layer * 64;
        const int c = (int)__hip_atomic_load(gcnt + tid, __ATOMIC_RELAXED, __HIP_MEMORY_SCOPE_AGENT);
        tab[32 + tid] = c; tab[48 + tid] = (c + 255) >> 8;
    }
    __syncthreads();
    if (tid == 0) {
        int acc = 0;
#pragma unroll
        for (int e = 0; e < 16; ++e) { tab[e] = acc; acc += tab[48 + e]; }
        tab[16] = acc;
    }
    __syncthreads();
}

__device__ __forceinline__ void moe_rows(const int tid, const pg8::MoeOrder<true>& S, LAS int* lrows) {
    size_t off[5]; bool ok[5];
#pragma unroll
    for (int k = 0; k < 5; ++k) {
        const int idx = tid + NTHR * k, i = idx >> 8, r = idx & 255; off[k] = 0; ok[k] = false;
        pg8::Unit u;
        if (i < 9 && S.next(i, u)) { const int pos = u.j * pg8::BM + r; if (pos < S.tab[32 + u.e]) { off[k] = (size_t)u.e * LCAP + pos; ok[k] = true; } }
    }
    int v[5];
#pragma unroll
    for (int k = 0; k < 5; ++k) v[k] = S.list[off[k]];
    asm volatile("" : "+v"(v[0]), "+v"(v[1]), "+v"(v[2]), "+v"(v[3]), "+v"(v[4]));
#pragma unroll
    for (int k = 0; k < 5; ++k) { const int idx = tid + NTHR * k; if (idx < 9 * 256) lrows[idx] = ok[k] ? (v[k] >> 1) : 0; }
    __syncthreads();
}

__global__ void __launch_bounds__(NTHR, 2) fwd_kernel(Args args) {
    extern __shared__ __attribute__((aligned(16))) unsigned char lds[];
    LAS unsigned char* ldsl = (LAS unsigned char*)lds;
    volatile LAS unsigned* misc = (volatile LAS unsigned*)(ldsl + MISC_OFF);
    const int wave_s = __builtin_amdgcn_readfirstlane((int)threadIdx.x >> 6);
#define MKTID() ({ unsigned z_ = 0u; asm volatile("" : "+v"(z_)); (int)(wave_s * 64 + (int)__builtin_amdgcn_mbcnt_hi(~0u, __builtin_amdgcn_mbcnt_lo(~0u, z_))); })
    { const int tid = MKTID(); for (int u = tid; u < (LDS_BYTES - MISC_OFF) / 4; u += NTHR) misc[u] = 0u; }
    __syncthreads();
    const int G = gridDim.x, bx = blockIdx.x;
    const int vcu = (G % 8 == 0) ? (bx % 8) * (G / 8) + bx / 8 : bx;
    unsigned* ctl = (unsigned*)(args.ws + WS_CTL);
    XcdBarrier bar; bar.bar = ctl + CW_BAR; bar.x = 0; bar.st = nullptr;
    if (args.use_bar) bar = xcd_barrier_post(MKTID(), ctl + CW_BAR, misc + 8);
    LAS int* tab = (LAS int*)(ldsl + MISC_OFF + 256);
    const int lo = args.ph_lo, hi = args.ph_hi;
#ifndef PHMASK
#define PHMASK 0x3FF
#endif
#define IN(k) (((PHMASK >> (k)) & 1) && lo <= (k) && (k) < hi)
#define SEAM(k) do { if (args.use_bar && (REP_PH || !((k) == NPH - 1 && layer == args.l_hi - 1))) xcd_barrier(MKTID(), bar); } while (0)
#ifndef REP_PH
#define REP_PH 0
#endif
#ifndef REP_UMASK
#define REP_UMASK 7
#endif
    for (int layer = args.l_lo; layer < args.l_hi; ++layer) {
      {
#define RUN(k) if (IN(k)) for (int rep = 0; rep < ((((REP_PH) >> (k)) & 1) ? 2 : 1); ++rep)
        RUN(0) { phase_convert(MKTID(), args, layer, (float*)lds, vcu, G); SEAM(0); }
        RUN(1) {
            pg8::DenseOrder S; S.init(M, INC, D, G, bx, args.ws + WS_WIN);
            pg8::EpiIn E{(bf16*)(args.ws + WS_P)};
            pg8::gemm_phase<pg8::EpiIn, pg8::DenseOrder, true>(MKTID(), ldsl, (const char*)(args.ws + WS_XB), D, S, E);
            SEAM(1);
        }
#ifndef R1STOP
#define R1STOP 99
#endif
        RUN(2) { const bool probe = ((REP_PH >> 2) & 1) && rep == 0; phase_mixers(MKTID(), args, layer, 0, lds, misc, probe ? REP_UMASK : 7, rep * 4, probe ? R1STOP : 99); SEAM(2); }
        RUN(3) { phase_mixers(MKTID(), args, layer, 1, lds, misc, rep ? REP_UMASK : 7, rep * 4); SEAM(3); }
        RUN(4) { phase_mixers(MKTID(), args, layer, 2, lds, misc, rep ? REP_UMASK : 7, rep * 4); SEAM(4); }
        RUN(5) {
            pg8::DenseOrder S; S.init(M, D, D, G, bx, args.ws + WS_WOUT);
            pg8::EpiOut E{(bf16*)(args.ws + WS_X1)};
            pg8::gemm_phase<pg8::EpiOut, pg8::DenseOrder, true>(MKTID(), ldsl, (const char*)(args.ws + WS_MIX), D, S, E);
            SEAM(5);
        }
        RUN(6) { phase_ln1_router(MKTID(), args, layer, lds, vcu, G); SEAM(6); }
        RUN(7) {
            moe_table(MKTID(), args, layer, tab);
            pg8::MoeOrder<true> S{tab, G, vcu, D, 4, (const char*)(args.ws + WS_WGU), (size_t)1024 * D * 2, (const int*)(args.ws + WS_LIST), (const LAS int*)(ldsl + GEMM_LDS)};
            moe_rows(MKTID(), S, (LAS int*)(ldsl + GEMM_LDS));
            pg8::EpiMoe1 E{(bf16*)(args.ws + WS_H)};
            pg8::gemm_phase<pg8::EpiMoe1, pg8::MoeOrder<true>, true>(MKTID(), ldsl, (const char*)(args.ws + WS_X1), D, S, E);
            SEAM(7);
        }
        RUN(8) {
            moe_table(MKTID(), args, layer, tab);
            pg8::MoeOrder<false> S{tab, G, vcu, DE, 4, (const char*)(args.ws + WS_WDN), (size_t)1024 * DE * 2, (const int*)(args.ws + WS_LIST), nullptr};
            pg8::EpiMoe2 E{(bf16*)(args.ws + WS_YM)};
            pg8::gemm_phase<pg8::EpiMoe2, pg8::MoeOrder<false>, true>(MKTID(), ldsl, (const char*)(args.ws + WS_H), DE, S, E);
            SEAM(8);
        }
        RUN(9) { moe_table(MKTID(), args, layer, tab); phase_ln2(MKTID(), args, layer, vcu, G, tab); SEAM(9); }
#undef RUN
      }
    }
#undef IN
#undef SEAM
}

extern "C" void kernel_launch(void* const* d_in, const int* in_sizes, int n_in, void* d_out, int out_size, void* d_ws, size_t ws_size, hipStream_t stream) {
    static int grid = 0;
    if (grid == 0) {
        if (n_in != 32 || out_size != M * D || ws_size < WS_END) { fprintf(stderr, "kernel_launch: unexpected shapes (n_in %d out %d ws %zu)\n", n_in, out_size, ws_size); grid = -1; return; }
        int dev = 0, cus = 0;
        if (hipGetDevice(&dev) != hipSuccess || hipDeviceGetAttribute(&cus, hipDeviceAttributeMultiprocessorCount, dev) != hipSuccess) { grid = -1; return; }
        if (hipFuncSetAttribute((const void*)fwd_kernel, hipFuncAttributeMaxDynamicSharedMemorySize, LDS_BYTES) != hipSuccess) { fprintf(stderr, "kernel_launch: hipFuncSetAttribute failed\n"); grid = -1; return; }
        int per_cu = 0;
        (void)hipOccupancyMaxActiveBlocksPerMultiprocessor(&per_cu, (const void*)fwd_kernel, NTHR, LDS_BYTES);
        (void)hipGetLastError();
        if (per_cu < 1) fprintf(stderr, "kernel_launch: occupancy query reports %d\n", per_cu);
        grid = cus;
    }
    if (grid < 0) return;
    (void)hipMemsetAsync((char*)d_ws + WS_CTL, 0, CTL_BYTES, stream);
    Args a{};
    for (int i = 0; i < 32; ++i) a.in[i] = (const float*)d_in[i];
    a.out = (float*)d_out; a.ws = (unsigned char*)d_ws;
#if MK_ONE_LAUNCH
    a.l_lo = 0; a.l_hi = DEPTH; a.ph_lo = 0; a.ph_hi = NPH; a.use_bar = 1; a.pad = 0;
    hipLaunchKernelGGL(fwd_kernel, dim3(grid), dim3(NTHR), LDS_BYTES, stream, a);
#else
    for (int l = 0; l < DEPTH; ++l)
        for (int p = 0; p < NPH; ++p) {
            a.l_lo = l; a.l_hi = l + 1; a.ph_lo = p; a.ph_hi = p + 1; a.use_bar = 0; a.pad = 0;
            hipLaunchKernelGGL(fwd_kernel, dim3(grid), dim3(NTHR), LDS_BYTES, stream, a);
        }
#endif
}
```
